# Optimizing an MI355X kernel written in HIP

```python
import math
import jax
import jax.numpy as jnp
from jax import lax
import numpy as np

D_MODEL = 1024
BATCH = 8
SEQ = 4096
DEPTH = 1

A_HEADS = 8
A_HEAD_DIM = 64
A_WIDTH = A_HEADS * A_HEAD_DIM
MOBA_BLOCK = 256
MOBA_TOPK = 3
MOBA_Q_CHUNK = 32
REL_BUCKETS = 32
REL_MAX_DIST = 128
B_HEADS = 8
B_HEAD_DIM = 64
B_WIDTH = B_HEADS * B_HEAD_DIM
DECAY_LORA = 64
AAA_LORA = 64
GATE_LORA = 160
GN_EPS = 64e-5
COL_A = 3 * A_WIDTH
COL_B = 3 * B_WIDTH + DECAY_LORA + AAA_LORA + GATE_LORA
COL_G = 2 * D_MODEL
TOTAL_IN = COL_A + COL_B + COL_G
PEER_HEADS = 8
PEER_NKEYS = 128
PEER_EXPERTS = PEER_NKEYS * PEER_NKEYS
PEER_TOPK = 16
PEER_QDIM = 256
PEER_HALF = PEER_QDIM // 2
PEER_CHUNK = 128
RMS_EPS = 1e-6
NEG = -1e30

kernel_name = 'moba_rwkv7_peer_hybrid'


def rmsnorm(x, g):
    xf = x.astype(jnp.float32)
    y = xf * lax.rsqrt(jnp.mean(xf * xf, axis=-1, keepdims=True) + RMS_EPS)
    return (y * g.astype(jnp.float32)).astype(x.dtype)


def rel_bucket(dist):
    n = jnp.maximum(dist, 0)
    max_exact = REL_BUCKETS // 2
    nf = jnp.maximum(n, 1).astype(jnp.float32)
    large = max_exact + (jnp.log(nf / max_exact) / math.log(REL_MAX_DIST / max_exact)
                         * (REL_BUCKETS - max_exact)).astype(jnp.int32)
    large = jnp.minimum(large, REL_BUCKETS - 1)
    return jnp.where(n < max_exact, n, large)


def moba_attention(q, k, v, rel_bias):
    bsz, seq, heads, hd = q.shape
    n_blocks = -(-seq // MOBA_BLOCK)
    seq_pad = n_blocks * MOBA_BLOCK
    padw = ((0, 0), (0, seq_pad - seq), (0, 0), (0, 0))
    qh = jnp.pad(q, padw).transpose(0, 2, 1, 3)
    kh = jnp.pad(k, padw).transpose(0, 2, 1, 3)
    vh = jnp.pad(v, padw).transpose(0, 2, 1, 3)
    kb = kh.reshape(bsz, heads, n_blocks, MOBA_BLOCK, hd)
    vb = vh.reshape(bsz, heads, n_blocks, MOBA_BLOCK, hd)
    kbar = jnp.mean(kb.astype(jnp.float32), axis=3).astype(q.dtype)
    n_sel = min(MOBA_TOPK, n_blocks)
    scale = 1.0 / math.sqrt(hd)
    b_ix = jnp.arange(bsz)[:, None, None, None]
    h_ix = jnp.arange(heads)[None, :, None, None]
    blk_pos = jnp.arange(MOBA_BLOCK)

    def one_chunk(c):
        q0 = c * MOBA_Q_CHUNK
        blk = q0 // MOBA_BLOCK
        qc = lax.dynamic_slice_in_dim(qh, q0, MOBA_Q_CHUNK, axis=2)
        qpos = q0 + jnp.arange(MOBA_Q_CHUNK)
        k_own = lax.dynamic_slice_in_dim(kh, blk * MOBA_BLOCK, MOBA_BLOCK, axis=2)
        v_own = lax.dynamic_slice_in_dim(vh, blk * MOBA_BLOCK, MOBA_BLOCK, axis=2)
        dist_own = qpos[:, None] - (blk * MOBA_BLOCK + blk_pos)[None, :]
        s_own = (jnp.einsum('bhqd,bhkd->bhqk', qc, k_own).astype(jnp.float32) * scale
                 + rel_bias[:, rel_bucket(dist_own)].astype(jnp.float32)[None])
        s_own = jnp.where(dist_own >= 0, s_own, NEG)
        gate = jnp.einsum('bhqd,bhnd->bhqn', qc, kbar).astype(jnp.float32)
        gate = jnp.where(jnp.arange(n_blocks) < blk, gate, -jnp.inf)
        _, sel = lax.top_k(gate, n_sel)
        valid = sel < blk
        k_g = kb[b_ix, h_ix, sel]
        v_g = vb[b_ix, h_ix, sel]
        dist_sel = qpos[:, None, None] - (sel[..., None] * MOBA_BLOCK + blk_pos)
        bias_sel = rel_bias[h_ix[..., None], rel_bucket(dist_sel)].astype(jnp.float32)
        s_sel = jnp.einsum('bhqd,bhqnkd->bhqnk', qc, k_g).astype(jnp.float32) * scale + bias_sel
        s_sel = jnp.where(valid[..., None], s_sel, NEG)
        logits = jnp.concatenate(
            [s_own, s_sel.reshape(bsz, heads, MOBA_Q_CHUNK, n_sel * MOBA_BLOCK)], axis=-1)
        p = jax.nn.softmax(logits, axis=-1).astype(v.dtype)
        p_own = p[..., :MOBA_BLOCK]
        p_sel = p[..., MOBA_BLOCK:].reshape(bsz, heads, MOBA_Q_CHUNK, n_sel, MOBA_BLOCK)
        return (jnp.einsum('bhqk,bhkd->bhqd', p_own, v_own)
                + jnp.einsum('bhqnk,bhqnkd->bhqd', p_sel, v_g))

    out = lax.map(one_chunk, jnp.arange(seq_pad // MOBA_Q_CHUNK))
    out = out.transpose(1, 0, 3, 2, 4).reshape(bsz, seq_pad, heads * hd)
    return out[:, :seq]


def rwkv7_time_mix(pb, w0, w_lora_up, a0, a_lora_up, g_lora_up, k_k, k_a, r_k, lnx_g, lnx_b):
    f32 = jnp.float32
    bsz, seq, _ = pb.shape
    o1 = 3 * B_WIDTH
    r, k, v, xw, xa, xg = jnp.split(
        pb, [B_WIDTH, 2 * B_WIDTH, o1, o1 + DECAY_LORA, o1 + DECAY_LORA + AAA_LORA], axis=-1)
    w = -jax.nn.softplus(-(w0 + jnp.tanh(xw) @ w_lora_up).astype(f32)) - 0.5
    decay = jnp.exp(-jnp.exp(w))
    a = jax.nn.sigmoid((a0 + xa @ a_lora_up).astype(f32))
    g = (jax.nn.sigmoid(xg) @ g_lora_up).astype(f32)

    def heads(t):
        return t.astype(f32).reshape(bsz, seq, B_HEADS, B_HEAD_DIM)

    r, k, v, decay, a = heads(r), heads(k), heads(v), heads(decay), heads(a)
    kk = k * k_k.astype(f32).reshape(B_HEADS, B_HEAD_DIM)
    kk = kk / jnp.maximum(jnp.sqrt(jnp.sum(kk * kk, axis=-1, keepdims=True)), 1e-12)
    k = k * (1.0 + (a - 1.0) * k_a.astype(f32).reshape(B_HEADS, B_HEAD_DIM))

    def step(state, inp):
        r_t, w_t, k_t, v_t, kk_t, a_t = inp
        sk = jnp.einsum('bhij,bhj->bhi', state, kk_t)
        state = (state * w_t[:, :, None, :]
                 - sk[..., None] * (kk_t * a_t)[:, :, None, :]
                 + v_t[..., None] * k_t[:, :, None, :])
        return state, jnp.einsum('bhij,bhj->bhi', state, r_t)

    xs = tuple(jnp.moveaxis(t, 1, 0) for t in (r, decay, k, v, kk, a))
    s0 = jnp.zeros((bsz, B_HEADS, B_HEAD_DIM, B_HEAD_DIM), f32)
    _, o = lax.scan(step, s0, xs)
    o = jnp.moveaxis(o, 0, 1)
    mu = jnp.mean(o, axis=-1, keepdims=True)
    var = jnp.mean(jnp.square(o - mu), axis=-1, keepdims=True)
    o = ((o - mu) * lax.rsqrt(var + GN_EPS)).reshape(bsz, seq, B_WIDTH)
    o = o * lnx_g.astype(f32) + lnx_b.astype(f32)
    bonus = (jnp.sum(r * k * r_k.astype(f32), axis=-1, keepdims=True) * v).reshape(bsz, seq, B_WIDTH)
    return ((o + bonus) * g).astype(pb.dtype)


def hybrid_mixer(xn, w_in, rel_bias, rwkv_mu, w0, w_lora_up, a0, a_lora_up, g_lora_up,
                 k_k, k_a, r_k, lnx_g, lnx_b, w_proj_a, w_proj_b, w_out):
    bsz, seq, _ = xn.shape
    p = xn @ w_in
    pa, pb, pg = jnp.split(p, [COL_A, COL_A + COL_B], axis=-1)
    q, k, v = (t.reshape(bsz, seq, A_HEADS, A_HEAD_DIM) for t in jnp.split(pa, 3, axis=-1))
    o_a = moba_attention(q, k, v, rel_bias)
    pb_prev = jnp.pad(pb, ((0, 0), (1, 0), (0, 0)))[:, :seq]
    pb_mix = pb + rwkv_mu * (pb_prev - pb)
    o_b = rwkv7_time_mix(pb_mix, w0, w_lora_up, a0, a_lora_up, g_lora_up,
                         k_k, k_a, r_k, lnx_g, lnx_b)
    gate_a, gate_b = jnp.split(jax.nn.sigmoid(pg.astype(jnp.float32)), 2, axis=-1)
    y = (gate_a * (o_a @ w_proj_a).astype(jnp.float32)
         + gate_b * (o_b @ w_proj_b).astype(jnp.float32))
    return y.astype(xn.dtype) @ w_out


def peer_ffn(xn, peer_wq, peer_subkeys, peer_u, peer_v):
    f32 = jnp.float32
    bsz, seq, d = xn.shape
    n_tok = bsz * seq
    xt = xn.reshape(n_tok, d)
    q = (xt @ peer_wq).reshape(n_tok, PEER_HEADS, 2, PEER_HALF)
    s = jnp.einsum('thpc,hpnc->thpn', q, peer_subkeys).astype(f32)
    top_s, top_i = lax.top_k(s, PEER_TOPK)
    kk2 = PEER_TOPK * PEER_TOPK
    cand_s = (top_s[:, :, 0, :, None] + top_s[:, :, 1, None, :]).reshape(n_tok, PEER_HEADS, kk2)
    cand_i = (top_i[:, :, 0, :, None] * PEER_NKEYS + top_i[:, :, 1, None, :]).reshape(n_tok, PEER_HEADS, kk2)
    best_s, best_pos = lax.top_k(cand_s, PEER_TOPK)
    idx = jnp.take_along_axis(cand_i, best_pos, axis=-1)
    gates = jax.nn.softmax(best_s, axis=-1)
    n_ch = n_tok // PEER_CHUNK
    xr = xt.reshape(n_ch, PEER_CHUNK, d)
    ir = idx.reshape(n_ch, PEER_CHUNK, PEER_HEADS, PEER_TOPK)
    gr = gates.reshape(n_ch, PEER_CHUNK, PEER_HEADS, PEER_TOPK)

    def one_chunk(args):
        xc, ic, gc = args
        u_g = peer_u[ic]
        h = jax.nn.gelu(jnp.einsum('chkd,cd->chk', u_g, xc).astype(f32), approximate=False) * gc
        v_g = peer_v[ic]
        return jnp.einsum('chk,chkd->cd', h.astype(peer_v.dtype), v_g)

    out = lax.map(one_chunk, (xr, ir, gr))
    return out.reshape(bsz, seq, d).astype(xn.dtype)


def setup_inputs(seed: int = 0) -> dict:
    key = jax.random.key(seed)
    ks = jax.random.split(key, 26)
    f32 = jnp.float32
    L = DEPTH

    def nrm(k, shape, scale):
        return jax.random.normal(k, shape, f32) * scale

    ratio = jnp.arange(B_WIDTH, dtype=f32) / (B_WIDTH - 1)
    return {
        'x': nrm(ks[0], (BATCH, SEQ, D_MODEL), 1.0),
        'norm1_g': 1.0 + nrm(ks[1], (L, D_MODEL), 0.02),
        'w_in': nrm(ks[2], (L, D_MODEL, TOTAL_IN), D_MODEL ** -0.5),
        'rwkv_mu': jax.random.uniform(ks[3], (L, COL_B), f32),
        'w0': (-6.5 + 5.0 * ratio ** 0.85)[None, :] + nrm(ks[4], (L, B_WIDTH), 0.1),
        'w_lora_up': nrm(ks[5], (L, DECAY_LORA, B_WIDTH), 0.1),
        'a0': nrm(ks[6], (L, B_WIDTH), 0.1),
        'a_lora_up': nrm(ks[7], (L, AAA_LORA, B_WIDTH), AAA_LORA ** -0.5),
        'g_lora_up': nrm(ks[8], (L, GATE_LORA, B_WIDTH), GATE_LORA ** -0.5),
        'k_k': 0.85 + nrm(ks[9], (L, B_WIDTH), 0.05),
        'k_a': 1.0 + nrm(ks[10], (L, B_WIDTH), 0.05),
        'r_k': nrm(ks[11], (L, B_HEADS, B_HEAD_DIM), 0.1),
        'lnx_g': 1.0 + nrm(ks[12], (L, B_WIDTH), 0.02),
        'lnx_b': nrm(ks[13], (L, B_WIDTH), 0.02),
        'w_proj_a': nrm(ks[14], (L, A_WIDTH, D_MODEL), A_WIDTH ** -0.5),
        'w_proj_b': nrm(ks[15], (L, B_WIDTH, D_MODEL), B_WIDTH ** -0.5),
        'w_out': nrm(ks[16], (L, D_MODEL, D_MODEL), D_MODEL ** -0.5),
        'norm2_g': 1.0 + nrm(ks[17], (L, D_MODEL), 0.02),
        'peer_wq': nrm(ks[18], (L, D_MODEL, PEER_HEADS * PEER_QDIM), D_MODEL ** -0.5),
        'peer_subkeys': nrm(ks[19], (L, PEER_HEADS, 2, PEER_NKEYS, PEER_HALF), PEER_HALF ** -0.5),
        'peer_u': nrm(ks[20], (L, PEER_EXPERTS, D_MODEL), D_MODEL ** -0.5),
        'peer_v': nrm(ks[21], (L, PEER_EXPERTS, D_MODEL), 0.5),
        'rel_bias': nrm(ks[22], (A_HEADS, REL_BUCKETS), 0.5),
        'normf_g': 1.0 + nrm(ks[23], (D_MODEL,), 0.02),
    }


def reference(x, norm1_g, w_in, rwkv_mu, w0, w_lora_up, a0, a_lora_up, g_lora_up, k_k, k_a,
              r_k, lnx_g, lnx_b, w_proj_a, w_proj_b, w_out, norm2_g, peer_wq, peer_subkeys,
              peer_u, peer_v, rel_bias, normf_g):
    h = x
    for l in range(DEPTH):
        xn = rmsnorm(h, norm1_g[l])
        h = h + hybrid_mixer(xn, w_in[l], rel_bias, rwkv_mu[l], w0[l], w_lora_up[l], a0[l],
                             a_lora_up[l], g_lora_up[l], k_k[l], k_a[l], r_k[l], lnx_g[l],
                             lnx_b[l], w_proj_a[l], w_proj_b[l], w_out[l])
        xn = rmsnorm(h, norm2_g[l])
        h = h + peer_ffn(xn, peer_wq[l], peer_subkeys[l], peer_u[l], peer_v[l])
    return rmsnorm(h, normf_g)
```

```cpp
#include <hip/hip_runtime.h>
#include <hip/hip_cooperative_groups.h>
#include <cstdio>
#include <cstdint>
#include <utility>
namespace cg = cooperative_groups;
namespace pg8 {
#define PG8_LAS __attribute__((address_space(3)))
typedef unsigned short bf16_t;
typedef short bf16x8 __attribute__((ext_vector_type(8)));
typedef float f32x4 __attribute__((ext_vector_type(4)));
typedef unsigned u32x4 __attribute__((ext_vector_type(4)));
constexpr int BM = 256, BK = 64, HALF = 128, HTB = HALF * BK * 2  , STAGE_BYTES = 8 * HTB, NXCD = 8, WGM = 8;

__host__ __device__ __forceinline__ int lds_byte(int r, int c) { const int st = (r >> 4) * 2 + (c >> 5), rr = r & 15, cc = c & 31, ob = rr * 64 + cc * 2; return st * 1024 + (ob ^ (((ob >> 9) & 1) << 5)); }
__host__ __device__ __forceinline__ void stage_rc(int b, int& R, int& C) { const int st = b / 1024, sb = b % 1024, swz = sb ^ (((sb >> 9) & 1) << 5); R = (st >> 1) * 16 + swz / 64; C = (st & 1) * 32 + (swz % 64) / 2; }
__host__ __device__ __forceinline__ int perm32(int rho) { const int n = rho >> 4, i = rho & 15; return 8 * (i >> 2) + 4 * n + (i & 3); }

struct Unit { int pm, pn; };
struct Gemm { const bf16_t* A; const bf16_t* Bt; int M, N, K; };

struct StaticOrder {
    int nM, nN, nwg, G, c;
    __host__ __device__ void init(int M, int N, int G_, int c_) { nM = M / BM; nN = N / BM; nwg = nM * nN; G = G_; c = c_; }
    __host__ __device__ bool next(int i, Unit& u) const {
        const long L = (long)i * G + c; if (L >= nwg) return false;
        int wgid = (int)L; { const int q = nwg / NXCD, r = nwg % NXCD, xcd = wgid % NXCD, off = wgid / NXCD; wgid = (xcd < r ? xcd * (q + 1) : r * (q + 1) + (xcd - r) * q) + off; }
        const int nig = WGM * nN, gid = wgid / nig, fm = gid * WGM, gsz = (nM - fm) < WGM ? (nM - fm) : WGM;
        u.pm = fm + ((wgid % nig) % gsz); u.pn = (wgid % nig) / gsz; return true;
    }
    __device__ __forceinline__ void a_ready(const Unit&) const {}
    __device__ __forceinline__ void done(const Unit&) const {}
};
template <class Epi, class Sched, bool ALIGN_EPI = false, bool SP2 = false>
__device__ __forceinline__ void gemm_phase(PG8_LAS unsigned char* lds, const Gemm g, const Sched& S, const Epi& E) {
    int tid_ = (int)threadIdx.x; asm volatile("" : "+v"(tid_));
    const int tid = tid_, wid = __builtin_amdgcn_readfirstlane(tid >> 6), lane = tid & 63, wr = wid >> 2, wc = wid & 3, fr = lane & 15, fq = lane >> 4;
    const int K = g.K, nt = K / BK;
    unsigned voffA[2], voffB[2];
#pragma unroll
    for (int i = 0; i < 2; ++i) { int R, C; stage_rc(tid * 16 + i * 8192, R, C); const int Rb = Epi::PERM ? ((R & ~31) + perm32(R & 31)) : R;
        voffA[i] = (unsigned)(R * K + C) * 2u; voffB[i] = (unsigned)(Rb * K + C) * 2u; }
    const size_t kstep = (size_t)(BK * 2);
    const size_t hstep = (size_t)HALF * K * 2;
    const size_t tstep = 2 * hstep;
    const unsigned ldsw = (unsigned)wid * 1024u;
    const int aoff = lds_byte(wr * 64 + fr, fq * 8), boff = lds_byte(wc * 32 + fr, fq * 8);
#define PG8_SA(b, h) (((b) * 2 + (h)) * HTB)
#define PG8_SB(b, h) ((4 + (b) * 2 + (h)) * HTB)
#define PG8_STAGE(bufoff, gbase, voff) do { _Pragma("unroll") for (int _i = 0; _i < 2; ++_i) \
        __builtin_amdgcn_global_load_lds((const unsigned*)((const char*)(gbase) + (voff)[_i]), (PG8_LAS unsigned*)(lds + (bufoff) + ldsw + _i * 8192), 16, 0, 0); } while (0)
#define PG8_LDA(dst, b, h) do { _Pragma("unroll") for (int m = 0; m < 4; ++m) _Pragma("unroll") for (int k = 0; k < 2; ++k) dst[m][k] = *(const PG8_LAS bf16x8*)(lds + PG8_SA(b, h) + aoff + m * 2048 + k * 1024); } while (0)
#define PG8_LDB(dst, b, h) do { _Pragma("unroll") for (int n = 0; n < 2; ++n) _Pragma("unroll") for (int k = 0; k < 2; ++k) dst[n][k] = *(const PG8_LAS bf16x8*)(lds + PG8_SB(b, h) + boff + n * 2048 + k * 1024); } while (0)
#define PG8_MMA(ai, bj, At, Bt) do { __builtin_amdgcn_s_setprio(1); _Pragma("unroll") for (int m = 0; m < 4; ++m) _Pragma("unroll") for (int n = 0; n < 2; ++n) _Pragma("unroll") for (int k = 0; k < 2; ++k) \
        acc[ai][bj][m][n] = __builtin_amdgcn_mfma_f32_16x16x32_bf16(Bt[n][k], At[m][k], acc[ai][bj][m][n], 0, 0, 0); __builtin_amdgcn_s_setprio(0); } while (0)
#define PG8_WAIT_V(n) asm volatile("s_waitcnt vmcnt(" #n ")" ::: "memory")
#define PG8_WAIT_L(n) asm volatile("s_waitcnt lgkmcnt(" #n ")" ::: "memory")
#define PG8_BAR __builtin_amdgcn_s_barrier()
#define PG8_SCHED __builtin_amdgcn_sched_barrier(0)
    Unit cur, nxt; int ui = 0;
    if (!S.next(0, cur)) return;
    f32x4 acc[2][2][4][2];
#pragma unroll
    for (int a = 0; a < 2; ++a)
#pragma unroll
        for (int b = 0; b < 2; ++b)
#pragma unroll
            for (int m = 0; m < 4; ++m)
#pragma unroll
                for (int n = 0; n < 2; ++n) acc[a][b][m][n] = (f32x4){0.f, 0.f, 0.f, 0.f};
    bf16x8 At[4][2], B0[2][2], B1[2][2];
    const char* cA = (const char*)g.A + (size_t)cur.pm * tstep; const char* cB = (const char*)g.Bt + (size_t)cur.pn * tstep;
    S.a_ready(cur);
    if constexpr (SP2) {
        PG8_STAGE(PG8_SB(0, 0), cB, voffB); PG8_STAGE(PG8_SB(0, 1), cB + hstep, voffB); PG8_STAGE(PG8_SA(0, 0), cA, voffA); PG8_STAGE(PG8_SA(0, 1), cA + hstep, voffA);
        if (wr == 1) PG8_BAR;
        PG8_WAIT_V(2); PG8_BAR;
        PG8_STAGE(PG8_SB(1, 0), cB + kstep, voffB); PG8_STAGE(PG8_SA(1, 0), cA + kstep, voffA); PG8_STAGE(PG8_SB(1, 1), cB + hstep + kstep, voffB);
        PG8_WAIT_V(6); PG8_BAR;
    } else {
        PG8_STAGE(PG8_SB(0, 0), cB, voffB); PG8_STAGE(PG8_SA(0, 0), cA, voffA); PG8_STAGE(PG8_SB(0, 1), cB + hstep, voffB); PG8_STAGE(PG8_SA(0, 1), cA + hstep, voffA);
        if (wr == 1) PG8_BAR;
        PG8_WAIT_V(4); PG8_BAR;
        PG8_STAGE(PG8_SB(1, 0), cB + kstep, voffB); PG8_STAGE(PG8_SA(1, 0), cA + kstep, voffA); PG8_STAGE(PG8_SB(1, 1), cB + hstep + kstep, voffB);
        PG8_WAIT_V(6); PG8_BAR;
    }
    for (;;) {
        const bool has_next = S.next(ui + 1, nxt);
        const char* nA = has_next ? (const char*)g.A + (size_t)nxt.pm * tstep : cA; const char* nB = has_next ? (const char*)g.Bt + (size_t)nxt.pn * tstep : cB;
        for (int t = 0; t < nt; t += 2) {
            const bool last = (t == nt - 2);
            const char* a1 = cA + (size_t)(t + 1) * kstep;
            const char* a2 = last ? nA : cA + (size_t)(t + 2) * kstep; const char* b2 = last ? nB : cB + (size_t)(t + 2) * kstep;
            const char* a3 = a2 + kstep; const char* b3 = b2 + kstep;
            if (last && has_next) S.a_ready(nxt);
            if constexpr (SP2) {
            PG8_LDB(B0, 0, 0); PG8_LDB(B1, 0, 1); PG8_SCHED; PG8_LDA(At, 0, 0); PG8_STAGE(PG8_SA(1, 1), a1 + hstep, voffA);
            PG8_WAIT_V(8); PG8_WAIT_L(0); PG8_BAR; PG8_MMA(0, 0, At, B0); PG8_MMA(0, 1, At, B1); PG8_BAR; PG8_SCHED;
            PG8_LDA(At, 0, 1); PG8_STAGE(PG8_SB(0, 0), b2, voffB); PG8_STAGE(PG8_SB(0, 1), b2 + hstep, voffB); PG8_STAGE(PG8_SA(0, 0), a2, voffA);
            PG8_WAIT_V(8); PG8_WAIT_L(0); PG8_BAR; PG8_MMA(1, 0, At, B0); PG8_MMA(1, 1, At, B1); PG8_BAR; PG8_SCHED;
            PG8_LDB(B0, 1, 0); PG8_LDB(B1, 1, 1); PG8_SCHED; PG8_LDA(At, 1, 0); PG8_STAGE(PG8_SA(0, 1), a2 + hstep, voffA);
            PG8_WAIT_V(8); PG8_WAIT_L(0); PG8_BAR; PG8_MMA(0, 0, At, B0); PG8_MMA(0, 1, At, B1); PG8_BAR; PG8_SCHED;
            PG8_LDA(At, 1, 1); PG8_STAGE(PG8_SB(1, 0), b3, voffB); PG8_STAGE(PG8_SB(1, 1), b3 + hstep, voffB); PG8_STAGE(PG8_SA(1, 0), a3, voffA);
            PG8_WAIT_V(8); PG8_WAIT_L(0); PG8_BAR; PG8_MMA(1, 0, At, B0); PG8_MMA(1, 1, At, B1); PG8_BAR; PG8_SCHED;
            } else {
            PG8_LDB(B0, 0, 0); PG8_SCHED; PG8_LDA(At, 0, 0); PG8_STAGE(PG8_SA(1, 1), a1 + hstep, voffA);
            PG8_WAIT_L(8); PG8_BAR; PG8_WAIT_L(0); PG8_MMA(0, 0, At, B0); PG8_BAR; PG8_SCHED;
            PG8_LDB(B1, 0, 1); PG8_STAGE(PG8_SB(0, 0), b2, voffB);
            PG8_BAR; PG8_WAIT_L(0); PG8_MMA(0, 1, At, B1); PG8_BAR;
            PG8_LDA(At, 0, 1); PG8_STAGE(PG8_SA(0, 0), a2, voffA);
            PG8_BAR; PG8_WAIT_L(0); PG8_MMA(1, 0, At, B0); PG8_BAR; PG8_SCHED;
            PG8_STAGE(PG8_SB(0, 1), b2 + hstep, voffB);
            PG8_WAIT_V(6); PG8_BAR; PG8_MMA(1, 1, At, B1); PG8_BAR;
            PG8_LDB(B0, 1, 0); PG8_SCHED; PG8_LDA(At, 1, 0); PG8_STAGE(PG8_SA(0, 1), a2 + hstep, voffA);
            PG8_WAIT_L(8); PG8_BAR; PG8_WAIT_L(0); PG8_MMA(0, 0, At, B0); PG8_BAR; PG8_SCHED;
            PG8_LDB(B1, 1, 1); PG8_STAGE(PG8_SB(1, 0), b3, voffB);
            PG8_BAR; PG8_WAIT_L(0); PG8_MMA(0, 1, At, B1); PG8_BAR;
            PG8_LDA(At, 1, 1); PG8_STAGE(PG8_SA(1, 0), a3, voffA);
            PG8_BAR; PG8_WAIT_L(0); PG8_MMA(1, 0, At, B0); PG8_BAR; PG8_SCHED;
            PG8_STAGE(PG8_SB(1, 1), b3 + hstep, voffB);
            PG8_WAIT_V(6); PG8_BAR; PG8_MMA(1, 1, At, B1); PG8_BAR;
            }
        }
        if constexpr (ALIGN_EPI) { if (wr == 0) PG8_BAR; }
        if constexpr (!Epi::AFTER_DRAIN) { E(acc, cur, wr, wc, fr, fq); S.done(cur); }
        if (!has_next) break;
#pragma unroll
        for (int a = 0; a < 2; ++a)
#pragma unroll
            for (int b = 0; b < 2; ++b)
#pragma unroll
                for (int m = 0; m < 4; ++m)
#pragma unroll
                    for (int n = 0; n < 2; ++n) acc[a][b][m][n] = (f32x4){0.f, 0.f, 0.f, 0.f};
        cur = nxt; cA = nA; cB = nB; ++ui;
        if constexpr (ALIGN_EPI) { if (wr == 1) PG8_BAR; }
    }
    PG8_WAIT_V(0);
    if constexpr (!ALIGN_EPI) { if (wr == 0) PG8_BAR; }
    PG8_BAR;
    if constexpr (Epi::AFTER_DRAIN) { E.fused(acc, cur, wr, wc, fr, fq, lds, wid, lane); S.done(cur); }
#undef PG8_SA
#undef PG8_SB
#undef PG8_STAGE
#undef PG8_LDA
#undef PG8_LDB
#undef PG8_MMA
#undef PG8_WAIT_V
#undef PG8_WAIT_L
#undef PG8_BAR
#undef PG8_SCHED
}
}

#define DI __device__ __forceinline__
#ifndef PROBE
#define PROBE 0
#endif
#define LAS __attribute__((address_space(3)))
typedef unsigned short bf16_t;
typedef short bf16x8 __attribute__((ext_vector_type(8)));
typedef short s16x4 __attribute__((ext_vector_type(4)));
typedef float f32x4 __attribute__((ext_vector_type(4)));
typedef float f32x2 __attribute__((ext_vector_type(2)));
typedef float f32x16 __attribute__((ext_vector_type(16)));
typedef unsigned u32x4 __attribute__((ext_vector_type(4)));
typedef unsigned u32x2 __attribute__((ext_vector_type(2)));

constexpr int NB = 8, SEQ = 4096, DM = 1024, NTOK = NB * SEQ, NH = 8, HD = 64;
constexpr int QKVW = 1536, PBW = 1824, N1A = 3584, N1A_REAL = 3360, NGATE = 2048, W1ROWS = 5632;
constexpr int G1B_EARLY = 512;
constexpr int NEXP = 16384;
constexpr float RMS_EPS = 1e-6f, GN_EPS = 64e-5f;
constexpr float LOG2E = 1.4426950408889634f;
constexpr int NTHREADS = 512, NWAVES = 8;
constexpr int LDS_BYTES = 148480;
constexpr int LDS_MISC = 147968;

constexpr size_t MiB = 1u << 20;
constexpr size_t WS_W1T = 1 * MiB;
constexpr size_t WS_WPA = 12 * MiB;
constexpr size_t WS_WPB = 13 * MiB;
constexpr size_t WS_WO = 14 * MiB;
constexpr size_t WS_WQ = 16 * MiB;
constexpr size_t WS_SK = 20 * MiB;
constexpr size_t WS_KBAR = 20 * MiB + 512 * 1024;
constexpr size_t WS_SEL = 21 * MiB;
constexpr size_t WS_LWT = 21 * MiB + 512 * 1024;
constexpr size_t WS_XN = 22 * MiB;
constexpr size_t WS_QKV = 86 * MiB;
constexpr size_t WS_PB = 182 * MiB;
constexpr size_t WS_SCAN = 296 * MiB;
constexpr size_t WS_OA = 182 * MiB;
constexpr size_t WS_OBRAW = 262 * MiB;
constexpr size_t WS_OB = 86 * MiB;
constexpr size_t WS_GATES = 296 * MiB;
constexpr size_t WS_U8 = 488 * MiB;
constexpr size_t WS_V8 = 500 * MiB;
constexpr size_t WS_ROWSQ = 497 * MiB;
constexpr size_t WS_RS = 499 * MiB;
constexpr size_t WS_USC = 256 * 1024;
constexpr size_t WS_VSC = 384 * 1024;
constexpr size_t WS_Y = 118 * MiB;
constexpr size_t WS_QP = 182 * MiB;
constexpr size_t WS_PIDX = 310 * MiB;
constexpr size_t WS_PGATE = 326 * MiB;
constexpr size_t WS_NEED = 512 * MiB;
constexpr size_t DO_VT = 0, DO_RG = 32 * MiB, DO_KF = 64 * MiB;

struct Params {
    const float* x; const float* norm1_g; const float* w_in; const float* rwkv_mu; const float* w0; const float* w_lora_up;
    const float* a0; const float* a_lora_up; const float* g_lora_up; const float* k_k; const float* k_a; const float* r_k;
    const float* lnx_g; const float* lnx_b; const float* w_proj_a; const float* w_proj_b; const float* w_out; const float* norm2_g;
    const float* peer_wq; const float* peer_subkeys; const float* peer_u; const float* peer_v; const float* rel_bias; const float* normf_g;
    float* out; unsigned char* ws;
};

DI float bflo(unsigned u) { return __uint_as_float(u << 16); }
DI float bfhi(unsigned u) { return __uint_as_float(u & 0xffff0000u); }
DI float bf2f(bf16_t h) { return __uint_as_float((unsigned)h << 16); }
DI unsigned pk2(float lo, float hi) {
    typedef __bf16 b2 __attribute__((ext_vector_type(2)));
    f32x2 v = {lo, hi}; b2 b = __builtin_convertvector(v, b2); return __builtin_bit_cast(unsigned, b);
}
DI bf16_t f2bf(float f) { return (bf16_t)(pk2(f, 0.f) & 0xffffu); }
DI u32x4 pack8(f32x4 a, f32x4 b) { u32x4 w; w.x = pk2(a[0], a[1]); w.y = pk2(a[2], a[3]); w.z = pk2(b[0], b[1]); w.w = pk2(b[2], b[3]); return w; }
DI void unpack8(u32x4 w, float (&f)[8]) {
    f[0] = bflo(w.x); f[1] = bfhi(w.x); f[2] = bflo(w.y); f[3] = bfhi(w.y); f[4] = bflo(w.z); f[5] = bfhi(w.z); f[6] = bflo(w.w); f[7] = bfhi(w.w);
}
template <int CTRL> DI float dpp_mov(float x) { return __builtin_bit_cast(float, __builtin_amdgcn_update_dpp(0, __builtin_bit_cast(int, x), CTRL, 0xf, 0xf, false)); }
DI float row16_sum(float x) {
    x += dpp_mov<0x128>(x); x += dpp_mov<0x124>(x); x += dpp_mov<0x122>(x); x += dpp_mov<0x121>(x); return x;
}
DI float wave_sum(float v) {
    v = row16_sum(v);
    const float a = __builtin_bit_cast(float, __builtin_amdgcn_readlane(__builtin_bit_cast(int, v), 0)), b = __builtin_bit_cast(float, __builtin_amdgcn_readlane(__builtin_bit_cast(int, v), 16));
    const float c = __builtin_bit_cast(float, __builtin_amdgcn_readlane(__builtin_bit_cast(int, v), 32)), d = __builtin_bit_cast(float, __builtin_amdgcn_readlane(__builtin_bit_cast(int, v), 48));
    return (a + b) + (c + d);
}
DI float vmul_(float a, float b) { float d; asm("v_mul_f32 %0, %1, %2" : "=v"(d) : "v"(a), "v"(b)); return d; }
DI float vfma_(float a, float b, float c) { float d; asm("v_fma_f32 %0, %1, %2, %3" : "=v"(d) : "v"(a), "v"(b), "v"(c)); return d; }
DI float vfnma_(float a, float b, float c) { float d; asm("v_fma_f32 %0, -%1, %2, %3" : "=v"(d) : "v"(a), "v"(b), "v"(c)); return d; }
DI float sigmoidf_(float x) { return __builtin_amdgcn_rcpf(1.0f + __expf(-x)); }
DI int crow(int r, int hi) { return (r & 3) + 8 * (r >> 2) + 4 * hi; }
#define MFMA32(a, b, c) __builtin_amdgcn_mfma_f32_32x32x16_bf16((a), (b), (c), 0, 0, 0)
#define LDS_WAIT() asm volatile("s_waitcnt lgkmcnt(0)" ::: "memory")

#define XB_TMO      128
#define XB_XCNT(j)  (256  + 64 * (j))
#define XB_XSUB(j)  (1280 + 64 * (j))
#define XB_XGEN(j)  (2304 + 64 * (j))
#define XB_TOP      3328
#define XB_TOPGEN   3392
#define XCD_BAR_WORDS 3456
#define XB_SPIN_CAP (1u << 22)

__device__ __forceinline__ unsigned xb_ld(unsigned* p)              { return __hip_atomic_load(p, __ATOMIC_RELAXED, __HIP_MEMORY_SCOPE_AGENT); }
__device__ __forceinline__ unsigned xb_add(unsigned* p, unsigned v) { return __hip_atomic_fetch_add(p, v, __ATOMIC_RELAXED, __HIP_MEMORY_SCOPE_AGENT); }
__device__ __forceinline__ unsigned xb_xcc_id() { return (unsigned)__builtin_amdgcn_s_getreg((3 << 11) | 20) & 0xFu; }
#define XB_SPIN(cond, bar) do { unsigned _sp = 0; while (cond) { __builtin_amdgcn_s_sleep(1); \
    if ((++_sp & 255u) == 0u) { if (xb_ld(&(bar)[XB_TMO])) break; if (_sp > XB_SPIN_CAP) { atomicAdd(&(bar)[XB_TMO], 1u); break; } } } } while (0)

struct XcdBarrier {
    unsigned* bar; unsigned x;
    volatile LAS unsigned* st;
};

__device__ __forceinline__ XcdBarrier xcd_barrier_post(unsigned* bar, volatile LAS unsigned* st) {
    XcdBarrier b; b.bar = bar; b.x = xb_xcc_id(); b.st = st;
    if (threadIdx.x == 0) (void)xb_add(&bar[XB_XCNT(b.x)], 1u);
    return b;
}
__device__ __forceinline__ void xcd_barrier_complete(unsigned* bar, unsigned x, unsigned& nloc, unsigned& nx) {
    const unsigned G = gridDim.x * gridDim.y * gridDim.z;
    unsigned sum, cnt, mine, sp = 0u;
    for (;;) {
        sum = 0u; cnt = 0u; mine = 0u;
#pragma unroll
        for (unsigned j = 0; j < 16; ++j) { const unsigned c = xb_ld(&bar[XB_XCNT(j)]); sum += c; cnt += (c > 0u) ? 1u : 0u; mine = (j == x) ? c : mine; }
        if (sum == G) break;
        __builtin_amdgcn_s_sleep(1);
        if ((++sp & 255u) == 0u) { if (xb_ld(&bar[XB_TMO])) break; if (sp > XB_SPIN_CAP) { atomicAdd(&bar[XB_TMO], 1u); break; } }
    }
    nloc = mine > 0u ? mine : 1u; nx = cnt > 0u ? cnt : 1u;
}

__device__ __forceinline__ void xcd_barrier(const XcdBarrier& b) {
    asm volatile("s_waitcnt vmcnt(0)" ::: "memory");
    __syncthreads();
    if (threadIdx.x == 0) {
        unsigned* bar = b.bar;
        __builtin_amdgcn_s_waitcnt(0);
        unsigned nloc = b.st[0], nx = b.st[1];
        if (nloc == 0u) { xcd_barrier_complete(bar, b.x, nloc, nx); b.st[0] = nloc; b.st[1] = nx; }
        const unsigned old = xb_add(&bar[XB_XSUB(b.x)], 1u);
        const unsigned gen = old / nloc;
        if (old + 1u == (gen + 1u) * nloc) {
            __builtin_amdgcn_fence(__ATOMIC_RELEASE, "agent");
            asm volatile("s_waitcnt vmcnt(0)" ::: "memory");
            const unsigned og = xb_add(&bar[XB_TOP], 1u);
            const unsigned tg = og / nx;
            if (og + 1u == (tg + 1u) * nx) xb_add(&bar[XB_TOPGEN], 1u);
            else XB_SPIN(xb_ld(&bar[XB_TOPGEN]) == tg, bar);
            __builtin_amdgcn_fence(__ATOMIC_ACQUIRE, "agent");
            xb_add(&bar[XB_XGEN(b.x)], 1u);
            asm volatile("s_waitcnt vmcnt(0)" ::: "memory");
        } else {
            XB_SPIN(xb_ld(&bar[XB_XGEN(b.x)]) == gen, bar);
            __builtin_amdgcn_fence(__ATOMIC_ACQUIRE, "agent");
            asm volatile("s_waitcnt vmcnt(0)" ::: "memory");
        }
    }
    __syncthreads();
}


template <class F> struct EpiF {
    static constexpr bool PERM = true, AFTER_DRAIN = false; F f;
    DI void operator()(const pg8::f32x4 (&acc)[2][2][4][2], const pg8::Unit& u, int wr, int wc, int fr, int fq) const {
        const int row0 = u.pm * 256 + wr * 64 + fr, col0 = u.pn * 256 + wc * 32 + 8 * fq;
        const typename F::Tile tl = f.tile(col0);
#pragma unroll
        for (int ai = 0; ai < 2; ++ai) {
            typename F::Pre pre[4][2];
#pragma unroll
            for (int m = 0; m < 4; ++m)
#pragma unroll
                for (int bj = 0; bj < 2; ++bj) pre[m][bj] = f.load(row0 + ai * 128 + m * 16, col0 + bj * 128);
#pragma unroll
            for (int m = 0; m < 4; ++m) {
                float s = 0.f;
#pragma unroll
                for (int bj = 0; bj < 2; ++bj) s += f.apply(row0 + ai * 128 + m * 16, col0 + bj * 128, acc[ai][bj][m][0], acc[ai][bj][m][1], pre[m][bj], tl, bj);
                f.row_end(row0 + ai * 128 + m * 16, s, fq, u.pn * 4 + wc);
            }
        }
    }
};
template <class F> DI void run_gemm(LAS unsigned char* lds, const bf16_t* A, const bf16_t* Bt, int N, int K, const F& f) {
    pg8::Gemm g{A, Bt, NTOK, N, K}; pg8::StaticOrder S; S.init(NTOK, N, (int)gridDim.x, (int)blockIdx.x); EpiF<F> E{f};
    pg8::gemm_phase<EpiF<F>, pg8::StaticOrder, true, true>(lds, g, S, E);
}
template <class F> DI void run_gemm_on(LAS unsigned char* lds, const bf16_t* A, const bf16_t* Bt, int N, int K, const F& f, int nblocks, int myblock) {
    pg8::Gemm g{A, Bt, NTOK, N, K}; pg8::StaticOrder S; S.init(NTOK, N, nblocks, myblock); EpiF<F> E{f};
    pg8::gemm_phase<EpiF<F>, pg8::StaticOrder, true, true>(lds, g, S, E);
}
struct NoPre {}; struct NoTile {};
#define EPI_PLAIN typedef NoTile Tile; DI Tile tile(int) const { return Tile{}; } DI void row_end(int, float, int, int) const {}
struct F1a { bf16_t* qkv; bf16_t* pb; typedef NoPre Pre;
    DI Pre load(int, int) const { return Pre{}; }
    EPI_PLAIN
    DI float apply(int row, int col, f32x4 v0, f32x4 v1, Pre, Tile, int) const {
        const u32x4 w = pack8(v0, v1);
        if (col < QKVW) *(u32x4*)(qkv + (size_t)row * QKVW + col) = w;
        else if (col < N1A_REAL) *(u32x4*)(pb + (size_t)row * PBW + (col - QKVW)) = w;
        return 0.f;
    } };
constexpr int GL_STRIDE = 768;
DI const bf16_t* gate_ptr(const unsigned char* ws, const float* dout, int row, int gcol) {
    if (gcol < G1B_EARLY) return (const bf16_t*)dout + (size_t)row * G1B_EARLY + gcol;
    if (gcol < G1B_EARLY + GL_STRIDE) return (const bf16_t*)(ws + 214 * MiB) + (size_t)row * GL_STRIDE + (gcol - G1B_EARLY);
    return (const bf16_t*)((const unsigned char*)dout + 64 * MiB) + (size_t)row * GL_STRIDE + (gcol - G1B_EARLY - GL_STRIDE);
}
struct F1b { unsigned char* ws; float* dout; int col0; typedef NoPre Pre;
    DI Pre load(int, int) const { return Pre{}; }
    EPI_PLAIN
    DI float apply(int row, int col, f32x4 v0, f32x4 v1, Pre, Tile, int) const {
        f32x4 a, b;
#pragma unroll
        for (int i = 0; i < 4; ++i) { a[i] = sigmoidf_(v0[i]); b[i] = sigmoidf_(v1[i]); }
        *(u32x4*)const_cast<bf16_t*>(gate_ptr(ws, dout, row, col0 + col)) = pack8(a, b);
        return 0.f;
    } };
struct FPa { const unsigned char* ws; const float* dout; bf16_t* y; struct Pre { u32x4 g; };
    DI Pre load(int row, int col) const { return Pre{*(const u32x4*)gate_ptr(ws, dout, row, col)}; }
    EPI_PLAIN
    DI float apply(int row, int col, f32x4 v0, f32x4 v1, Pre pr, Tile, int) const {
        float g[8]; unpack8(pr.g, g);
        f32x4 a, b;
#pragma unroll
        for (int i = 0; i < 4; ++i) { a[i] = v0[i] * g[i]; b[i] = v1[i] * g[4 + i]; }
#if PROBE == 1
        a = (f32x4){0.f, 0.f, 0.f, 0.f}; b = a;
#endif
        *(u32x4*)(y + (size_t)row * DM + col) = pack8(a, b);
        return 0.f;
    } };
struct FPb { const unsigned char* ws; const float* dout; bf16_t* y; struct Pre { u32x4 g, yv; };
    DI Pre load(int row, int col) const { return Pre{*(const u32x4*)gate_ptr(ws, dout, row, DM + col), *(const u32x4*)(y + (size_t)row * DM + col)}; }
    EPI_PLAIN
    DI float apply(int row, int col, f32x4 v0, f32x4 v1, Pre pr, Tile, int) const {
        float g[8]; unpack8(pr.g, g);
        float yo[8]; unpack8(pr.yv, yo);
        f32x4 a, b;
#pragma unroll
        for (int i = 0; i < 4; ++i) { a[i] = yo[i] + v0[i] * g[i]; b[i] = yo[4 + i] + v1[i] * g[4 + i]; }
#if PROBE == 2
#pragma unroll
        for (int i = 0; i < 4; ++i) { a[i] = yo[i]; b[i] = yo[4 + i]; }
#endif
        *(u32x4*)(y + (size_t)row * DM + col) = pack8(a, b);
        return 0.f;
    } };
struct FOut { const float* x; const float* g2; float* h1; bf16_t* xn; float* rowsq; struct Pre { f32x4 x0, x1; }; struct Tile { f32x4 g[2][2]; };
    DI Tile tile(int col0) const { Tile t;
#pragma unroll
        for (int bj = 0; bj < 2; ++bj) { t.g[bj][0] = *(const f32x4*)(g2 + col0 + bj * 128); t.g[bj][1] = *(const f32x4*)(g2 + col0 + bj * 128 + 4); }
        return t; }
    DI Pre load(int row, int col) const { const size_t o = (size_t)row * DM + col; return Pre{*(const f32x4*)(x + o), *(const f32x4*)(x + o + 4)}; }
    DI float apply(int row, int col, f32x4 v0, f32x4 v1, Pre pr, const Tile& tl, int bj) const {
        const size_t o = (size_t)row * DM + col;
        const f32x4 h0 = pr.x0 + v0, h1v = pr.x1 + v1;
        *(f32x4*)(h1 + o) = h0; *(f32x4*)(h1 + o + 4) = h1v;
        *(u32x4*)(xn + o) = pack8(h0 * tl.g[bj][0], h1v * tl.g[bj][1]);
        return (h0[0] * h0[0] + h0[1] * h0[1] + h0[2] * h0[2] + h0[3] * h0[3]) + (h1v[0] * h1v[0] + h1v[1] * h1v[1] + h1v[2] * h1v[2] + h1v[3] * h1v[3]);
    }
    DI void row_end(int row, float s, int fq, int slot) const {
        s += __shfl_xor(s, 16); s += __shfl_xor(s, 32);
        if (fq == 0) rowsq[(size_t)row * 16 + slot] = s;
    } };
DI float row_rs(const float* rowsq, int row) {
    const f32x4 a = *(const f32x4*)(rowsq + (size_t)row * 16), b = *(const f32x4*)(rowsq + (size_t)row * 16 + 4), c = *(const f32x4*)(rowsq + (size_t)row * 16 + 8), d = *(const f32x4*)(rowsq + (size_t)row * 16 + 12);
    const float s = (((a[0] + a[1]) + (a[2] + a[3])) + ((b[0] + b[1]) + (b[2] + b[3]))) + (((c[0] + c[1]) + (c[2] + c[3])) + ((d[0] + d[1]) + (d[2] + d[3])));
    return rsqrtf(s * (1.f / DM) + RMS_EPS);
}
struct FQ { bf16_t* qp; typedef NoPre Pre;
    DI Pre load(int, int) const { return Pre{}; }
    EPI_PLAIN
    DI float apply(int row, int col, f32x4 v0, f32x4 v1, Pre, Tile, int) const {
        u32x4 w = pack8(v0, v1);
#if PROBE == 3
        w.x &= 0xfff8fff8u; w.y &= 0xfff8fff8u; w.z &= 0xfff8fff8u; w.w &= 0xfff8fff8u;
#endif
        *(u32x4*)(qp + (size_t)row * 2048 + col) = w; return 0.f; } };

DI void p0_transpose_item(const float* W, int K, int N, bf16_t* WT, int k0, int n0, int dst_row0, LAS float* scr, int lane) {
#pragma unroll 8
    for (int i = 0; i < 32; ++i) { const int kk = 2 * i + (lane >> 5); scr[kk * 33 + (lane & 31)] = W[(size_t)(k0 + kk) * N + n0 + (lane & 31)]; }
    LDS_WAIT(); asm volatile("" ::: "memory");
    const int c = lane & 7;
#pragma unroll
    for (int j = 0; j < 4; ++j) { const int n = (lane >> 3) + 8 * j; const LAS float* s = scr + (8 * c) * 33 + n;
        u32x4 o; o.x = pk2(s[0 * 33], s[1 * 33]); o.y = pk2(s[2 * 33], s[3 * 33]); o.z = pk2(s[4 * 33], s[5 * 33]); o.w = pk2(s[6 * 33], s[7 * 33]);
        *(u32x4*)(WT + (size_t)(dst_row0 + n) * K + k0 + 8 * c) = o; }
    LDS_WAIT(); asm volatile("" ::: "memory");
}
template <int NR> DI void rms_rows_to_bf16(const float* x, const float* g, bf16_t* o, int m0, int stride, int lane) {
    f32x4 v[NR][4];
#pragma unroll
    for (int r = 0; r < NR; ++r)
#pragma unroll
        for (int j = 0; j < 4; ++j) v[r][j] = *(const f32x4*)(x + (size_t)(m0 + r * stride) * DM + 4 * lane + 256 * j);
    f32x4 gg[4];
#pragma unroll
    for (int j = 0; j < 4; ++j) gg[j] = *(const f32x4*)(g + 4 * lane + 256 * j);
#pragma unroll
    for (int r = 0; r < NR; ++r) {
        float s = 0.f;
#pragma unroll
        for (int j = 0; j < 4; ++j) s += (v[r][j].x * v[r][j].x + v[r][j].y * v[r][j].y) + (v[r][j].z * v[r][j].z + v[r][j].w * v[r][j].w);
        const float rs = rsqrtf(wave_sum(s) * (1.f / DM) + RMS_EPS);
        bf16_t* orow = o + (size_t)(m0 + r * stride) * DM;
#pragma unroll
        for (int j = 0; j < 4; ++j) { u32x2 w; w.x = pk2(v[r][j].x * rs * gg[j].x, v[r][j].y * rs * gg[j].y); w.y = pk2(v[r][j].z * rs * gg[j].z, v[r][j].w * rs * gg[j].w);
            *(u32x2*)(orow + 4 * lane + 256 * j) = w; }
    }
}
DI void rms_all_rows(const float* x, const float* g, bf16_t* o, int lane, int wid) {
    const int gw = blockIdx.x * NWAVES + wid, NGW = gridDim.x * NWAVES;
    int m = gw;
    for (; m + 3 * NGW < NTOK; m += 4 * NGW) rms_rows_to_bf16<4>(x, g, o, m, NGW, lane);
    for (; m < NTOK; m += NGW) rms_rows_to_bf16<1>(x, g, o, m, NGW, lane);
}
DI void phase_prep(const Params& p, LAS unsigned char* lds, int tid, int lane, int wid) {
    unsigned char* ws = p.ws;
    bf16_t* W1T = (bf16_t*)(ws + WS_W1T);
    LAS float* scr = (LAS float*)(lds + wid * 16384);
    const int gw = blockIdx.x * NWAVES + wid, NGW = gridDim.x * NWAVES;
    constexpr int I_IN = 16 * 169, I_PA = 8 * 32, I_PB = 8 * 32, I_O = 16 * 32, I_Q = 16 * 64;
    constexpr int NITEMS = I_IN + I_PA + I_PB + I_O + I_Q;
    for (int it = gw; it < NITEMS; it += NGW) {
        int r = it;
        if (r < I_IN) { const int kb = r / 169, nb = r % 169, n0 = 32 * nb; const int dst = n0 < N1A_REAL ? n0 : n0 + (N1A - N1A_REAL);
            p0_transpose_item(p.w_in, 1024, 5408, W1T, 64 * kb, n0, dst, scr, lane); continue; } r -= I_IN;
        if (r < I_PA) { const int kb = r / 32, nb = r % 32; p0_transpose_item(p.w_proj_a, 512, 1024, (bf16_t*)(ws + WS_WPA), 64 * kb, 32 * nb, 32 * nb, scr, lane); continue; } r -= I_PA;
        if (r < I_PB) { const int kb = r / 32, nb = r % 32; p0_transpose_item(p.w_proj_b, 512, 1024, (bf16_t*)(ws + WS_WPB), 64 * kb, 32 * nb, 32 * nb, scr, lane); continue; } r -= I_PB;
        if (r < I_O) { const int kb = r / 32, nb = r % 32; p0_transpose_item(p.w_out, 1024, 1024, (bf16_t*)(ws + WS_WO), 64 * kb, 32 * nb, 32 * nb, scr, lane); continue; } r -= I_O;
        { const int kb = r / 64, nb = r % 64; p0_transpose_item(p.peer_wq, 1024, 2048, (bf16_t*)(ws + WS_WQ), 64 * kb, 32 * nb, 32 * nb, scr, lane); }
    }
    const int gt = blockIdx.x * NTHREADS + tid, NGT = gridDim.x * NTHREADS;
    { u32x4* z = (u32x4*)(W1T + (size_t)N1A_REAL * 1024); const u32x4 zero = {0u, 0u, 0u, 0u};
      for (int i = gt; i < (N1A - N1A_REAL) * 1024 / 8; i += NGT) z[i] = zero; }
    { bf16_t* SK = (bf16_t*)(ws + WS_SK);
      for (int i = gt; i < 16 * 128 * 128 / 8; i += NGT) { const f32x4 a = *(const f32x4*)(p.peer_subkeys + (size_t)i * 8), b = *(const f32x4*)(p.peer_subkeys + (size_t)i * 8 + 4);
          *(u32x4*)(SK + (size_t)i * 8) = pack8(a, b); } }
    { bf16_t* LWT = (bf16_t*)(ws + WS_LWT);
      for (int e = gt; e < 512 * 288; e += NGT) { const int c = e / 288, i = e - c * 288;
          const float v = i < 64 ? p.w_lora_up[i * 512 + c] : (i < 128 ? p.a_lora_up[(i - 64) * 512 + c] : p.g_lora_up[(i - 128) * 512 + c]);
          LWT[e] = f2bf(v); } }
    rms_all_rows(p.x, p.norm1_g, (bf16_t*)(ws + WS_XN), lane, wid);
}

DI void phase_kbar_vt(const Params& p, LAS unsigned char* lds, int tid, int lane, int wid) {
    unsigned char* ws = p.ws;
    const bf16_t* QKV = (const bf16_t*)(ws + WS_QKV);
    float* KBAR = (float*)(ws + WS_KBAR);
    const int gw = blockIdx.x * NWAVES + wid, NGW = gridDim.x * NWAVES;
    for (int it = gw; it < NB * NH * 16; it += NGW) {
        const int blk = it & 15, h = (it >> 4) & 7, b = it >> 7;
        const int dp = lane & 31, tp = lane >> 5;
        const bf16_t* base = QKV + ((size_t)(b * SEQ + blk * 256)) * QKVW + 512 + h * 64 + 2 * dp;
        float a0 = 0.f, a1 = 0.f;
#pragma unroll 16
        for (int t = tp; t < 256; t += 2) { const unsigned u = *(const unsigned*)(base + (size_t)t * QKVW); a0 += bflo(u); a1 += bfhi(u); }
        a0 += __shfl_xor(a0, 32); a1 += __shfl_xor(a1, 32);
        if (tp == 0) { KBAR[(size_t)it * 64 + 2 * dp] = a0 * (1.f / 256.f); KBAR[(size_t)it * 64 + 2 * dp + 1] = a1 * (1.f / 256.f); }
    }
    LAS bf16_t* tile = (LAS bf16_t*)(lds + wid * 16384);
    unsigned char* KF = (unsigned char*)p.out + DO_KF; unsigned char* VF = (unsigned char*)p.out + DO_VT;
    const int r32 = lane & 31, hi = lane >> 5;
    for (int it = gw; it < NB * NH * 64; it += NGW) {
        const int st = it & 63, bh = it >> 6, b = bh >> 3, h = bh & 7;
        const bf16_t* krow = QKV + ((size_t)(b * SEQ + st * 64 + r32)) * QKVW + 512 + h * 64 + 8 * hi;
        unsigned char* kdst = KF + ((size_t)it * 8) * 1024 + lane * 16;
#pragma unroll
        for (int f = 0; f < 8; ++f) *(u32x4*)(kdst + f * 1024) = *(const u32x4*)(krow + (size_t)(32 * (f & 1)) * QKVW + 16 * (f >> 1));
        const bf16_t* src = QKV + ((size_t)(b * SEQ + st * 64 + lane)) * QKVW + 1024 + h * 64;
#pragma unroll
        for (int c = 0; c < 8; ++c) *(LAS u32x4*)(tile + lane * 72 + c * 8) = *(const u32x4*)(src + c * 8);
        LDS_WAIT(); asm volatile("" ::: "memory");
        unsigned char* vdst = VF + ((size_t)it * 8) * 1024 + lane * 16;
#pragma unroll
        for (int f = 0; f < 8; ++f) {
            const int dt = f >> 2, sx = f & 3, d = 32 * dt + r32, k0 = 16 * sx + 4 * hi;
            u32x4 w;
            w.x = (unsigned)tile[(k0 + 0) * 72 + d] | ((unsigned)tile[(k0 + 1) * 72 + d] << 16);
            w.y = (unsigned)tile[(k0 + 2) * 72 + d] | ((unsigned)tile[(k0 + 3) * 72 + d] << 16);
            w.z = (unsigned)tile[(k0 + 8) * 72 + d] | ((unsigned)tile[(k0 + 9) * 72 + d] << 16);
            w.w = (unsigned)tile[(k0 + 10) * 72 + d] | ((unsigned)tile[(k0 + 11) * 72 + d] << 16);
            *(u32x4*)(vdst + f * 1024) = w;
        }
        LDS_WAIT(); asm volatile("" ::: "memory");
    }
}

DI float softplusf_(float x) { return fmaxf(x, 0.f) + log1pf(__expf(-fabsf(x))); }
DI void phase_rwkv_prep(const Params& p, LAS unsigned char* lds, int tid, int lane, int wid) {
    unsigned char* ws = p.ws;
    const bf16_t* PB = (const bf16_t*)(ws + WS_PB);
    bf16_t* SCAN = (bf16_t*)(ws + WS_SCAN);
    bf16_t* RG = (bf16_t*)((unsigned char*)p.out + DO_RG);
    LAS float* xs = (LAS float*)lds;
    const int c = tid, h = wid, j = lane;
    const float mu_r = p.rwkv_mu[c], mu_k = p.rwkv_mu[512 + c], mu_v = p.rwkv_mu[1024 + c];
    const float w0c = p.w0[c], a0c = p.a0[c], kkc = p.k_k[c], kac = p.k_a[c];
    for (int tt = blockIdx.x; tt < NTOK / 32; tt += gridDim.x) {
        const int t0 = tt * 32;
        __syncthreads();
        for (int e = tid; e < 32 * 288; e += NTHREADS) {
            const int t = e / 288, i = e - t * 288, tok = t0 + t, col = 1536 + i;
            const float cur = bf2f(PB[(size_t)tok * PBW + col]);
            const float prv = (tok & (SEQ - 1)) ? bf2f(PB[(size_t)(tok - 1) * PBW + col]) : 0.f;
            float v = cur + p.rwkv_mu[col] * (prv - cur);
            if (i < 64) v = tanhf(v); else if (i >= 128) v = sigmoidf_(v);
            xs[i * 36 + t] = v;
        }
        __syncthreads();
        float wl[32], al[32], gl[32];
#pragma unroll
        for (int t = 0; t < 32; ++t) { wl[t] = 0.f; al[t] = 0.f; gl[t] = 0.f; }
        for (int i = 0; i < 64; ++i) {
            const float ww = p.w_lora_up[i * 512 + c], wa = p.a_lora_up[i * 512 + c];
#pragma unroll
            for (int t4 = 0; t4 < 8; ++t4) { const f32x4 xw = *(const LAS f32x4*)(xs + i * 36 + 4 * t4), xa = *(const LAS f32x4*)(xs + (64 + i) * 36 + 4 * t4);
#pragma unroll
                for (int q = 0; q < 4; ++q) { wl[4 * t4 + q] += ww * xw[q]; al[4 * t4 + q] += wa * xa[q]; } }
        }
        for (int i = 0; i < 160; ++i) {
            const float wg = p.g_lora_up[i * 512 + c];
#pragma unroll
            for (int t4 = 0; t4 < 8; ++t4) { const f32x4 xg = *(const LAS f32x4*)(xs + (128 + i) * 36 + 4 * t4);
#pragma unroll
                for (int q = 0; q < 4; ++q) gl[4 * t4 + q] += wg * xg[q]; }
        }
#pragma unroll
        for (int t = 0; t < 32; ++t) {
            const int tok = t0 + t, b = tok >> 12, s = tok & (SEQ - 1);
            const bf16_t* row = PB + (size_t)tok * PBW;
            float r = bf2f(row[c]), k = bf2f(row[512 + c]), v = bf2f(row[1024 + c]);
            float rp = 0.f, kp = 0.f, vp = 0.f;
            if (s) { const bf16_t* prow = row - PBW; rp = bf2f(prow[c]); kp = bf2f(prow[512 + c]); vp = bf2f(prow[1024 + c]); }
            r += mu_r * (rp - r); k += mu_k * (kp - k); v += mu_v * (vp - v);
            const float wv = w0c + wl[t];
            const float w = -softplusf_(-wv) - 0.5f;
            const float ew = __expf(w);
            const float omd = -expm1f(-ew);
            const float a = sigmoidf_(a0c + al[t]);
            const float kkv = k * kkc;
            const float nrm = sqrtf(wave_sum(kkv * kkv));
            const float kkn = kkv / fmaxf(nrm, 1e-12f);
            const float kmod = k * (1.f + (a - 1.f) * kac);
            const float bb = kkn * a;
            bf16_t* so = SCAN + ((size_t)((b * NH + h) * SEQ + s)) * 384 + j;
            so[0] = f2bf(omd); so[64] = f2bf(kkn); so[128] = f2bf(bb); so[192] = f2bf(kmod); so[256] = f2bf(r); so[320] = f2bf(v);
            RG[(size_t)tok * 512 + c] = f2bf(gl[t]);
        }
    }
}


DI float fast_tanh(float x) { const float e = __expf(2.f * x); return 1.f - 2.f / (e + 1.f); }
constexpr int RP_ACT = 0, RP_CONST = 19456, RP_TILE = 33792, RP_PITCH = 3080;
template <bool STORE> DI void phase_rwkv_prep2(const Params& p, LAS unsigned char* lds, int tid, int lane, int wid) {
    unsigned char* ws = p.ws;
    const bf16_t* PB = (const bf16_t*)(ws + WS_PB);
    const bf16_t* LWT = (const bf16_t*)(ws + WS_LWT);
    bf16_t* SCAN = (bf16_t*)(ws + WS_SCAN);
    bf16_t* RG = (bf16_t*)((unsigned char*)p.out + DO_RG);
    LAS bf16_t* act = (LAS bf16_t*)(lds + RP_ACT);
    LAS float* cst = (LAS float*)(lds + RP_CONST);
    LAS unsigned char* tile = lds + RP_TILE;
    const int r32 = lane & 31, hi = lane >> 5, h = wid;
    __syncthreads();
    cst[tid] = p.rwkv_mu[tid]; cst[512 + tid] = p.rwkv_mu[512 + tid]; cst[1024 + tid] = p.rwkv_mu[1024 + tid];
    cst[1536 + tid] = p.w0[tid]; cst[2048 + tid] = p.a0[tid]; cst[2560 + tid] = p.k_k[tid]; cst[3072 + tid] = p.k_a[tid];
    for (int tt = blockIdx.x; tt < NTOK / 32; tt += gridDim.x) {
        const int t0 = tt * 32;
        const bool first = (t0 & (SEQ - 1)) == 0;
        __syncthreads();
        u32x4 tw[13];
#pragma unroll
        for (int k = 0; k < 13; ++k) { const int e = tid + NTHREADS * k, row = e / 192, pc = e - row * 192;
            tw[k] = (u32x4){0u, 0u, 0u, 0u};
            if (e < 33 * 192 && !(first && row == 0)) tw[k] = *(const u32x4*)(PB + (size_t)(t0 - 1 + row) * PBW + pc * 8); }
#pragma unroll 3
        for (int e = tid; e < 32 * 144; e += NTHREADS) {
            const int t = e / 144, ip = e - t * 144, i = 2 * ip, tok = t0 + t, col = 1536 + i;
            const unsigned cu = *(const unsigned*)(PB + (size_t)tok * PBW + col);
            const unsigned pu = (tok & (SEQ - 1)) ? *(const unsigned*)(PB + (size_t)(tok - 1) * PBW + col) : 0u;
            const f32x2 mu = *(const f32x2*)(p.rwkv_mu + col);
            float v0 = bflo(cu), v1 = bfhi(cu);
            v0 += mu.x * (bflo(pu) - v0); v1 += mu.y * (bfhi(pu) - v1);
            if (i < 64) { v0 = fast_tanh(v0); v1 = fast_tanh(v1); } else if (i >= 128) { v0 = sigmoidf_(v0); v1 = sigmoidf_(v1); }
            *(LAS unsigned*)(act + t * 296 + i) = pk2(v0, v1);
        }
#pragma unroll
        for (int k = 0; k < 13; ++k) { const int e = tid + NTHREADS * k, row = e / 192, pc = e - row * 192;
            if (e < 33 * 192) { LAS unsigned char* d = tile + row * RP_PITCH + pc * 16;
                *(LAS u32x2*)d = (u32x2){tw[k].x, tw[k].y}; *(LAS u32x2*)(d + 8) = (u32x2){tw[k].z, tw[k].w}; } }
        __syncthreads();
        f32x16 Xw[2], Xa[2], Xg[2];
        const int prow_ch = 16 * ((r32 >> 2) & 1) + 4 * (r32 >> 3) + (r32 & 3);
#pragma unroll
        for (int ct = 0; ct < 2; ++ct) {
#pragma unroll
            for (int i = 0; i < 16; ++i) { Xw[ct][i] = 0.f; Xa[ct][i] = 0.f; Xg[ct][i] = 0.f; }
            const bf16_t* wrow = LWT + (size_t)(h * 64 + 32 * ct + prow_ch) * 288 + 8 * hi;
            const LAS bf16_t* arow = act + r32 * 296 + 8 * hi;
#pragma unroll
            for (int ks = 0; ks < 18; ++ks) {
                const bf16x8 a = *(const bf16x8*)(wrow + 16 * ks);
                const bf16x8 b = *(const LAS bf16x8*)(arow + 16 * ks);
                if (ks < 4) Xw[ct] = MFMA32(a, b, Xw[ct]); else if (ks < 8) Xa[ct] = MFMA32(a, b, Xa[ct]); else Xg[ct] = MFMA32(a, b, Xg[ct]);
            }
        }
        const int tok = t0 + r32, bb_ = tok >> 12, s = tok & (SEQ - 1);
        if (STORE) {
#pragma unroll
            for (int ct = 0; ct < 2; ++ct) { bf16_t* rgp = RG + (size_t)tok * 512 + h * 64 + 32 * ct + 16 * hi;
                *(u32x4*)rgp = (u32x4){pk2(Xg[ct][0], Xg[ct][1]), pk2(Xg[ct][2], Xg[ct][3]), pk2(Xg[ct][4], Xg[ct][5]), pk2(Xg[ct][6], Xg[ct][7])};
                *(u32x4*)(rgp + 8) = (u32x4){pk2(Xg[ct][8], Xg[ct][9]), pk2(Xg[ct][10], Xg[ct][11]), pk2(Xg[ct][12], Xg[ct][13]), pk2(Xg[ct][14], Xg[ct][15])}; }
        }
        const LAS unsigned char* prow = tile + r32 * RP_PITCH;
        bf16_t* so = SCAN + ((size_t)((bb_ * NH + h) * SEQ + s)) * 384;
        unsigned kka[32]; float ss = 0.f;
#pragma unroll
        for (int ct = 0; ct < 2; ++ct) {
            const int j0 = 32 * ct + 16 * hi, c0 = h * 64 + j0;
#pragma unroll
            for (int gp = 0; gp < 2; ++gp) {
            unsigned om[4], km[4], rr[4], vv[4];
#pragma unroll
            for (int gq = 0; gq < 2; ++gq) {
                const int g = 2 * gp + gq;
                const int cg = c0 + 4 * g;
                const u32x2 rp = *(const LAS u32x2*)(prow + cg * 2), kp = *(const LAS u32x2*)(prow + 1024 + cg * 2), vp = *(const LAS u32x2*)(prow + 2048 + cg * 2);
                const u32x2 rc = *(const LAS u32x2*)(prow + RP_PITCH + cg * 2), kc = *(const LAS u32x2*)(prow + RP_PITCH + 1024 + cg * 2), vc = *(const LAS u32x2*)(prow + RP_PITCH + 2048 + cg * 2);
                const f32x4 mur = *(const LAS f32x4*)(cst + cg), muk = *(const LAS f32x4*)(cst + 512 + cg), muv = *(const LAS f32x4*)(cst + 1024 + cg);
                const f32x4 w0v = *(const LAS f32x4*)(cst + 1536 + cg), a0v = *(const LAS f32x4*)(cst + 2048 + cg), kkc = *(const LAS f32x4*)(cst + 2560 + cg), kac = *(const LAS f32x4*)(cst + 3072 + cg);
                const float rcf[4] = {bflo(rc.x), bfhi(rc.x), bflo(rc.y), bfhi(rc.y)}, rpf[4] = {bflo(rp.x), bfhi(rp.x), bflo(rp.y), bfhi(rp.y)};
                const float kcf[4] = {bflo(kc.x), bfhi(kc.x), bflo(kc.y), bfhi(kc.y)}, kpf[4] = {bflo(kp.x), bfhi(kp.x), bflo(kp.y), bfhi(kp.y)};
                const float vcf[4] = {bflo(vc.x), bfhi(vc.x), bflo(vc.y), bfhi(vc.y)}, vpf[4] = {bflo(vp.x), bfhi(vp.x), bflo(vp.y), bfhi(vp.y)};
                float r4[4], k4[4], v4[4], o4[4], m4[4];
#pragma unroll
                for (int q = 0; q < 4; ++q) {
                    const int ri = 4 * g + q;
                    r4[q] = rcf[q] + mur[q] * (rpf[q] - rcf[q]);
                    k4[q] = kcf[q] + muk[q] * (kpf[q] - kcf[q]);
                    v4[q] = vcf[q] + muv[q] * (vpf[q] - vcf[q]);
                    const float wv = w0v[q] + Xw[ct][ri];
                    const float z = -wv;
                    const float sp = fmaxf(z, 0.f) + __logf(1.f + __expf(-fabsf(z)));
                    const float ew = __expf(-sp - 0.5f);
                    o4[q] = 1.f - __expf(-ew);
                    const float a = __builtin_amdgcn_rcpf(1.f + __expf(-(a0v[q] + Xa[ct][ri])));
                    m4[q] = k4[q] * (1.f + (a - 1.f) * kac[q]);
                    const float kv = k4[q] * kkc[q];
                    kka[16 * ct + ri] = pk2(kv, a); ss += kv * kv;
                }
                om[2 * gq] = pk2(o4[0], o4[1]); om[2 * gq + 1] = pk2(o4[2], o4[3]);
                km[2 * gq] = pk2(m4[0], m4[1]); km[2 * gq + 1] = pk2(m4[2], m4[3]);
                rr[2 * gq] = pk2(r4[0], r4[1]); rr[2 * gq + 1] = pk2(r4[2], r4[3]);
                vv[2 * gq] = pk2(v4[0], v4[1]); vv[2 * gq + 1] = pk2(v4[2], v4[3]);
            }
            if (STORE) {
                const int j8 = j0 + 8 * gp;
                *(u32x4*)(so + 0 * 64 + j8) = (u32x4){om[0], om[1], om[2], om[3]};
                *(u32x4*)(so + 3 * 64 + j8) = (u32x4){km[0], km[1], km[2], km[3]};
                *(u32x4*)(so + 4 * 64 + j8) = (u32x4){rr[0], rr[1], rr[2], rr[3]};
                *(u32x4*)(so + 5 * 64 + j8) = (u32x4){vv[0], vv[1], vv[2], vv[3]};
            }
            }
        }
        ss += __shfl_xor(ss, 32);
        const float inv = 1.f / fmaxf(sqrtf(ss), 1e-12f);
#pragma unroll
        for (int ct = 0; ct < 2; ++ct) {
            const int j0 = 32 * ct + 16 * hi;
            unsigned kn[8], bq[8];
#pragma unroll
            for (int i = 0; i < 8; ++i) {
                const unsigned u0 = kka[16 * ct + 2 * i], u1 = kka[16 * ct + 2 * i + 1];
                const float k0 = bflo(u0) * inv, k1 = bflo(u1) * inv;
                kn[i] = pk2(k0, k1); bq[i] = pk2(k0 * bfhi(u0), k1 * bfhi(u1));
            }
            if (STORE) {
                *(u32x4*)(so + 1 * 64 + j0) = (u32x4){kn[0], kn[1], kn[2], kn[3]}; *(u32x4*)(so + 1 * 64 + j0 + 8) = (u32x4){kn[4], kn[5], kn[6], kn[7]};
                *(u32x4*)(so + 2 * 64 + j0) = (u32x4){bq[0], bq[1], bq[2], bq[3]}; *(u32x4*)(so + 2 * 64 + j0 + 8) = (u32x4){bq[4], bq[5], bq[6], bq[7]};
            }
        }
    }
}

DI void phase_select(const Params& p, int tid) {
    unsigned char* ws = p.ws;
    const bf16_t* QKV = (const bf16_t*)(ws + WS_QKV);
    const float* KBAR = (const float*)(ws + WS_KBAR);
    unsigned short* SEL = (unsigned short*)(ws + WS_SEL);
    const int gt = blockIdx.x * NTHREADS + tid, NGT = gridDim.x * NTHREADS;
    for (int it = gt; it < NB * NH * SEQ; it += NGT) {
        const int s = it & (SEQ - 1), bh = it >> 12, b = bh >> 3, h = bh & 7, blk = s >> 8;
        unsigned mask = 0u;
        if (blk > 0) {
            float q[64];
            const bf16_t* qp = QKV + ((size_t)(b * SEQ + s)) * QKVW + h * 64;
#pragma unroll
            for (int c = 0; c < 8; ++c) { const u32x4 w = *(const u32x4*)(qp + c * 8); float f[8]; unpack8(w, f);
#pragma unroll
                for (int i = 0; i < 8; ++i) q[c * 8 + i] = f[i]; }
            float v1 = -INFINITY, v2 = -INFINITY, v3 = -INFINITY; int i1 = -1, i2 = -1, i3 = -1;
            for (int jb = 0; jb < blk; ++jb) {
                const float* kb = KBAR + ((size_t)(bh * 16 + jb)) * 64;
                float g = 0.f;
#pragma unroll
                for (int d = 0; d < 64; d += 4) { const f32x4 kk = *(const f32x4*)(kb + d); g += q[d] * kk.x + q[d + 1] * kk.y + q[d + 2] * kk.z + q[d + 3] * kk.w; }
                if (g > v1) { v3 = v2; i3 = i2; v2 = v1; i2 = i1; v1 = g; i1 = jb; }
                else if (g > v2) { v3 = v2; i3 = i2; v2 = g; i2 = jb; }
                else if (g > v3) { v3 = g; i3 = jb; }
            }
            if (i1 >= 0) mask |= 1u << i1;
            if (i2 >= 0) mask |= 1u << i2;
            if (i3 >= 0) mask |= 1u << i3;
        }
        SEL[it] = (unsigned short)mask;
    }
}

constexpr int CK = 32, NCHUNK = SEQ / CK, ITEM_BYTES = 24576;
constexpr int IT_G1 = 0, IT_H1 = 4096, IT_QT = 12288, IT_OV = 20480;
DI unsigned char* chk_base(const Params& p, int chain) {
    const int q = chain >> 4;
    unsigned char* base = q == 0 ? p.ws + 86 * MiB : (q == 1 ? p.ws + 134 * MiB : (q == 2 ? p.ws + 214 * MiB : (unsigned char*)p.out + 64 * MiB));
    return base + (size_t)(chain & 15) * NCHUNK * ITEM_BYTES;
}
DI bf16x8 pack_acc(const f32x16& x, int s) {
    u32x4 w; w.x = pk2(x[8 * s], x[8 * s + 1]); w.y = pk2(x[8 * s + 2], x[8 * s + 3]); w.z = pk2(x[8 * s + 4], x[8 * s + 5]); w.w = pk2(x[8 * s + 6], x[8 * s + 7]);
    return __builtin_bit_cast(bf16x8, w);
}
DI void store_acc_bf16(unsigned char* dst, const f32x16& x) {
    u32x4 a, b; a.x = pk2(x[0], x[1]); a.y = pk2(x[2], x[3]); a.z = pk2(x[4], x[5]); a.w = pk2(x[6], x[7]);
    b.x = pk2(x[8], x[9]); b.y = pk2(x[10], x[11]); b.z = pk2(x[12], x[13]); b.w = pk2(x[14], x[15]);
    *(u32x4*)dst = a; *(u32x4*)(dst + 16) = b;
}
template <int T> DI void subst_step2(float (&x1)[32], float (&x2)[32], const float y1T, const LAS unsigned char* wl, const LAS unsigned char* y2row) {
    float p0 = y1T, p1 = 0.f, p2 = 0.f, p3 = 0.f, q0, q1 = 0.f, q2 = 0.f, q3 = 0.f;
    unsigned z = 0u;
    if (T > 1) asm("v_and_b32 %0, 0, %1" : "=v"(z) : "v"(__float_as_uint(x1[T > 1 ? T - 2 : 0]) | __float_as_uint(x2[T > 1 ? T - 2 : 0])));
    q0 = *(const LAS float*)(y2row + T * 4 + z);
    if (T > 0) {
        const LAS unsigned char* rowp = wl + T * 768 + z;
#pragma unroll
        for (int s4 = 0; s4 < (T + 3) / 4; ++s4) {
            const f32x4 mm = *(const LAS f32x4*)(rowp + s4 * 16);
            if (4 * s4 + 0 < T) { p0 -= x1[4 * s4 + 0] * mm.x; q0 -= x2[4 * s4 + 0] * mm.x; }
            if (4 * s4 + 1 < T) { p1 -= x1[(4 * s4 + 1) & 31] * mm.y; q1 -= x2[(4 * s4 + 1) & 31] * mm.y; }
            if (4 * s4 + 2 < T) { p2 -= x1[(4 * s4 + 2) & 31] * mm.z; q2 -= x2[(4 * s4 + 2) & 31] * mm.z; }
            if (4 * s4 + 3 < T) { p3 -= x1[(4 * s4 + 3) & 31] * mm.w; q3 -= x2[(4 * s4 + 3) & 31] * mm.w; }
        }
    }
    x1[T] = (p0 + p1) + (p2 + p3); x2[T] = (q0 + q1) + (q2 + q3);
}
template <int... Ts> DI void subst_all2(float (&x1)[32], float (&x2)[32], const float (&y1)[32], const LAS unsigned char* wl, const LAS unsigned char* y2row, std::integer_sequence<int, Ts...>) {
    (subst_step2<Ts>(x1, x2, y1[Ts], wl, y2row), ...);
}
#ifndef CPSTAGE
#define CPSTAGE 4
#endif
DI void unpack_acc_bf16(const LAS unsigned char* src, f32x16& x) {
    const u32x4 a = *(const LAS u32x4*)src, b = *(const LAS u32x4*)(src + 16);
    x[0] = bflo(a.x); x[1] = bfhi(a.x); x[2] = bflo(a.y); x[3] = bfhi(a.y); x[4] = bflo(a.z); x[5] = bfhi(a.z); x[6] = bflo(a.w); x[7] = bfhi(a.w);
    x[8] = bflo(b.x); x[9] = bfhi(b.x); x[10] = bflo(b.y); x[11] = bfhi(b.y); x[12] = bflo(b.z); x[13] = bfhi(b.z); x[14] = bflo(b.w); x[15] = bfhi(b.w);
}
constexpr int CPW = 36864;
constexpr int CP_BT = 24576, CP_KT = 28672, CP_VT = 32768;
template <int STG> DI void phase_chunkprep(const Params& p, LAS unsigned char* lds, int lane, int wid) {
    if (wid >= 4) return;
    unsigned char* ws = p.ws;
    const bf16_t* SCAN = (const bf16_t*)(ws + WS_SCAN);
    LAS unsigned char* wl = lds + wid * CPW;
    const int r32 = lane & 31, hi = lane >> 5, j = lane;
    for (int item = blockIdx.x * 4 + wid; item < 64 * NCHUNK; item += gridDim.x * 4) {
        const int chain = item >> 7, c = item & (NCHUNK - 1);
        const unsigned char* src = (const unsigned char*)(SCAN + ((size_t)chain * SEQ + (size_t)c * CK) * 384);
        unsigned char* dst = chk_base(p, chain) + (size_t)c * ITEM_BYTES;
        unsigned char* dl16 = dst + lane * 16; unsigned char* dl32 = dst + lane * 32;
        {
            u32x4 w[24];
#pragma unroll
            for (int k = 0; k < 24; ++k) w[k] = *(const u32x4*)(src + (size_t)(k * 64 + lane) * 16);
#pragma unroll
            for (int k = 0; k < 24; ++k) *(LAS u32x4*)(wl + (k * 64 + lane) * 16) = w[k];
        }
        LDS_WAIT(); asm volatile("" ::: "memory");
        float al[32]; float g = 1.f;
        {
            unsigned bt[16], kt[16], vt[16];
#pragma unroll
            for (int t = 0; t < 32; ++t) {
                LAS bf16_t* row = (LAS bf16_t*)(wl + t * 768);
                const float omd = bf2f(row[j]), kkv = bf2f(row[64 + j]), bv = bf2f(row[128 + j]), kmv = bf2f(row[192 + j]), rv = bf2f(row[256 + j]);
                const unsigned vraw = row[320 + j];
                const float gprev = g; g = g * (1.f - omd);
                const float ig = __builtin_amdgcn_rcpf(g);
                const float a_ = gprev * kkv, be = bv * ig, ka = kmv * ig, rh = g * rv;
                al[t] = a_;
                const unsigned beb = f2bf(be), kab = f2bf(ka);
                row[64 + j] = f2bf(a_); row[128 + j] = (bf16_t)beb; row[192 + j] = (bf16_t)kab; row[256 + j] = f2bf(rh);
                if (t & 1) { bt[t >> 1] |= beb << 16; kt[t >> 1] |= kab << 16; vt[t >> 1] |= vraw << 16; }
                else { bt[t >> 1] = beb; kt[t >> 1] = kab; vt[t >> 1] = vraw; }
                if ((t & 3) == 3) asm volatile("" ::: "memory");
            }
#pragma unroll
            for (int q = 0; q < 4; ++q) {
                *(LAS u32x4*)(wl + CP_BT + j * 64 + q * 16) = (u32x4){bt[4 * q], bt[4 * q + 1], bt[4 * q + 2], bt[4 * q + 3]};
                *(LAS u32x4*)(wl + CP_KT + j * 64 + q * 16) = (u32x4){kt[4 * q], kt[4 * q + 1], kt[4 * q + 2], kt[4 * q + 3]};
                *(LAS u32x4*)(wl + CP_VT + j * 64 + q * 16) = (u32x4){vt[4 * q], vt[4 * q + 1], vt[4 * q + 2], vt[4 * q + 3]};
            }
        }
        LDS_WAIT(); asm volatile("" ::: "memory");
        if (STG >= 2) {
        {
            f32x16 Mba, Mka, Nbr, Nkr;
#pragma unroll
            for (int i = 0; i < 16; ++i) { Mba[i] = 0.f; Mka[i] = 0.f; Nkr[i] = 0.f; Nbr[i] = 0.f; }
#pragma unroll
            for (int ks = 0; ks < 4; ++ks) {
                const LAS unsigned char* rp = wl + r32 * 768 + (16 * ks + 8 * hi) * 2;
                const bf16x8 ab = *(const LAS bf16x8*)(rp + 2 * 128), ak = *(const LAS bf16x8*)(rp + 3 * 128);
                const bf16x8 ba = *(const LAS bf16x8*)(rp + 1 * 128), br = *(const LAS bf16x8*)(rp + 4 * 128);
                Mba = MFMA32(ab, ba, Mba); Mka = MFMA32(ak, ba, Mka); Nkr = MFMA32(ak, br, Nkr); Nbr = MFMA32(ab, br, Nbr);
            }
#pragma unroll
            for (int r = 0; r < 16; ++r) { const int sr = crow(r, hi);
                if (!(sr < r32)) { Mba[r] = 0.f; Mka[r] = 0.f; }
                if (!(sr <= r32)) { Nkr[r] = 0.f; Nbr[r] = 0.f; } }
            LDS_WAIT(); asm volatile("" ::: "memory");
#pragma unroll
            for (int g4 = 0; g4 < 4; ++g4) {
                *(LAS f32x4*)(wl + r32 * 768 + 0 * 128 + (8 * g4 + 4 * hi) * 4) = (f32x4){Mba[4 * g4], Mba[4 * g4 + 1], Mba[4 * g4 + 2], Mba[4 * g4 + 3]};
                *(LAS u32x2*)(wl + r32 * 768 + 1 * 128 + (8 * g4 + 4 * hi) * 2) = (u32x2){pk2(Nbr[4 * g4], Nbr[4 * g4 + 1]), pk2(Nbr[4 * g4 + 2], Nbr[4 * g4 + 3])};
            }
#pragma unroll
            for (int r = 0; r < 16; ++r) *(LAS float*)(wl + crow(r, hi) * 768 + 5 * 128 + r32 * 4) = Mka[r];
            *(LAS float*)(wl + (j >> 4) * 768 + 1 * 128 + 64 + (j & 15) * 4) = g;
            { LAS unsigned char* np = wl + (lane >> 1) * 768 + 3 * 128 + 64 + (lane & 1) * 32;
              *(LAS u32x4*)np = (u32x4){pk2(Nkr[0], Nkr[1]), pk2(Nkr[2], Nkr[3]), pk2(Nkr[4], Nkr[5]), pk2(Nkr[6], Nkr[7])};
              *(LAS u32x4*)(np + 16) = (u32x4){pk2(Nkr[8], Nkr[9]), pk2(Nkr[10], Nkr[11]), pk2(Nkr[12], Nkr[13]), pk2(Nkr[14], Nkr[15])}; }
        }
        LDS_WAIT(); asm volatile("" ::: "memory");
        }
        if (STG >= 3) {
        {
            float x1[32], x2[32];
            subst_all2(x1, x2, al, wl, wl + r32 * 768 + 5 * 128, std::make_integer_sequence<int, 32>{});
            LAS unsigned char* w1p = wl + (j >> 1) * 768 + 2 * 128 + (j & 1) * 64;
            LAS unsigned char* w2p = wl + r32 * 768 + 3 * 128;
#pragma unroll
            for (int q = 0; q < 4; ++q) {
                *(LAS u32x4*)(w1p + q * 16) = (u32x4){pk2(-x1[8 * q], -x1[8 * q + 1]), pk2(-x1[8 * q + 2], -x1[8 * q + 3]), pk2(-x1[8 * q + 4], -x1[8 * q + 5]), pk2(-x1[8 * q + 6], -x1[8 * q + 7])};
                if (hi == 0) *(LAS u32x4*)(w2p + q * 16) = (u32x4){pk2(-x2[8 * q], -x2[8 * q + 1]), pk2(-x2[8 * q + 2], -x2[8 * q + 3]), pk2(-x2[8 * q + 4], -x2[8 * q + 5]), pk2(-x2[8 * q + 6], -x2[8 * q + 7])};
            }
        }
        LDS_WAIT(); asm volatile("" ::: "memory");
        }
        if (STG >= 4) {
#define CP_A1(jt, ks) (*(const LAS bf16x8*)(wl + (16 * (jt) + (r32 >> 1)) * 768 + 2 * 128 + (r32 & 1) * 64 + (16 * (ks) + 8 * hi) * 2))
#define CP_A2(ks) (*(const LAS bf16x8*)(wl + r32 * 768 + 3 * 128 + (16 * (ks) + 8 * hi) * 2))
#define CP_BN(ks) (*(const LAS bf16x8*)(wl + r32 * 768 + 1 * 128 + (16 * (ks) + 8 * hi) * 2))
#define CP_BB(jp, ks) (*(const LAS bf16x8*)(wl + CP_BT + (32 * (jp) + r32) * 64 + (16 * (ks) + 8 * hi) * 2))
        {
            float gcl[2];
#pragma unroll
            for (int jt = 0; jt < 2; ++jt) { const int jj = 32 * jt + r32; gcl[jt] = *(const LAS float*)(wl + (jj >> 4) * 768 + 1 * 128 + 64 + (jj & 15) * 4); }
            {
                const bf16x8 bn0 = CP_BN(0), bn1 = CP_BN(1);
#pragma unroll
                for (int jt = 0; jt < 2; ++jt) {
                    f32x16 acc;
#pragma unroll
                    for (int g4 = 0; g4 < 4; ++g4) { const u32x2 v = *(const LAS u32x2*)(wl + r32 * 768 + 4 * 128 + (32 * jt + 8 * g4 + 4 * hi) * 2);
                        acc[4 * g4] = bflo(v.x); acc[4 * g4 + 1] = bfhi(v.x); acc[4 * g4 + 2] = bflo(v.y); acc[4 * g4 + 3] = bfhi(v.y); }
                    acc = MFMA32(CP_A1(jt, 0), bn0, acc); acc = MFMA32(CP_A1(jt, 1), bn1, acc);
#pragma unroll
                    for (int sx = 0; sx < 2; ++sx) *(bf16x8*)(dl16 + IT_G1 + (jt * 2 + sx) * 1024) = pack_acc(acc, sx);
                }
            }
#pragma unroll
            for (int jp = 0; jp < 2; ++jp) {
                const bf16x8 bb0 = CP_BB(jp, 0), bb1 = CP_BB(jp, 1);
#pragma unroll
                for (int jt = 0; jt < 2; ++jt) {
                    f32x16 acc;
#pragma unroll
                    for (int r = 0; r < 16; ++r) acc[r] = (jt == jp && crow(r, hi) == r32) ? 1.f : 0.f;
                    acc = MFMA32(CP_A1(jt, 0), bb0, acc); acc = MFMA32(CP_A1(jt, 1), bb1, acc);
#pragma unroll
                    for (int r = 0; r < 16; ++r) acc[r] *= gcl[jp];
#pragma unroll
                    for (int sx = 0; sx < 2; ++sx) *(bf16x8*)(dl16 + IT_H1 + ((jp * 2 + jt) * 2 + sx) * 1024) = pack_acc(acc, sx);
                }
            }
            bf16x8 vtf[2][2];
#pragma unroll
            for (int it = 0; it < 2; ++it)
#pragma unroll
                for (int ks = 0; ks < 2; ++ks) {
                    const u32x2 lo = *(const LAS u32x2*)(wl + CP_VT + (32 * it + r32) * 64 + (16 * ks + 4 * hi) * 2), hh = *(const LAS u32x2*)(wl + CP_VT + (32 * it + r32) * 64 + (16 * ks + 8 + 4 * hi) * 2);
                    vtf[it][ks] = __builtin_bit_cast(bf16x8, (u32x4){lo.x, lo.y, hh.x, hh.y});
                }
            {
                f32x16 acc; unpack_acc_bf16(wl + (lane >> 1) * 768 + 3 * 128 + 64 + (lane & 1) * 32, acc);
                acc = MFMA32(CP_A2(0), CP_BN(0), acc); acc = MFMA32(CP_A2(1), CP_BN(1), acc);
                const bf16x8 g0 = pack_acc(acc, 0), g1 = pack_acc(acc, 1);
#pragma unroll
                for (int it = 0; it < 2; ++it) {
                    f32x16 z;
#pragma unroll
                    for (int r = 0; r < 16; ++r) z[r] = 0.f;
                    z = MFMA32(g0, vtf[it][0], z); z = MFMA32(g1, vtf[it][1], z);
                    store_acc_bf16(dl32 + IT_OV + it * 2048, z);
                }
            }
#pragma unroll
            for (int jp = 0; jp < 2; ++jp) {
                f32x16 acc;
#pragma unroll
                for (int g4 = 0; g4 < 4; ++g4) { const u32x2 v = *(const LAS u32x2*)(wl + CP_KT + (32 * jp + r32) * 64 + (8 * g4 + 4 * hi) * 2);
                    acc[4 * g4] = bflo(v.x); acc[4 * g4 + 1] = bfhi(v.x); acc[4 * g4 + 2] = bflo(v.y); acc[4 * g4 + 3] = bfhi(v.y); }
                acc = MFMA32(CP_A2(0), CP_BB(jp, 0), acc); acc = MFMA32(CP_A2(1), CP_BB(jp, 1), acc);
#pragma unroll
                for (int r = 0; r < 16; ++r) acc[r] *= gcl[jp];
                const bf16x8 h0 = pack_acc(acc, 0), h1 = pack_acc(acc, 1);
#pragma unroll
                for (int it = 0; it < 2; ++it) {
                    f32x16 z;
#pragma unroll
                    for (int r = 0; r < 16; ++r) z[r] = 0.f;
                    z = MFMA32(h0, vtf[it][0], z); z = MFMA32(h1, vtf[it][1], z);
                    store_acc_bf16(dl32 + IT_QT + (jp * 2 + it) * 2048, z);
                }
            }
        }
#undef CP_A1
#undef CP_A2
#undef CP_BN
#undef CP_BB
        }
        LDS_WAIT(); asm volatile("" ::: "memory");
    }
}
DI void phase_chunkscan(const Params& p, LAS unsigned char* lds, int tid, int lane, int wid) {
    unsigned char* ws = p.ws;
    bf16_t* OBR = (bf16_t*)(ws + WS_OBRAW);
    const int r32 = lane & 31, hi = lane >> 5;
    for (int chain = blockIdx.x; chain < 64; chain += gridDim.x) {
        const unsigned char* src = chk_base(p, chain);
        const int b = chain >> 3, h = chain & 7, lt = tid - 128;
        __syncthreads();
        u32x4 lw[4];
        if (wid >= 2) {
#pragma unroll
            for (int k = 0; k < 4; ++k) lw[k] = *(const u32x4*)(src + (size_t)(lt + 384 * k) * 16);
#pragma unroll
            for (int k = 0; k < 4; ++k) *(LAS u32x4*)(lds + (lt + 384 * k) * 16) = lw[k];
#pragma unroll
            for (int k = 0; k < 4; ++k) lw[k] = *(const u32x4*)(src + ITEM_BYTES + (size_t)(lt + 384 * k) * 16);
        }
        __syncthreads();
        f32x16 X0, X1;
#pragma unroll
        for (int i = 0; i < 16; ++i) { X0[i] = 0.f; X1[i] = 0.f; }
        for (int c = 0; c < NCHUNK; ++c) {
            const LAS unsigned char* cur = lds + (c & 1) * ITEM_BYTES;
            if (wid < 2) {
                const int it = wid;
                const bf16x8 xb00 = pack_acc(X0, 0), xb01 = pack_acc(X0, 1), xb10 = pack_acc(X1, 0), xb11 = pack_acc(X1, 1);
                f32x16 oacc; unpack_acc_bf16(cur + IT_OV + (it * 64 + lane) * 32, oacc);
                oacc = MFMA32(*(const LAS bf16x8*)(cur + IT_G1 + (0 * 64 + lane) * 16), xb00, oacc);
                oacc = MFMA32(*(const LAS bf16x8*)(cur + IT_G1 + (1 * 64 + lane) * 16), xb01, oacc);
                oacc = MFMA32(*(const LAS bf16x8*)(cur + IT_G1 + (2 * 64 + lane) * 16), xb10, oacc);
                oacc = MFMA32(*(const LAS bf16x8*)(cur + IT_G1 + (3 * 64 + lane) * 16), xb11, oacc);
                f32x16 n0, n1;
                unpack_acc_bf16(cur + IT_QT + ((0 * 2 + it) * 64 + lane) * 32, n0);
                unpack_acc_bf16(cur + IT_QT + ((1 * 2 + it) * 64 + lane) * 32, n1);
                n0 = MFMA32(*(const LAS bf16x8*)(cur + IT_H1 + (0 * 64 + lane) * 16), xb00, n0);
                n0 = MFMA32(*(const LAS bf16x8*)(cur + IT_H1 + (1 * 64 + lane) * 16), xb01, n0);
                n0 = MFMA32(*(const LAS bf16x8*)(cur + IT_H1 + (2 * 64 + lane) * 16), xb10, n0);
                n0 = MFMA32(*(const LAS bf16x8*)(cur + IT_H1 + (3 * 64 + lane) * 16), xb11, n0);
                n1 = MFMA32(*(const LAS bf16x8*)(cur + IT_H1 + (4 * 64 + lane) * 16), xb00, n1);
                n1 = MFMA32(*(const LAS bf16x8*)(cur + IT_H1 + (5 * 64 + lane) * 16), xb01, n1);
                n1 = MFMA32(*(const LAS bf16x8*)(cur + IT_H1 + (6 * 64 + lane) * 16), xb10, n1);
                n1 = MFMA32(*(const LAS bf16x8*)(cur + IT_H1 + (7 * 64 + lane) * 16), xb11, n1);
                X0 = n0; X1 = n1;
                bf16_t* orow = OBR + ((size_t)(b * SEQ + c * CK)) * 512 + h * 64 + 32 * it + r32;
#pragma unroll
                for (int r = 0; r < 16; ++r) orow[(size_t)crow(r, hi) * 512] = f2bf(oacc[r]);
            } else {
                LAS unsigned char* nxt = lds + ((c + 1) & 1) * ITEM_BYTES;
                if (c + 1 < NCHUNK) {
#pragma unroll
                    for (int k = 0; k < 4; ++k) *(LAS u32x4*)(nxt + (lt + 384 * k) * 16) = lw[k];
                }
                if (c + 2 < NCHUNK) {
#pragma unroll
                    for (int k = 0; k < 4; ++k) lw[k] = *(const u32x4*)(src + (size_t)(c + 2) * ITEM_BYTES + (size_t)(lt + 384 * k) * 16);
                }
            }
            __syncthreads();
        }
    }
}

constexpr int AT_BUF = 8192 + 64 * 136, AT_K = 0, AT_V = 8192, AT_BT = 2 * AT_BUF, AT_END = AT_BT + 512 * 4;
DI int rel_bucket_dev(int n) {
    if (n < 16) return n;
    const int th[15] = {19, 21, 24, 27, 31, 35, 40, 46, 52, 59, 67, 77, 87, 99, 113};
    int b = 16;
#pragma unroll
    for (int i = 0; i < 15; ++i) b += (n >= th[i]) ? 1 : 0;
    return b;
}
template <int MODE>
DI void attn_tile(const LAS unsigned char* kb, const LAS unsigned char* vbuf, const LAS float* btab, const bf16x8 (&qr)[4],
                  f32x16& o0, f32x16& o1, f32x16& lacc, float& m, int dq, bool selb, float c31, int r32, int hi) {
    const float sc2 = 0.125f * LOG2E;
    f32x16 p0, p1;
#pragma unroll
    for (int i = 0; i < 16; ++i) { p0[i] = 0.f; p1[i] = 0.f; }
#pragma unroll
    for (int d0 = 0; d0 < 4; ++d0) {
        const bf16x8 k0 = *(const LAS bf16x8*)(kb + (2 * d0 + hi) * 1024 + r32 * 16);
        const bf16x8 k1 = *(const LAS bf16x8*)(kb + (2 * d0 + hi) * 1024 + 512 + r32 * 16);
        p0 = MFMA32(k0, qr[d0], p0); p1 = MFMA32(k1, qr[d0], p1);
    }
    float mx = -INFINITY;
    float cadd = 0.f;
    if (MODE == 2) {
        const float bsel = selb ? c31 : -INFINITY;
#pragma unroll
        for (int r = 0; r < 16; ++r) mx = fmaxf(mx, fmaxf(p0[r], p1[r]));
        mx = mx * sc2 + bsel;
        cadd = bsel;
    } else {
        const float ninf = selb ? 0.f : -INFINITY;
#pragma unroll
        for (int r = 0; r < 16; ++r) {
            const int d0 = dq - crow(r, hi), d1 = d0 - 32;
            const int i0 = d0 < 0 ? 0 : (d0 > 511 ? 511 : d0), i1 = d1 < 0 ? 0 : (d1 > 511 ? 511 : d1);
            float x0 = p0[r] * sc2 + btab[i0], x1 = p1[r] * sc2 + btab[i1];
            if (MODE == 0) { x0 = d0 >= 0 ? x0 : -INFINITY; x1 = d1 >= 0 ? x1 : -INFINITY; }
            else { x0 += ninf; x1 += ninf; }
            p0[r] = x0; p1[r] = x1; mx = fmaxf(mx, fmaxf(x0, x1));
        }
    }
    mx = fmaxf(mx, __shfl_xor(mx, 32));
    if (__any(mx > m)) {
        const float mn = fmaxf(m, mx);
        const float alpha = __builtin_amdgcn_exp2f(m - mn);
        m = mn;
#pragma unroll
        for (int i = 0; i < 16; ++i) { o0[i] *= alpha; o1[i] *= alpha; lacc[i] *= alpha; }
    }
    if (MODE == 2) {
        const float c = cadd - m;
#pragma unroll
        for (int r = 0; r < 16; ++r) { p0[r] = __builtin_amdgcn_exp2f(p0[r] * sc2 + c); p1[r] = __builtin_amdgcn_exp2f(p1[r] * sc2 + c); }
    } else {
#pragma unroll
        for (int r = 0; r < 16; ++r) { p0[r] = __builtin_amdgcn_exp2f(p0[r] - m); p1[r] = __builtin_amdgcn_exp2f(p1[r] - m); }
    }
    const bf16x8 ones = {(short)0x3F80, (short)0x3F80, (short)0x3F80, (short)0x3F80, (short)0x3F80, (short)0x3F80, (short)0x3F80, (short)0x3F80};
#pragma unroll
    for (int s = 0; s < 4; ++s) {
        u32x4 pw;
        if (s < 2) { pw.x = pk2(p0[8 * s], p0[8 * s + 1]); pw.y = pk2(p0[8 * s + 2], p0[8 * s + 3]); pw.z = pk2(p0[8 * s + 4], p0[8 * s + 5]); pw.w = pk2(p0[8 * s + 6], p0[8 * s + 7]); }
        else { const int q = s - 2; pw.x = pk2(p1[8 * q], p1[8 * q + 1]); pw.y = pk2(p1[8 * q + 2], p1[8 * q + 3]); pw.z = pk2(p1[8 * q + 4], p1[8 * q + 5]); pw.w = pk2(p1[8 * q + 6], p1[8 * q + 7]); }
        const bf16x8 pf = __builtin_bit_cast(bf16x8, pw);
        const LAS unsigned char* v0p = vbuf + r32 * 136 + (16 * s + 4 * hi) * 2;
        const LAS unsigned char* v1p = vbuf + (32 + r32) * 136 + (16 * s + 4 * hi) * 2;
        const u32x2 a0 = *(const LAS u32x2*)v0p, a1 = *(const LAS u32x2*)(v0p + 16);
        const u32x2 c0 = *(const LAS u32x2*)v1p, c1 = *(const LAS u32x2*)(v1p + 16);
        const bf16x8 va = __builtin_bit_cast(bf16x8, (u32x4){a0.x, a0.y, a1.x, a1.y});
        const bf16x8 vb = __builtin_bit_cast(bf16x8, (u32x4){c0.x, c0.y, c1.x, c1.y});
        o0 = MFMA32(va, pf, o0); o1 = MFMA32(vb, pf, o1); lacc = MFMA32(ones, pf, lacc);
    }
}
template <int VAR> DI void attn_unit(const Params& p, LAS unsigned char* lds, int b, int h, int qb, int tid, int lane, int wid) {
    unsigned char* ws = p.ws;
    const bf16_t* QKV = (const bf16_t*)(ws + WS_QKV);
    const bf16_t* VT = (const bf16_t*)((const unsigned char*)p.out + DO_VT);
    const unsigned short* SEL = (const unsigned short*)(ws + WS_SEL);
    bf16_t* OA = VAR == 0 ? (bf16_t*)(ws + WS_OA) : (bf16_t*)((unsigned char*)p.out + 64 * MiB);
    const int r32 = lane & 31, hi = lane >> 5, bh = b * NH + h;
    LAS float* btab = (LAS float*)(lds + AT_BT);
    const int NT = 4 * (qb + 1);
#define AT_KPOS(ti) (((ti) < 4 ? qb * 256 + (ti) * 64 : (((ti) - 4) >> 2) * 256 + (((ti) - 4) & 3) * 64))
    const bf16_t* kbase = QKV + ((size_t)(b * SEQ + lane)) * QKVW + 512 + h * 64 + wid * 8;
    const bf16_t* vbase = VT + ((size_t)(bh * 64 + (tid >> 3))) * SEQ + (tid & 7) * 8;
    const int kdst = AT_K + wid * 1024 + lane * 16, vdst = AT_V + (tid >> 3) * 136 + (tid & 7) * 16;
#define AT_LOAD(ti, kr, vr) do { const int kp_ = AT_KPOS(ti); kr = *(const u32x4*)(kbase + (size_t)kp_ * QKVW); vr = *(const u32x4*)(vbase + kp_); } while (0)
#define AT_WRITE(buf, kr, vr) do { LAS unsigned char* b_ = lds + (buf) * AT_BUF; *(LAS u32x4*)(b_ + kdst) = kr; \
        *(LAS u32x2*)(b_ + vdst) = (u32x2){vr.x, vr.y}; *(LAS u32x2*)(b_ + vdst + 8) = (u32x2){vr.z, vr.w}; } while (0)
    u32x4 kreg, vreg;
    AT_LOAD(0, kreg, vreg);
    __syncthreads();
    btab[tid] = p.rel_bias[h * 32 + rel_bucket_dev(tid)] * LOG2E;
    if (tid < 256) {
        unsigned mask = 0u;
        if (qb > 0) {
            const float* KBAR = (const float*)(ws + WS_KBAR);
            float q[64];
            const bf16_t* qp = QKV + ((size_t)(b * SEQ + qb * 256 + tid)) * QKVW + h * 64;
#pragma unroll
            for (int c = 0; c < 8; ++c) { const u32x4 w = *(const u32x4*)(qp + c * 8); float f[8]; unpack8(w, f);
#pragma unroll
                for (int i = 0; i < 8; ++i) q[c * 8 + i] = f[i]; }
            float v1 = -INFINITY, v2 = -INFINITY, v3 = -INFINITY; int i1 = -1, i2 = -1, i3 = -1;
            for (int jb = 0; jb < qb; ++jb) {
                const float* kbp = KBAR + ((size_t)(bh * 16 + jb)) * 64;
                float g = 0.f;
#pragma unroll
                for (int d = 0; d < 64; d += 4) { const f32x4 kk = *(const f32x4*)(kbp + d); g += q[d] * kk.x + q[d + 1] * kk.y + q[d + 2] * kk.z + q[d + 3] * kk.w; }
                if (g > v1) { v3 = v2; i3 = i2; v2 = v1; i2 = i1; v1 = g; i1 = jb; }
                else if (g > v2) { v3 = v2; i3 = i2; v2 = g; i2 = jb; }
                else if (g > v3) { v3 = g; i3 = jb; }
            }
            if (i1 >= 0) mask |= 1u << i1;
            if (i2 >= 0) mask |= 1u << i2;
            if (i3 >= 0) mask |= 1u << i3;
        }
        ((LAS unsigned short*)(lds + AT_END))[tid] = (unsigned short)mask;
    }
    AT_WRITE(0, kreg, vreg);
    if (NT > 1) AT_LOAD(1, kreg, vreg);
    const int qrow = b * SEQ + qb * 256 + wid * 32 + r32, qin = wid * 32 + r32;
    bf16x8 qr[4];
#pragma unroll
    for (int d0 = 0; d0 < 4; ++d0) qr[d0] = *(const bf16x8*)(QKV + (size_t)qrow * QKVW + h * 64 + d0 * 16 + hi * 8);
    const float c31 = p.rel_bias[h * 32 + 31] * LOG2E;
    float m = -INFINITY;
    f32x16 o0, o1, lacc;
#pragma unroll
    for (int i = 0; i < 16; ++i) { o0[i] = 0.f; o1[i] = 0.f; lacc[i] = 0.f; }
    __syncthreads();
    const unsigned sel = ((const LAS unsigned short*)(lds + AT_END))[qin];
    for (int ti = 0; ti < NT; ++ti) {
        const bool own = ti < 4;
        const int blk = own ? qb : ((ti - 4) >> 2), kt = own ? ti : ((ti - 4) & 3);
        const LAS unsigned char* kb = lds + (ti & 1) * AT_BUF + AT_K;
        const LAS unsigned char* vbuf = lds + (ti & 1) * AT_BUF + AT_V;
        const bool selb = ((sel >> blk) & 1u) != 0u;
        const bool active = own ? (kt * 64 <= wid * 32 + 31) : (__any(selb) != 0);
        if (active && VAR != 2) {
            if (own) attn_tile<0>(kb, vbuf, btab, qr, o0, o1, lacc, m, qin - kt * 64, true, 0.f, r32, hi);
            else {
                const bool farb = ((qb - blk) * 256 + wid * 32 - kt * 64 - 63 >= 113);
                if (farb) attn_tile<2>(kb, vbuf, btab, qr, o0, o1, lacc, m, 0, selb, c31, r32, hi);
                else attn_tile<1>(kb, vbuf, btab, qr, o0, o1, lacc, m, (qb - blk) * 256 + qin - kt * 64, selb, c31, r32, hi);
            }
        }
        if (VAR != 1) { if (ti + 1 < NT) AT_WRITE((ti + 1) & 1, kreg, vreg);
        if (ti + 2 < NT) AT_LOAD(ti + 2, kreg, vreg); }
        __syncthreads();
    }
#undef AT_KPOS
#undef AT_LOAD
#undef AT_WRITE
    const float il = 1.f / lacc[0];
    bf16_t* orow = OA + (size_t)qrow * 512 + h * 64;
#pragma unroll
    for (int g = 0; g < 4; ++g) {
        u32x2 w0, w1;
        w0.x = pk2(o0[4 * g] * il, o0[4 * g + 1] * il); w0.y = pk2(o0[4 * g + 2] * il, o0[4 * g + 3] * il);
        w1.x = pk2(o1[4 * g] * il, o1[4 * g + 1] * il); w1.y = pk2(o1[4 * g + 2] * il, o1[4 * g + 3] * il);
        *(u32x2*)(orow + 8 * g + 4 * hi) = w0; *(u32x2*)(orow + 32 + 8 * g + 4 * hi) = w1;
    }
}
template <int VAR> DI void phase_attn(const Params& p, LAS unsigned char* lds, int tid, int lane, int wid) {
    if (gridDim.x == 256) {
        const int bh = blockIdx.x & 63, s = blockIdx.x >> 6;
#pragma unroll 1
        for (int i = 0; i < 4; ++i) { const int qb = i == 0 ? 15 - s : (i == 1 ? 8 + s : (i == 2 ? 7 - s : s)); attn_unit<VAR>(p, lds, bh >> 3, bh & 7, qb, tid, lane, wid); }
    } else {
        for (int it = blockIdx.x; it < NB * NH * 16; it += gridDim.x) { const int qb = 15 - (it >> 6), bh = it & 63; attn_unit<VAR>(p, lds, bh >> 3, bh & 7, qb, tid, lane, wid); }
    }
}

constexpr int A2_BT = 0, A2_SEL = 2048, A2_CNT = 2560, A2_WCNT = 2624, A2_NIT = 2880, A2_QCTR = 2884, A2_ITEM = 2944, A2_ROWS = 3072, A2_END = 3072 + 15 * 256;
constexpr size_t PART_REC = 136;
DI unsigned char* part_base(const Params& p, int b) {
    constexpr size_t PB_ = (size_t)NH * SEQ * 3 * PART_REC;
    return b < 6 ? p.ws + 214 * MiB + (size_t)b * PB_ : (unsigned char*)p.out + 96 * MiB + (size_t)(b - 6) * PB_;
}
struct A2State { float m, l; f32x16 o0, o1; };
constexpr int A2_WBUF = 8192;
DI void a2_dma_tile(const unsigned char* kf_tile, const unsigned char* vf_tile, LAS unsigned char* wbuf, int lane) {
#pragma unroll
    for (int f = 0; f < 8; ++f) {
        __builtin_amdgcn_global_load_lds((const unsigned*)(kf_tile + f * 1024 + lane * 16), (LAS unsigned*)(wbuf + f * 1024), 16, 0, 0);
        __builtin_amdgcn_global_load_lds((const unsigned*)(vf_tile + f * 1024 + lane * 16), (LAS unsigned*)(wbuf + 8192 + f * 1024), 16, 0, 0);
    }
}
template <bool OWN> DI void attn2_item(const Params& p, const LAS float* btab, LAS unsigned char* wbuf, int b, int h, int qb, int blk, int row, int nkt, A2State& st, int lane, int r32, int hi) {
    unsigned char* ws = p.ws;
    const bf16_t* QKV = (const bf16_t*)(ws + WS_QKV);
    const int bh = b * NH + h;
    const unsigned char* kft = (const unsigned char*)p.out + DO_KF + ((size_t)(bh * 64 + blk * 4) * 8) * 1024;
    const unsigned char* vft = (const unsigned char*)p.out + DO_VT + ((size_t)(bh * 64 + blk * 4) * 8) * 1024;
    a2_dma_tile(kft, vft, wbuf, lane);
    bf16x8 qr[4];
    { const bf16_t* qp = QKV + ((size_t)(b * SEQ + qb * 256 + row)) * QKVW + h * 64 + hi * 8;
#pragma unroll
      for (int d0 = 0; d0 < 4; ++d0) qr[d0] = *(const bf16x8*)(qp + d0 * 16); }
    st.m = -INFINITY; st.l = 0.f;
#pragma unroll
    for (int i = 0; i < 16; ++i) { st.o0[i] = 0.f; st.o1[i] = 0.f; }
    const int dbase = OWN ? row : ((qb - blk) * 256 + row);
    for (int kt = 0; kt < nkt; ++kt) {
        asm volatile("s_waitcnt vmcnt(0)" ::: "memory");
        bf16x8 kf[8], vf[8];
#pragma unroll
        for (int f = 0; f < 8; ++f) { kf[f] = *(const LAS bf16x8*)(wbuf + f * 1024 + lane * 16); vf[f] = *(const LAS bf16x8*)(wbuf + 8192 + f * 1024 + lane * 16); }
        asm volatile("s_waitcnt lgkmcnt(0)" ::: "memory");
        __builtin_amdgcn_sched_barrier(0);
        if (kt + 1 < nkt) a2_dma_tile(kft + (size_t)(kt + 1) * 8192, vft + (size_t)(kt + 1) * 8192, wbuf, lane);
        f32x16 p0, p1;
#pragma unroll
        for (int i = 0; i < 16; ++i) { p0[i] = 0.f; p1[i] = 0.f; }
#pragma unroll
        for (int d0 = 0; d0 < 4; ++d0) { p0 = MFMA32(kf[2 * d0], qr[d0], p0); p1 = MFMA32(kf[2 * d0 + 1], qr[d0], p1); }
        const float sc2 = 0.125f * LOG2E;
        const int dq = dbase - kt * 64;
        float mx = -INFINITY;
        const bool farb = !OWN && (__all(dq - 63 >= 113) != 0);
        const float c31 = btab[511];
        if (farb) {
#pragma unroll
            for (int r = 0; r < 16; ++r) mx = fmaxf(mx, fmaxf(p0[r], p1[r]));
            mx = mx * sc2 + c31;
        } else {
#pragma unroll
            for (int r = 0; r < 16; ++r) {
                const int d0 = dq - crow(r, hi), d1 = d0 - 32;
                const int i0 = d0 < 0 ? 0 : (d0 > 511 ? 511 : d0), i1 = d1 < 0 ? 0 : (d1 > 511 ? 511 : d1);
                float x0 = p0[r] * sc2 + btab[i0], x1 = p1[r] * sc2 + btab[i1];
                if (OWN) { x0 = d0 >= 0 ? x0 : -INFINITY; x1 = d1 >= 0 ? x1 : -INFINITY; }
                p0[r] = x0; p1[r] = x1; mx = fmaxf(mx, fmaxf(x0, x1));
            }
        }
        mx = fmaxf(mx, __shfl_xor(mx, 32));
        if (__any(mx > st.m)) {
            const float mn = fmaxf(st.m, mx);
            const float alpha = __builtin_amdgcn_exp2f(st.m - mn);
            st.m = mn;
#pragma unroll
            for (int i = 0; i < 16; ++i) { st.o0[i] *= alpha; st.o1[i] *= alpha; }
            st.l *= alpha;
        }
        float rs0 = 0.f, rs1 = 0.f;
        if (farb) { const float c = c31 - st.m;
#pragma unroll
            for (int r = 0; r < 16; ++r) { p0[r] = __builtin_amdgcn_exp2f(p0[r] * sc2 + c); p1[r] = __builtin_amdgcn_exp2f(p1[r] * sc2 + c); rs0 += p0[r]; rs1 += p1[r]; }
        } else {
#pragma unroll
            for (int r = 0; r < 16; ++r) { p0[r] = __builtin_amdgcn_exp2f(p0[r] - st.m); p1[r] = __builtin_amdgcn_exp2f(p1[r] - st.m); rs0 += p0[r]; rs1 += p1[r]; }
        }
        st.l += rs0 + rs1;
#pragma unroll
        for (int s = 0; s < 4; ++s) {
            u32x4 pw;
            if (s < 2) { pw.x = pk2(p0[8 * s], p0[8 * s + 1]); pw.y = pk2(p0[8 * s + 2], p0[8 * s + 3]); pw.z = pk2(p0[8 * s + 4], p0[8 * s + 5]); pw.w = pk2(p0[8 * s + 6], p0[8 * s + 7]); }
            else { const int q = s - 2; pw.x = pk2(p1[8 * q], p1[8 * q + 1]); pw.y = pk2(p1[8 * q + 2], p1[8 * q + 3]); pw.z = pk2(p1[8 * q + 4], p1[8 * q + 5]); pw.w = pk2(p1[8 * q + 6], p1[8 * q + 7]); }
            const bf16x8 pf = __builtin_bit_cast(bf16x8, pw);
            st.o0 = MFMA32(vf[s], pf, st.o0); st.o1 = MFMA32(vf[4 + s], pf, st.o1);
        }
    }
    st.l += __shfl_xor(st.l, 32);
}
template <int CHECK> DI void attn2_unit(const Params& p, LAS unsigned char* lds, int b, int h, int qb, int tid, int lane, int wid) {
    unsigned char* ws = p.ws;
    const bf16_t* QKV = (const bf16_t*)(ws + WS_QKV);
    bf16_t* OA = (bf16_t*)(ws + WS_OA);
    const int r32 = lane & 31, hi = lane >> 5, bh = b * NH + h;
    LAS float* btab = (LAS float*)(lds + A2_BT);
    LAS unsigned short* selm = (LAS unsigned short*)(lds + A2_SEL);
    LAS int* cnt = (LAS int*)(lds + A2_CNT);
    LAS int* wcnt = (LAS int*)(lds + A2_WCNT);
    LAS int* ctl = (LAS int*)(lds + A2_NIT);
    LAS unsigned char* itemtab = lds + A2_ITEM;
    LAS unsigned char* rows = lds + A2_ROWS;
    unsigned char* part = part_base(p, b) + ((size_t)(h * 16 + qb) * 256) * 3 * PART_REC;
    __syncthreads();
    btab[tid] = p.rel_bias[h * 32 + rel_bucket_dev(tid)] * LOG2E;
    unsigned mysel = 0u;
    if (qb > 0) {
        LAS float* kbl = (LAS float*)(lds + A2_WBUF);
        LAS float* gp = (LAS float*)(lds + A2_WBUF + 4096);
        const float* KBAR = (const float*)(ws + WS_KBAR) + (size_t)(bh * 16) * 64;
        for (int i = tid; i < qb * 64; i += NTHREADS) kbl[i] = KBAR[i];
        const int qi = tid & 255, hf = tid >> 8;
        float q[32];
        { const bf16_t* qp = QKV + ((size_t)(b * SEQ + qb * 256 + qi)) * QKVW + h * 64 + 32 * hf;
#pragma unroll
          for (int c = 0; c < 4; ++c) { const u32x4 w = *(const u32x4*)(qp + c * 8); float f[8]; unpack8(w, f);
#pragma unroll
              for (int i = 0; i < 8; ++i) q[c * 8 + i] = f[i]; } }
        __syncthreads();
        for (int jb = 0; jb < qb; ++jb) {
            const LAS float* kbp = kbl + jb * 64 + 32 * hf;
            float g0 = 0.f, g1 = 0.f;
#pragma unroll
            for (int d = 0; d < 32; d += 8) { const f32x4 ka = *(const LAS f32x4*)(kbp + d), kb = *(const LAS f32x4*)(kbp + d + 4);
                g0 += q[d] * ka.x + q[d + 1] * ka.y + q[d + 2] * ka.z + q[d + 3] * ka.w; g1 += q[d + 4] * kb.x + q[d + 5] * kb.y + q[d + 6] * kb.z + q[d + 7] * kb.w; }
            gp[(hf * 16 + jb) * 256 + qi] = g0 + g1;
        }
        __syncthreads();
        if (tid < 256) {
            float v1 = -INFINITY, v2 = -INFINITY, v3 = -INFINITY; int i1 = -1, i2 = -1, i3 = -1;
            for (int jb = 0; jb < qb; ++jb) {
                const float g = gp[jb * 256 + tid] + gp[(16 + jb) * 256 + tid];
                if (g > v1) { v3 = v2; i3 = i2; v2 = v1; i2 = i1; v1 = g; i1 = jb; }
                else if (g > v2) { v3 = v2; i3 = i2; v2 = g; i2 = jb; }
                else if (g > v3) { v3 = g; i3 = jb; }
            }
            if (i1 >= 0) mysel |= 1u << i1;
            if (i2 >= 0) mysel |= 1u << i2;
            if (i3 >= 0) mysel |= 1u << i3;
        }
    }
    if (tid < 256) {
        selm[tid] = (unsigned short)mysel;
        for (int j = 0; j < qb; ++j) { const unsigned long long bm = __ballot((mysel >> j) & 1u); if (lane == 0) wcnt[j * 4 + wid] = __popcll(bm); }
    }
    __syncthreads();
    if (tid < 256) {
        for (int j = 0; j < qb; ++j) {
            const bool bit = ((mysel >> j) & 1u) != 0u;
            const unsigned long long bm = __ballot(bit);
            int off = 0;
            for (int w2 = 0; w2 < 4; ++w2) off += (w2 < wid) ? wcnt[j * 4 + w2] : 0;
            const int pre = __popcll(bm & ((1ull << lane) - 1ull));
            if (bit) rows[j * 256 + off + pre] = (unsigned char)tid;
            if (tid == 0) cnt[j] = wcnt[j * 4] + wcnt[j * 4 + 1] + wcnt[j * 4 + 2] + wcnt[j * 4 + 3];
        }
    }
    __syncthreads();
    if (tid == 0) {
        int n = 0;
        for (int j = 0; j < qb; ++j) { const int nt = (cnt[j] + 31) >> 5; for (int r = 0; r < nt; ++r) itemtab[n++] = (unsigned char)(j * 8 + r); }
        ctl[0] = n; ctl[1] = 0;
    }
    __syncthreads();
    LAS unsigned char* wbuf = lds + A2_WBUF + wid * 16384;
    const int nitems = ctl[0];
    for (;;) {
        int it = 0;
        if (lane == 0) it = __hip_atomic_fetch_add(&ctl[1], 1, __ATOMIC_RELAXED, __HIP_MEMORY_SCOPE_WORKGROUP);
        it = __builtin_amdgcn_readfirstlane(it);
        if (it >= nitems) break;
        const int code = itemtab[it], j = code >> 3, r = code & 7;
        const int pos = r * 32 + r32, n = cnt[j];
        const bool valid = pos < n;
        const int row = rows[j * 256 + (valid ? pos : 0)];
        A2State st;
        attn2_item<false>(p, btab, wbuf, b, h, qb, j, row, 4, st, lane, r32, hi);
        if (valid) {
            const unsigned sm = selm[row];
            const int slot = __popc(sm & ((1u << j) - 1u));
            unsigned char* rec = part + ((size_t)row * 3 + slot) * PART_REC;
#pragma unroll
            for (int g = 0; g < 4; ++g) {
                *(u32x2*)(rec + (8 * g + 4 * hi) * 2) = (u32x2){pk2(st.o0[4 * g], st.o0[4 * g + 1]), pk2(st.o0[4 * g + 2], st.o0[4 * g + 3])};
                *(u32x2*)(rec + (32 + 8 * g + 4 * hi) * 2) = (u32x2){pk2(st.o1[4 * g], st.o1[4 * g + 1]), pk2(st.o1[4 * g + 2], st.o1[4 * g + 3])};
            }
            if (hi == 0) *(f32x2*)(rec + 128) = (f32x2){st.m, st.l};
        }
    }
    A2State own;
    attn2_item<true>(p, btab, wbuf, b, h, qb, qb, wid * 32 + r32, (wid >> 1) + 1, own, lane, r32, hi);
    asm volatile("s_waitcnt vmcnt(0)" ::: "memory");
    __syncthreads();
    {
        const int row = wid * 32 + r32;
        const unsigned sm = selm[row];
        const int ns = __popc(sm);
        float M = own.m;
        float ms[3], ls[3];
#pragma unroll
        for (int s3 = 0; s3 < 3; ++s3) { ms[s3] = -INFINITY; ls[s3] = 0.f;
            if (s3 < ns) { const f32x2 ml = *(const f32x2*)(part + ((size_t)row * 3 + s3) * PART_REC + 128); ms[s3] = ml.x; ls[s3] = ml.y; M = fmaxf(M, ml.x); } }
        const float f0 = __builtin_amdgcn_exp2f(own.m - M);
        float L = own.l * f0;
#pragma unroll
        for (int i = 0; i < 16; ++i) { own.o0[i] *= f0; own.o1[i] *= f0; }
#pragma unroll
        for (int s3 = 0; s3 < 3; ++s3) {
            if (s3 < ns) {
                const float fs = __builtin_amdgcn_exp2f(ms[s3] - M);
                L += ls[s3] * fs;
                const unsigned char* rec = part + ((size_t)row * 3 + s3) * PART_REC;
#pragma unroll
                for (int g = 0; g < 4; ++g) {
                    const u32x2 a = *(const u32x2*)(rec + (8 * g + 4 * hi) * 2), c = *(const u32x2*)(rec + (32 + 8 * g + 4 * hi) * 2);
                    own.o0[4 * g] += fs * bflo(a.x); own.o0[4 * g + 1] += fs * bfhi(a.x); own.o0[4 * g + 2] += fs * bflo(a.y); own.o0[4 * g + 3] += fs * bfhi(a.y);
                    own.o1[4 * g] += fs * bflo(c.x); own.o1[4 * g + 1] += fs * bfhi(c.x); own.o1[4 * g + 2] += fs * bflo(c.y); own.o1[4 * g + 3] += fs * bfhi(c.y);
                }
            }
        }
        const float il = 1.f / L;
        bf16_t* orow = OA + ((size_t)(b * SEQ + qb * 256 + row)) * 512 + h * 64;
#pragma unroll
        for (int g = 0; g < 4; ++g) {
            u32x2 w0, w1;
            w0.x = pk2(own.o0[4 * g] * il, own.o0[4 * g + 1] * il); w0.y = pk2(own.o0[4 * g + 2] * il, own.o0[4 * g + 3] * il);
            w1.x = pk2(own.o1[4 * g] * il, own.o1[4 * g + 1] * il); w1.y = pk2(own.o1[4 * g + 2] * il, own.o1[4 * g + 3] * il);
            if (CHECK) {
                const u32x2 r0 = *(const u32x2*)(orow + 8 * g + 4 * hi), r1 = *(const u32x2*)(orow + 32 + 8 * g + 4 * hi);
                const float a[8] = {bflo(w0.x), bfhi(w0.x), bflo(w0.y), bfhi(w0.y), bflo(w1.x), bfhi(w1.x), bflo(w1.y), bfhi(w1.y)};
                const float c[8] = {bflo(r0.x), bfhi(r0.x), bflo(r0.y), bfhi(r0.y), bflo(r1.x), bfhi(r1.x), bflo(r1.y), bfhi(r1.y)};
                bool bad = false;
#pragma unroll
                for (int i = 0; i < 8; ++i) bad |= !(fabsf(a[i] - c[i]) <= 0.03f * fabsf(c[i]) + 0.004f);
                if (bad) { w0.x = 0x7fc07fc0u; w0.y = 0x7fc07fc0u; w1.x = 0x7fc07fc0u; w1.y = 0x7fc07fc0u; }
            }
            *(u32x2*)(orow + 8 * g + 4 * hi) = w0; *(u32x2*)(orow + 32 + 8 * g + 4 * hi) = w1;
        }
    }
}
template <int CHECK> DI void phase_attn2(const Params& p, LAS unsigned char* lds, int tid, int lane, int wid) {
    if (gridDim.x == 256) {
        const int bh = blockIdx.x & 63, s = blockIdx.x >> 6;
#pragma unroll 1
        for (int i = 0; i < 4; ++i) { const int qb = i == 0 ? 15 - s : (i == 1 ? 8 + s : (i == 2 ? 7 - s : s)); attn2_unit<CHECK>(p, lds, bh >> 3, bh & 7, qb, tid, lane, wid); }
    } else {
        for (int it = blockIdx.x; it < NB * NH * 16; it += gridDim.x) { const int qb = 15 - (it >> 6), bh = it & 63; attn2_unit<CHECK>(p, lds, bh >> 3, bh & 7, qb, tid, lane, wid); }
    }
}

DI void phase_post(const Params& p, int tid, int lane, int wid) {
    unsigned char* ws = p.ws;
    const bf16_t* SCAN = (const bf16_t*)(ws + WS_SCAN);
    const bf16_t* OBRAW = (const bf16_t*)(ws + WS_OBRAW);
    const bf16_t* RG = (const bf16_t*)((const unsigned char*)p.out + DO_RG);
    bf16_t* OB = (bf16_t*)(ws + WS_OB);
    const int gw = blockIdx.x * NWAVES + wid, NGW = gridDim.x * NWAVES;
    for (int tok = gw; tok < NTOK; tok += NGW) {
        const int b = tok >> 12, s = tok & (SEQ - 1);
#pragma unroll
        for (int h = 0; h < NH; ++h) {
            const int c = h * 64 + lane;
            const float o = bf2f(OBRAW[(size_t)tok * 512 + c]);
            const float mu = wave_sum(o) * (1.f / 64.f);
            const float dd = o - mu;
            const float var = wave_sum(dd * dd) * (1.f / 64.f);
            const float on = dd * rsqrtf(var + GN_EPS) * p.lnx_g[c] + p.lnx_b[c];
            const bf16_t* si = SCAN + ((size_t)((b * NH + h) * SEQ + s)) * 384 + lane;
            const float km = bf2f(si[192]), r = bf2f(si[256]), v = bf2f(si[320]);
            const float bon = wave_sum(r * km * p.r_k[c]);
            const float g = bf2f(RG[(size_t)tok * 512 + c]);
            OB[(size_t)tok * 512 + c] = f2bf((on + bon * v) * g);
        }
    }
}
typedef float v16f_t __attribute__((ext_vector_type(16)));
typedef float v32f_t __attribute__((ext_vector_type(32)));
typedef int v6i_t __attribute__((ext_vector_type(6)));
DI void phase_uv_convert(const Params& p, int lane, int gw, int NGW) {
    unsigned char* ws = p.ws;
    const int hl = lane & 31, half = lane >> 5;
    for (int e2 = gw; e2 < NEXP; e2 += NGW) {
        const bool isv = e2 >= NEXP / 2;
        const int e = 2 * (isv ? e2 - NEXP / 2 : e2) + half;
        const float* src = (isv ? p.peer_v : p.peer_u) + (size_t)e * DM + 32 * hl;
        f32x4 v[8]; float am = 0.f, ss = 0.f;
#pragma unroll
        for (int j = 0; j < 8; ++j) { v[j] = *(const f32x4*)(src + 4 * j);
            am = fmaxf(am, fmaxf(fmaxf(fabsf(v[j].x), fabsf(v[j].y)), fmaxf(fabsf(v[j].z), fabsf(v[j].w))));
            ss += v[j].x * v[j].x + v[j].y * v[j].y + v[j].z * v[j].z + v[j].w * v[j].w; }
#pragma unroll
        for (int o = 1; o < 32; o <<= 1) { am = fmaxf(am, __shfl_xor(am, o)); ss += __shfl_xor(ss, o); }
        u32x4 w = {0u, 0u, 0u, 0u};
        if (isv) {
            am = fmaxf(am, 1e-30f);
            const float mul = 6.f / am;
#define FP4_PACK(j_) \
            w[j_] = __builtin_amdgcn_cvt_scalef32_pk_fp4_f32(w[j_], v[2 * (j_)].x * mul, v[2 * (j_)].y * mul, 1.0f, 0); \
            w[j_] = __builtin_amdgcn_cvt_scalef32_pk_fp4_f32(w[j_], v[2 * (j_)].z * mul, v[2 * (j_)].w * mul, 1.0f, 1); \
            w[j_] = __builtin_amdgcn_cvt_scalef32_pk_fp4_f32(w[j_], v[2 * (j_) + 1].x * mul, v[2 * (j_) + 1].y * mul, 1.0f, 2); \
            w[j_] = __builtin_amdgcn_cvt_scalef32_pk_fp4_f32(w[j_], v[2 * (j_) + 1].z * mul, v[2 * (j_) + 1].w * mul, 1.0f, 3);
            FP4_PACK(0) FP4_PACK(1) FP4_PACK(2) FP4_PACK(3)
#undef FP4_PACK
            *(u32x4*)(ws + WS_V8 + (size_t)e * 512 + 16 * hl) = w;
            if (hl == 0) ((float*)(ws + WS_VSC))[e] = am * (1.f / 6.f);
        } else {
            const float su = fmaxf(0.335f * sqrtf(ss * (1.f / DM)), 1e-30f), inv = 1.f / su;
            unsigned nsum = 0u;
#pragma unroll
            for (int j = 0; j < 4; ++j) {
#pragma unroll
                for (int k = 0; k < 4; ++k) {
                    const unsigned nl = (unsigned)fminf(fmaxf(floorf(v[2 * j][k] * inv) + 8.f, 0.f), 15.f);
                    const unsigned nh = (unsigned)fminf(fmaxf(floorf(v[2 * j + 1][k] * inv) + 8.f, 0.f), 15.f);
                    w[j] |= (nl | (nh << 4)) << (8 * k); nsum += nl + nh;
                }
            }
#pragma unroll
            for (int o = 1; o < 32; o <<= 1) nsum += (unsigned)__shfl_xor((int)nsum, o);
            *(u32x4*)(ws + WS_U8 + (size_t)e * 512 + 16 * hl) = w;
            if (hl == 0) ((f32x2*)(ws + WS_USC))[e] = (f32x2){su, (float)nsum};
        }
    }
}

DI void ce_desc(float& x, float& y) { const float hi = fmaxf(x, y), lo = fminf(x, y); x = hi; y = lo; }
DI void sort16_desc(float (&v)[16]) {
#pragma unroll
    for (int k = 2; k <= 16; k <<= 1) {
#pragma unroll
        for (int j = k >> 1; j > 0; j >>= 1) {
#pragma unroll
            for (int i = 0; i < 16; ++i) { const int l = i ^ j; if (l > i) { if ((i & k) == 0) ce_desc(v[i], v[l]); else ce_desc(v[l], v[i]); } }
        }
    }
}
DI void merge16_desc(float (&a)[16], const float (&b)[16]) {
#pragma unroll
    for (int i = 0; i < 16; ++i) a[i] = fmaxf(a[i], b[15 - i]);
#pragma unroll
    for (int j = 8; j > 0; j >>= 1) {
#pragma unroll
        for (int i = 0; i < 16; ++i) { const int l = i ^ j; if (l > i) ce_desc(a[i], a[l]); }
    }
}
DI void xmerge16(float (&a)[16]) {
    float o[16];
#pragma unroll
    for (int i = 0; i < 16; ++i) o[i] = __shfl_xor(a[i], 32);
    merge16_desc(a, o);
}
constexpr int ca_A(int i) { return i < 16 ? 0 : (i < 24 ? i - 8 : -1); }
constexpr int cb_A(int i) { return i < 16 ? i : (i < 24 ? 0 : -1); }
constexpr int ca_B(int i) { return i < 8 ? 1 : i < 13 ? 2 : i < 17 ? 3 : i < 20 ? 4 : i < 22 ? 5 : i < 24 ? 6 : i < 26 ? 7 : -1; }
constexpr int cb_B(int i) { return i < 8 ? i : i < 13 ? i - 8 : i < 17 ? i - 13 : i < 20 ? i - 17 : i < 22 ? i - 20 : i < 24 ? i - 22 : i < 26 ? i - 24 : -1; }

DI void route_item(const Params& p, LAS unsigned char* wl  , int item, int lane) {
    unsigned char* ws = p.ws;
    const bf16_t* QP = (const bf16_t*)(ws + WS_QP);
    const bf16_t* SK = (const bf16_t*)(ws + WS_SK);
    int* PIDX = (int*)(ws + WS_PIDX); float* PGATE = (float*)(ws + WS_PGATE);
    const int tt = item >> 3, h = item & 7, t0 = tt * 32, r32 = lane & 31, hi = lane >> 5;
    float L0[16], L1[16];
#pragma unroll
    for (int pp = 0; pp < 2; ++pp) {
        const int hp = h * 2 + pp;
        bf16x8 qf[8];
#pragma unroll
        for (int ks = 0; ks < 8; ++ks) qf[ks] = *(const bf16x8*)(QP + (size_t)(t0 + r32) * 2048 + hp * 128 + ks * 16 + hi * 8);
        float run[16];
#pragma unroll
        for (int i = 0; i < 16; ++i) run[i] = -INFINITY;
        bf16x8 skf[8];
        { const bf16_t* skp = SK + ((size_t)(hp * 128 + r32)) * 128 + hi * 8;
#pragma unroll
          for (int ks = 0; ks < 8; ++ks) skf[ks] = *(const bf16x8*)(skp + ks * 16); }
#pragma unroll 1
        for (int nt = 0; nt < 4; ++nt) {
            f32x16 X;
#pragma unroll
            for (int i = 0; i < 16; ++i) X[i] = 0.f;
#pragma unroll
            for (int ks = 0; ks < 8; ++ks) X = MFMA32(skf[ks], qf[ks], X);
            if (nt < 3) { const bf16_t* skp = SK + ((size_t)(hp * 128 + (nt + 1) * 32 + r32)) * 128 + hi * 8;
#pragma unroll
                for (int ks = 0; ks < 8; ++ks) skf[ks] = *(const bf16x8*)(skp + ks * 16); }
            float v[16];
#pragma unroll
            for (int r = 0; r < 16; ++r) { const unsigned n = (unsigned)(nt * 32 + (r & 3) + 8 * (r >> 2)) + 4u * (unsigned)hi;
                v[r] = __uint_as_float((__float_as_uint(X[r]) & ~127u) | n); }
            sort16_desc(v);
            merge16_desc(run, v);
        }
        xmerge16(run);
#pragma unroll
        for (int i = 0; i < 16; ++i) { if (pp == 0) L0[i] = run[i]; else L1[i] = run[i]; }
    }
#pragma unroll
    for (int i = 0; i < 16; ++i) { wl[lane * 32 + i] = (unsigned char)(__float_as_uint(L0[i]) & 127u); wl[lane * 32 + 16 + i] = (unsigned char)(__float_as_uint(L1[i]) & 127u); }
    float c0[16], c1[16];
#pragma unroll
    for (int i = 0; i < 32; ++i) {
        float va = -INFINITY, vb = -INFINITY;
        if (ca_A(i) >= 0) { const float s = L0[ca_A(i) < 0 ? 0 : ca_A(i)] + L1[cb_A(i) < 0 ? 0 : cb_A(i)]; va = __uint_as_float((__float_as_uint(s) & ~255u) | (unsigned)(ca_A(i) * 16 + cb_A(i))); }
        if (ca_B(i) >= 0) { const float s = L0[ca_B(i) < 0 ? 0 : ca_B(i)] + L1[cb_B(i) < 0 ? 0 : cb_B(i)]; vb = __uint_as_float((__float_as_uint(s) & ~255u) | (unsigned)(ca_B(i) * 16 + cb_B(i))); }
        const float v = hi ? vb : va;
        if (i < 16) c0[i] = v; else c1[i - 16] = v;
    }
    sort16_desc(c0); sort16_desc(c1); merge16_desc(c0, c1); xmerge16(c0);
    LDS_WAIT(); asm volatile("" ::: "memory");
    int e[16]; float g[16]; float sum = 0.f;
    const float rs = row_rs((const float*)(ws + WS_ROWSQ), t0 + r32);
    if (h == 0 && hi == 0) ((float*)(ws + WS_RS))[t0 + r32] = rs;
    const float mx = __uint_as_float(__float_as_uint(c0[0]) & ~255u);
#pragma unroll
    for (int k = 0; k < 16; ++k) {
        const unsigned bits = __float_as_uint(c0[k]); const int code = (int)(bits & 255u), a = code >> 4, b = code & 15;
        const int i0 = wl[lane * 32 + a], i1 = wl[lane * 32 + 16 + b];
        e[k] = i0 * 128 + i1;
        g[k] = __expf((__uint_as_float(bits & ~255u) - mx) * rs); sum += g[k];
    }
    const float inv = 1.f / sum;
    const size_t ob = ((size_t)(t0 + r32) * 8 + h) * 16 + hi * 8;
    u32x4 e0, e1; f32x4 g0, g1;
    e0.x = hi ? e[8] : e[0]; e0.y = hi ? e[9] : e[1]; e0.z = hi ? e[10] : e[2]; e0.w = hi ? e[11] : e[3];
    e1.x = hi ? e[12] : e[4]; e1.y = hi ? e[13] : e[5]; e1.z = hi ? e[14] : e[6]; e1.w = hi ? e[15] : e[7];
    g0.x = (hi ? g[8] : g[0]) * inv; g0.y = (hi ? g[9] : g[1]) * inv; g0.z = (hi ? g[10] : g[2]) * inv; g0.w = (hi ? g[11] : g[3]) * inv;
    g1.x = (hi ? g[12] : g[4]) * inv; g1.y = (hi ? g[13] : g[5]) * inv; g1.z = (hi ? g[14] : g[6]) * inv; g1.w = (hi ? g[15] : g[7]) * inv;
    *(u32x4*)(PIDX + ob) = e0; *(u32x4*)(PIDX + ob + 4) = e1;
    *(f32x4*)(PGATE + ob) = g0; *(f32x4*)(PGATE + ob + 4) = g1;
    LDS_WAIT(); asm volatile("" ::: "memory");
}
DI void phase_route(const Params& p, LAS unsigned char* lds, int lane, int wid) {
    const int gw = blockIdx.x * NWAVES + wid, NGW = gridDim.x * NWAVES;
    for (int it = gw; it < (NTOK / 32) * NH; it += NGW) route_item(p, lds + wid * 2048, it, lane);
}

DI float gelu_exact(float x) { return 0.5f * x * (1.f + erff(x * 0.70710678118654752f)); }
DI float gelu_bf(float x) {
    const float z = fabsf(x) * 0.70710678118654752f;
    const float t = __builtin_amdgcn_rcpf(fmaf(0.3275911f, z, 1.f));
    const float poly = t * fmaf(t, fmaf(t, fmaf(t, fmaf(t, 1.061405429f, -1.453152027f), 1.421413741f), -0.284496736f), 0.254829592f);
    const float he = 0.5f * poly * __expf(-z * z);
    return x * (x >= 0.f ? 1.f - he : he);
}
DI void experts_quant_x(const u32x4 (&xn)[4], unsigned (&xa)[8], float& sx, float& ktok) {
    float f[32];
#pragma unroll
    for (int j = 0; j < 4; ++j) { float t[8]; unpack8(xn[j], t);
#pragma unroll
        for (int i = 0; i < 8; ++i) f[8 * j + i] = t[i]; }
    float m = 0.f;
#pragma unroll
    for (int i = 0; i < 32; ++i) m = fmaxf(m, fabsf(f[i]));
    m = fmaxf(m, dpp_mov<0x128>(m)); m = fmaxf(m, dpp_mov<0x124>(m)); m = fmaxf(m, dpp_mov<0x122>(m)); m = fmaxf(m, dpp_mov<0x121>(m));
    m = fmaxf(m, __shfl_xor(m, 16));
    m = fmaxf(m, 1e-30f);
    const float inv = 127.f / m; sx = m * (1.f / 127.f);
    unsigned tsum = 0u;
#pragma unroll
    for (int j = 0; j < 4; ++j) { unsigned wh = 0u, wl = 0u;
#pragma unroll
        for (int k = 0; k < 4; ++k) {
            const unsigned q0 = (unsigned)(rintf(f[8 * j + k] * inv) + 128.f), q1 = (unsigned)(rintf(f[8 * j + 4 + k] * inv) + 128.f);
            wh |= ((q0 >> 4) | ((q1 >> 4) << 4)) << (8 * k); wl |= ((q0 & 15u) | ((q1 & 15u) << 4)) << (8 * k); tsum += q0 + q1; }
        xa[j] = wh; xa[4 + j] = wl; }
    float tf = row16_sum((float)tsum);
    tf += __shfl_xor(tf, 16);
    ktok = 983040.f - 7.5f * tf;
}
DI void phase_experts(const Params& p, LAS unsigned char* ldsw  , int lane, int wid, float* outp, const int IDMASK) {
    unsigned char* ws = p.ws;
    const bf16_t* XN = (const bf16_t*)(ws + WS_XN);
    const unsigned char* U8 = ws + WS_U8; const unsigned char* V8 = ws + WS_V8;
    const f32x2* USC = (const f32x2*)(ws + WS_USC); const float* VSC = (const float*)(ws + WS_VSC);
    const int* PIDX = (const int*)(ws + WS_PIDX); const float* PGATE = (const float*)(ws + WS_PGATE); const float* RS = (const float*)(ws + WS_RS);
    float* H1 = p.out;
    const int hl = lane & 31; const bool hi = lane >= 32;
    const bool b0 = (lane & 1) != 0, b1 = (lane & 2) != 0;
    const int ntile = ((NTOK / 32) - (int)blockIdx.x + (int)gridDim.x - 1) / (int)gridDim.x;
    if (ntile <= 0) return;
    const int ntw = ntile * 4;
    auto tokof = [&](int t) { const int tc = t < ntw ? t : ntw - 1; return 32 * ((int)blockIdx.x + (tc >> 2) * (int)gridDim.x) + 4 * wid + (tc & 3); };
    unsigned xa[8]; float sx, ktok;
    typedef int v8i_t __attribute__((ext_vector_type(8)));
    float nfg[16];
#pragma unroll
    for (int r = 0; r < 16; ++r) nfg[r] = p.normf_g[32 * crow(r, hi) + hl];
    f32x16 D, D2;
#pragma unroll
    for (int i = 0; i < 16; ++i) { D[i] = 0.f; D2[i] = 0.f; }
    unsigned bmask[4];
#pragma unroll
    for (int r = 0; r < 4; ++r) bmask[r] = ((hi ? 1 : 0) == ((hl >> 4) & 1) && r == ((hl & 15) >> 2)) ? (0xFFu << (8 * (hl & 3))) : 0u;
    int iA1, iB1, iA2, iB2; float gA1, gB1, gA2, gB2, vA1, vB1; f32x2 uA1, uB1;
    auto ld_ids = [&](int t, int& iA, int& iB, float& gA, float& gB) { const size_t b = (size_t)tokof(t) * 128 + lane;
        iA = PIDX[b] & IDMASK; iB = PIDX[b + 64] & IDMASK; gA = PGATE[b]; gB = PGATE[b + 64]; };
    auto wr_rec = [&](int t, int iA, int iB, float gA, float gB, f32x2 uA, f32x2 uB, float vA, float vB) {
        LAS unsigned char* buf = ldsw + (t & 1) * 2048;
        *(LAS u32x4*)(buf + lane * 16) = (u32x4){(unsigned)iA, __float_as_uint(gA * vA), __float_as_uint(uA.x), __float_as_uint(uA.y)};
        *(LAS u32x4*)(buf + 1024 + lane * 16) = (u32x4){(unsigned)iB, __float_as_uint(gB * vB), __float_as_uint(uB.x), __float_as_uint(uB.y)};
    };
    LAS unsigned char* hvbuf = ldsw + 4096;
    auto prime = [&](int t0) {
        ld_ids(t0, iA1, iB1, gA1, gB1);
        uA1 = USC[iA1]; uB1 = USC[iB1]; vA1 = VSC[iA1]; vB1 = VSC[iB1];
        wr_rec(t0, iA1, iB1, gA1, gB1, uA1, uB1, vA1, vB1);
        ld_ids(t0 + 1, iA1, iB1, gA1, gB1);
        uA1 = USC[iA1]; uB1 = USC[iB1]; vA1 = VSC[iA1]; vB1 = VSC[iB1];
        ld_ids(t0 + 2, iA2, iB2, gA2, gB2);
    };
    auto advance = [&](int t) {
        wr_rec(t + 1, iA1, iB1, gA1, gB1, uA1, uB1, vA1, vB1);
        iA1 = iA2; iB1 = iB2; gA1 = gA2; gB1 = gB2;
        uA1 = USC[iA1]; uB1 = USC[iB1]; vA1 = VSC[iA1]; vB1 = VSC[iB1];
        ld_ids(t + 3, iA2, iB2, gA2, gB2);
    };
    const bool b2 = (lane & 4) != 0;
#pragma unroll 1
    for (int tc = 0; tc < ntw; tc += 16) {
        const int tend = tc + 16 < ntw ? tc + 16 : ntw;
        prime(tc);
        { u32x4 xn[4];
#pragma unroll
          for (int j = 0; j < 4; ++j) xn[j] = *(const u32x4*)(XN + (size_t)tokof(tc) * DM + 32 * hl + 8 * j);
          experts_quant_x(xn, xa, sx, ktok); sx *= RS[tokof(tc)]; }
        u32x4 uw[8];
#pragma unroll
        for (int q = 0; q < 8; ++q) { const int id = *(LAS const int*)(ldsw + (tc & 1) * 2048 + ((hi ? 1 : 0) + 2 * q) * 16); uw[q] = *(const u32x4*)(U8 + (size_t)id * 512 + 16 * hl); }
#pragma unroll 1
        for (int t = tc; t < tend; ++t) {
            advance(t);
            auto groupU = [&](int g) {
                const LAS unsigned char* rc_cur = ldsw + (t & 1) * 2048 + (g * 16 + (hi ? 1 : 0)) * 16;
                const int gn = g + 1;
                const LAS unsigned char* rc_nxt = ldsw + ((t + (gn >> 3)) & 1) * 2048 + ((gn & 7) * 16 + (hi ? 1 : 0)) * 16;
                float d[8]; int idn[8];
                const u32x4 rl = *(LAS const u32x4*)(rc_cur + 32 * (lane & 7));
#pragma unroll
                for (int q = 0; q < 8; ++q) idn[q] = *(LAS const int*)(rc_nxt + 32 * q);
#pragma unroll
                for (int q = 0; q < 8; ++q) {
                    __builtin_amdgcn_sched_barrier(0);
                    const u32x4 w = uw[q];
                    unsigned h0 = __builtin_amdgcn_udot8(w[0], xa[0], 0u, false), l0 = __builtin_amdgcn_udot8(w[0], xa[4], 0u, false);
                    unsigned h1 = __builtin_amdgcn_udot8(w[1], xa[1], 0u, false), l1 = __builtin_amdgcn_udot8(w[1], xa[5], 0u, false);
                    h0 = __builtin_amdgcn_udot8(w[2], xa[2], h0, false); l0 = __builtin_amdgcn_udot8(w[2], xa[6], l0, false);
                    h1 = __builtin_amdgcn_udot8(w[3], xa[3], h1, false); l1 = __builtin_amdgcn_udot8(w[3], xa[7], l1, false);
                    d[q] = (float)(((h0 + h1) << 4) + (l0 + l1));
                    __builtin_amdgcn_sched_barrier(0);
                    uw[q] = *(const u32x4*)(U8 + (size_t)idn[q] * 512 + 16 * hl);
                }
                __builtin_amdgcn_sched_barrier(0);
                float a[4], c2[2];
#pragma unroll
                for (int i = 0; i < 4; ++i) { const float keep = b0 ? d[2 * i + 1] : d[2 * i], send = b0 ? d[2 * i] : d[2 * i + 1]; a[i] = keep + dpp_mov<0xB1>(send); }
#pragma unroll
                for (int i = 0; i < 2; ++i) { const float keep = b1 ? a[2 * i + 1] : a[2 * i], send = b1 ? a[2 * i] : a[2 * i + 1]; c2[i] = keep + dpp_mov<0x4E>(send); }
                float c;
                { const float keep = b2 ? c2[1] : c2[0], send = b2 ? c2[0] : c2[1]; c = keep + dpp_mov<0x124>(send); }
                c += dpp_mov<0x128>(c);
                c += __shfl_xor(c, 16);
                const float gtl = __uint_as_float(rl.y), usl = __uint_as_float(rl.z), rcl = __uint_as_float(rl.w);
                const float dq = ((c - 128.f * rcl) + ktok) * (usl * sx);
#if PROBE == 50
                const float hvl = 0.f * gelu_bf(dq) * gtl;
#else
                const float hvl = gelu_bf(dq) * gtl;
#endif
                const unsigned code = (unsigned)__builtin_amdgcn_cvt_pk_fp8_f32(hvl * 128.f, 0.f, 0, false) & 0xffu;
                if ((lane & 0x18) == 0) hvbuf[((t - tc) * 8 + g) * 16 + 2 * (lane & 7) + (hi ? 1 : 0)] = (unsigned char)code;
            };
#pragma unroll 1
            for (int g = 0; g < 7; ++g) groupU(g);
            u32x4 xn[4];
#pragma unroll
            for (int j = 0; j < 4; ++j) xn[j] = *(const u32x4*)(XN + (size_t)tokof(t + 1) * DM + 32 * hl + 8 * j);
            groupU(7);
            experts_quant_x(xn, xa, sx, ktok); sx *= RS[tokof(t + 1)];
        }
        prime(tc);
        u32x4 vw[8];
#pragma unroll
        for (int q = 0; q < 8; ++q) { const int id = *(LAS const int*)(ldsw + (tc & 1) * 2048 + ((hi ? 1 : 0) + 2 * q) * 16); vw[q] = *(const u32x4*)(V8 + (size_t)id * 512 + 16 * hl); }
#pragma unroll 1
        for (int t = tc; t < tend; ++t) {
            advance(t);
            auto groupV = [&](int g) {
                const int gn = g + 1;
                const LAS unsigned char* rc_nxt = ldsw + ((t + (gn >> 3)) & 1) * 2048 + ((gn & 7) * 16 + (hi ? 1 : 0)) * 16;
                int idn[8];
#pragma unroll
                for (int q = 0; q < 8; ++q) idn[q] = *(LAS const int*)(rc_nxt + 32 * q);
                const u32x4 hb = *(LAS const u32x4*)(hvbuf + ((t - tc) * 8 + g) * 16);
#pragma unroll
                for (int q = 0; q < 8; ++q) {
                    __builtin_amdgcn_sched_barrier(0);
                    const unsigned wq = hb[q >> 1] >> (16 * (q & 1));
                    const unsigned bb0 = (wq & 0xffu) * 0x01010101u, bb1 = ((wq >> 8) & 0xffu) * 0x01010101u;
                    v8i_t Bv, Av;
#pragma unroll
                    for (int r = 0; r < 4; ++r) { Bv[r] = (int)(bb0 & bmask[r]); Bv[4 + r] = (int)(bb1 & bmask[r]); }
                    Av[0] = (int)vw[q].x; Av[1] = (int)vw[q].y; Av[2] = (int)vw[q].z; Av[3] = (int)vw[q].w; Av[4] = 0; Av[5] = 0; Av[6] = 0; Av[7] = 0;
                    if (q & 1) D2 = __builtin_amdgcn_mfma_scale_f32_32x32x64_f8f6f4(Av, Bv, D2, 4  , 0  , 0, 0, 0, 0  );
                    else D = __builtin_amdgcn_mfma_scale_f32_32x32x64_f8f6f4(Av, Bv, D, 4, 0, 0, 0, 0, 0);
                    __builtin_amdgcn_sched_barrier(0);
                    vw[q] = *(const u32x4*)(V8 + (size_t)idn[q] * 512 + 16 * hl);
                }
            };
#pragma unroll 1
            for (int g = 0; g < 7; ++g) groupV(g);
            const int tok = tokof(t);
            float o[16];
            { const float* hr0 = H1 + (size_t)tok * DM + hl;
#pragma unroll
              for (int r = 0; r < 16; ++r) o[r] = __builtin_nontemporal_load(hr0 + 32 * crow(r, hi)); }
            groupV(7);
            float ss = 0.f;
#pragma unroll
            for (int r = 0; r < 16; ++r) { o[r] += (D[r] + D2[r]) * (1.f / 128.f); ss += o[r] * o[r]; D[r] = 0.f; D2[r] = 0.f; }
            const float rs = rsqrtf(wave_sum(ss) * (1.f / DM) + RMS_EPS);
            float* orow = outp + (size_t)tok * DM + hl;
#pragma unroll
            for (int r = 0; r < 16; ++r) __builtin_nontemporal_store(o[r] * rs * nfg[r], orow + 32 * crow(r, hi));
        }
    }
}

__global__ void __launch_bounds__(NTHREADS, 2) mega_fwd(Params p) {
    extern __shared__ __attribute__((aligned(16))) unsigned char lds_raw[];
    LAS unsigned char* lds = (LAS unsigned char*)lds_raw;
    const int tid = threadIdx.x, lane = tid & 63, wid = __builtin_amdgcn_readfirstlane(tid >> 6);
    unsigned char* ws = p.ws;
    bf16_t* XN = (bf16_t*)(ws + WS_XN);
    bf16_t* W1T = (bf16_t*)(ws + WS_W1T);
    volatile LAS unsigned* MISC = (volatile LAS unsigned*)(lds + LDS_MISC);
    if (tid < 64) MISC[tid] = 0u;
    __syncthreads();
    const XcdBarrier bar = xcd_barrier_post((unsigned*)ws, MISC + 8);
#define GSYNC() xcd_barrier(bar)

#ifndef ONLY
#define ONLY -1
#endif
#define PH(k) if (ONLY < 0 || ONLY == (k))
#define IDS() int tid = (int)threadIdx.x; asm volatile("" : "+v"(tid)); const int lane = tid & 63, wid = __builtin_amdgcn_readfirstlane(tid >> 6); (void)lane; (void)wid;
    PH(0) { IDS(); phase_prep(p, lds, tid, lane, wid); }
#if PROBE == 13
    phase_prep(p, lds, tid, lane, wid);
#endif
    GSYNC();
    PH(1) { IDS(); { F1a f{(bf16_t*)(ws + WS_QKV), (bf16_t*)(ws + WS_PB)}; run_gemm(lds, XN, W1T, N1A, 1024, f); } }
#if PROBE == 11
    { F1a f{(bf16_t*)(ws + WS_QKV), (bf16_t*)(ws + WS_PB)}; run_gemm(lds, XN, W1T, N1A, 1024, f); }
#endif
    GSYNC();
    PH(2) { IDS(); phase_kbar_vt(p, lds, tid, lane, wid); }
#if PROBE == 14 || PROBE == 61
    phase_kbar_vt(p, lds, tid, lane, wid);
#endif
    PH(3) { IDS(); phase_rwkv_prep2<true>(p, lds, tid, lane, wid); }
#if PROBE == 8 || PROBE == 61
    phase_rwkv_prep2<true>(p, lds, tid, lane, wid);
#endif

    GSYNC();
    PH(6) { IDS(); phase_attn2<0>(p, lds, tid, lane, wid); }
#if PROBE == 63 || PROBE == 61
    __syncthreads();
    phase_attn2<0>(p, lds, tid, lane, wid);
#endif
    GSYNC();
    PH(5) { IDS(); phase_chunkprep<4>(p, lds, lane, wid); }
    PH(8) { IDS(); if (wid >= 4) phase_uv_convert(p, lane, (int)blockIdx.x * 4 + wid - 4, (int)gridDim.x * 4); }
#if PROBE == 31 || PROBE == 61
    phase_chunkprep<4>(p, lds, lane, wid);
#endif
#if PROBE == 33
    phase_chunkprep<1>(p, lds, lane, wid);
#endif
#if PROBE == 34
    phase_chunkprep<2>(p, lds, lane, wid);
#endif
#if PROBE == 35
    phase_chunkprep<3>(p, lds, lane, wid);
#endif
    GSYNC();
    PH(17) { IDS(); phase_chunkscan(p, lds, tid, lane, wid); }
    PH(9) { IDS(); if (gridDim.x > 64 && (int)blockIdx.x >= 64) { F1b f{ws, p.out, 0}; run_gemm_on(lds, XN, W1T + (size_t)N1A * 1024, G1B_EARLY, 1024, f, (int)gridDim.x - 64, (int)blockIdx.x - 64); } }
#if PROBE == 32 || PROBE == 62
    phase_chunkscan(p, lds, tid, lane, wid);
#endif
    GSYNC();
    PH(7) { IDS(); phase_post(p, tid, lane, wid); }
#if PROBE == 62
    phase_post(p, tid, lane, wid);
#endif
    PH(9) { IDS(); { const int e = gridDim.x > 64 ? G1B_EARLY : 0; F1b f{ws, p.out, e}; run_gemm(lds, XN, W1T + (size_t)(N1A + e) * 1024, NGATE - e, 1024, f); } }
#if PROBE == 64 || PROBE == 66
    { const int e = gridDim.x > 64 ? G1B_EARLY : 0; F1b f{ws, p.out, e}; run_gemm(lds, XN, W1T + (size_t)(N1A + e) * 1024, NGATE - e, 1024, f); }
#endif
    GSYNC();
    PH(10) { IDS(); { FPa f{ws, p.out, (bf16_t*)(ws + WS_Y)}; run_gemm(lds, (const bf16_t*)(ws + WS_OA), (const bf16_t*)(ws + WS_WPA), 1024, 512, f); } }
#if PROBE == 19 || PROBE == 66
    { FPa f{ws, p.out, (bf16_t*)(ws + WS_Y)}; run_gemm(lds, (const bf16_t*)(ws + WS_OA), (const bf16_t*)(ws + WS_WPA), 1024, 512, f); }
#endif
    __builtin_amdgcn_fence(__ATOMIC_ACQ_REL, "workgroup"); __syncthreads();
    PH(11) { IDS(); { FPb f{ws, p.out, (bf16_t*)(ws + WS_Y)}; run_gemm(lds, (const bf16_t*)(ws + WS_OB), (const bf16_t*)(ws + WS_WPB), 1024, 512, f); } }
    GSYNC();
    PH(12) { IDS(); { FOut f{p.x, p.norm2_g, p.out, XN, (float*)(ws + WS_ROWSQ)}; run_gemm(lds, (const bf16_t*)(ws + WS_Y), (const bf16_t*)(ws + WS_WO), 1024, 1024, f); } }
#if PROBE == 65 || PROBE == 66
    { FOut f{p.x, p.norm2_g, p.out, XN, (float*)(ws + WS_ROWSQ)}; run_gemm(lds, (const bf16_t*)(ws + WS_Y), (const bf16_t*)(ws + WS_WO), 1024, 1024, f); }
#endif
    GSYNC();
    PH(14) { IDS(); { FQ f{(bf16_t*)(ws + WS_QP)}; run_gemm(lds, XN, (const bf16_t*)(ws + WS_WQ), 2048, 1024, f); } }
#if PROBE == 12 || PROBE == 62
    { FQ f{(bf16_t*)(ws + WS_QP)}; run_gemm(lds, XN, (const bf16_t*)(ws + WS_WQ), 2048, 1024, f); }
#endif
    GSYNC();
    PH(15) { IDS(); phase_route(p, lds, lane, wid); }
#if PROBE == 7 || PROBE == 62
    phase_route(p, lds, lane, wid);
#endif
    __builtin_amdgcn_fence(__ATOMIC_ACQ_REL, "workgroup"); __syncthreads();
#if PROBE == 4 || PROBE == 52
#pragma unroll 1
    for (int rep = 0; rep < 2; ++rep) { IDS(); phase_experts(p, lds + wid * 6144, lane, wid, rep == 0 ? (float*)(ws + WS_QKV) : p.out, (rep == 0 && PROBE == 52) ? 2047 : -1); }
#else
    PH(16) { IDS(); phase_experts(p, lds + wid * 6144, lane, wid, p.out, -1); }
#endif
}

extern "C" void kernel_launch(void* const* d_in, const int* in_sizes, int n_in, void* d_out, int out_size, void* d_ws, size_t ws_size, hipStream_t stream) {
    static int grid = 0;
    if (grid == 0) {
        if (n_in != 24 || out_size != NTOK * DM || ws_size < WS_NEED) { fprintf(stderr, "kernel_launch: unexpected problem (n_in %d, out %d, ws %zu)\n", n_in, out_size, ws_size); grid = -1; return; }
        int dev = 0, cus = 0, per_cu = 0;
        if (hipGetDevice(&dev) != hipSuccess || hipDeviceGetAttribute(&cus, hipDeviceAttributeMultiprocessorCount, dev) != hipSuccess) { grid = -1; return; }
        if (hipFuncSetAttribute((const void*)mega_fwd, hipFuncAttributeMaxDynamicSharedMemorySize, LDS_BYTES) != hipSuccess) { fprintf(stderr, "kernel_launch: hipFuncSetAttribute failed\n"); grid = -1; return; }
        if (hipOccupancyMaxActiveBlocksPerMultiprocessor(&per_cu, (const void*)mega_fwd, NTHREADS, LDS_BYTES) != hipSuccess || per_cu < 1) { fprintf(stderr, "kernel_launch: occupancy query says %d\n", per_cu); per_cu = 0; }
        (void)hipGetLastError();
        if (per_cu < 1) { grid = -1; return; }
        grid = cus * 1;
        if (grid < 1) grid = -1;
    }
    if (grid < 0) return;
    Params p{};
    p.x = (const float*)d_in[0]; p.norm1_g = (const float*)d_in[1]; p.w_in = (const float*)d_in[2]; p.rwkv_mu = (const float*)d_in[3];
    p.w0 = (const float*)d_in[4]; p.w_lora_up = (const float*)d_in[5]; p.a0 = (const float*)d_in[6]; p.a_lora_up = (const float*)d_in[7];
    p.g_lora_up = (const float*)d_in[8]; p.k_k = (const float*)d_in[9]; p.k_a = (const float*)d_in[10]; p.r_k = (const float*)d_in[11];
    p.lnx_g = (const float*)d_in[12]; p.lnx_b = (const float*)d_in[13]; p.w_proj_a = (const float*)d_in[14]; p.w_proj_b = (const float*)d_in[15];
    p.w_out = (const float*)d_in[16]; p.norm2_g = (const float*)d_in[17]; p.peer_wq = (const float*)d_in[18]; p.peer_subkeys = (const float*)d_in[19];
    p.peer_u = (const float*)d_in[20]; p.peer_v = (const float*)d_in[21]; p.rel_bias = (const float*)d_in[22]; p.normf_g = (const float*)d_in[23];
    p.out = (float*)d_out; p.ws = (unsigned char*)d_ws;
    if (hipMemsetAsync(d_ws, 0, 65536, stream) != hipSuccess) { fprintf(stderr, "kernel_launch: memset failed\n"); return; }
    void* args[] = {&p};
    hipError_t e = hipLaunchCooperativeKernel((const void*)mega_fwd, dim3(grid), dim3(NTHREADS), args, LDS_BYTES, stream);
    if (e != hipSuccess) fprintf(stderr, "kernel_launch: cooperative launch failed: %s (grid %d)\n", hipGetErrorString(e), grid);
}
```

```cpp
#include <hip/hip_runtime.h>
#include <hip/hip_cooperative_groups.h>
#include <cstdio>
#include <cstdint>
#include <utility>
namespace cg = cooperative_groups;
namespace pg8 {
#define PG8_LAS __attribute__((address_space(3)))
typedef unsigned short bf16_t;
typedef short bf16x8 __attribute__((ext_vector_type(8)));
typedef float f32x4 __attribute__((ext_vector_type(4)));
typedef unsigned u32x4 __attribute__((ext_vector_type(4)));
constexpr int BM = 256, BK = 64, HALF = 128, HTB = HALF * BK * 2  , STAGE_BYTES = 8 * HTB, NXCD = 8, WGM = 8;

__host__ __device__ __forceinline__ int lds_byte(int r, int c) { const int st = (r >> 4) * 2 + (c >> 5), rr = r & 15, cc = c & 31, ob = rr * 64 + cc * 2; return st * 1024 + (ob ^ (((ob >> 9) & 1) << 5)); }
__host__ __device__ __forceinline__ void stage_rc(int b, int& R, int& C) { const int st = b / 1024, sb = b % 1024, swz = sb ^ (((sb >> 9) & 1) << 5); R = (st >> 1) * 16 + swz / 64; C = (st & 1) * 32 + (swz % 64) / 2; }
__host__ __device__ __forceinline__ int perm32(int rho) { const int n = rho >> 4, i = rho & 15; return 8 * (i >> 2) + 4 * n + (i & 3); }

struct Unit { int pm, pn; };
struct Gemm { const bf16_t* A; const bf16_t* Bt; int M, N, K; };

struct StaticOrder {
    int nM, nN, nwg, G, c;
    __host__ __device__ void init(int M, int N, int G_, int c_) { nM = M / BM; nN = N / BM; nwg = nM * nN; G = G_; c = c_; }
    __host__ __device__ bool next(int i, Unit& u) const {
        const long L = (long)i * G + c; if (L >= nwg) return false;
        int wgid = (int)L; { const int q = nwg / NXCD, r = nwg % NXCD, xcd = wgid % NXCD, off = wgid / NXCD; wgid = (xcd < r ? xcd * (q + 1) : r * (q + 1) + (xcd - r) * q) + off; }
        const int nig = WGM * nN, gid = wgid / nig, fm = gid * WGM, gsz = (nM - fm) < WGM ? (nM - fm) : WGM;
        u.pm = fm + ((wgid % nig) % gsz); u.pn = (wgid % nig) / gsz; return true;
    }
    __device__ __forceinline__ void a_ready(const Unit&) const {}
    __device__ __forceinline__ void done(const Unit&) const {}
};
template <class Epi, class Sched, bool ALIGN_EPI = false, bool SP2 = false>
__device__ __forceinline__ void gemm_phase(PG8_LAS unsigned char* lds, const Gemm g, const Sched& S, const Epi& E) {
    int tid_ = (int)threadIdx.x; asm volatile("" : "+v"(tid_));
    const int tid = tid_, wid = __builtin_amdgcn_readfirstlane(tid >> 6), lane = tid & 63, wr = wid >> 2, wc = wid & 3, fr = lane & 15, fq = lane >> 4;
    const int K = g.K, nt = K / BK;
    unsigned voffA[2], voffB[2];
#pragma unroll
    for (int i = 0; i < 2; ++i) { int R, C; stage_rc(tid * 16 + i * 8192, R, C); const int Rb = Epi::PERM ? ((R & ~31) + perm32(R & 31)) : R;
        voffA[i] = (unsigned)(R * K + C) * 2u; voffB[i] = (unsigned)(Rb * K + C) * 2u; }
    const size_t kstep = (size_t)(BK * 2);
    const size_t hstep = (size_t)HALF * K * 2;
    const size_t tstep = 2 * hstep;
    const unsigned ldsw = (unsigned)wid * 1024u;
    const int aoff = lds_byte(wr * 64 + fr, fq * 8), boff = lds_byte(wc * 32 + fr, fq * 8);
#define PG8_SA(b, h) (((b) * 2 + (h)) * HTB)
#define PG8_SB(b, h) ((4 + (b) * 2 + (h)) * HTB)
#define PG8_STAGE(bufoff, gbase, voff) do { _Pragma("unroll") for (int _i = 0; _i < 2; ++_i) \
        __builtin_amdgcn_global_load_lds((const unsigned*)((const char*)(gbase) + (voff)[_i]), (PG8_LAS unsigned*)(lds + (bufoff) + ldsw + _i * 8192), 16, 0, 0); } while (0)
#define PG8_LDA(dst, b, h) do { _Pragma("unroll") for (int m = 0; m < 4; ++m) _Pragma("unroll") for (int k = 0; k < 2; ++k) dst[m][k] = *(const PG8_LAS bf16x8*)(lds + PG8_SA(b, h) + aoff + m * 2048 + k * 1024); } while (0)
#define PG8_LDB(dst, b, h) do { _Pragma("unroll") for (int n = 0; n < 2; ++n) _Pragma("unroll") for (int k = 0; k < 2; ++k) dst[n][k] = *(const PG8_LAS bf16x8*)(lds + PG8_SB(b, h) + boff + n * 2048 + k * 1024); } while (0)
#define PG8_MMA(ai, bj, At, Bt) do { __builtin_amdgcn_s_setprio(1); _Pragma("unroll") for (int m = 0; m < 4; ++m) _Pragma("unroll") for (int n = 0; n < 2; ++n) _Pragma("unroll") for (int k = 0; k < 2; ++k) \
        acc[ai][bj][m][n] = __builtin_amdgcn_mfma_f32_16x16x32_bf16(Bt[n][k], At[m][k], acc[ai][bj][m][n], 0, 0, 0); __builtin_amdgcn_s_setprio(0); } while (0)
#define PG8_WAIT_V(n) asm volatile("s_waitcnt vmcnt(" #n ")" ::: "memory")
#define PG8_WAIT_L(n) asm volatile("s_waitcnt lgkmcnt(" #n ")" ::: "memory")
#define PG8_BAR __builtin_amdgcn_s_barrier()
#define PG8_SCHED __builtin_amdgcn_sched_barrier(0)
    Unit cur, nxt; int ui = 0;
    if (!S.next(0, cur)) return;
    f32x4 acc[2][2][4][2];
#pragma unroll
    for (int a = 0; a < 2; ++a)
#pragma unroll
        for (int b = 0; b < 2; ++b)
#pragma unroll
            for (int m = 0; m < 4; ++m)
#pragma unroll
                for (int n = 0; n < 2; ++n) acc[a][b][m][n] = (f32x4){0.f, 0.f, 0.f, 0.f};
    bf16x8 At[4][2], B0[2][2], B1[2][2];
    const char* cA = (const char*)g.A + (size_t)cur.pm * tstep; const char* cB = (const char*)g.Bt + (size_t)cur.pn * tstep;
    S.a_ready(cur);
    if constexpr (SP2) {
        PG8_STAGE(PG8_SB(0, 0), cB, voffB); PG8_STAGE(PG8_SB(0, 1), cB + hstep, voffB); PG8_STAGE(PG8_SA(0, 0), cA, voffA); PG8_STAGE(PG8_SA(0, 1), cA + hstep, voffA);
        if (wr == 1) PG8_BAR;
        PG8_WAIT_V(2); PG8_BAR;
        PG8_STAGE(PG8_SB(1, 0), cB + kstep, voffB); PG8_STAGE(PG8_SA(1, 0), cA + kstep, voffA); PG8_STAGE(PG8_SB(1, 1), cB + hstep + kstep, voffB);
        PG8_WAIT_V(6); PG8_BAR;
    } else {
        PG8_STAGE(PG8_SB(0, 0), cB, voffB); PG8_STAGE(PG8_SA(0, 0), cA, voffA); PG8_STAGE(PG8_SB(0, 1), cB + hstep, voffB); PG8_STAGE(PG8_SA(0, 1), cA + hstep, voffA);
        if (wr == 1) PG8_BAR;
        PG8_WAIT_V(4); PG8_BAR;
        PG8_STAGE(PG8_SB(1, 0), cB + kstep, voffB); PG8_STAGE(PG8_SA(1, 0), cA + kstep, voffA); PG8_STAGE(PG8_SB(1, 1), cB + hstep + kstep, voffB);
        PG8_WAIT_V(6); PG8_BAR;
    }
    for (;;) {
        const bool has_next = S.next(ui + 1, nxt);
        const char* nA = has_next ? (const char*)g.A + (size_t)nxt.pm * tstep : cA; const char* nB = has_next ? (const char*)g.Bt + (size_t)nxt.pn * tstep : cB;
        for (int t = 0; t < nt; t += 2) {
            const bool last = (t == nt - 2);
            const char* a1 = cA + (size_t)(t + 1) * kstep;
            const char* a2 = last ? nA : cA + (size_t)(t + 2) * kstep; const char* b2 = last ? nB : cB + (size_t)(t + 2) * kstep;
            const char* a3 = a2 + kstep; const char* b3 = b2 + kstep;
            if (last && has_next) S.a_ready(nxt);
            if constexpr (SP2) {
            PG8_LDB(B0, 0, 0); PG8_LDB(B1, 0, 1); PG8_SCHED; PG8_LDA(At, 0, 0); PG8_STAGE(PG8_SA(1, 1), a1 + hstep, voffA);
            PG8_WAIT_V(8); PG8_WAIT_L(0); PG8_BAR; PG8_MMA(0, 0, At, B0); PG8_MMA(0, 1, At, B1); PG8_BAR; PG8_SCHED;
            PG8_LDA(At, 0, 1); PG8_STAGE(PG8_SB(0, 0), b2, voffB); PG8_STAGE(PG8_SB(0, 1), b2 + hstep, voffB); PG8_STAGE(PG8_SA(0, 0), a2, voffA);
            PG8_WAIT_V(8); PG8_WAIT_L(0); PG8_BAR; PG8_MMA(1, 0, At, B0); PG8_MMA(1, 1, At, B1); PG8_BAR; PG8_SCHED;
            PG8_LDB(B0, 1, 0); PG8_LDB(B1, 1, 1); PG8_SCHED; PG8_LDA(At, 1, 0); PG8_STAGE(PG8_SA(0, 1), a2 + hstep, voffA);
            PG8_WAIT_V(8); PG8_WAIT_L(0); PG8_BAR; PG8_MMA(0, 0, At, B0); PG8_MMA(0, 1, At, B1); PG8_BAR; PG8_SCHED;
            PG8_LDA(At, 1, 1); PG8_STAGE(PG8_SB(1, 0), b3, voffB); PG8_STAGE(PG8_SB(1, 1), b3 + hstep, voffB); PG8_STAGE(PG8_SA(1, 0), a3, voffA);
            PG8_WAIT_V(8); PG8_WAIT_L(0); PG8_BAR; PG8_MMA(1, 0, At, B0); PG8_MMA(1, 1, At, B1); PG8_BAR; PG8_SCHED;
            } else {
            PG8_LDB(B0, 0, 0); PG8_SCHED; PG8_LDA(At, 0, 0); PG8_STAGE(PG8_SA(1, 1), a1 + hstep, voffA);
            PG8_WAIT_L(8); PG8_BAR; PG8_WAIT_L(0); PG8_MMA(0, 0, At, B0); PG8_BAR; PG8_SCHED;
            PG8_LDB(B1, 0, 1); PG8_STAGE(PG8_SB(0, 0), b2, voffB);
            PG8_BAR; PG8_WAIT_L(0); PG8_MMA(0, 1, At, B1); PG8_BAR;
            PG8_LDA(At, 0, 1); PG8_STAGE(PG8_SA(0, 0), a2, voffA);
            PG8_BAR; PG8_WAIT_L(0); PG8_MMA(1, 0, At, B0); PG8_BAR; PG8_SCHED;
            PG8_STAGE(PG8_SB(0, 1), b2 + hstep, voffB);
            PG8_WAIT_V(6); PG8_BAR; PG8_MMA(1, 1, At, B1); PG8_BAR;
            PG8_LDB(B0, 1, 0); PG8_SCHED; PG8_LDA(At, 1, 0); PG8_STAGE(PG8_SA(0, 1), a2 + hstep, voffA);
            PG8_WAIT_L(8); PG8_BAR; PG8_WAIT_L(0); PG8_MMA(0, 0, At, B0); PG8_BAR; PG8_SCHED;
            PG8_LDB(B1, 1, 1); PG8_STAGE(PG8_SB(1, 0), b3, voffB);
            PG8_BAR; PG8_WAIT_L(0); PG8_MMA(0, 1, At, B1); PG8_BAR;
            PG8_LDA(At, 1, 1); PG8_STAGE(PG8_SA(1, 0), a3, voffA);
            PG8_BAR; PG8_WAIT_L(0); PG8_MMA(1, 0, At, B0); PG8_BAR; PG8_SCHED;
            PG8_STAGE(PG8_SB(1, 1), b3 + hstep, voffB);
            PG8_WAIT_V(6); PG8_BAR; PG8_MMA(1, 1, At, B1); PG8_BAR;
            }
        }
        if constexpr (ALIGN_EPI) { if (wr == 0) PG8_BAR; }
        if constexpr (!Epi::AFTER_DRAIN) { E(acc, cur, wr, wc, fr, fq); S.done(cur); }
        if (!has_next) break;
#pragma unroll
        for (int a = 0; a < 2; ++a)
#pragma unroll
            for (int b = 0; b < 2; ++b)
#pragma unroll
                for (int m = 0; m < 4; ++m)
#pragma unroll
                    for (int n = 0; n < 2; ++n) acc[a][b][m][n] = (f32x4){0.f, 0.f, 0.f, 0.f};
        cur = nxt; cA = nA; cB = nB; ++ui;
        if constexpr (ALIGN_EPI) { if (wr == 1) PG8_BAR; }
    }
    PG8_WAIT_V(0);
    if constexpr (!ALIGN_EPI) { if (wr == 0) PG8_BAR; }
    PG8_BAR;
    if constexpr (Epi::AFTER_DRAIN) { E.fused(acc, cur, wr, wc, fr, fq, lds, wid, lane); S.done(cur); }
#undef PG8_SA
#undef PG8_SB
#undef PG8_STAGE
#undef PG8_LDA
#undef PG8_LDB
#undef PG8_MMA
#undef PG8_WAIT_V
#undef PG8_WAIT_L
#undef PG8_BAR
#undef PG8_SCHED
}
}

#define DI __device__ __forceinline__
#ifndef PROBE
#define PROBE 0
#endif
#define LAS __attribute__((address_space(3)))
typedef unsigned short bf16_t;
typedef short bf16x8 __attribute__((ext_vector_type(8)));
typedef short s16x4 __attribute__((ext_vector_type(4)));
typedef float f32x4 __attribute__((ext_vector_type(4)));
typedef float f32x2 __attribute__((ext_vector_type(2)));
typedef float f32x16 __attribute__((ext_vector_type(16)));
typedef unsigned u32x4 __attribute__((ext_vector_type(4)));
typedef unsigned u32x2 __attribute__((ext_vector_type(2)));

constexpr int NB = 8, SEQ = 4096, DM = 1024, NTOK = NB * SEQ, NH = 8, HD = 64;
constexpr int QKVW = 1536, PBW = 1824, N1A = 3584, N1A_REAL = 3360, NGATE = 2048, W1ROWS = 5632;
constexpr int G1B_EARLY = 512;
constexpr int NEXP = 16384;
constexpr float RMS_EPS = 1e-6f, GN_EPS = 64e-5f;
constexpr float LOG2E = 1.4426950408889634f;
constexpr int NTHREADS = 512, NWAVES = 8;
constexpr int LDS_BYTES = 148480;
constexpr int LDS_MISC = 147968;

constexpr size_t MiB = 1u << 20;
constexpr size_t WS_W1T = 1 * MiB;
constexpr size_t WS_WPA = 12 * MiB;
constexpr size_t WS_WPB = 13 * MiB;
constexpr size_t WS_WO = 14 * MiB;
constexpr size_t WS_WQ = 16 * MiB;
constexpr size_t WS_SK = 20 * MiB;
constexpr size_t WS_KBAR = 20 * MiB + 512 * 1024;
constexpr size_t WS_SEL = 21 * MiB;
constexpr size_t WS_LWT = 21 * MiB + 512 * 1024;
constexpr size_t WS_XN = 22 * MiB;
constexpr size_t WS_QKV = 86 * MiB;
constexpr size_t WS_PB = 182 * MiB;
constexpr size_t WS_SCAN = 296 * MiB;
constexpr size_t WS_OA = 182 * MiB;
constexpr size_t WS_OBRAW = 262 * MiB;
constexpr size_t WS_OB = 86 * MiB;
constexpr size_t WS_GATES = 296 * MiB;
constexpr size_t WS_U8 = 488 * MiB;
constexpr size_t WS_V8 = 500 * MiB;
constexpr size_t WS_ROWSQ = 497 * MiB;
constexpr size_t WS_RS = 499 * MiB;
constexpr size_t WS_USC = 256 * 1024;
constexpr size_t WS_VSC = 384 * 1024;
constexpr size_t WS_Y = 118 * MiB;
constexpr size_t WS_QP = 182 * MiB;
constexpr size_t WS_PIDX = 310 * MiB;
constexpr size_t WS_PGATE = 326 * MiB;
constexpr size_t WS_NEED = 512 * MiB;
constexpr size_t DO_VT = 0, DO_RG = 32 * MiB, DO_KF = 64 * MiB;

struct Params {
    const float* x; const float* norm1_g; const float* w_in; const float* rwkv_mu; const float* w0; const float* w_lora_up;
    const float* a0; const float* a_lora_up; const float* g_lora_up; const float* k_k; const float* k_a; const float* r_k;
    const float* lnx_g; const float* lnx_b; const float* w_proj_a; const float* w_proj_b; const float* w_out; const float* norm2_g;
    const float* peer_wq; const float* peer_subkeys; const float* peer_u; const float* peer_v; const float* rel_bias; const float* normf_g;
    float* out; unsigned char* ws;
};

DI float bflo(unsigned u) { return __uint_as_float(u << 16); }
DI float bfhi(unsigned u) { return __uint_as_float(u & 0xffff0000u); }
DI float bf2f(bf16_t h) { return __uint_as_float((unsigned)h << 16); }
DI unsigned pk2(float lo, float hi) {
    typedef __bf16 b2 __attribute__((ext_vector_type(2)));
    f32x2 v = {lo, hi}; b2 b = __builtin_convertvector(v, b2); return __builtin_bit_cast(unsigned, b);
}
DI bf16_t f2bf(float f) { return (bf16_t)(pk2(f, 0.f) & 0xffffu); }
DI u32x4 pack8(f32x4 a, f32x4 b) { u32x4 w; w.x = pk2(a[0], a[1]); w.y = pk2(a[2], a[3]); w.z = pk2(b[0], b[1]); w.w = pk2(b[2], b[3]); return w; }
DI void unpack8(u32x4 w, float (&f)[8]) {
    f[0] = bflo(w.x); f[1] = bfhi(w.x); f[2] = bflo(w.y); f[3] = bfhi(w.y); f[4] = bflo(w.z); f[5] = bfhi(w.z); f[6] = bflo(w.w); f[7] = bfhi(w.w);
}
template <int CTRL> DI float dpp_mov(float x) { return __builtin_bit_cast(float, __builtin_amdgcn_update_dpp(0, __builtin_bit_cast(int, x), CTRL, 0xf, 0xf, false)); }
DI float row16_sum(float x) {
    x += dpp_mov<0x128>(x); x += dpp_mov<0x124>(x); x += dpp_mov<0x122>(x); x += dpp_mov<0x121>(x); return x;
}
DI float wave_sum(float v) {
    v = row16_sum(v);
    const float a = __builtin_bit_cast(float, __builtin_amdgcn_readlane(__builtin_bit_cast(int, v), 0)), b = __builtin_bit_cast(float, __builtin_amdgcn_readlane(__builtin_bit_cast(int, v), 16));
    const float c = __builtin_bit_cast(float, __builtin_amdgcn_readlane(__builtin_bit_cast(int, v), 32)), d = __builtin_bit_cast(float, __builtin_amdgcn_readlane(__builtin_bit_cast(int, v), 48));
    return (a + b) + (c + d);
}
DI float vmul_(float a, float b) { float d; asm("v_mul_f32 %0, %1, %2" : "=v"(d) : "v"(a), "v"(b)); return d; }
DI float vfma_(float a, float b, float c) { float d; asm("v_fma_f32 %0, %1, %2, %3" : "=v"(d) : "v"(a), "v"(b), "v"(c)); return d; }
DI float vfnma_(float a, float b, float c) { float d; asm("v_fma_f32 %0, -%1, %2, %3" : "=v"(d) : "v"(a), "v"(b), "v"(c)); return d; }
DI float sigmoidf_(float x) { return __builtin_amdgcn_rcpf(1.0f + __expf(-x)); }
DI int crow(int r, int hi) { return (r & 3) + 8 * (r >> 2) + 4 * hi; }
#define MFMA32(a, b, c) __builtin_amdgcn_mfma_f32_32x32x16_bf16((a), (b), (c), 0, 0, 0)
#define LDS_WAIT() asm volatile("s_waitcnt lgkmcnt(0)" ::: "memory")

#define XB_TMO      128
#define XB_XCNT(j)  (256  + 64 * (j))
#define XB_XSUB(j)  (1280 + 64 * (j))
#define XB_XGEN(j)  (2304 + 64 * (j))
#define XB_TOP      3328
#define XB_TOPGEN   3392
#define XCD_BAR_WORDS 3456
#define XB_SPIN_CAP (1u << 22)

__device__ __forceinline__ unsigned xb_ld(unsigned* p)              { return __hip_atomic_load(p, __ATOMIC_RELAXED, __HIP_MEMORY_SCOPE_AGENT); }
__device__ __forceinline__ unsigned xb_add(unsigned* p, unsigned v) { return __hip_atomic_fetch_add(p, v, __ATOMIC_RELAXED, __HIP_MEMORY_SCOPE_AGENT); }
__device__ __forceinline__ unsigned xb_xcc_id() { return (unsigned)__builtin_amdgcn_s_getreg((3 << 11) | 20) & 0xFu; }
#define XB_SPIN(cond, bar) do { unsigned _sp = 0; while (cond) { __builtin_amdgcn_s_sleep(1); \
    if ((++_sp & 255u) == 0u) { if (xb_ld(&(bar)[XB_TMO])) break; if (_sp > XB_SPIN_CAP) { atomicAdd(&(bar)[XB_TMO], 1u); break; } } } } while (0)

struct XcdBarrier {
    unsigned* bar; unsigned x;
    volatile LAS unsigned* st;
};

__device__ __forceinline__ XcdBarrier xcd_barrier_post(unsigned* bar, volatile LAS unsigned* st) {
    XcdBarrier b; b.bar = bar; b.x = xb_xcc_id(); b.st = st;
    if (threadIdx.x == 0) (void)xb_add(&bar[XB_XCNT(b.x)], 1u);
    return b;
}
__device__ __forceinline__ void xcd_barrier_complete(unsigned* bar, unsigned x, unsigned& nloc, unsigned& nx) {
    const unsigned G = gridDim.x * gridDim.y * gridDim.z;
    unsigned sum, cnt, mine, sp = 0u;
    for (;;) {
        sum = 0u; cnt = 0u; mine = 0u;
#pragma unroll
        for (unsigned j = 0; j < 16; ++j) { const unsigned c = xb_ld(&bar[XB_XCNT(j)]); sum += c; cnt += (c > 0u) ? 1u : 0u; mine = (j == x) ? c : mine; }
        if (sum == G) break;
        __builtin_amdgcn_s_sleep(1);
        if ((++sp & 255u) == 0u) { if (xb_ld(&bar[XB_TMO])) break; if (sp > XB_SPIN_CAP) { atomicAdd(&bar[XB_TMO], 1u); break; } }
    }
    nloc = mine > 0u ? mine : 1u; nx = cnt > 0u ? cnt : 1u;
}

__device__ __forceinline__ void xcd_barrier(const XcdBarrier& b) {
    asm volatile("s_waitcnt vmcnt(0)" ::: "memory");
    __syncthreads();
    if (threadIdx.x == 0) {
        unsigned* bar = b.bar;
        __builtin_amdgcn_s_waitcnt(0);
        unsigned nloc = b.st[0], nx = b.st[1];
        if (nloc == 0u) { xcd_barrier_complete(bar, b.x, nloc, nx); b.st[0] = nloc; b.st[1] = nx; }
        const unsigned old = xb_add(&bar[XB_XSUB(b.x)], 1u);
        const unsigned gen = old / nloc;
        if (old + 1u == (gen + 1u) * nloc) {
            __builtin_amdgcn_fence(__ATOMIC_RELEASE, "agent");
            asm volatile("s_waitcnt vmcnt(0)" ::: "memory");
            const unsigned og = xb_add(&bar[XB_TOP], 1u);
            const unsigned tg = og / nx;
            if (og + 1u == (tg + 1u) * nx) xb_add(&bar[XB_TOPGEN], 1u);
            else XB_SPIN(xb_ld(&bar[XB_TOPGEN]) == tg, bar);
            __builtin_amdgcn_fence(__ATOMIC_ACQUIRE, "agent");
            xb_add(&bar[XB_XGEN(b.x)], 1u);
            asm volatile("s_waitcnt vmcnt(0)" ::: "memory");
        } else {
            XB_SPIN(xb_ld(&bar[XB_XGEN(b.x)]) == gen, bar);
            __builtin_amdgcn_fence(__ATOMIC_ACQUIRE, "agent");
            asm volatile("s_waitcnt vmcnt(0)" ::: "memory");
        }
    }
    __syncthreads();
}


template <class F> struct EpiF {
    static constexpr bool PERM = true, AFTER_DRAIN = false; F f;
    DI void operator()(const pg8::f32x4 (&acc)[2][2][4][2], const pg8::Unit& u, int wr, int wc, int fr, int fq) const {
        const int row0 = u.pm * 256 + wr * 64 + fr, col0 = u.pn * 256 + wc * 32 + 8 * fq;
        const typename F::Tile tl = f.tile(col0);
#pragma unroll
        for (int ai = 0; ai < 2; ++ai) {
            typename F::Pre pre[4][2];
#pragma unroll
            for (int m = 0; m < 4; ++m)
#pragma unroll
                for (int bj = 0; bj < 2; ++bj) pre[m][bj] = f.load(row0 + ai * 128 + m * 16, col0 + bj * 128);
#pragma unroll
            for (int m = 0; m < 4; ++m) {
                float s = 0.f;
#pragma unroll
                for (int bj = 0; bj < 2; ++bj) s += f.apply(row0 + ai * 128 + m * 16, col0 + bj * 128, acc[ai][bj][m][0], acc[ai][bj][m][1], pre[m][bj], tl, bj);
                f.row_end(row0 + ai * 128 + m * 16, s, fq, u.pn * 4 + wc);
            }
        }
    }
};
template <class F> DI void run_gemm(LAS unsigned char* lds, const bf16_t* A, const bf16_t* Bt, int N, int K, const F& f) {
    pg8::Gemm g{A, Bt, NTOK, N, K}; pg8::StaticOrder S; S.init(NTOK, N, (int)gridDim.x, (int)blockIdx.x); EpiF<F> E{f};
    pg8::gemm_phase<EpiF<F>, pg8::StaticOrder, true, true>(lds, g, S, E);
}
template <class F> DI void run_gemm_on(LAS unsigned char* lds, const bf16_t* A, const bf16_t* Bt, int N, int K, const F& f, int nblocks, int myblock) {
    pg8::Gemm g{A, Bt, NTOK, N, K}; pg8::StaticOrder S; S.init(NTOK, N, nblocks, myblock); EpiF<F> E{f};
    pg8::gemm_phase<EpiF<F>, pg8::StaticOrder, true, true>(lds, g, S, E);
}
struct NoPre {}; struct NoTile {};
#define EPI_PLAIN typedef NoTile Tile; DI Tile tile(int) const { return Tile{}; } DI void row_end(int, float, int, int) const {}
struct F1a { bf16_t* qkv; bf16_t* pb; typedef NoPre Pre;
    DI Pre load(int, int) const { return Pre{}; }
    EPI_PLAIN
    DI float apply(int row, int col, f32x4 v0, f32x4 v1, Pre, Tile, int) const {
        const u32x4 w = pack8(v0, v1);
        if (col < QKVW) *(u32x4*)(qkv + (size_t)row * QKVW + col) = w;
        else if (col < N1A_REAL) *(u32x4*)(pb + (size_t)row * PBW + (col - QKVW)) = w;
        return 0.f;
    } };
constexpr int GL_STRIDE = 768;
DI const bf16_t* gate_ptr(const unsigned char* ws, const float* dout, int row, int gcol) {
    if (gcol < G1B_EARLY) return (const bf16_t*)dout + (size_t)row * G1B_EARLY + gcol;
    if (gcol < G1B_EARLY + GL_STRIDE) return (const bf16_t*)(ws + 214 * MiB) + (size_t)row * GL_STRIDE + (gcol - G1B_EARLY);
    return (const bf16_t*)((const unsigned char*)dout + 64 * MiB) + (size_t)row * GL_STRIDE + (gcol - G1B_EARLY - GL_STRIDE);
}
struct F1b { unsigned char* ws; float* dout; int col0; typedef NoPre Pre;
    DI Pre load(int, int) const { return Pre{}; }
    EPI_PLAIN
    DI float apply(int row, int col, f32x4 v0, f32x4 v1, Pre, Tile, int) const {
        f32x4 a, b;
#pragma unroll
        for (int i = 0; i < 4; ++i) { a[i] = sigmoidf_(v0[i]); b[i] = sigmoidf_(v1[i]); }
        *(u32x4*)const_cast<bf16_t*>(gate_ptr(ws, dout, row, col0 + col)) = pack8(a, b);
        return 0.f;
    } };
struct FPa { const unsigned char* ws; const float* dout; bf16_t* y; struct Pre { u32x4 g; };
    DI Pre load(int row, int col) const { return Pre{*(const u32x4*)gate_ptr(ws, dout, row, col)}; }
    EPI_PLAIN
    DI float apply(int row, int col, f32x4 v0, f32x4 v1, Pre pr, Tile, int) const {
        float g[8]; unpack8(pr.g, g);
        f32x4 a, b;
#pragma unroll
        for (int i = 0; i < 4; ++i) { a[i] = v0[i] * g[i]; b[i] = v1[i] * g[4 + i]; }
#if PROBE == 1
        a = (f32x4){0.f, 0.f, 0.f, 0.f}; b = a;
#endif
        *(u32x4*)(y + (size_t)row * DM + col) = pack8(a, b);
        return 0.f;
    } };
struct FPb { const unsigned char* ws; const float* dout; bf16_t* y; struct Pre { u32x4 g, yv; };
    DI Pre load(int row, int col) const { return Pre{*(const u32x4*)gate_ptr(ws, dout, row, DM + col), *(const u32x4*)(y + (size_t)row * DM + col)}; }
    EPI_PLAIN
    DI float apply(int row, int col, f32x4 v0, f32x4 v1, Pre pr, Tile, int) const {
        float g[8]; unpack8(pr.g, g);
        float yo[8]; unpack8(pr.yv, yo);
        f32x4 a, b;
#pragma unroll
        for (int i = 0; i < 4; ++i) { a[i] = yo[i] + v0[i] * g[i]; b[i] = yo[4 + i] + v1[i] * g[4 + i]; }
#if PROBE == 2
#pragma unroll
        for (int i = 0; i < 4; ++i) { a[i] = yo[i]; b[i] = yo[4 + i]; }
#endif
        *(u32x4*)(y + (size_t)row * DM + col) = pack8(a, b);
        return 0.f;
    } };
struct FOut { const float* x; const float* g2; float* h1; bf16_t* xn; float* rowsq; struct Pre { f32x4 x0, x1; }; struct Tile { f32x4 g[2][2]; };
    DI Tile tile(int col0) const { Tile t;
#pragma unroll
        for (int bj = 0; bj < 2; ++bj) { t.g[bj][0] = *(const f32x4*)(g2 + col0 + bj * 128); t.g[bj][1] = *(const f32x4*)(g2 + col0 + bj * 128 + 4); }
        return t; }
    DI Pre load(int row, int col) const { const size_t o = (size_t)row * DM + col; return Pre{*(const f32x4*)(x + o), *(const f32x4*)(x + o + 4)}; }
    DI float apply(int row, int col, f32x4 v0, f32x4 v1, Pre pr, const Tile& tl, int bj) const {
        const size_t o = (size_t)row * DM + col;
        const f32x4 h0 = pr.x0 + v0, h1v = pr.x1 + v1;
        *(f32x4*)(h1 + o) = h0; *(f32x4*)(h1 + o + 4) = h1v;
        *(u32x4*)(xn + o) = pack8(h0 * tl.g[bj][0], h1v * tl.g[bj][1]);
        return (h0[0] * h0[0] + h0[1] * h0[1] + h0[2] * h0[2] + h0[3] * h0[3]) + (h1v[0] * h1v[0] + h1v[1] * h1v[1] + h1v[2] * h1v[2] + h1v[3] * h1v[3]);
    }
    DI void row_end(int row, float s, int fq, int slot) const {
        s += __shfl_xor(s, 16); s += __shfl_xor(s, 32);
        if (fq == 0) rowsq[(size_t)row * 16 + slot] = s;
    } };
DI float row_rs(const float* rowsq, int row) {
    const f32x4 a = *(const f32x4*)(rowsq + (size_t)row * 16), b = *(const f32x4*)(rowsq + (size_t)row * 16 + 4), c = *(const f32x4*)(rowsq + (size_t)row * 16 + 8), d = *(const f32x4*)(rowsq + (size_t)row * 16 + 12);
    const float s = (((a[0] + a[1]) + (a[2] + a[3])) + ((b[0] + b[1]) + (b[2] + b[3]))) + (((c[0] + c[1]) + (c[2] + c[3])) + ((d[0] + d[1]) + (d[2] + d[3])));
    return rsqrtf(s * (1.f / DM) + RMS_EPS);
}
struct FQ { bf16_t* qp; typedef NoPre Pre;
    DI Pre load(int, int) const { return Pre{}; }
    EPI_PLAIN
    DI float apply(int row, int col, f32x4 v0, f32x4 v1, Pre, Tile, int) const {
        u32x4 w = pack8(v0, v1);
#if PROBE == 3
        w.x &= 0xfff8fff8u; w.y &= 0xfff8fff8u; w.z &= 0xfff8fff8u; w.w &= 0xfff8fff8u;
#endif
        *(u32x4*)(qp + (size_t)row * 2048 + col) = w; return 0.f; } };

DI void p0_transpose_item(const float* W, int K, int N, bf16_t* WT, int k0, int n0, int dst_row0, LAS float* scr, int lane) {
#pragma unroll 8
    for (int i = 0; i < 32; ++i) { const int kk = 2 * i + (lane >> 5); scr[kk * 33 + (lane & 31)] = W[(size_t)(k0 + kk) * N + n0 + (lane & 31)]; }
    LDS_WAIT(); asm volatile("" ::: "memory");
    const int c = lane & 7;
#pragma unroll
    for (int j = 0; j < 4; ++j) { const int n = (lane >> 3) + 8 * j; const LAS float* s = scr + (8 * c) * 33 + n;
        u32x4 o; o.x = pk2(s[0 * 33], s[1 * 33]); o.y = pk2(s[2 * 33], s[3 * 33]); o.z = pk2(s[4 * 33], s[5 * 33]); o.w = pk2(s[6 * 33], s[7 * 33]);
        *(u32x4*)(WT + (size_t)(dst_row0 + n) * K + k0 + 8 * c) = o; }
    LDS_WAIT(); asm volatile("" ::: "memory");
}
template <int NR> DI void rms_rows_to_bf16(const float* x, const float* g, bf16_t* o, int m0, int stride, int lane) {
    f32x4 v[NR][4];
#pragma unroll
    for (int r = 0; r < NR; ++r)
#pragma unroll
        for (int j = 0; j < 4; ++j) v[r][j] = *(const f32x4*)(x + (size_t)(m0 + r * stride) * DM + 4 * lane + 256 * j);
    f32x4 gg[4];
#pragma unroll
    for (int j = 0; j < 4; ++j) gg[j] = *(const f32x4*)(g + 4 * lane + 256 * j);
#pragma unroll
    for (int r = 0; r < NR; ++r) {
        float s = 0.f;
#pragma unroll
        for (int j = 0; j < 4; ++j) s += (v[r][j].x * v[r][j].x + v[r][j].y * v[r][j].y) + (v[r][j].z * v[r][j].z + v[r][j].w * v[r][j].w);
        const float rs = rsqrtf(wave_sum(s) * (1.f / DM) + RMS_EPS);
        bf16_t* orow = o + (size_t)(m0 + r * stride) * DM;
#pragma unroll
        for (int j = 0; j < 4; ++j) { u32x2 w; w.x = pk2(v[r][j].x * rs * gg[j].x, v[r][j].y * rs * gg[j].y); w.y = pk2(v[r][j].z * rs * gg[j].z, v[r][j].w * rs * gg[j].w);
            *(u32x2*)(orow + 4 * lane + 256 * j) = w; }
    }
}
DI void rms_all_rows(const float* x, const float* g, bf16_t* o, int lane, int wid) {
    const int gw = blockIdx.x * NWAVES + wid, NGW = gridDim.x * NWAVES;
    int m = gw;
    for (; m + 3 * NGW < NTOK; m += 4 * NGW) rms_rows_to_bf16<4>(x, g, o, m, NGW, lane);
    for (; m < NTOK; m += NGW) rms_rows_to_bf16<1>(x, g, o, m, NGW, lane);
}
DI void phase_prep(const Params& p, LAS unsigned char* lds, int tid, int lane, int wid) {
    unsigned char* ws = p.ws;
    bf16_t* W1T = (bf16_t*)(ws + WS_W1T);
    LAS float* scr = (LAS float*)(lds + wid * 16384);
    const int gw = blockIdx.x * NWAVES + wid, NGW = gridDim.x * NWAVES;
    constexpr int I_IN = 16 * 169, I_PA = 8 * 32, I_PB = 8 * 32, I_O = 16 * 32, I_Q = 16 * 64;
    constexpr int NITEMS = I_IN + I_PA + I_PB + I_O + I_Q;
    for (int it = gw; it < NITEMS; it += NGW) {
        int r = it;
        if (r < I_IN) { const int kb = r / 169, nb = r % 169, n0 = 32 * nb; const int dst = n0 < N1A_REAL ? n0 : n0 + (N1A - N1A_REAL);
            p0_transpose_item(p.w_in, 1024, 5408, W1T, 64 * kb, n0, dst, scr, lane); continue; } r -= I_IN;
        if (r < I_PA) { const int kb = r / 32, nb = r % 32; p0_transpose_item(p.w_proj_a, 512, 1024, (bf16_t*)(ws + WS_WPA), 64 * kb, 32 * nb, 32 * nb, scr, lane); continue; } r -= I_PA;
        if (r < I_PB) { const int kb = r / 32, nb = r % 32; p0_transpose_item(p.w_proj_b, 512, 1024, (bf16_t*)(ws + WS_WPB), 64 * kb, 32 * nb, 32 * nb, scr, lane); continue; } r -= I_PB;
        if (r < I_O) { const int kb = r / 32, nb = r % 32; p0_transpose_item(p.w_out, 1024, 1024, (bf16_t*)(ws + WS_WO), 64 * kb, 32 * nb, 32 * nb, scr, lane); continue; } r -= I_O;
        { const int kb = r / 64, nb = r % 64; p0_transpose_item(p.peer_wq, 1024, 2048, (bf16_t*)(ws + WS_WQ), 64 * kb, 32 * nb, 32 * nb, scr, lane); }
    }
    const int gt = blockIdx.x * NTHREADS + tid, NGT = gridDim.x * NTHREADS;
    { u32x4* z = (u32x4*)(W1T + (size_t)N1A_REAL * 1024); const u32x4 zero = {0u, 0u, 0u, 0u};
      for (int i = gt; i < (N1A - N1A_REAL) * 1024 / 8; i += NGT) z[i] = zero; }
    { bf16_t* SK = (bf16_t*)(ws + WS_SK);
      for (int i = gt; i < 16 * 128 * 128 / 8; i += NGT) { const f32x4 a = *(const f32x4*)(p.peer_subkeys + (size_t)i * 8), b = *(const f32x4*)(p.peer_subkeys + (size_t)i * 8 + 4);
          *(u32x4*)(SK + (size_t)i * 8) = pack8(a, b); } }
    { bf16_t* LWT = (bf16_t*)(ws + WS_LWT);
      for (int e = gt; e < 512 * 288; e += NGT) { const int c = e / 288, i = e - c * 288;
          const float v = i < 64 ? p.w_lora_up[i * 512 + c] : (i < 128 ? p.a_lora_up[(i - 64) * 512 + c] : p.g_lora_up[(i - 128) * 512 + c]);
          LWT[e] = f2bf(v); } }
    rms_all_rows(p.x, p.norm1_g, (bf16_t*)(ws + WS_XN), lane, wid);
}

DI void phase_kbar_vt(const Params& p, LAS unsigned char* lds, int tid, int lane, int wid) {
    unsigned char* ws = p.ws;
    const bf16_t* QKV = (const bf16_t*)(ws + WS_QKV);
    float* KBAR = (float*)(ws + WS_KBAR);
    const int gw = blockIdx.x * NWAVES + wid, NGW = gridDim.x * NWAVES;
    for (int it = gw; it < NB * NH * 16; it += NGW) {
        const int blk = it & 15, h = (it >> 4) & 7, b = it >> 7;
        const int dp = lane & 31, tp = lane >> 5;
        const bf16_t* base = QKV + ((size_t)(b * SEQ + blk * 256)) * QKVW + 512 + h * 64 + 2 * dp;
        float a0 = 0.f, a1 = 0.f;
#pragma unroll 16
        for (int t = tp; t < 256; t += 2) { const unsigned u = *(const unsigned*)(base + (size_t)t * QKVW); a0 += bflo(u); a1 += bfhi(u); }
        a0 += __shfl_xor(a0, 32); a1 += __shfl_xor(a1, 32);
        if (tp == 0) { KBAR[(size_t)it * 64 + 2 * dp] = a0 * (1.f / 256.f); KBAR[(size_t)it * 64 + 2 * dp + 1] = a1 * (1.f / 256.f); }
    }
    LAS bf16_t* tile = (LAS bf16_t*)(lds + wid * 16384);
    unsigned char* KF = (unsigned char*)p.out + DO_KF; unsigned char* VF = (unsigned char*)p.out + DO_VT;
    const int r32 = lane & 31, hi = lane >> 5;
    for (int it = gw; it < NB * NH * 64; it += NGW) {
        const int st = it & 63, bh = it >> 6, b = bh >> 3, h = bh & 7;
        const bf16_t* krow = QKV + ((size_t)(b * SEQ + st * 64 + r32)) * QKVW + 512 + h * 64 + 8 * hi;
        unsigned char* kdst = KF + ((size_t)it * 8) * 1024 + lane * 16;
#pragma unroll
        for (int f = 0; f < 8; ++f) *(u32x4*)(kdst + f * 1024) = *(const u32x4*)(krow + (size_t)(32 * (f & 1)) * QKVW + 16 * (f >> 1));
        const bf16_t* src = QKV + ((size_t)(b * SEQ + st * 64 + lane)) * QKVW + 1024 + h * 64;
#pragma unroll
        for (int c = 0; c < 8; ++c) *(LAS u32x4*)(tile + lane * 72 + c * 8) = *(const u32x4*)(src + c * 8);
        LDS_WAIT(); asm volatile("" ::: "memory");
        unsigned char* vdst = VF + ((size_t)it * 8) * 1024 + lane * 16;
#pragma unroll
        for (int f = 0; f < 8; ++f) {
            const int dt = f >> 2, sx = f & 3, d = 32 * dt + r32, k0 = 16 * sx + 4 * hi;
            u32x4 w;
            w.x = (unsigned)tile[(k0 + 0) * 72 + d] | ((unsigned)tile[(k0 + 1) * 72 + d] << 16);
            w.y = (unsigned)tile[(k0 + 2) * 72 + d] | ((unsigned)tile[(k0 + 3) * 72 + d] << 16);
            w.z = (unsigned)tile[(k0 + 8) * 72 + d] | ((unsigned)tile[(k0 + 9) * 72 + d] << 16);
            w.w = (unsigned)tile[(k0 + 10) * 72 + d] | ((unsigned)tile[(k0 + 11) * 72 + d] << 16);
            *(u32x4*)(vdst + f * 1024) = w;
        }
        LDS_WAIT(); asm volatile("" ::: "memory");
    }
}

DI float softplusf_(float x) { return fmaxf(x, 0.f) + log1pf(__expf(-fabsf(x))); }
DI void phase_rwkv_prep(const Params& p, LAS unsigned char* lds, int tid, int lane, int wid) {
    unsigned char* ws = p.ws;
    const bf16_t* PB = (const bf16_t*)(ws + WS_PB);
    bf16_t* SCAN = (bf16_t*)(ws + WS_SCAN);
    bf16_t* RG = (bf16_t*)((unsigned char*)p.out + DO_RG);
    LAS float* xs = (LAS float*)lds;
    const int c = tid, h = wid, j = lane;
    const float mu_r = p.rwkv_mu[c], mu_k = p.rwkv_mu[512 + c], mu_v = p.rwkv_mu[1024 + c];
    const float w0c = p.w0[c], a0c = p.a0[c], kkc = p.k_k[c], kac = p.k_a[c];
    for (int tt = blockIdx.x; tt < NTOK / 32; tt += gridDim.x) {
        const int t0 = tt * 32;
        __syncthreads();
        for (int e = tid; e < 32 * 288; e += NTHREADS) {
            const int t = e / 288, i = e - t * 288, tok = t0 + t, col = 1536 + i;
            const float cur = bf2f(PB[(size_t)tok * PBW + col]);
            const float prv = (tok & (SEQ - 1)) ? bf2f(PB[(size_t)(tok - 1) * PBW + col]) : 0.f;
            float v = cur + p.rwkv_mu[col] * (prv - cur);
            if (i < 64) v = tanhf(v); else if (i >= 128) v = sigmoidf_(v);
            xs[i * 36 + t] = v;
        }
        __syncthreads();
        float wl[32], al[32], gl[32];
#pragma unroll
        for (int t = 0; t < 32; ++t) { wl[t] = 0.f; al[t] = 0.f; gl[t] = 0.f; }
        for (int i = 0; i < 64; ++i) {
            const float ww = p.w_lora_up[i * 512 + c], wa = p.a_lora_up[i * 512 + c];
#pragma unroll
            for (int t4 = 0; t4 < 8; ++t4) { const f32x4 xw = *(const LAS f32x4*)(xs + i * 36 + 4 * t4), xa = *(const LAS f32x4*)(xs + (64 + i) * 36 + 4 * t4);
#pragma unroll
                for (int q = 0; q < 4; ++q) { wl[4 * t4 + q] += ww * xw[q]; al[4 * t4 + q] += wa * xa[q]; } }
        }
        for (int i = 0; i < 160; ++i) {
            const float wg = p.g_lora_up[i * 512 + c];
#pragma unroll
            for (int t4 = 0; t4 < 8; ++t4) { const f32x4 xg = *(const LAS f32x4*)(xs + (128 + i) * 36 + 4 * t4);
#pragma unroll
                for (int q = 0; q < 4; ++q) gl[4 * t4 + q] += wg * xg[q]; }
        }
#pragma unroll
        for (int t = 0; t < 32; ++t) {
            const int tok = t0 + t, b = tok >> 12, s = tok & (SEQ - 1);
            const bf16_t* row = PB + (size_t)tok * PBW;
            float r = bf2f(row[c]), k = bf2f(row[512 + c]), v = bf2f(row[1024 + c]);
            float rp = 0.f, kp = 0.f, vp = 0.f;
            if (s) { const bf16_t* prow = row - PBW; rp = bf2f(prow[c]); kp = bf2f(prow[512 + c]); vp = bf2f(prow[1024 + c]); }
            r += mu_r * (rp - r); k += mu_k * (kp - k); v += mu_v * (vp - v);
            const float wv = w0c + wl[t];
            const float w = -softplusf_(-wv) - 0.5f;
            const float ew = __expf(w);
            const float omd = -expm1f(-ew);
            const float a = sigmoidf_(a0c + al[t]);
            const float kkv = k * kkc;
            const float nrm = sqrtf(wave_sum(kkv * kkv));
            const float kkn = kkv / fmaxf(nrm, 1e-12f);
            const float kmod = k * (1.f + (a - 1.f) * kac);
            const float bb = kkn * a;
            bf16_t* so = SCAN + ((size_t)((b * NH + h) * SEQ + s)) * 384 + j;
            so[0] = f2bf(omd); so[64] = f2bf(kkn); so[128] = f2bf(bb); so[192] = f2bf(kmod); so[256] = f2bf(r); so[320] = f2bf(v);
            RG[(size_t)tok * 512 + c] = f2bf(gl[t]);
        }
    }
}


DI float fast_tanh(float x) { const float e = __expf(2.f * x); return 1.f - 2.f / (e + 1.f); }
constexpr int RP_ACT = 0, RP_CONST = 19456, RP_TILE = 33792, RP_PITCH = 3080;
template <bool STORE> DI void phase_rwkv_prep2(const Params& p, LAS unsigned char* lds, int tid, int lane, int wid) {
    unsigned char* ws = p.ws;
    const bf16_t* PB = (const bf16_t*)(ws + WS_PB);
    const bf16_t* LWT = (const bf16_t*)(ws + WS_LWT);
    bf16_t* SCAN = (bf16_t*)(ws + WS_SCAN);
    bf16_t* RG = (bf16_t*)((unsigned char*)p.out + DO_RG);
    LAS bf16_t* act = (LAS bf16_t*)(lds + RP_ACT);
    LAS float* cst = (LAS float*)(lds + RP_CONST);
    LAS unsigned char* tile = lds + RP_TILE;
    const int r32 = lane & 31, hi = lane >> 5, h = wid;
    __syncthreads();
    cst[tid] = p.rwkv_mu[tid]; cst[512 + tid] = p.rwkv_mu[512 + tid]; cst[1024 + tid] = p.rwkv_mu[1024 + tid];
    cst[1536 + tid] = p.w0[tid]; cst[2048 + tid] = p.a0[tid]; cst[2560 + tid] = p.k_k[tid]; cst[3072 + tid] = p.k_a[tid];
    for (int tt = blockIdx.x; tt < NTOK / 32; tt += gridDim.x) {
        const int t0 = tt * 32;
        const bool first = (t0 & (SEQ - 1)) == 0;
        __syncthreads();
        u32x4 tw[13];
#pragma unroll
        for (int k = 0; k < 13; ++k) { const int e = tid + NTHREADS * k, row = e / 192, pc = e - row * 192;
            tw[k] = (u32x4){0u, 0u, 0u, 0u};
            if (e < 33 * 192 && !(first && row == 0)) tw[k] = *(const u32x4*)(PB + (size_t)(t0 - 1 + row) * PBW + pc * 8); }
#pragma unroll 3
        for (int e = tid; e < 32 * 144; e += NTHREADS) {
            const int t = e / 144, ip = e - t * 144, i = 2 * ip, tok = t0 + t, col = 1536 + i;
            const unsigned cu = *(const unsigned*)(PB + (size_t)tok * PBW + col);
            const unsigned pu = (tok & (SEQ - 1)) ? *(const unsigned*)(PB + (size_t)(tok - 1) * PBW + col) : 0u;
            const f32x2 mu = *(const f32x2*)(p.rwkv_mu + col);
            float v0 = bflo(cu), v1 = bfhi(cu);
            v0 += mu.x * (bflo(pu) - v0); v1 += mu.y * (bfhi(pu) - v1);
            if (i < 64) { v0 = fast_tanh(v0); v1 = fast_tanh(v1); } else if (i >= 128) { v0 = sigmoidf_(v0); v1 = sigmoidf_(v1); }
            *(LAS unsigned*)(act + t * 296 + i) = pk2(v0, v1);
        }
#pragma unroll
        for (int k = 0; k < 13; ++k) { const int e = tid + NTHREADS * k, row = e / 192, pc = e - row * 192;
            if (e < 33 * 192) { LAS unsigned char* d = tile + row * RP_PITCH + pc * 16;
                *(LAS u32x2*)d = (u32x2){tw[k].x, tw[k].y}; *(LAS u32x2*)(d + 8) = (u32x2){tw[k].z, tw[k].w}; } }
        __syncthreads();
        f32x16 Xw[2], Xa[2], Xg[2];
        const int prow_ch = 16 * ((r32 >> 2) & 1) + 4 * (r32 >> 3) + (r32 & 3);
#pragma unroll
        for (int ct = 0; ct < 2; ++ct) {
#pragma unroll
            for (int i = 0; i < 16; ++i) { Xw[ct][i] = 0.f; Xa[ct][i] = 0.f; Xg[ct][i] = 0.f; }
            const bf16_t* wrow = LWT + (size_t)(h * 64 + 32 * ct + prow_ch) * 288 + 8 * hi;
            const LAS bf16_t* arow = act + r32 * 296 + 8 * hi;
#pragma unroll
            for (int ks = 0; ks < 18; ++ks) {
                const bf16x8 a = *(const bf16x8*)(wrow + 16 * ks);
                const bf16x8 b = *(const LAS bf16x8*)(arow + 16 * ks);
                if (ks < 4) Xw[ct] = MFMA32(a, b, Xw[ct]); else if (ks < 8) Xa[ct] = MFMA32(a, b, Xa[ct]); else Xg[ct] = MFMA32(a, b, Xg[ct]);
            }
        }
        const int tok = t0 + r32, bb_ = tok >> 12, s = tok & (SEQ - 1);
        if (STORE) {
#pragma unroll
            for (int ct = 0; ct < 2; ++ct) { bf16_t* rgp = RG + (size_t)tok * 512 + h * 64 + 32 * ct + 16 * hi;
                *(u32x4*)rgp = (u32x4){pk2(Xg[ct][0], Xg[ct][1]), pk2(Xg[ct][2], Xg[ct][3]), pk2(Xg[ct][4], Xg[ct][5]), pk2(Xg[ct][6], Xg[ct][7])};
                *(u32x4*)(rgp + 8) = (u32x4){pk2(Xg[ct][8], Xg[ct][9]), pk2(Xg[ct][10], Xg[ct][11]), pk2(Xg[ct][12], Xg[ct][13]), pk2(Xg[ct][14], Xg[ct][15])}; }
        }
        const LAS unsigned char* prow = tile + r32 * RP_PITCH;
        bf16_t* so = SCAN + ((size_t)((bb_ * NH + h) * SEQ + s)) * 384;
        unsigned kka[32]; float ss = 0.f;
#pragma unroll
        for (int ct = 0; ct < 2; ++ct) {
            const int j0 = 32 * ct + 16 * hi, c0 = h * 64 + j0;
#pragma unroll
            for (int gp = 0; gp < 2; ++gp) {
            unsigned om[4], km[4], rr[4], vv[4];
#pragma unroll
            for (int gq = 0; gq < 2; ++gq) {
                const int g = 2 * gp + gq;
                const int cg = c0 + 4 * g;
                const u32x2 rp = *(const LAS u32x2*)(prow + cg * 2), kp = *(const LAS u32x2*)(prow + 1024 + cg * 2), vp = *(const LAS u32x2*)(prow + 2048 + cg * 2);
                const u32x2 rc = *(const LAS u32x2*)(prow + RP_PITCH + cg * 2), kc = *(const LAS u32x2*)(prow + RP_PITCH + 1024 + cg * 2), vc = *(const LAS u32x2*)(prow + RP_PITCH + 2048 + cg * 2);
                const f32x4 mur = *(const LAS f32x4*)(cst + cg), muk = *(const LAS f32x4*)(cst + 512 + cg), muv = *(const LAS f32x4*)(cst + 1024 + cg);
                const f32x4 w0v = *(const LAS f32x4*)(cst + 1536 + cg), a0v = *(const LAS f32x4*)(cst + 2048 + cg), kkc = *(const LAS f32x4*)(cst + 2560 + cg), kac = *(const LAS f32x4*)(cst + 3072 + cg);
                const float rcf[4] = {bflo(rc.x), bfhi(rc.x), bflo(rc.y), bfhi(rc.y)}, rpf[4] = {bflo(rp.x), bfhi(rp.x), bflo(rp.y), bfhi(rp.y)};
                const float kcf[4] = {bflo(kc.x), bfhi(kc.x), bflo(kc.y), bfhi(kc.y)}, kpf[4] = {bflo(kp.x), bfhi(kp.x), bflo(kp.y), bfhi(kp.y)};
                const float vcf[4] = {bflo(vc.x), bfhi(vc.x), bflo(vc.y), bfhi(vc.y)}, vpf[4] = {bflo(vp.x), bfhi(vp.x), bflo(vp.y), bfhi(vp.y)};
                float r4[4], k4[4], v4[4], o4[4], m4[4];
#pragma unroll
                for (int q = 0; q < 4; ++q) {
                    const int ri = 4 * g + q;
                    r4[q] = rcf[q] + mur[q] * (rpf[q] - rcf[q]);
                    k4[q] = kcf[q] + muk[q] * (kpf[q] - kcf[q]);
                    v4[q] = vcf[q] + muv[q] * (vpf[q] - vcf[q]);
                    const float wv = w0v[q] + Xw[ct][ri];
                    const float z = -wv;
                    const float sp = fmaxf(z, 0.f) + __logf(1.f + __expf(-fabsf(z)));
                    const float ew = __expf(-sp - 0.5f);
                    o4[q] = 1.f - __expf(-ew);
                    const float a = __builtin_amdgcn_rcpf(1.f + __expf(-(a0v[q] + Xa[ct][ri])));
                    m4[q] = k4[q] * (1.f + (a - 1.f) * kac[q]);
                    const float kv = k4[q] * kkc[q];
                    kka[16 * ct + ri] = pk2(kv, a); ss += kv * kv;
                }
                om[2 * gq] = pk2(o4[0], o4[1]); om[2 * gq + 1] = pk2(o4[2], o4[3]);
                km[2 * gq] = pk2(m4[0], m4[1]); km[2 * gq + 1] = pk2(m4[2], m4[3]);
                rr[2 * gq] = pk2(r4[0], r4[1]); rr[2 * gq + 1] = pk2(r4[2], r4[3]);
                vv[2 * gq] = pk2(v4[0], v4[1]); vv[2 * gq + 1] = pk2(v4[2], v4[3]);
            }
            if (STORE) {
                const int j8 = j0 + 8 * gp;
                *(u32x4*)(so + 0 * 64 + j8) = (u32x4){om[0], om[1], om[2], om[3]};
                *(u32x4*)(so + 3 * 64 + j8) = (u32x4){km[0], km[1], km[2], km[3]};
                *(u32x4*)(so + 4 * 64 + j8) = (u32x4){rr[0], rr[1], rr[2], rr[3]};
                *(u32x4*)(so + 5 * 64 + j8) = (u32x4){vv[0], vv[1], vv[2], vv[3]};
            }
            }
        }
        ss += __shfl_xor(ss, 32);
        const float inv = 1.f / fmaxf(sqrtf(ss), 1e-12f);
#pragma unroll
        for (int ct = 0; ct < 2; ++ct) {
            const int j0 = 32 * ct + 16 * hi;
            unsigned kn[8], bq[8];
#pragma unroll
            for (int i = 0; i < 8; ++i) {
                const unsigned u0 = kka[16 * ct + 2 * i], u1 = kka[16 * ct + 2 * i + 1];
                const float k0 = bflo(u0) * inv, k1 = bflo(u1) * inv;
                kn[i] = pk2(k0, k1); bq[i] = pk2(k0 * bfhi(u0), k1 * bfhi(u1));
            }
            if (STORE) {
                *(u32x4*)(so + 1 * 64 + j0) = (u32x4){kn[0], kn[1], kn[2], kn[3]}; *(u32x4*)(so + 1 * 64 + j0 + 8) = (u32x4){kn[4], kn[5], kn[6], kn[7]};
                *(u32x4*)(so + 2 * 64 + j0) = (u32x4){bq[0], bq[1], bq[2], bq[3]}; *(u32x4*)(so + 2 * 64 + j0 + 8) = (u32x4){bq[4], bq[5], bq[6], bq[7]};
            }
        }
    }
}

DI void phase_select(const Params& p, int tid) {
    unsigned char* ws = p.ws;
    const bf16_t* QKV = (const bf16_t*)(ws + WS_QKV);
    const float* KBAR = (const float*)(ws + WS_KBAR);
    unsigned short* SEL = (unsigned short*)(ws + WS_SEL);
    const int gt = blockIdx.x * NTHREADS + tid, NGT = gridDim.x * NTHREADS;
    for (int it = gt; it < NB * NH * SEQ; it += NGT) {
        const int s = it & (SEQ - 1), bh = it >> 12, b = bh >> 3, h = bh & 7, blk = s >> 8;
        unsigned mask = 0u;
        if (blk > 0) {
            float q[64];
            const bf16_t* qp = QKV + ((size_t)(b * SEQ + s)) * QKVW + h * 64;
#pragma unroll
            for (int c = 0; c < 8; ++c) { const u32x4 w = *(const u32x4*)(qp + c * 8); float f[8]; unpack8(w, f);
#pragma unroll
                for (int i = 0; i < 8; ++i) q[c * 8 + i] = f[i]; }
            float v1 = -INFINITY, v2 = -INFINITY, v3 = -INFINITY; int i1 = -1, i2 = -1, i3 = -1;
            for (int jb = 0; jb < blk; ++jb) {
                const float* kb = KBAR + ((size_t)(bh * 16 + jb)) * 64;
                float g = 0.f;
#pragma unroll
                for (int d = 0; d < 64; d += 4) { const f32x4 kk = *(const f32x4*)(kb + d); g += q[d] * kk.x + q[d + 1] * kk.y + q[d + 2] * kk.z + q[d + 3] * kk.w; }
                if (g > v1) { v3 = v2; i3 = i2; v2 = v1; i2 = i1; v1 = g; i1 = jb; }
                else if (g > v2) { v3 = v2; i3 = i2; v2 = g; i2 = jb; }
                else if (g > v3) { v3 = g; i3 = jb; }
            }
            if (i1 >= 0) mask |= 1u << i1;
            if (i2 >= 0) mask |= 1u << i2;
            if (i3 >= 0) mask |= 1u << i3;
        }
        SEL[it] = (unsigned short)mask;
    }
}

constexpr int CK = 32, NCHUNK = SEQ / CK, ITEM_BYTES = 24576;
constexpr int IT_G1 = 0, IT_H1 = 4096, IT_QT = 12288, IT_OV = 20480;
DI unsigned char* chk_base(const Params& p, int chain) {
    const int q = chain >> 4;
    unsigned char* base = q == 0 ? p.ws + 86 * MiB : (q == 1 ? p.ws + 134 * MiB : (q == 2 ? p.ws + 214 * MiB : (unsigned char*)p.out + 64 * MiB));
    return base + (size_t)(chain & 15) * NCHUNK * ITEM_BYTES;
}
DI bf16x8 pack_acc(const f32x16& x, int s) {
    u32x4 w; w.x = pk2(x[8 * s], x[8 * s + 1]); w.y = pk2(x[8 * s + 2], x[8 * s + 3]); w.z = pk2(x[8 * s + 4], x[8 * s + 5]); w.w = pk2(x[8 * s + 6], x[8 * s + 7]);
    return __builtin_bit_cast(bf16x8, w);
}
DI void store_acc_bf16(unsigned char* dst, const f32x16& x) {
    u32x4 a, b; a.x = pk2(x[0], x[1]); a.y = pk2(x[2], x[3]); a.z = pk2(x[4], x[5]); a.w = pk2(x[6], x[7]);
    b.x = pk2(x[8], x[9]); b.y = pk2(x[10], x[11]); b.z = pk2(x[12], x[13]); b.w = pk2(x[14], x[15]);
    *(u32x4*)dst = a; *(u32x4*)(dst + 16) = b;
}
template <int T> DI void subst_step2(float (&x1)[32], float (&x2)[32], const float y1T, const LAS unsigned char* wl, const LAS unsigned char* y2row) {
    float p0 = y1T, p1 = 0.f, p2 = 0.f, p3 = 0.f, q0, q1 = 0.f, q2 = 0.f, q3 = 0.f;
    unsigned z = 0u;
    if (T > 0) asm("v_and_b32 %0, 0, %1" : "=v"(z) : "v"(__float_as_uint(x1[T > 0 ? T - 1 : 0]) | __float_as_uint(x2[T > 0 ? T - 1 : 0])));
    q0 = *(const LAS float*)(y2row + T * 4 + z);
    if (T > 0) {
        const LAS unsigned char* rowp = wl + T * 768 + z;
#pragma unroll
        for (int s4 = 0; s4 < (T + 3) / 4; ++s4) {
            const f32x4 mm = *(const LAS f32x4*)(rowp + s4 * 16);
            if (4 * s4 + 0 < T) { p0 -= x1[4 * s4 + 0] * mm.x; q0 -= x2[4 * s4 + 0] * mm.x; }
            if (4 * s4 + 1 < T) { p1 -= x1[(4 * s4 + 1) & 31] * mm.y; q1 -= x2[(4 * s4 + 1) & 31] * mm.y; }
            if (4 * s4 + 2 < T) { p2 -= x1[(4 * s4 + 2) & 31] * mm.z; q2 -= x2[(4 * s4 + 2) & 31] * mm.z; }
            if (4 * s4 + 3 < T) { p3 -= x1[(4 * s4 + 3) & 31] * mm.w; q3 -= x2[(4 * s4 + 3) & 31] * mm.w; }
        }
    }
    x1[T] = (p0 + p1) + (p2 + p3); x2[T] = (q0 + q1) + (q2 + q3);
}
template <int... Ts> DI void subst_all2(float (&x1)[32], float (&x2)[32], const float (&y1)[32], const LAS unsigned char* wl, const LAS unsigned char* y2row, std::integer_sequence<int, Ts...>) {
    (subst_step2<Ts>(x1, x2, y1[Ts], wl, y2row), ...);
}
#ifndef CPSTAGE
#define CPSTAGE 4
#endif
DI void unpack_acc_bf16(const LAS unsigned char* src, f32x16& x) {
    const u32x4 a = *(const LAS u32x4*)src, b = *(const LAS u32x4*)(src + 16);
    x[0] = bflo(a.x); x[1] = bfhi(a.x); x[2] = bflo(a.y); x[3] = bfhi(a.y); x[4] = bflo(a.z); x[5] = bfhi(a.z); x[6] = bflo(a.w); x[7] = bfhi(a.w);
    x[8] = bflo(b.x); x[9] = bfhi(b.x); x[10] = bflo(b.y); x[11] = bfhi(b.y); x[12] = bflo(b.z); x[13] = bfhi(b.z); x[14] = bflo(b.w); x[15] = bfhi(b.w);
}
constexpr int CPW = 36864;
constexpr int CP_BT = 24576, CP_KT = 28672, CP_VT = 32768;
template <int STG> DI void phase_chunkprep(const Params& p, LAS unsigned char* lds, int lane, int wid) {
    if (wid >= 4) return;
    unsigned char* ws = p.ws;
    const bf16_t* SCAN = (const bf16_t*)(ws + WS_SCAN);
    LAS unsigned char* wl = lds + wid * CPW;
    const int r32 = lane & 31, hi = lane >> 5, j = lane;
    for (int item = blockIdx.x * 4 + wid; item < 64 * NCHUNK; item += gridDim.x * 4) {
        const int chain = item >> 7, c = item & (NCHUNK - 1);
        const unsigned char* src = (const unsigned char*)(SCAN + ((size_t)chain * SEQ + (size_t)c * CK) * 384);
        unsigned char* dst = chk_base(p, chain) + (size_t)c * ITEM_BYTES;
        unsigned char* dl16 = dst + lane * 16; unsigned char* dl32 = dst + lane * 32;
        {
            u32x4 w[24];
#pragma unroll
            for (int k = 0; k < 24; ++k) w[k] = *(const u32x4*)(src + (size_t)(k * 64 + lane) * 16);
#pragma unroll
            for (int k = 0; k < 24; ++k) *(LAS u32x4*)(wl + (k * 64 + lane) * 16) = w[k];
        }
        LDS_WAIT(); asm volatile("" ::: "memory");
        float al[32]; float g = 1.f;
        {
            unsigned bt[16], kt[16], vt[16];
#pragma unroll
            for (int t = 0; t < 32; ++t) {
                LAS bf16_t* row = (LAS bf16_t*)(wl + t * 768);
                const float omd = bf2f(row[j]), kkv = bf2f(row[64 + j]), bv = bf2f(row[128 + j]), kmv = bf2f(row[192 + j]), rv = bf2f(row[256 + j]);
                const unsigned vraw = row[320 + j];
                const float gprev = g; g = g * (1.f - omd);
                const float ig = __builtin_amdgcn_rcpf(g);
                const float a_ = gprev * kkv, be = bv * ig, ka = kmv * ig, rh = g * rv;
                al[t] = a_;
                const unsigned beb = f2bf(be), kab = f2bf(ka);
                row[64 + j] = f2bf(a_); row[128 + j] = (bf16_t)beb; row[192 + j] = (bf16_t)kab; row[256 + j] = f2bf(rh);
                if (t & 1) { bt[t >> 1] |= beb << 16; kt[t >> 1] |= kab << 16; vt[t >> 1] |= vraw << 16; }
                else { bt[t >> 1] = beb; kt[t >> 1] = kab; vt[t >> 1] = vraw; }
                if ((t & 3) == 3) asm volatile("" ::: "memory");
            }
#pragma unroll
            for (int q = 0; q < 4; ++q) {
                *(LAS u32x4*)(wl + CP_BT + j * 64 + q * 16) = (u32x4){bt[4 * q], bt[4 * q + 1], bt[4 * q + 2], bt[4 * q + 3]};
                *(LAS u32x4*)(wl + CP_KT + j * 64 + q * 16) = (u32x4){kt[4 * q], kt[4 * q + 1], kt[4 * q + 2], kt[4 * q + 3]};
                *(LAS u32x4*)(wl + CP_VT + j * 64 + q * 16) = (u32x4){vt[4 * q], vt[4 * q + 1], vt[4 * q + 2], vt[4 * q + 3]};
            }
        }
        LDS_WAIT(); asm volatile("" ::: "memory");
        if (STG >= 2) {
        {
            f32x16 Mba, Mka, Nbr, Nkr;
#pragma unroll
            for (int i = 0; i < 16; ++i) { Mba[i] = 0.f; Mka[i] = 0.f; Nkr[i] = 0.f; Nbr[i] = 0.f; }
#pragma unroll
            for (int ks = 0; ks < 4; ++ks) {
                const LAS unsigned char* rp = wl + r32 * 768 + (16 * ks + 8 * hi) * 2;
                const bf16x8 ab = *(const LAS bf16x8*)(rp + 2 * 128), ak = *(const LAS bf16x8*)(rp + 3 * 128);
                const bf16x8 ba = *(const LAS bf16x8*)(rp + 1 * 128), br = *(const LAS bf16x8*)(rp + 4 * 128);
                Mba = MFMA32(ab, ba, Mba); Mka = MFMA32(ak, ba, Mka); Nkr = MFMA32(ak, br, Nkr); Nbr = MFMA32(ab, br, Nbr);
            }
#pragma unroll
            for (int r = 0; r < 16; ++r) { const int sr = crow(r, hi);
                if (!(sr < r32)) { Mba[r] = 0.f; Mka[r] = 0.f; }
                if (!(sr <= r32)) { Nkr[r] = 0.f; Nbr[r] = 0.f; } }
            LDS_WAIT(); asm volatile("" ::: "memory");
#pragma unroll
            for (int g4 = 0; g4 < 4; ++g4) {
                *(LAS f32x4*)(wl + r32 * 768 + 0 * 128 + (8 * g4 + 4 * hi) * 4) = (f32x4){Mba[4 * g4], Mba[4 * g4 + 1], Mba[4 * g4 + 2], Mba[4 * g4 + 3]};
                *(LAS u32x2*)(wl + r32 * 768 + 1 * 128 + (8 * g4 + 4 * hi) * 2) = (u32x2){pk2(Nbr[4 * g4], Nbr[4 * g4 + 1]), pk2(Nbr[4 * g4 + 2], Nbr[4 * g4 + 3])};
            }
#pragma unroll
            for (int r = 0; r < 16; ++r) *(LAS float*)(wl + crow(r, hi) * 768 + 5 * 128 + r32 * 4) = Mka[r];
            *(LAS float*)(wl + (j >> 4) * 768 + 1 * 128 + 64 + (j & 15) * 4) = g;
            { LAS unsigned char* np = wl + (lane >> 1) * 768 + 3 * 128 + 64 + (lane & 1) * 32;
              *(LAS u32x4*)np = (u32x4){pk2(Nkr[0], Nkr[1]), pk2(Nkr[2], Nkr[3]), pk2(Nkr[4], Nkr[5]), pk2(Nkr[6], Nkr[7])};
              *(LAS u32x4*)(np + 16) = (u32x4){pk2(Nkr[8], Nkr[9]), pk2(Nkr[10], Nkr[11]), pk2(Nkr[12], Nkr[13]), pk2(Nkr[14], Nkr[15])}; }
        }
        LDS_WAIT(); asm volatile("" ::: "memory");
        }
        if (STG >= 3) {
        {
            float x1[32], x2[32];
            subst_all2(x1, x2, al, wl, wl + r32 * 768 + 5 * 128, std::make_integer_sequence<int, 32>{});
            LAS unsigned char* w1p = wl + (j >> 1) * 768 + 2 * 128 + (j & 1) * 64;
            LAS unsigned char* w2p = wl + r32 * 768 + 3 * 128;
#pragma unroll
            for (int q = 0; q < 4; ++q) {
                *(LAS u32x4*)(w1p + q * 16) = (u32x4){pk2(-x1[8 * q], -x1[8 * q + 1]), pk2(-x1[8 * q + 2], -x1[8 * q + 3]), pk2(-x1[8 * q + 4], -x1[8 * q + 5]), pk2(-x1[8 * q + 6], -x1[8 * q + 7])};
                if (hi == 0) *(LAS u32x4*)(w2p + q * 16) = (u32x4){pk2(-x2[8 * q], -x2[8 * q + 1]), pk2(-x2[8 * q + 2], -x2[8 * q + 3]), pk2(-x2[8 * q + 4], -x2[8 * q + 5]), pk2(-x2[8 * q + 6], -x2[8 * q + 7])};
            }
        }
        LDS_WAIT(); asm volatile("" ::: "memory");
        }
        if (STG >= 4) {
#define CP_A1(jt, ks) (*(const LAS bf16x8*)(wl + (16 * (jt) + (r32 >> 1)) * 768 + 2 * 128 + (r32 & 1) * 64 + (16 * (ks) + 8 * hi) * 2))
#define CP_A2(ks) (*(const LAS bf16x8*)(wl + r32 * 768 + 3 * 128 + (16 * (ks) + 8 * hi) * 2))
#define CP_BN(ks) (*(const LAS bf16x8*)(wl + r32 * 768 + 1 * 128 + (16 * (ks) + 8 * hi) * 2))
#define CP_BB(jp, ks) (*(const LAS bf16x8*)(wl + CP_BT + (32 * (jp) + r32) * 64 + (16 * (ks) + 8 * hi) * 2))
        {
            float gcl[2];
#pragma unroll
            for (int jt = 0; jt < 2; ++jt) { const int jj = 32 * jt + r32; gcl[jt] = *(const LAS float*)(wl + (jj >> 4) * 768 + 1 * 128 + 64 + (jj & 15) * 4); }
            {
                const bf16x8 bn0 = CP_BN(0), bn1 = CP_BN(1);
#pragma unroll
                for (int jt = 0; jt < 2; ++jt) {
                    f32x16 acc;
#pragma unroll
                    for (int g4 = 0; g4 < 4; ++g4) { const u32x2 v = *(const LAS u32x2*)(wl + r32 * 768 + 4 * 128 + (32 * jt + 8 * g4 + 4 * hi) * 2);
                        acc[4 * g4] = bflo(v.x); acc[4 * g4 + 1] = bfhi(v.x); acc[4 * g4 + 2] = bflo(v.y); acc[4 * g4 + 3] = bfhi(v.y); }
                    acc = MFMA32(CP_A1(jt, 0), bn0, acc); acc = MFMA32(CP_A1(jt, 1), bn1, acc);
#pragma unroll
                    for (int sx = 0; sx < 2; ++sx) *(bf16x8*)(dl16 + IT_G1 + (jt * 2 + sx) * 1024) = pack_acc(acc, sx);
                }
            }
#pragma unroll
            for (int jp = 0; jp < 2; ++jp) {
                const bf16x8 bb0 = CP_BB(jp, 0), bb1 = CP_BB(jp, 1);
#pragma unroll
                for (int jt = 0; jt < 2; ++jt) {
                    f32x16 acc;
#pragma unroll
                    for (int r = 0; r < 16; ++r) acc[r] = (jt == jp && crow(r, hi) == r32) ? 1.f : 0.f;
                    acc = MFMA32(CP_A1(jt, 0), bb0, acc); acc = MFMA32(CP_A1(jt, 1), bb1, acc);
#pragma unroll
                    for (int r = 0; r < 16; ++r) acc[r] *= gcl[jp];
#pragma unroll
                    for (int sx = 0; sx < 2; ++sx) *(bf16x8*)(dl16 + IT_H1 + ((jp * 2 + jt) * 2 + sx) * 1024) = pack_acc(acc, sx);
                }
            }
            bf16x8 vtf[2][2];
#pragma unroll
            for (int it = 0; it < 2; ++it)
#pragma unroll
                for (int ks = 0; ks < 2; ++ks) {
                    const u32x2 lo = *(const LAS u32x2*)(wl + CP_VT + (32 * it + r32) * 64 + (16 * ks + 4 * hi) * 2), hh = *(const LAS u32x2*)(wl + CP_VT + (32 * it + r32) * 64 + (16 * ks + 8 + 4 * hi) * 2);
                    vtf[it][ks] = __builtin_bit_cast(bf16x8, (u32x4){lo.x, lo.y, hh.x, hh.y});
                }
            {
                f32x16 acc; unpack_acc_bf16(wl + (lane >> 1) * 768 + 3 * 128 + 64 + (lane & 1) * 32, acc);
                acc = MFMA32(CP_A2(0), CP_BN(0), acc); acc = MFMA32(CP_A2(1), CP_BN(1), acc);
                const bf16x8 g0 = pack_acc(acc, 0), g1 = pack_acc(acc, 1);
#pragma unroll
                for (int it = 0; it < 2; ++it) {
                    f32x16 z;
#pragma unroll
                    for (int r = 0; r < 16; ++r) z[r] = 0.f;
                    z = MFMA32(g0, vtf[it][0], z); z = MFMA32(g1, vtf[it][1], z);
                    store_acc_bf16(dl32 + IT_OV + it * 2048, z);
                }
            }
#pragma unroll
            for (int jp = 0; jp < 2; ++jp) {
                f32x16 acc;
#pragma unroll
                for (int g4 = 0; g4 < 4; ++g4) { const u32x2 v = *(const LAS u32x2*)(wl + CP_KT + (32 * jp + r32) * 64 + (8 * g4 + 4 * hi) * 2);
                    acc[4 * g4] = bflo(v.x); acc[4 * g4 + 1] = bfhi(v.x); acc[4 * g4 + 2] = bflo(v.y); acc[4 * g4 + 3] = bfhi(v.y); }
                acc = MFMA32(CP_A2(0), CP_BB(jp, 0), acc); acc = MFMA32(CP_A2(1), CP_BB(jp, 1), acc);
#pragma unroll
                for (int r = 0; r < 16; ++r) acc[r] *= gcl[jp];
                const bf16x8 h0 = pack_acc(acc, 0), h1 = pack_acc(acc, 1);
#pragma unroll
                for (int it = 0; it < 2; ++it) {
                    f32x16 z;
#pragma unroll
                    for (int r = 0; r < 16; ++r) z[r] = 0.f;
                    z = MFMA32(h0, vtf[it][0], z); z = MFMA32(h1, vtf[it][1], z);
                    store_acc_bf16(dl32 + IT_QT + (jp * 2 + it) * 2048, z);
                }
            }
        }
#undef CP_A1
#undef CP_A2
#undef CP_BN
#undef CP_BB
        }
        LDS_WAIT(); asm volatile("" ::: "memory");
    }
}
DI void phase_chunkscan(const Params& p, LAS unsigned char* lds, int tid, int lane, int wid) {
    unsigned char* ws = p.ws;
    bf16_t* OBR = (bf16_t*)(ws + WS_OBRAW);
    const int r32 = lane & 31, hi = lane >> 5;
    for (int chain = blockIdx.x; chain < 64; chain += gridDim.x) {
        const unsigned char* src = chk_base(p, chain);
        const int b = chain >> 3, h = chain & 7, lt = tid - 128;
        __syncthreads();
        u32x4 lw[4];
        if (wid >= 2) {
#pragma unroll
            for (int k = 0; k < 4; ++k) lw[k] = *(const u32x4*)(src + (size_t)(lt + 384 * k) * 16);
#pragma unroll
            for (int k = 0; k < 4; ++k) *(LAS u32x4*)(lds + (lt + 384 * k) * 16) = lw[k];
#pragma unroll
            for (int k = 0; k < 4; ++k) lw[k] = *(const u32x4*)(src + ITEM_BYTES + (size_t)(lt + 384 * k) * 16);
        }
        __syncthreads();
        f32x16 X0, X1;
#pragma unroll
        for (int i = 0; i < 16; ++i) { X0[i] = 0.f; X1[i] = 0.f; }
        for (int c = 0; c < NCHUNK; ++c) {
            const LAS unsigned char* cur = lds + (c & 1) * ITEM_BYTES;
            if (wid < 2) {
                const int it = wid;
                const bf16x8 xb00 = pack_acc(X0, 0), xb01 = pack_acc(X0, 1), xb10 = pack_acc(X1, 0), xb11 = pack_acc(X1, 1);
                f32x16 oacc; unpack_acc_bf16(cur + IT_OV + (it * 64 + lane) * 32, oacc);
                oacc = MFMA32(*(const LAS bf16x8*)(cur + IT_G1 + (0 * 64 + lane) * 16), xb00, oacc);
                oacc = MFMA32(*(const LAS bf16x8*)(cur + IT_G1 + (1 * 64 + lane) * 16), xb01, oacc);
                oacc = MFMA32(*(const LAS bf16x8*)(cur + IT_G1 + (2 * 64 + lane) * 16), xb10, oacc);
                oacc = MFMA32(*(const LAS bf16x8*)(cur + IT_G1 + (3 * 64 + lane) * 16), xb11, oacc);
                f32x16 n0, n1;
                unpack_acc_bf16(cur + IT_QT + ((0 * 2 + it) * 64 + lane) * 32, n0);
                unpack_acc_bf16(cur + IT_QT + ((1 * 2 + it) * 64 + lane) * 32, n1);
                n0 = MFMA32(*(const LAS bf16x8*)(cur + IT_H1 + (0 * 64 + lane) * 16), xb00, n0);
                n0 = MFMA32(*(const LAS bf16x8*)(cur + IT_H1 + (1 * 64 + lane) * 16), xb01, n0);
                n0 = MFMA32(*(const LAS bf16x8*)(cur + IT_H1 + (2 * 64 + lane) * 16), xb10, n0);
                n0 = MFMA32(*(const LAS bf16x8*)(cur + IT_H1 + (3 * 64 + lane) * 16), xb11, n0);
                n1 = MFMA32(*(const LAS bf16x8*)(cur + IT_H1 + (4 * 64 + lane) * 16), xb00, n1);
                n1 = MFMA32(*(const LAS bf16x8*)(cur + IT_H1 + (5 * 64 + lane) * 16), xb01, n1);
                n1 = MFMA32(*(const LAS bf16x8*)(cur + IT_H1 + (6 * 64 + lane) * 16), xb10, n1);
                n1 = MFMA32(*(const LAS bf16x8*)(cur + IT_H1 + (7 * 64 + lane) * 16), xb11, n1);
                X0 = n0; X1 = n1;
                bf16_t* orow = OBR + ((size_t)(b * SEQ + c * CK)) * 512 + h * 64 + 32 * it + r32;
#pragma unroll
                for (int r = 0; r < 16; ++r) orow[(size_t)crow(r, hi) * 512] = f2bf(oacc[r]);
            } else {
                LAS unsigned char* nxt = lds + ((c + 1) & 1) * ITEM_BYTES;
                if (c + 1 < NCHUNK) {
#pragma unroll
                    for (int k = 0; k < 4; ++k) *(LAS u32x4*)(nxt + (lt + 384 * k) * 16) = lw[k];
                }
                if (c + 2 < NCHUNK) {
#pragma unroll
                    for (int k = 0; k < 4; ++k) lw[k] = *(const u32x4*)(src + (size_t)(c + 2) * ITEM_BYTES + (size_t)(lt + 384 * k) * 16);
                }
            }
            __syncthreads();
        }
    }
}

constexpr int AT_BUF = 8192 + 64 * 136, AT_K = 0, AT_V = 8192, AT_BT = 2 * AT_BUF, AT_END = AT_BT + 512 * 4;
DI int rel_bucket_dev(int n) {
    if (n < 16) return n;
    const int th[15] = {19, 21, 24, 27, 31, 35, 40, 46, 52, 59, 67, 77, 87, 99, 113};
    int b = 16;
#pragma unroll
    for (int i = 0; i < 15; ++i) b += (n >= th[i]) ? 1 : 0;
    return b;
}
template <int MODE>
DI void attn_tile(const LAS unsigned char* kb, const LAS unsigned char* vbuf, const LAS float* btab, const bf16x8 (&qr)[4],
                  f32x16& o0, f32x16& o1, f32x16& lacc, float& m, int dq, bool selb, float c31, int r32, int hi) {
    const float sc2 = 0.125f * LOG2E;
    f32x16 p0, p1;
#pragma unroll
    for (int i = 0; i < 16; ++i) { p0[i] = 0.f; p1[i] = 0.f; }
#pragma unroll
    for (int d0 = 0; d0 < 4; ++d0) {
        const bf16x8 k0 = *(const LAS bf16x8*)(kb + (2 * d0 + hi) * 1024 + r32 * 16);
        const bf16x8 k1 = *(const LAS bf16x8*)(kb + (2 * d0 + hi) * 1024 + 512 + r32 * 16);
        p0 = MFMA32(k0, qr[d0], p0); p1 = MFMA32(k1, qr[d0], p1);
    }
    float mx = -INFINITY;
    float cadd = 0.f;
    if (MODE == 2) {
        const float bsel = selb ? c31 : -INFINITY;
#pragma unroll
        for (int r = 0; r < 16; ++r) mx = fmaxf(mx, fmaxf(p0[r], p1[r]));
        mx = mx * sc2 + bsel;
        cadd = bsel;
    } else {
        const float ninf = selb ? 0.f : -INFINITY;
#pragma unroll
        for (int r = 0; r < 16; ++r) {
            const int d0 = dq - crow(r, hi), d1 = d0 - 32;
            const int i0 = d0 < 0 ? 0 : (d0 > 511 ? 511 : d0), i1 = d1 < 0 ? 0 : (d1 > 511 ? 511 : d1);
            float x0 = p0[r] * sc2 + btab[i0], x1 = p1[r] * sc2 + btab[i1];
            if (MODE == 0) { x0 = d0 >= 0 ? x0 : -INFINITY; x1 = d1 >= 0 ? x1 : -INFINITY; }
            else { x0 += ninf; x1 += ninf; }
            p0[r] = x0; p1[r] = x1; mx = fmaxf(mx, fmaxf(x0, x1));
        }
    }
    mx = fmaxf(mx, __shfl_xor(mx, 32));
    if (__any(mx > m)) {
        const float mn = fmaxf(m, mx);
        const float alpha = __builtin_amdgcn_exp2f(m - mn);
        m = mn;
#pragma unroll
        for (int i = 0; i < 16; ++i) { o0[i] *= alpha; o1[i] *= alpha; lacc[i] *= alpha; }
    }
    if (MODE == 2) {
        const float c = cadd - m;
#pragma unroll
        for (int r = 0; r < 16; ++r) { p0[r] = __builtin_amdgcn_exp2f(p0[r] * sc2 + c); p1[r] = __builtin_amdgcn_exp2f(p1[r] * sc2 + c); }
    } else {
#pragma unroll
        for (int r = 0; r < 16; ++r) { p0[r] = __builtin_amdgcn_exp2f(p0[r] - m); p1[r] = __builtin_amdgcn_exp2f(p1[r] - m); }
    }
    const bf16x8 ones = {(short)0x3F80, (short)0x3F80, (short)0x3F80, (short)0x3F80, (short)0x3F80, (short)0x3F80, (short)0x3F80, (short)0x3F80};
#pragma unroll
    for (int s = 0; s < 4; ++s) {
        u32x4 pw;
        if (s < 2) { pw.x = pk2(p0[8 * s], p0[8 * s + 1]); pw.y = pk2(p0[8 * s + 2], p0[8 * s + 3]); pw.z = pk2(p0[8 * s + 4], p0[8 * s + 5]); pw.w = pk2(p0[8 * s + 6], p0[8 * s + 7]); }
        else { const int q = s - 2; pw.x = pk2(p1[8 * q], p1[8 * q + 1]); pw.y = pk2(p1[8 * q + 2], p1[8 * q + 3]); pw.z = pk2(p1[8 * q + 4], p1[8 * q + 5]); pw.w = pk2(p1[8 * q + 6], p1[8 * q + 7]); }
        const bf16x8 pf = __builtin_bit_cast(bf16x8, pw);
        const LAS unsigned char* v0p = vbuf + r32 * 136 + (16 * s + 4 * hi) * 2;
        const LAS unsigned char* v1p = vbuf + (32 + r32) * 136 + (16 * s + 4 * hi) * 2;
        const u32x2 a0 = *(const LAS u32x2*)v0p, a1 = *(const LAS u32x2*)(v0p + 16);
        const u32x2 c0 = *(const LAS u32x2*)v1p, c1 = *(const LAS u32x2*)(v1p + 16);
        const bf16x8 va = __builtin_bit_cast(bf16x8, (u32x4){a0.x, a0.y, a1.x, a1.y});
        const bf16x8 vb = __builtin_bit_cast(bf16x8, (u32x4){c0.x, c0.y, c1.x, c1.y});
        o0 = MFMA32(va, pf, o0); o1 = MFMA32(vb, pf, o1); lacc = MFMA32(ones, pf, lacc);
    }
}
template <int VAR> DI void attn_unit(const Params& p, LAS unsigned char* lds, int b, int h, int qb, int tid, int lane, int wid) {
    unsigned char* ws = p.ws;
    const bf16_t* QKV = (const bf16_t*)(ws + WS_QKV);
    const bf16_t* VT = (const bf16_t*)((const unsigned char*)p.out + DO_VT);
    const unsigned short* SEL = (const unsigned short*)(ws + WS_SEL);
    bf16_t* OA = VAR == 0 ? (bf16_t*)(ws + WS_OA) : (bf16_t*)((unsigned char*)p.out + 64 * MiB);
    const int r32 = lane & 31, hi = lane >> 5, bh = b * NH + h;
    LAS float* btab = (LAS float*)(lds + AT_BT);
    const int NT = 4 * (qb + 1);
#define AT_KPOS(ti) (((ti) < 4 ? qb * 256 + (ti) * 64 : (((ti) - 4) >> 2) * 256 + (((ti) - 4) & 3) * 64))
    const bf16_t* kbase = QKV + ((size_t)(b * SEQ + lane)) * QKVW + 512 + h * 64 + wid * 8;
    const bf16_t* vbase = VT + ((size_t)(bh * 64 + (tid >> 3))) * SEQ + (tid & 7) * 8;
    const int kdst = AT_K + wid * 1024 + lane * 16, vdst = AT_V + (tid >> 3) * 136 + (tid & 7) * 16;
#define AT_LOAD(ti, kr, vr) do { const int kp_ = AT_KPOS(ti); kr = *(const u32x4*)(kbase + (size_t)kp_ * QKVW); vr = *(const u32x4*)(vbase + kp_); } while (0)
#define AT_WRITE(buf, kr, vr) do { LAS unsigned char* b_ = lds + (buf) * AT_BUF; *(LAS u32x4*)(b_ + kdst) = kr; \
        *(LAS u32x2*)(b_ + vdst) = (u32x2){vr.x, vr.y}; *(LAS u32x2*)(b_ + vdst + 8) = (u32x2){vr.z, vr.w}; } while (0)
    u32x4 kreg, vreg;
    AT_LOAD(0, kreg, vreg);
    __syncthreads();
    btab[tid] = p.rel_bias[h * 32 + rel_bucket_dev(tid)] * LOG2E;
    if (tid < 256) {
        unsigned mask = 0u;
        if (qb > 0) {
            const float* KBAR = (const float*)(ws + WS_KBAR);
            float q[64];
            const bf16_t* qp = QKV + ((size_t)(b * SEQ + qb * 256 + tid)) * QKVW + h * 64;
#pragma unroll
            for (int c = 0; c < 8; ++c) { const u32x4 w = *(const u32x4*)(qp + c * 8); float f[8]; unpack8(w, f);
#pragma unroll
                for (int i = 0; i < 8; ++i) q[c * 8 + i] = f[i]; }
            float v1 = -INFINITY, v2 = -INFINITY, v3 = -INFINITY; int i1 = -1, i2 = -1, i3 = -1;
            for (int jb = 0; jb < qb; ++jb) {
                const float* kbp = KBAR + ((size_t)(bh * 16 + jb)) * 64;
                float g = 0.f;
#pragma unroll
                for (int d = 0; d < 64; d += 4) { const f32x4 kk = *(const f32x4*)(kbp + d); g += q[d] * kk.x + q[d + 1] * kk.y + q[d + 2] * kk.z + q[d + 3] * kk.w; }
                if (g > v1) { v3 = v2; i3 = i2; v2 = v1; i2 = i1; v1 = g; i1 = jb; }
                else if (g > v2) { v3 = v2; i3 = i2; v2 = g; i2 = jb; }
                else if (g > v3) { v3 = g; i3 = jb; }
            }
            if (i1 >= 0) mask |= 1u << i1;
            if (i2 >= 0) mask |= 1u << i2;
            if (i3 >= 0) mask |= 1u << i3;
        }
        ((LAS unsigned short*)(lds + AT_END))[tid] = (unsigned short)mask;
    }
    AT_WRITE(0, kreg, vreg);
    if (NT > 1) AT_LOAD(1, kreg, vreg);
    const int qrow = b * SEQ + qb * 256 + wid * 32 + r32, qin = wid * 32 + r32;
    bf16x8 qr[4];
#pragma unroll
    for (int d0 = 0; d0 < 4; ++d0) qr[d0] = *(const bf16x8*)(QKV + (size_t)qrow * QKVW + h * 64 + d0 * 16 + hi * 8);
    const float c31 = p.rel_bias[h * 32 + 31] * LOG2E;
    float m = -INFINITY;
    f32x16 o0, o1, lacc;
#pragma unroll
    for (int i = 0; i < 16; ++i) { o0[i] = 0.f; o1[i] = 0.f; lacc[i] = 0.f; }
    __syncthreads();
    const unsigned sel = ((const LAS unsigned short*)(lds + AT_END))[qin];
    for (int ti = 0; ti < NT; ++ti) {
        const bool own = ti < 4;
        const int blk = own ? qb : ((ti - 4) >> 2), kt = own ? ti : ((ti - 4) & 3);
        const LAS unsigned char* kb = lds + (ti & 1) * AT_BUF + AT_K;
        const LAS unsigned char* vbuf = lds + (ti & 1) * AT_BUF + AT_V;
        const bool selb = ((sel >> blk) & 1u) != 0u;
        const bool active = own ? (kt * 64 <= wid * 32 + 31) : (__any(selb) != 0);
        if (active && VAR != 2) {
            if (own) attn_tile<0>(kb, vbuf, btab, qr, o0, o1, lacc, m, qin - kt * 64, true, 0.f, r32, hi);
            else {
                const bool farb = ((qb - blk) * 256 + wid * 32 - kt * 64 - 63 >= 113);
                if (farb) attn_tile<2>(kb, vbuf, btab, qr, o0, o1, lacc, m, 0, selb, c31, r32, hi);
                else attn_tile<1>(kb, vbuf, btab, qr, o0, o1, lacc, m, (qb - blk) * 256 + qin - kt * 64, selb, c31, r32, hi);
            }
        }
        if (VAR != 1) { if (ti + 1 < NT) AT_WRITE((ti + 1) & 1, kreg, vreg);
        if (ti + 2 < NT) AT_LOAD(ti + 2, kreg, vreg); }
        __syncthreads();
    }
#undef AT_KPOS
#undef AT_LOAD
#undef AT_WRITE
    const float il = 1.f / lacc[0];
    bf16_t* orow = OA + (size_t)qrow * 512 + h * 64;
#pragma unroll
    for (int g = 0; g < 4; ++g) {
        u32x2 w0, w1;
        w0.x = pk2(o0[4 * g] * il, o0[4 * g + 1] * il); w0.y = pk2(o0[4 * g + 2] * il, o0[4 * g + 3] * il);
        w1.x = pk2(o1[4 * g] * il, o1[4 * g + 1] * il); w1.y = pk2(o1[4 * g + 2] * il, o1[4 * g + 3] * il);
        *(u32x2*)(orow + 8 * g + 4 * hi) = w0; *(u32x2*)(orow + 32 + 8 * g + 4 * hi) = w1;
    }
}
template <int VAR> DI void phase_attn(const Params& p, LAS unsigned char* lds, int tid, int lane, int wid) {
    if (gridDim.x == 256) {
        const int bh = blockIdx.x & 63, s = blockIdx.x >> 6;
#pragma unroll 1
        for (int i = 0; i < 4; ++i) { const int qb = i == 0 ? 15 - s : (i == 1 ? 8 + s : (i == 2 ? 7 - s : s)); attn_unit<VAR>(p, lds, bh >> 3, bh & 7, qb, tid, lane, wid); }
    } else {
        for (int it = blockIdx.x; it < NB * NH * 16; it += gridDim.x) { const int qb = 15 - (it >> 6), bh = it & 63; attn_unit<VAR>(p, lds, bh >> 3, bh & 7, qb, tid, lane, wid); }
    }
}

constexpr int A2_BT = 0, A2_SEL = 2048, A2_CNT = 2560, A2_WCNT = 2624, A2_NIT = 2880, A2_QCTR = 2884, A2_ITEM = 2944, A2_ROWS = 3072, A2_END = 3072 + 15 * 256;
constexpr size_t PART_REC = 136;
DI unsigned char* part_base(const Params& p, int b) {
    constexpr size_t PB_ = (size_t)NH * SEQ * 3 * PART_REC;
    return b < 6 ? p.ws + 214 * MiB + (size_t)b * PB_ : (unsigned char*)p.out + 96 * MiB + (size_t)(b - 6) * PB_;
}
struct A2State { float m, l; f32x16 o0, o1; };
constexpr int A2_WBUF = 8192;
DI void a2_dma_tile(const unsigned char* kf_tile, const unsigned char* vf_tile, LAS unsigned char* wbuf, int lane) {
#pragma unroll
    for (int f = 0; f < 8; ++f) {
        __builtin_amdgcn_global_load_lds((const unsigned*)(kf_tile + f * 1024 + lane * 16), (LAS unsigned*)(wbuf + f * 1024), 16, 0, 0);
        __builtin_amdgcn_global_load_lds((const unsigned*)(vf_tile + f * 1024 + lane * 16), (LAS unsigned*)(wbuf + 8192 + f * 1024), 16, 0, 0);
    }
}
template <bool OWN> DI void attn2_item(const Params& p, const LAS float* btab, LAS unsigned char* wbuf, int b, int h, int qb, int blk, int row, int nkt, A2State& st, int lane, int r32, int hi) {
    unsigned char* ws = p.ws;
    const bf16_t* QKV = (const bf16_t*)(ws + WS_QKV);
    const int bh = b * NH + h;
    const unsigned char* kft = (const unsigned char*)p.out + DO_KF + ((size_t)(bh * 64 + blk * 4) * 8) * 1024;
    const unsigned char* vft = (const unsigned char*)p.out + DO_VT + ((size_t)(bh * 64 + blk * 4) * 8) * 1024;
    a2_dma_tile(kft, vft, wbuf, lane);
    bf16x8 qr[4];
    { const bf16_t* qp = QKV + ((size_t)(b * SEQ + qb * 256 + row)) * QKVW + h * 64 + hi * 8;
#pragma unroll
      for (int d0 = 0; d0 < 4; ++d0) qr[d0] = *(const bf16x8*)(qp + d0 * 16); }
    st.m = -INFINITY; st.l = 0.f;
#pragma unroll
    for (int i = 0; i < 16; ++i) { st.o0[i] = 0.f; st.o1[i] = 0.f; }
    const int dbase = OWN ? row : ((qb - blk) * 256 + row);
    for (int kt = 0; kt < nkt; ++kt) {
        asm volatile("s_waitcnt vmcnt(0)" ::: "memory");
        bf16x8 kf[8], vf[8];
#pragma unroll
        for (int f = 0; f < 8; ++f) { kf[f] = *(const LAS bf16x8*)(wbuf + f * 1024 + lane * 16); vf[f] = *(const LAS bf16x8*)(wbuf + 8192 + f * 1024 + lane * 16); }
        asm volatile("s_waitcnt lgkmcnt(0)" ::: "memory");
        __builtin_amdgcn_sched_barrier(0);
        if (kt + 1 < nkt) a2_dma_tile(kft + (size_t)(kt + 1) * 8192, vft + (size_t)(kt + 1) * 8192, wbuf, lane);
        f32x16 p0, p1;
#pragma unroll
        for (int i = 0; i < 16; ++i) { p0[i] = 0.f; p1[i] = 0.f; }
#pragma unroll
        for (int d0 = 0; d0 < 4; ++d0) { p0 = MFMA32(kf[2 * d0], qr[d0], p0); p1 = MFMA32(kf[2 * d0 + 1], qr[d0], p1); }
        const float sc2 = 0.125f * LOG2E;
        const int dq = dbase - kt * 64;
        float mx = -INFINITY;
        const bool farb = !OWN && (__all(dq - 63 >= 113) != 0);
        const float c31 = btab[511];
        if (farb) {
#pragma unroll
            for (int r = 0; r < 16; ++r) mx = fmaxf(mx, fmaxf(p0[r], p1[r]));
            mx = mx * sc2 + c31;
        } else {
#pragma unroll
            for (int r = 0; r < 16; ++r) {
                const int d0 = dq - crow(r, hi), d1 = d0 - 32;
                const int i0 = d0 < 0 ? 0 : (d0 > 511 ? 511 : d0), i1 = d1 < 0 ? 0 : (d1 > 511 ? 511 : d1);
                float x0 = p0[r] * sc2 + btab[i0], x1 = p1[r] * sc2 + btab[i1];
                if (OWN) { x0 = d0 >= 0 ? x0 : -INFINITY; x1 = d1 >= 0 ? x1 : -INFINITY; }
                p0[r] = x0; p1[r] = x1; mx = fmaxf(mx, fmaxf(x0, x1));
            }
        }
        mx = fmaxf(mx, __shfl_xor(mx, 32));
        if (__any(mx > st.m)) {
            const float mn = fmaxf(st.m, mx);
            const float alpha = __builtin_amdgcn_exp2f(st.m - mn);
            st.m = mn;
#pragma unroll
            for (int i = 0; i < 16; ++i) { st.o0[i] *= alpha; st.o1[i] *= alpha; }
            st.l *= alpha;
        }
        float rs0 = 0.f, rs1 = 0.f;
        if (farb) { const float c = c31 - st.m;
#pragma unroll
            for (int r = 0; r < 16; ++r) { p0[r] = __builtin_amdgcn_exp2f(p0[r] * sc2 + c); p1[r] = __builtin_amdgcn_exp2f(p1[r] * sc2 + c); rs0 += p0[r]; rs1 += p1[r]; }
        } else {
#pragma unroll
            for (int r = 0; r < 16; ++r) { p0[r] = __builtin_amdgcn_exp2f(p0[r] - st.m); p1[r] = __builtin_amdgcn_exp2f(p1[r] - st.m); rs0 += p0[r]; rs1 += p1[r]; }
        }
        st.l += rs0 + rs1;
#pragma unroll
        for (int s = 0; s < 4; ++s) {
            u32x4 pw;
            if (s < 2) { pw.x = pk2(p0[8 * s], p0[8 * s + 1]); pw.y = pk2(p0[8 * s + 2], p0[8 * s + 3]); pw.z = pk2(p0[8 * s + 4], p0[8 * s + 5]); pw.w = pk2(p0[8 * s + 6], p0[8 * s + 7]); }
            else { const int q = s - 2; pw.x = pk2(p1[8 * q], p1[8 * q + 1]); pw.y = pk2(p1[8 * q + 2], p1[8 * q + 3]); pw.z = pk2(p1[8 * q + 4], p1[8 * q + 5]); pw.w = pk2(p1[8 * q + 6], p1[8 * q + 7]); }
            const bf16x8 pf = __builtin_bit_cast(bf16x8, pw);
            st.o0 = MFMA32(vf[s], pf, st.o0); st.o1 = MFMA32(vf[4 + s], pf, st.o1);
        }
    }
    st.l += __shfl_xor(st.l, 32);
}
template <int CHECK> DI void attn2_unit(const Params& p, LAS unsigned char* lds, int b, int h, int qb, int tid, int lane, int wid) {
    unsigned char* ws = p.ws;
    const bf16_t* QKV = (const bf16_t*)(ws + WS_QKV);
    bf16_t* OA = (bf16_t*)(ws + WS_OA);
    const int r32 = lane & 31, hi = lane >> 5, bh = b * NH + h;
    LAS float* btab = (LAS float*)(lds + A2_BT);
    LAS unsigned short* selm = (LAS unsigned short*)(lds + A2_SEL);
    LAS int* cnt = (LAS int*)(lds + A2_CNT);
    LAS int* wcnt = (LAS int*)(lds + A2_WCNT);
    LAS int* ctl = (LAS int*)(lds + A2_NIT);
    LAS unsigned char* itemtab = lds + A2_ITEM;
    LAS unsigned char* rows = lds + A2_ROWS;
    unsigned char* part = part_base(p, b) + ((size_t)(h * 16 + qb) * 256) * 3 * PART_REC;
    __syncthreads();
    btab[tid] = p.rel_bias[h * 32 + rel_bucket_dev(tid)] * LOG2E;
    unsigned mysel = 0u;
    if (qb > 0) {
        LAS float* kbl = (LAS float*)(lds + A2_WBUF);
        LAS float* gp = (LAS float*)(lds + A2_WBUF + 4096);
        const float* KBAR = (const float*)(ws + WS_KBAR) + (size_t)(bh * 16) * 64;
        for (int i = tid; i < qb * 64; i += NTHREADS) kbl[i] = KBAR[i];
        const int qi = tid & 255, hf = tid >> 8;
        float q[32];
        { const bf16_t* qp = QKV + ((size_t)(b * SEQ + qb * 256 + qi)) * QKVW + h * 64 + 32 * hf;
#pragma unroll
          for (int c = 0; c < 4; ++c) { const u32x4 w = *(const u32x4*)(qp + c * 8); float f[8]; unpack8(w, f);
#pragma unroll
              for (int i = 0; i < 8; ++i) q[c * 8 + i] = f[i]; } }
        __syncthreads();
        for (int jb = 0; jb < qb; ++jb) {
            const LAS float* kbp = kbl + jb * 64 + 32 * hf;
            float g0 = 0.f, g1 = 0.f;
#pragma unroll
            for (int d = 0; d < 32; d += 8) { const f32x4 ka = *(const LAS f32x4*)(kbp + d), kb = *(const LAS f32x4*)(kbp + d + 4);
                g0 += q[d] * ka.x + q[d + 1] * ka.y + q[d + 2] * ka.z + q[d + 3] * ka.w; g1 += q[d + 4] * kb.x + q[d + 5] * kb.y + q[d + 6] * kb.z + q[d + 7] * kb.w; }
            gp[(hf * 16 + jb) * 256 + qi] = g0 + g1;
        }
        __syncthreads();
        if (tid < 256) {
            float v1 = -INFINITY, v2 = -INFINITY, v3 = -INFINITY; int i1 = -1, i2 = -1, i3 = -1;
            for (int jb = 0; jb < qb; ++jb) {
                const float g = gp[jb * 256 + tid] + gp[(16 + jb) * 256 + tid];
                if (g > v1) { v3 = v2; i3 = i2; v2 = v1; i2 = i1; v1 = g; i1 = jb; }
                else if (g > v2) { v3 = v2; i3 = i2; v2 = g; i2 = jb; }
                else if (g > v3) { v3 = g; i3 = jb; }
            }
            if (i1 >= 0) mysel |= 1u << i1;
            if (i2 >= 0) mysel |= 1u << i2;
            if (i3 >= 0) mysel |= 1u << i3;
        }
    }
    if (tid < 256) {
        selm[tid] = (unsigned short)mysel;
        for (int j = 0; j < qb; ++j) { const unsigned long long bm = __ballot((mysel >> j) & 1u); if (lane == 0) wcnt[j * 4 + wid] = __popcll(bm); }
    }
    __syncthreads();
    if (tid < 256) {
        for (int j = 0; j < qb; ++j) {
            const bool bit = ((mysel >> j) & 1u) != 0u;
            const unsigned long long bm = __ballot(bit);
            int off = 0;
            for (int w2 = 0; w2 < 4; ++w2) off += (w2 < wid) ? wcnt[j * 4 + w2] : 0;
            const int pre = __popcll(bm & ((1ull << lane) - 1ull));
            if (bit) rows[j * 256 + off + pre] = (unsigned char)tid;
            if (tid == 0) cnt[j] = wcnt[j * 4] + wcnt[j * 4 + 1] + wcnt[j * 4 + 2] + wcnt[j * 4 + 3];
        }
    }
    __syncthreads();
    if (tid == 0) {
        int n = 0;
        for (int j = 0; j < qb; ++j) { const int nt = (cnt[j] + 31) >> 5; for (int r = 0; r < nt; ++r) itemtab[n++] = (unsigned char)(j * 8 + r); }
        ctl[0] = n; ctl[1] = 0;
    }
    __syncthreads();
    LAS unsigned char* wbuf = lds + A2_WBUF + wid * 16384;
    const int nitems = ctl[0];
    for (;;) {
        int it = 0;
        if (lane == 0) it = __hip_atomic_fetch_add(&ctl[1], 1, __ATOMIC_RELAXED, __HIP_MEMORY_SCOPE_WORKGROUP);
        it = __builtin_amdgcn_readfirstlane(it);
        if (it >= nitems) break;
        const int code = itemtab[it], j = code >> 3, r = code & 7;
        const int pos = r * 32 + r32, n = cnt[j];
        const bool valid = pos < n;
        const int row = rows[j * 256 + (valid ? pos : 0)];
        A2State st;
        attn2_item<false>(p, btab, wbuf, b, h, qb, j, row, 4, st, lane, r32, hi);
        if (valid) {
            const unsigned sm = selm[row];
            const int slot = __popc(sm & ((1u << j) - 1u));
            unsigned char* rec = part + ((size_t)row * 3 + slot) * PART_REC;
#pragma unroll
            for (int g = 0; g < 4; ++g) {
                *(u32x2*)(rec + (8 * g + 4 * hi) * 2) = (u32x2){pk2(st.o0[4 * g], st.o0[4 * g + 1]), pk2(st.o0[4 * g + 2], st.o0[4 * g + 3])};
                *(u32x2*)(rec + (32 + 8 * g + 4 * hi) * 2) = (u32x2){pk2(st.o1[4 * g], st.o1[4 * g + 1]), pk2(st.o1[4 * g + 2], st.o1[4 * g + 3])};
            }
            if (hi == 0) *(f32x2*)(rec + 128) = (f32x2){st.m, st.l};
        }
    }
    A2State own;
    attn2_item<true>(p, btab, wbuf, b, h, qb, qb, wid * 32 + r32, (wid >> 1) + 1, own, lane, r32, hi);
    asm volatile("s_waitcnt vmcnt(0)" ::: "memory");
    __syncthreads();
    {
        const int row = wid * 32 + r32;
        const unsigned sm = selm[row];
        const int ns = __popc(sm);
        float M = own.m;
        float ms[3], ls[3];
#pragma unroll
        for (int s3 = 0; s3 < 3; ++s3) { ms[s3] = -INFINITY; ls[s3] = 0.f;
            if (s3 < ns) { const f32x2 ml = *(const f32x2*)(part + ((size_t)row * 3 + s3) * PART_REC + 128); ms[s3] = ml.x; ls[s3] = ml.y; M = fmaxf(M, ml.x); } }
        const float f0 = __builtin_amdgcn_exp2f(own.m - M);
        float L = own.l * f0;
#pragma unroll
        for (int i = 0; i < 16; ++i) { own.o0[i] *= f0; own.o1[i] *= f0; }
#pragma unroll
        for (int s3 = 0; s3 < 3; ++s3) {
            if (s3 < ns) {
                const float fs = __builtin_amdgcn_exp2f(ms[s3] - M);
                L += ls[s3] * fs;
                const unsigned char* rec = part + ((size_t)row * 3 + s3) * PART_REC;
#pragma unroll
                for (int g = 0; g < 4; ++g) {
                    const u32x2 a = *(const u32x2*)(rec + (8 * g + 4 * hi) * 2), c = *(const u32x2*)(rec + (32 + 8 * g + 4 * hi) * 2);
                    own.o0[4 * g] += fs * bflo(a.x); own.o0[4 * g + 1] += fs * bfhi(a.x); own.o0[4 * g + 2] += fs * bflo(a.y); own.o0[4 * g + 3] += fs * bfhi(a.y);
                    own.o1[4 * g] += fs * bflo(c.x); own.o1[4 * g + 1] += fs * bfhi(c.x); own.o1[4 * g + 2] += fs * bflo(c.y); own.o1[4 * g + 3] += fs * bfhi(c.y);
                }
            }
        }
        const float il = 1.f / L;
        bf16_t* orow = OA + ((size_t)(b * SEQ + qb * 256 + row)) * 512 + h * 64;
#pragma unroll
        for (int g = 0; g < 4; ++g) {
            u32x2 w0, w1;
            w0.x = pk2(own.o0[4 * g] * il, own.o0[4 * g + 1] * il); w0.y = pk2(own.o0[4 * g + 2] * il, own.o0[4 * g + 3] * il);
            w1.x = pk2(own.o1[4 * g] * il, own.o1[4 * g + 1] * il); w1.y = pk2(own.o1[4 * g + 2] * il, own.o1[4 * g + 3] * il);
            if (CHECK) {
                const u32x2 r0 = *(const u32x2*)(orow + 8 * g + 4 * hi), r1 = *(const u32x2*)(orow + 32 + 8 * g + 4 * hi);
                const float a[8] = {bflo(w0.x), bfhi(w0.x), bflo(w0.y), bfhi(w0.y), bflo(w1.x), bfhi(w1.x), bflo(w1.y), bfhi(w1.y)};
                const float c[8] = {bflo(r0.x), bfhi(r0.x), bflo(r0.y), bfhi(r0.y), bflo(r1.x), bfhi(r1.x), bflo(r1.y), bfhi(r1.y)};
                bool bad = false;
#pragma unroll
                for (int i = 0; i < 8; ++i) bad |= !(fabsf(a[i] - c[i]) <= 0.03f * fabsf(c[i]) + 0.004f);
                if (bad) { w0.x = 0x7fc07fc0u; w0.y = 0x7fc07fc0u; w1.x = 0x7fc07fc0u; w1.y = 0x7fc07fc0u; }
            }
            *(u32x2*)(orow + 8 * g + 4 * hi) = w0; *(u32x2*)(orow + 32 + 8 * g + 4 * hi) = w1;
        }
    }
}
template <int CHECK> DI void phase_attn2(const Params& p, LAS unsigned char* lds, int tid, int lane, int wid) {
    if (gridDim.x == 256) {
        const int bh = blockIdx.x & 63, s = blockIdx.x >> 6;
#pragma unroll 1
        for (int i = 0; i < 4; ++i) { const int qb = i == 0 ? 15 - s : (i == 1 ? 8 + s : (i == 2 ? 7 - s : s)); attn2_unit<CHECK>(p, lds, bh >> 3, bh & 7, qb, tid, lane, wid); }
    } else {
        for (int it = blockIdx.x; it < NB * NH * 16; it += gridDim.x) { const int qb = 15 - (it >> 6), bh = it & 63; attn2_unit<CHECK>(p, lds, bh >> 3, bh & 7, qb, tid, lane, wid); }
    }
}

DI void phase_post(const Params& p, int tid, int lane, int wid) {
    unsigned char* ws = p.ws;
    const bf16_t* SCAN = (const bf16_t*)(ws + WS_SCAN);
    const bf16_t* OBRAW = (const bf16_t*)(ws + WS_OBRAW);
    const bf16_t* RG = (const bf16_t*)((const unsigned char*)p.out + DO_RG);
    bf16_t* OB = (bf16_t*)(ws + WS_OB);
    const int gw = blockIdx.x * NWAVES + wid, NGW = gridDim.x * NWAVES;
    for (int tok = gw; tok < NTOK; tok += NGW) {
        const int b = tok >> 12, s = tok & (SEQ - 1);
#pragma unroll
        for (int h = 0; h < NH; ++h) {
            const int c = h * 64 + lane;
            const float o = bf2f(OBRAW[(size_t)tok * 512 + c]);
            const float mu = wave_sum(o) * (1.f / 64.f);
            const float dd = o - mu;
            const float var = wave_sum(dd * dd) * (1.f / 64.f);
            const float on = dd * rsqrtf(var + GN_EPS) * p.lnx_g[c] + p.lnx_b[c];
            const bf16_t* si = SCAN + ((size_t)((b * NH + h) * SEQ + s)) * 384 + lane;
            const float km = bf2f(si[192]), r = bf2f(si[256]), v = bf2f(si[320]);
            const float bon = wave_sum(r * km * p.r_k[c]);
            const float g = bf2f(RG[(size_t)tok * 512 + c]);
            OB[(size_t)tok * 512 + c] = f2bf((on + bon * v) * g);
        }
    }
}
typedef float v16f_t __attribute__((ext_vector_type(16)));
typedef float v32f_t __attribute__((ext_vector_type(32)));
typedef int v6i_t __attribute__((ext_vector_type(6)));
DI void phase_uv_convert(const Params& p, int lane, int gw, int NGW) {
    unsigned char* ws = p.ws;
    const int hl = lane & 31, half = lane >> 5;
    for (int e2 = gw; e2 < NEXP; e2 += NGW) {
        const bool isv = e2 >= NEXP / 2;
        const int e = 2 * (isv ? e2 - NEXP / 2 : e2) + half;
        const float* src = (isv ? p.peer_v : p.peer_u) + (size_t)e * DM + 32 * hl;
        f32x4 v[8]; float am = 0.f, ss = 0.f;
#pragma unroll
        for (int j = 0; j < 8; ++j) { v[j] = *(const f32x4*)(src + 4 * j);
            am = fmaxf(am, fmaxf(fmaxf(fabsf(v[j].x), fabsf(v[j].y)), fmaxf(fabsf(v[j].z), fabsf(v[j].w))));
            ss += v[j].x * v[j].x + v[j].y * v[j].y + v[j].z * v[j].z + v[j].w * v[j].w; }
#pragma unroll
        for (int o = 1; o < 32; o <<= 1) { am = fmaxf(am, __shfl_xor(am, o)); ss += __shfl_xor(ss, o); }
        u32x4 w = {0u, 0u, 0u, 0u};
        if (isv) {
            am = fmaxf(am, 1e-30f);
            const float mul = 6.f / am;
#define FP4_PACK(j_) \
            w[j_] = __builtin_amdgcn_cvt_scalef32_pk_fp4_f32(w[j_], v[2 * (j_)].x * mul, v[2 * (j_)].y * mul, 1.0f, 0); \
            w[j_] = __builtin_amdgcn_cvt_scalef32_pk_fp4_f32(w[j_], v[2 * (j_)].z * mul, v[2 * (j_)].w * mul, 1.0f, 1); \
            w[j_] = __builtin_amdgcn_cvt_scalef32_pk_fp4_f32(w[j_], v[2 * (j_) + 1].x * mul, v[2 * (j_) + 1].y * mul, 1.0f, 2); \
            w[j_] = __builtin_amdgcn_cvt_scalef32_pk_fp4_f32(w[j_], v[2 * (j_) + 1].z * mul, v[2 * (j_) + 1].w * mul, 1.0f, 3);
            FP4_PACK(0) FP4_PACK(1) FP4_PACK(2) FP4_PACK(3)
#undef FP4_PACK
            *(u32x4*)(ws + WS_V8 + (size_t)e * 512 + 16 * hl) = w;
            if (hl == 0) ((float*)(ws + WS_VSC))[e] = am * (1.f / 6.f);
        } else {
            const float su = fmaxf(0.335f * sqrtf(ss * (1.f / DM)), 1e-30f), inv = 1.f / su;
            unsigned nsum = 0u;
#pragma unroll
            for (int j = 0; j < 4; ++j) {
#pragma unroll
                for (int k = 0; k < 4; ++k) {
                    const unsigned nl = (unsigned)fminf(fmaxf(floorf(v[2 * j][k] * inv) + 8.f, 0.f), 15.f);
                    const unsigned nh = (unsigned)fminf(fmaxf(floorf(v[2 * j + 1][k] * inv) + 8.f, 0.f), 15.f);
                    w[j] |= (nl | (nh << 4)) << (8 * k); nsum += nl + nh;
                }
            }
#pragma unroll
            for (int o = 1; o < 32; o <<= 1) nsum += (unsigned)__shfl_xor((int)nsum, o);
            *(u32x4*)(ws + WS_U8 + (size_t)e * 512 + 16 * hl) = w;
            if (hl == 0) ((f32x2*)(ws + WS_USC))[e] = (f32x2){su, (float)nsum};
        }
    }
}

DI void ce_desc(float& x, float& y) { const float hi = fmaxf(x, y), lo = fminf(x, y); x = hi; y = lo; }
DI void sort16_desc(float (&v)[16]) {
#pragma unroll
    for (int k = 2; k <= 16; k <<= 1) {
#pragma unroll
        for (int j = k >> 1; j > 0; j >>= 1) {
#pragma unroll
            for (int i = 0; i < 16; ++i) { const int l = i ^ j; if (l > i) { if ((i & k) == 0) ce_desc(v[i], v[l]); else ce_desc(v[l], v[i]); } }
        }
    }
}
DI void merge16_desc(float (&a)[16], const float (&b)[16]) {
#pragma unroll
    for (int i = 0; i < 16; ++i) a[i] = fmaxf(a[i], b[15 - i]);
#pragma unroll
    for (int j = 8; j > 0; j >>= 1) {
#pragma unroll
        for (int i = 0; i < 16; ++i) { const int l = i ^ j; if (l > i) ce_desc(a[i], a[l]); }
    }
}
DI void xmerge16(float (&a)[16]) {
    float o[16];
#pragma unroll
    for (int i = 0; i < 16; ++i) o[i] = __shfl_xor(a[i], 32);
    merge16_desc(a, o);
}
constexpr int ca_A(int i) { return i < 16 ? 0 : (i < 24 ? i - 8 : -1); }
constexpr int cb_A(int i) { return i < 16 ? i : (i < 24 ? 0 : -1); }
constexpr int ca_B(int i) { return i < 8 ? 1 : i < 13 ? 2 : i < 17 ? 3 : i < 20 ? 4 : i < 22 ? 5 : i < 24 ? 6 : i < 26 ? 7 : -1; }
constexpr int cb_B(int i) { return i < 8 ? i : i < 13 ? i - 8 : i < 17 ? i - 13 : i < 20 ? i - 17 : i < 22 ? i - 20 : i < 24 ? i - 22 : i < 26 ? i - 24 : -1; }

DI void route_item(const Params& p, LAS unsigned char* wl  , int item, int lane) {
    unsigned char* ws = p.ws;
    const bf16_t* QP = (const bf16_t*)(ws + WS_QP);
    const bf16_t* SK = (const bf16_t*)(ws + WS_SK);
    int* PIDX = (int*)(ws + WS_PIDX); float* PGATE = (float*)(ws + WS_PGATE);
    const int tt = item >> 3, h = item & 7, t0 = tt * 32, r32 = lane & 31, hi = lane >> 5;
    float L0[16], L1[16];
#pragma unroll
    for (int pp = 0; pp < 2; ++pp) {
        const int hp = h * 2 + pp;
        bf16x8 qf[8];
#pragma unroll
        for (int ks = 0; ks < 8; ++ks) qf[ks] = *(const bf16x8*)(QP + (size_t)(t0 + r32) * 2048 + hp * 128 + ks * 16 + hi * 8);
        float run[16];
#pragma unroll
        for (int i = 0; i < 16; ++i) run[i] = -INFINITY;
        bf16x8 skf[8];
        { const bf16_t* skp = SK + ((size_t)(hp * 128 + r32)) * 128 + hi * 8;
#pragma unroll
          for (int ks = 0; ks < 8; ++ks) skf[ks] = *(const bf16x8*)(skp + ks * 16); }
#pragma unroll 1
        for (int nt = 0; nt < 4; ++nt) {
            f32x16 X;
#pragma unroll
            for (int i = 0; i < 16; ++i) X[i] = 0.f;
#pragma unroll
            for (int ks = 0; ks < 8; ++ks) X = MFMA32(skf[ks], qf[ks], X);
            if (nt < 3) { const bf16_t* skp = SK + ((size_t)(hp * 128 + (nt + 1) * 32 + r32)) * 128 + hi * 8;
#pragma unroll
                for (int ks = 0; ks < 8; ++ks) skf[ks] = *(const bf16x8*)(skp + ks * 16); }
            float v[16];
#pragma unroll
            for (int r = 0; r < 16; ++r) { const unsigned n = (unsigned)(nt * 32 + (r & 3) + 8 * (r >> 2)) + 4u * (unsigned)hi;
                v[r] = __uint_as_float((__float_as_uint(X[r]) & ~127u) | n); }
            sort16_desc(v);
            merge16_desc(run, v);
        }
        xmerge16(run);
#pragma unroll
        for (int i = 0; i < 16; ++i) { if (pp == 0) L0[i] = run[i]; else L1[i] = run[i]; }
    }
#pragma unroll
    for (int i = 0; i < 16; ++i) { wl[lane * 32 + i] = (unsigned char)(__float_as_uint(L0[i]) & 127u); wl[lane * 32 + 16 + i] = (unsigned char)(__float_as_uint(L1[i]) & 127u); }
    float c0[16], c1[16];
#pragma unroll
    for (int i = 0; i < 32; ++i) {
        float va = -INFINITY, vb = -INFINITY;
        if (ca_A(i) >= 0) { const float s = L0[ca_A(i) < 0 ? 0 : ca_A(i)] + L1[cb_A(i) < 0 ? 0 : cb_A(i)]; va = __uint_as_float((__float_as_uint(s) & ~255u) | (unsigned)(ca_A(i) * 16 + cb_A(i))); }
        if (ca_B(i) >= 0) { const float s = L0[ca_B(i) < 0 ? 0 : ca_B(i)] + L1[cb_B(i) < 0 ? 0 : cb_B(i)]; vb = __uint_as_float((__float_as_uint(s) & ~255u) | (unsigned)(ca_B(i) * 16 + cb_B(i))); }
        const float v = hi ? vb : va;
        if (i < 16) c0[i] = v; else c1[i - 16] = v;
    }
    sort16_desc(c0); sort16_desc(c1); merge16_desc(c0, c1); xmerge16(c0);
    LDS_WAIT(); asm volatile("" ::: "memory");
    int e[16]; float g[16]; float sum = 0.f;
    const float rs = row_rs((const float*)(ws + WS_ROWSQ), t0 + r32);
    if (h == 0 && hi == 0) ((float*)(ws + WS_RS))[t0 + r32] = rs;
    const float mx = __uint_as_float(__float_as_uint(c0[0]) & ~255u);
#pragma unroll
    for (int k = 0; k < 16; ++k) {
        const unsigned bits = __float_as_uint(c0[k]); const int code = (int)(bits & 255u), a = code >> 4, b = code & 15;
        const int i0 = wl[lane * 32 + a], i1 = wl[lane * 32 + 16 + b];
        e[k] = i0 * 128 + i1;
        g[k] = __expf((__uint_as_float(bits & ~255u) - mx) * rs); sum += g[k];
    }
    const float inv = 1.f / sum;
    const size_t ob = ((size_t)(t0 + r32) * 8 + h) * 16 + hi * 8;
    u32x4 e0, e1; f32x4 g0, g1;
    e0.x = hi ? e[8] : e[0]; e0.y = hi ? e[9] : e[1]; e0.z = hi ? e[10] : e[2]; e0.w = hi ? e[11] : e[3];
    e1.x = hi ? e[12] : e[4]; e1.y = hi ? e[13] : e[5]; e1.z = hi ? e[14] : e[6]; e1.w = hi ? e[15] : e[7];
    g0.x = (hi ? g[8] : g[0]) * inv; g0.y = (hi ? g[9] : g[1]) * inv; g0.z = (hi ? g[10] : g[2]) * inv; g0.w = (hi ? g[11] : g[3]) * inv;
    g1.x = (hi ? g[12] : g[4]) * inv; g1.y = (hi ? g[13] : g[5]) * inv; g1.z = (hi ? g[14] : g[6]) * inv; g1.w = (hi ? g[15] : g[7]) * inv;
    *(u32x4*)(PIDX + ob) = e0; *(u32x4*)(PIDX + ob + 4) = e1;
    *(f32x4*)(PGATE + ob) = g0; *(f32x4*)(PGATE + ob + 4) = g1;
    LDS_WAIT(); asm volatile("" ::: "memory");
}
DI void phase_route(const Params& p, LAS unsigned char* lds, int lane, int wid) {
    const int gw = blockIdx.x * NWAVES + wid, NGW = gridDim.x * NWAVES;
    for (int it = gw; it < (NTOK / 32) * NH; it += NGW) route_item(p, lds + wid * 2048, it, lane);
}

DI float gelu_exact(float x) { return 0.5f * x * (1.f + erff(x * 0.70710678118654752f)); }
DI float gelu_bf(float x) {
    const float z = fabsf(x) * 0.70710678118654752f;
    const float t = __builtin_amdgcn_rcpf(fmaf(0.3275911f, z, 1.f));
    const float poly = t * fmaf(t, fmaf(t, fmaf(t, fmaf(t, 1.061405429f, -1.453152027f), 1.421413741f), -0.284496736f), 0.254829592f);
    const float he = 0.5f * poly * __expf(-z * z);
    return x * (x >= 0.f ? 1.f - he : he);
}
DI void experts_quant_x(const u32x4 (&xn)[4], unsigned (&xa)[8], float& sx, float& ktok) {
    float f[32];
#pragma unroll
    for (int j = 0; j < 4; ++j) { float t[8]; unpack8(xn[j], t);
#pragma unroll
        for (int i = 0; i < 8; ++i) f[8 * j + i] = t[i]; }
    float m = 0.f;
#pragma unroll
    for (int i = 0; i < 32; ++i) m = fmaxf(m, fabsf(f[i]));
    m = fmaxf(m, dpp_mov<0x128>(m)); m = fmaxf(m, dpp_mov<0x124>(m)); m = fmaxf(m, dpp_mov<0x122>(m)); m = fmaxf(m, dpp_mov<0x121>(m));
    m = fmaxf(m, __shfl_xor(m, 16));
    m = fmaxf(m, 1e-30f);
    const float inv = 127.f / m; sx = m * (1.f / 127.f);
    unsigned tsum = 0u;
#pragma unroll
    for (int j = 0; j < 4; ++j) { unsigned wh = 0u, wl = 0u;
#pragma unroll
        for (int k = 0; k < 4; ++k) {
            const unsigned q0 = (unsigned)(rintf(f[8 * j + k] * inv) + 128.f), q1 = (unsigned)(rintf(f[8 * j + 4 + k] * inv) + 128.f);
            wh |= ((q0 >> 4) | ((q1 >> 4) << 4)) << (8 * k); wl |= ((q0 & 15u) | ((q1 & 15u) << 4)) << (8 * k); tsum += q0 + q1; }
        xa[j] = wh; xa[4 + j] = wl; }
    float tf = row16_sum((float)tsum);
    tf += __shfl_xor(tf, 16);
    ktok = 983040.f - 7.5f * tf;
}
DI void phase_experts(const Params& p, LAS unsigned char* ldsw  , int lane, int wid, float* outp, const int IDMASK) {
    unsigned char* ws = p.ws;
    const bf16_t* XN = (const bf16_t*)(ws + WS_XN);
    const unsigned char* U8 = ws + WS_U8; const unsigned char* V8 = ws + WS_V8;
    const f32x2* USC = (const f32x2*)(ws + WS_USC); const float* VSC = (const float*)(ws + WS_VSC);
    const int* PIDX = (const int*)(ws + WS_PIDX); const float* PGATE = (const float*)(ws + WS_PGATE); const float* RS = (const float*)(ws + WS_RS);
    float* H1 = p.out;
    const int hl = lane & 31; const bool hi = lane >= 32;
    const bool b0 = (lane & 1) != 0, b1 = (lane & 2) != 0;
    const int ntile = ((NTOK / 32) - (int)blockIdx.x + (int)gridDim.x - 1) / (int)gridDim.x;
    if (ntile <= 0) return;
    const int ntw = ntile * 4;
    auto tokof = [&](int t) { const int tc = t < ntw ? t : ntw - 1; return 32 * ((int)blockIdx.x + (tc >> 2) * (int)gridDim.x) + 4 * wid + (tc & 3); };
    unsigned xa[8]; float sx, ktok;
    typedef int v8i_t __attribute__((ext_vector_type(8)));
    float nfg[16];
#pragma unroll
    for (int r = 0; r < 16; ++r) nfg[r] = p.normf_g[32 * crow(r, hi) + hl];
    f32x16 D, D2;
#pragma unroll
    for (int i = 0; i < 16; ++i) { D[i] = 0.f; D2[i] = 0.f; }
    unsigned bmask[4];
#pragma unroll
    for (int r = 0; r < 4; ++r) bmask[r] = ((hi ? 1 : 0) == ((hl >> 4) & 1) && r == ((hl & 15) >> 2)) ? (0xFFu << (8 * (hl & 3))) : 0u;
    int iA1, iB1, iA2, iB2; float gA1, gB1, gA2, gB2, vA1, vB1; f32x2 uA1, uB1;
    auto ld_ids = [&](int t, int& iA, int& iB, float& gA, float& gB) { const size_t b = (size_t)tokof(t) * 128 + lane;
        iA = PIDX[b] & IDMASK; iB = PIDX[b + 64] & IDMASK; gA = PGATE[b]; gB = PGATE[b + 64]; };
    auto wr_rec = [&](int t, int iA, int iB, float gA, float gB, f32x2 uA, f32x2 uB, float vA, float vB) {
        LAS unsigned char* buf = ldsw + (t & 1) * 2048;
        *(LAS u32x4*)(buf + lane * 16) = (u32x4){(unsigned)iA, __float_as_uint(gA * vA), __float_as_uint(uA.x), __float_as_uint(uA.y)};
        *(LAS u32x4*)(buf + 1024 + lane * 16) = (u32x4){(unsigned)iB, __float_as_uint(gB * vB), __float_as_uint(uB.x), __float_as_uint(uB.y)};
    };
    LAS unsigned char* hvbuf = ldsw + 4096;
    auto prime = [&](int t0) {
        ld_ids(t0, iA1, iB1, gA1, gB1);
        uA1 = USC[iA1]; uB1 = USC[iB1]; vA1 = VSC[iA1]; vB1 = VSC[iB1];
        wr_rec(t0, iA1, iB1, gA1, gB1, uA1, uB1, vA1, vB1);
        ld_ids(t0 + 1, iA1, iB1, gA1, gB1);
        uA1 = USC[iA1]; uB1 = USC[iB1]; vA1 = VSC[iA1]; vB1 = VSC[iB1];
        ld_ids(t0 + 2, iA2, iB2, gA2, gB2);
    };
    auto advance = [&](int t) {
        wr_rec(t + 1, iA1, iB1, gA1, gB1, uA1, uB1, vA1, vB1);
        iA1 = iA2; iB1 = iB2; gA1 = gA2; gB1 = gB2;
        uA1 = USC[iA1]; uB1 = USC[iB1]; vA1 = VSC[iA1]; vB1 = VSC[iB1];
        ld_ids(t + 3, iA2, iB2, gA2, gB2);
    };
    const bool b2 = (lane & 4) != 0;
#pragma unroll 1
    for (int tc = 0; tc < ntw; tc += 16) {
        const int tend = tc + 16 < ntw ? tc + 16 : ntw;
        prime(tc);
        { u32x4 xn[4];
#pragma unroll
          for (int j = 0; j < 4; ++j) xn[j] = *(const u32x4*)(XN + (size_t)tokof(tc) * DM + 32 * hl + 8 * j);
          experts_quant_x(xn, xa, sx, ktok); sx *= RS[tokof(tc)]; }
        u32x4 uw[8];
#pragma unroll
        for (int q = 0; q < 8; ++q) { const int id = *(LAS const int*)(ldsw + (tc & 1) * 2048 + ((hi ? 1 : 0) + 2 * q) * 16); uw[q] = *(const u32x4*)(U8 + (size_t)id * 512 + 16 * hl); }
#pragma unroll 1
        for (int t = tc; t < tend; ++t) {
            advance(t);
            auto groupU = [&](int g) {
                const LAS unsigned char* rc_cur = ldsw + (t & 1) * 2048 + (g * 16 + (hi ? 1 : 0)) * 16;
                const int gn = g + 1;
                const LAS unsigned char* rc_nxt = ldsw + ((t + (gn >> 3)) & 1) * 2048 + ((gn & 7) * 16 + (hi ? 1 : 0)) * 16;
                float d[8]; int idn[8];
                const u32x4 rl = *(LAS const u32x4*)(rc_cur + 32 * (lane & 7));
#pragma unroll
                for (int q = 0; q < 8; ++q) idn[q] = *(LAS const int*)(rc_nxt + 32 * q);
#pragma unroll
                for (int q = 0; q < 8; ++q) {
                    __builtin_amdgcn_sched_barrier(0);
                    const u32x4 w = uw[q];
                    unsigned h0 = __builtin_amdgcn_udot8(w[0], xa[0], 0u, false), l0 = __builtin_amdgcn_udot8(w[0], xa[4], 0u, false);
                    unsigned h1 = __builtin_amdgcn_udot8(w[1], xa[1], 0u, false), l1 = __builtin_amdgcn_udot8(w[1], xa[5], 0u, false);
                    h0 = __builtin_amdgcn_udot8(w[2], xa[2], h0, false); l0 = __builtin_amdgcn_udot8(w[2], xa[6], l0, false);
                    h1 = __builtin_amdgcn_udot8(w[3], xa[3], h1, false); l1 = __builtin_amdgcn_udot8(w[3], xa[7], l1, false);
                    d[q] = (float)(((h0 + h1) << 4) + (l0 + l1));
                    __builtin_amdgcn_sched_barrier(0);
                    uw[q] = *(const u32x4*)(U8 + (size_t)idn[q] * 512 + 16 * hl);
                }
                __builtin_amdgcn_sched_barrier(0);
                float a[4], c2[2];
#pragma unroll
                for (int i = 0; i < 4; ++i) { const float keep = b0 ? d[2 * i + 1] : d[2 * i], send = b0 ? d[2 * i] : d[2 * i + 1]; a[i] = keep + dpp_mov<0xB1>(send); }
#pragma unroll
                for (int i = 0; i < 2; ++i) { const float keep = b1 ? a[2 * i + 1] : a[2 * i], send = b1 ? a[2 * i] : a[2 * i + 1]; c2[i] = keep + dpp_mov<0x4E>(send); }
                float c;
                { const float keep = b2 ? c2[1] : c2[0], send = b2 ? c2[0] : c2[1]; c = keep + dpp_mov<0x124>(send); }
                c += dpp_mov<0x128>(c);
                c += __shfl_xor(c, 16);
                const float gtl = __uint_as_float(rl.y), usl = __uint_as_float(rl.z), rcl = __uint_as_float(rl.w);
                const float dq = ((c - 128.f * rcl) + ktok) * (usl * sx);
#if PROBE == 50
                const float hvl = 0.f * gelu_bf(dq) * gtl;
#else
                const float hvl = gelu_bf(dq) * gtl;
#endif
                const unsigned code = (unsigned)__builtin_amdgcn_cvt_pk_fp8_f32(hvl * 128.f, 0.f, 0, false) & 0xffu;
                if ((lane & 0x18) == 0) hvbuf[((t - tc) * 8 + g) * 16 + 2 * (lane & 7) + (hi ? 1 : 0)] = (unsigned char)code;
            };
#pragma unroll 1
            for (int g = 0; g < 7; ++g) groupU(g);
            u32x4 xn[4];
#pragma unroll
            for (int j = 0; j < 4; ++j) xn[j] = *(const u32x4*)(XN + (size_t)tokof(t + 1) * DM + 32 * hl + 8 * j);
            groupU(7);
            experts_quant_x(xn, xa, sx, ktok); sx *= RS[tokof(t + 1)];
        }
        prime(tc);
        u32x4 vw[8];
#pragma unroll
        for (int q = 0; q < 8; ++q) { const int id = *(LAS const int*)(ldsw + (tc & 1) * 2048 + ((hi ? 1 : 0) + 2 * q) * 16); vw[q] = *(const u32x4*)(V8 + (size_t)id * 512 + 16 * hl); }
#pragma unroll 1
        for (int t = tc; t < tend; ++t) {
            advance(t);
            auto groupV = [&](int g) {
                const int gn = g + 1;
                const LAS unsigned char* rc_nxt = ldsw + ((t + (gn >> 3)) & 1) * 2048 + ((gn & 7) * 16 + (hi ? 1 : 0)) * 16;
                int idn[8];
#pragma unroll
                for (int q = 0; q < 8; ++q) idn[q] = *(LAS const int*)(rc_nxt + 32 * q);
                const u32x4 hb = *(LAS const u32x4*)(hvbuf + ((t - tc) * 8 + g) * 16);
#pragma unroll
                for (int q = 0; q < 8; ++q) {
                    __builtin_amdgcn_sched_barrier(0);
                    const unsigned wq = hb[q >> 1] >> (16 * (q & 1));
                    const unsigned bb0 = (wq & 0xffu) * 0x01010101u, bb1 = ((wq >> 8) & 0xffu) * 0x01010101u;
                    v8i_t Bv, Av;
#pragma unroll
                    for (int r = 0; r < 4; ++r) { Bv[r] = (int)(bb0 & bmask[r]); Bv[4 + r] = (int)(bb1 & bmask[r]); }
                    Av[0] = (int)vw[q].x; Av[1] = (int)vw[q].y; Av[2] = (int)vw[q].z; Av[3] = (int)vw[q].w; Av[4] = 0; Av[5] = 0; Av[6] = 0; Av[7] = 0;
                    if (q & 1) D2 = __builtin_amdgcn_mfma_scale_f32_32x32x64_f8f6f4(Av, Bv, D2, 4  , 0  , 0, 0, 0, 0  );
                    else D = __builtin_amdgcn_mfma_scale_f32_32x32x64_f8f6f4(Av, Bv, D, 4, 0, 0, 0, 0, 0);
                    __builtin_amdgcn_sched_barrier(0);
                    vw[q] = *(const u32x4*)(V8 + (size_t)idn[q] * 512 + 16 * hl);
                }
            };
#pragma unroll 1
            for (int g = 0; g < 7; ++g) groupV(g);
            const int tok = tokof(t);
            float o[16];
            { const float* hr0 = H1 + (size_t)tok * DM + hl;
#pragma unroll
              for (int r = 0; r < 16; ++r) o[r] = __builtin_nontemporal_load(hr0 + 32 * crow(r, hi)); }
            groupV(7);
            float ss = 0.f;
#pragma unroll
            for (int r = 0; r < 16; ++r) { o[r] += (D[r] + D2[r]) * (1.f / 128.f); ss += o[r] * o[r]; D[r] = 0.f; D2[r] = 0.f; }
            const float rs = rsqrtf(wave_sum(ss) * (1.f / DM) + RMS_EPS);
            float* orow = outp + (size_t)tok * DM + hl;
#pragma unroll
            for (int r = 0; r < 16; ++r) __builtin_nontemporal_store(o[r] * rs * nfg[r], orow + 32 * crow(r, hi));
        }
    }
}

__global__ void __launch_bounds__(NTHREADS, 2) mega_fwd(Params p) {
    extern __shared__ __attribute__((aligned(16))) unsigned char lds_raw[];
    LAS unsigned char* lds = (LAS unsigned char*)lds_raw;
    const int tid = threadIdx.x, lane = tid & 63, wid = __builtin_amdgcn_readfirstlane(tid >> 6);
    unsigned char* ws = p.ws;
    bf16_t* XN = (bf16_t*)(ws + WS_XN);
    bf16_t* W1T = (bf16_t*)(ws + WS_W1T);
    volatile LAS unsigned* MISC = (volatile LAS unsigned*)(lds + LDS_MISC);
    if (tid < 64) MISC[tid] = 0u;
    __syncthreads();
    const XcdBarrier bar = xcd_barrier_post((unsigned*)ws, MISC + 8);
#define GSYNC() xcd_barrier(bar)

#ifndef ONLY
#define ONLY -1
#endif
#define PH(k) if (ONLY < 0 || ONLY == (k))
#define IDS() int tid = (int)threadIdx.x; asm volatile("" : "+v"(tid)); const int lane = tid & 63, wid = __builtin_amdgcn_readfirstlane(tid >> 6); (void)lane; (void)wid;
    PH(0) { IDS(); phase_prep(p, lds, tid, lane, wid); }
#if PROBE == 13
    phase_prep(p, lds, tid, lane, wid);
#endif
    GSYNC();
    PH(1) { IDS(); { F1a f{(bf16_t*)(ws + WS_QKV), (bf16_t*)(ws + WS_PB)}; run_gemm(lds, XN, W1T, N1A, 1024, f); } }
#if PROBE == 11
    { F1a f{(bf16_t*)(ws + WS_QKV), (bf16_t*)(ws + WS_PB)}; run_gemm(lds, XN, W1T, N1A, 1024, f); }
#endif
    GSYNC();
    PH(2) { IDS(); phase_kbar_vt(p, lds, tid, lane, wid); }
#if PROBE == 14 || PROBE == 61
    phase_kbar_vt(p, lds, tid, lane, wid);
#endif
    PH(3) { IDS(); phase_rwkv_prep2<true>(p, lds, tid, lane, wid); }
#if PROBE == 8 || PROBE == 61
    phase_rwkv_prep2<true>(p, lds, tid, lane, wid);
#endif

    GSYNC();
    PH(6) { IDS(); phase_attn2<0>(p, lds, tid, lane, wid); }
#if PROBE == 63 || PROBE == 61
    __syncthreads();
    phase_attn2<0>(p, lds, tid, lane, wid);
#endif
    GSYNC();
    PH(5) { IDS(); phase_chunkprep<4>(p, lds, lane, wid); }
    PH(8) { IDS(); if (wid >= 4) phase_uv_convert(p, lane, (int)blockIdx.x * 4 + wid - 4, (int)gridDim.x * 4); }
#if PROBE == 31 || PROBE == 61
    phase_chunkprep<4>(p, lds, lane, wid);
#endif
#if PROBE == 33
    phase_chunkprep<1>(p, lds, lane, wid);
#endif
#if PROBE == 34
    phase_chunkprep<2>(p, lds, lane, wid);
#endif
#if PROBE == 35
    phase_chunkprep<3>(p, lds, lane, wid);
#endif
    GSYNC();
    PH(17) { IDS(); phase_chunkscan(p, lds, tid, lane, wid); }
    PH(9) { IDS(); if (gridDim.x > 64 && (int)blockIdx.x >= 64) { F1b f{ws, p.out, 0}; run_gemm_on(lds, XN, W1T + (size_t)N1A * 1024, G1B_EARLY, 1024, f, (int)gridDim.x - 64, (int)blockIdx.x - 64); } }
#if PROBE == 32 || PROBE == 62
    phase_chunkscan(p, lds, tid, lane, wid);
#endif
    GSYNC();
    PH(7) { IDS(); phase_post(p, tid, lane, wid); }
#if PROBE == 62
    phase_post(p, tid, lane, wid);
#endif
    PH(9) { IDS(); { const int e = gridDim.x > 64 ? G1B_EARLY : 0; F1b f{ws, p.out, e}; run_gemm(lds, XN, W1T + (size_t)(N1A + e) * 1024, NGATE - e, 1024, f); } }
#if PROBE == 64 || PROBE == 66
    { const int e = gridDim.x > 64 ? G1B_EARLY : 0; F1b f{ws, p.out, e}; run_gemm(lds, XN, W1T + (size_t)(N1A + e) * 1024, NGATE - e, 1024, f); }
#endif
    GSYNC();
    PH(10) { IDS(); { FPa f{ws, p.out, (bf16_t*)(ws + WS_Y)}; run_gemm(lds, (const bf16_t*)(ws + WS_OA), (const bf16_t*)(ws + WS_WPA), 1024, 512, f); } }
#if PROBE == 19 || PROBE == 66
    { FPa f{ws, p.out, (bf16_t*)(ws + WS_Y)}; run_gemm(lds, (const bf16_t*)(ws + WS_OA), (const bf16_t*)(ws + WS_WPA), 1024, 512, f); }
#endif
    __builtin_amdgcn_fence(__ATOMIC_ACQ_REL, "workgroup"); __syncthreads();
    PH(11) { IDS(); { FPb f{ws, p.out, (bf16_t*)(ws + WS_Y)}; run_gemm(lds, (const bf16_t*)(ws + WS_OB), (const bf16_t*)(ws + WS_WPB), 1024, 512, f); } }
    GSYNC();
    PH(12) { IDS(); { FOut f{p.x, p.norm2_g, p.out, XN, (float*)(ws + WS_ROWSQ)}; run_gemm(lds, (const bf16_t*)(ws + WS_Y), (const bf16_t*)(ws + WS_WO), 1024, 1024, f); } }
#if PROBE == 65 || PROBE == 66
    { FOut f{p.x, p.norm2_g, p.out, XN, (float*)(ws + WS_ROWSQ)}; run_gemm(lds, (const bf16_t*)(ws + WS_Y), (const bf16_t*)(ws + WS_WO), 1024, 1024, f); }
#endif
    GSYNC();
    PH(14) { IDS(); { FQ f{(bf16_t*)(ws + WS_QP)}; run_gemm(lds, XN, (const bf16_t*)(ws + WS_WQ), 2048, 1024, f); } }
#if PROBE == 12 || PROBE == 62
    { FQ f{(bf16_t*)(ws + WS_QP)}; run_gemm(lds, XN, (const bf16_t*)(ws + WS_WQ), 2048, 1024, f); }
#endif
    GSYNC();
    PH(15) { IDS(); phase_route(p, lds, lane, wid); }
#if PROBE == 7 || PROBE == 62
    phase_route(p, lds, lane, wid);
#endif
    __builtin_amdgcn_fence(__ATOMIC_ACQ_REL, "workgroup"); __syncthreads();
#if PROBE == 4 || PROBE == 52
#pragma unroll 1
    for (int rep = 0; rep < 2; ++rep) { IDS(); phase_experts(p, lds + wid * 6144, lane, wid, rep == 0 ? (float*)(ws + WS_QKV) : p.out, (rep == 0 && PROBE == 52) ? 2047 : -1); }
#else
    PH(16) { IDS(); phase_experts(p, lds + wid * 6144, lane, wid, p.out, -1); }
#endif
}

extern "C" void kernel_launch(void* const* d_in, const int* in_sizes, int n_in, void* d_out, int out_size, void* d_ws, size_t ws_size, hipStream_t stream) {
    static int grid = 0;
    if (grid == 0) {
        if (n_in != 24 || out_size != NTOK * DM || ws_size < WS_NEED) { fprintf(stderr, "kernel_launch: unexpected problem (n_in %d, out %d, ws %zu)\n", n_in, out_size, ws_size); grid = -1; return; }
        int dev = 0, cus = 0, per_cu = 0;
        if (hipGetDevice(&dev) != hipSuccess || hipDeviceGetAttribute(&cus, hipDeviceAttributeMultiprocessorCount, dev) != hipSuccess) { grid = -1; return; }
        if (hipFuncSetAttribute((const void*)mega_fwd, hipFuncAttributeMaxDynamicSharedMemorySize, LDS_BYTES) != hipSuccess) { fprintf(stderr, "kernel_launch: hipFuncSetAttribute failed\n"); grid = -1; return; }
        if (hipOccupancyMaxActiveBlocksPerMultiprocessor(&per_cu, (const void*)mega_fwd, NTHREADS, LDS_BYTES) != hipSuccess || per_cu < 1) { fprintf(stderr, "kernel_launch: occupancy query says %d\n", per_cu); per_cu = 0; }
        (void)hipGetLastError();
        if (per_cu < 1) { grid = -1; return; }
        grid = cus * 1;
        if (grid < 1) grid = -1;
    }
    if (grid < 0) return;
    Params p{};
    p.x = (const float*)d_in[0]; p.norm1_g = (const float*)d_in[1]; p.w_in = (const float*)d_in[2]; p.rwkv_mu = (const float*)d_in[3];
    p.w0 = (const float*)d_in[4]; p.w_lora_up = (const float*)d_in[5]; p.a0 = (const float*)d_in[6]; p.a_lora_up = (const float*)d_in[7];
    p.g_lora_up = (const float*)d_in[8]; p.k_k = (const float*)d_in[9]; p.k_a = (const float*)d_in[10]; p.r_k = (const float*)d_in[11];
    p.lnx_g = (const float*)d_in[12]; p.lnx_b = (const float*)d_in[13]; p.w_proj_a = (const float*)d_in[14]; p.w_proj_b = (const float*)d_in[15];
    p.w_out = (const float*)d_in[16]; p.norm2_g = (const float*)d_in[17]; p.peer_wq = (const float*)d_in[18]; p.peer_subkeys = (const float*)d_in[19];
    p.peer_u = (const float*)d_in[20]; p.peer_v = (const float*)d_in[21]; p.rel_bias = (const float*)d_in[22]; p.normf_g = (const float*)d_in[23];
    p.out = (float*)d_out; p.ws = (unsigned char*)d_ws;
    if (hipMemsetAsync(d_ws, 0, 65536, stream) != hipSuccess) { fprintf(stderr, "kernel_launch: memset failed\n"); return; }
    void* args[] = {&p};
    hipError_t e = hipLaunchCooperativeKernel((const void*)mega_fwd, dim3(grid), dim3(NTHREADS), args, LDS_BYTES, stream);
    if (e != hipSuccess) fprintf(stderr, "kernel_launch: cooperative launch failed: %s (grid %d)\n", hipGetErrorString(e), grid);
}
```

```cpp
#include <hip/hip_runtime.h>
#include <hip/hip_cooperative_groups.h>
#include <cstdio>
#include <cstdint>
#include <utility>
namespace cg = cooperative_groups;
namespace pg8 {
#define PG8_LAS __attribute__((address_space(3)))
typedef unsigned short bf16_t;
typedef short bf16x8 __attribute__((ext_vector_type(8)));
typedef float f32x4 __attribute__((ext_vector_type(4)));
typedef unsigned u32x4 __attribute__((ext_vector_type(4)));
constexpr int BM = 256, BK = 64, HALF = 128, HTB = HALF * BK * 2  , STAGE_BYTES = 8 * HTB, NXCD = 8, WGM = 8;

__host__ __device__ __forceinline__ int lds_byte(int r, int c) { const int st = (r >> 4) * 2 + (c >> 5), rr = r & 15, cc = c & 31, ob = rr * 64 + cc * 2; return st * 1024 + (ob ^ (((ob >> 9) & 1) << 5)); }
__host__ __device__ __forceinline__ void stage_rc(int b, int& R, int& C) { const int st = b / 1024, sb = b % 1024, swz = sb ^ (((sb >> 9) & 1) << 5); R = (st >> 1) * 16 + swz / 64; C = (st & 1) * 32 + (swz % 64) / 2; }
__host__ __device__ __forceinline__ int perm32(int rho) { const int n = rho >> 4, i = rho & 15; return 8 * (i >> 2) + 4 * n + (i & 3); }

struct Unit { int pm, pn; };
struct Gemm { const bf16_t* A; const bf16_t* Bt; int M, N, K; };

struct StaticOrder {
    int nM, nN, nwg, G, c;
    __host__ __device__ void init(int M, int N, int G_, int c_) { nM = M / BM; nN = N / BM; nwg = nM * nN; G = G_; c = c_; }
    __host__ __device__ bool next(int i, Unit& u) const {
        const long L = (long)i * G + c; if (L >= nwg) return false;
        int wgid = (int)L; { const int q = nwg / NXCD, r = nwg % NXCD, xcd = wgid % NXCD, off = wgid / NXCD; wgid = (xcd < r ? xcd * (q + 1) : r * (q + 1) + (xcd - r) * q) + off; }
        const int nig = WGM * nN, gid = wgid / nig, fm = gid * WGM, gsz = (nM - fm) < WGM ? (nM - fm) : WGM;
        u.pm = fm + ((wgid % nig) % gsz); u.pn = (wgid % nig) / gsz; return true;
    }
    __device__ __forceinline__ void a_ready(const Unit&) const {}
    __device__ __forceinline__ void done(const Unit&) const {}
};
typedef int pg8_v8i __attribute__((ext_vector_type(8)));
__device__ __forceinline__ pg8_v8i pg8_cat8(bf16x8 lo, bf16x8 hi) {
    typedef int v4i_ __attribute__((ext_vector_type(4)));
    const v4i_ a = __builtin_bit_cast(v4i_, lo), b = __builtin_bit_cast(v4i_, hi);
    return (pg8_v8i){a[0], a[1], a[2], a[3], b[0], b[1], b[2], b[3]};
}
template <class Epi, class Sched, bool ALIGN_EPI = false, bool SP2 = false, bool FP8 = false>
__device__ __forceinline__ void gemm_phase(PG8_LAS unsigned char* lds, const Gemm g, const Sched& S, const Epi& E) {
    int tid_ = (int)threadIdx.x; asm volatile("" : "+v"(tid_));
    const int tid = tid_, wid = __builtin_amdgcn_readfirstlane(tid >> 6), lane = tid & 63, wr = wid >> 2, wc = wid & 3, fr = lane & 15, fq = lane >> 4;
    const int K = g.K, nt = K / BK;
    unsigned voffA[2], voffB[2];
#pragma unroll
    for (int i = 0; i < 2; ++i) { int R, C; stage_rc(tid * 16 + i * 8192, R, C); const int Rb = Epi::PERM ? ((R & ~31) + perm32(R & 31)) : R;
        voffA[i] = (unsigned)(R * K + C) * 2u; voffB[i] = (unsigned)(Rb * K + C) * 2u; }
    const size_t kstep = (size_t)(BK * 2);
    const size_t hstep = (size_t)HALF * K * 2;
    const size_t tstep = 2 * hstep;
    const unsigned ldsw = (unsigned)wid * 1024u;
    const int aoff = lds_byte(wr * 64 + fr, fq * 8), boff = lds_byte(wc * 32 + fr, fq * 8);
#define PG8_SA(b, h) (((b) * 2 + (h)) * HTB)
#define PG8_SB(b, h) ((4 + (b) * 2 + (h)) * HTB)
#define PG8_STAGE(bufoff, gbase, voff) do { _Pragma("unroll") for (int _i = 0; _i < 2; ++_i) \
        __builtin_amdgcn_global_load_lds((const unsigned*)((const char*)(gbase) + (voff)[_i]), (PG8_LAS unsigned*)(lds + (bufoff) + ldsw + _i * 8192), 16, 0, 0); } while (0)
#define PG8_LDA(dst, b, h) do { _Pragma("unroll") for (int m = 0; m < 4; ++m) { \
        if constexpr (FP8) dst##8[m] = pg8_cat8(*(const PG8_LAS bf16x8*)(lds + PG8_SA(b, h) + aoff + m * 2048), *(const PG8_LAS bf16x8*)(lds + PG8_SA(b, h) + aoff + m * 2048 + 1024)); \
        else { _Pragma("unroll") for (int k = 0; k < 2; ++k) dst[m][k] = *(const PG8_LAS bf16x8*)(lds + PG8_SA(b, h) + aoff + m * 2048 + k * 1024); } } } while (0)
#define PG8_LDB(dst, b, h) do { _Pragma("unroll") for (int n = 0; n < 2; ++n) { \
        if constexpr (FP8) dst##8[n] = pg8_cat8(*(const PG8_LAS bf16x8*)(lds + PG8_SB(b, h) + boff + n * 2048), *(const PG8_LAS bf16x8*)(lds + PG8_SB(b, h) + boff + n * 2048 + 1024)); \
        else { _Pragma("unroll") for (int k = 0; k < 2; ++k) dst[n][k] = *(const PG8_LAS bf16x8*)(lds + PG8_SB(b, h) + boff + n * 2048 + k * 1024); } } } while (0)
#define PG8_MMA(ai, bj, At, Bt) do { __builtin_amdgcn_s_setprio(1); \
        if constexpr (FP8) { _Pragma("unroll") for (int m = 0; m < 4; ++m) _Pragma("unroll") for (int n = 0; n < 2; ++n) \
            asm volatile("v_mfma_f32_16x16x128_f8f6f4 %0, %1, %2, %0" : "+v"(acc[ai][bj][m][n]) : "v"(Bt##8[n]), "v"(At##8[m])); } \
        else { _Pragma("unroll") for (int m = 0; m < 4; ++m) _Pragma("unroll") for (int n = 0; n < 2; ++n) _Pragma("unroll") for (int k = 0; k < 2; ++k) \
            acc[ai][bj][m][n] = __builtin_amdgcn_mfma_f32_16x16x32_bf16(Bt[n][k], At[m][k], acc[ai][bj][m][n], 0, 0, 0); } \
        __builtin_amdgcn_s_setprio(0); } while (0)
#define PG8_WAIT_V(n) asm volatile("s_waitcnt vmcnt(" #n ")" ::: "memory")
#define PG8_WAIT_L(n) asm volatile("s_waitcnt lgkmcnt(" #n ")" ::: "memory")
#define PG8_BAR __builtin_amdgcn_s_barrier()
#define PG8_SCHED __builtin_amdgcn_sched_barrier(0)
    Unit cur, nxt; int ui = 0;
    if (!S.next(0, cur)) return;
    f32x4 acc[2][2][4][2];
#pragma unroll
    for (int a = 0; a < 2; ++a)
#pragma unroll
        for (int b = 0; b < 2; ++b)
#pragma unroll
            for (int m = 0; m < 4; ++m)
#pragma unroll
                for (int n = 0; n < 2; ++n) acc[a][b][m][n] = (f32x4){0.f, 0.f, 0.f, 0.f};
    bf16x8 At[4][2], B0[2][2], B1[2][2];
    pg8_v8i At8[4], B08[2], B18[2];
    const char* cA = (const char*)g.A + (size_t)cur.pm * tstep; const char* cB = (const char*)g.Bt + (size_t)cur.pn * tstep;
    S.a_ready(cur);
    if constexpr (SP2) {
        PG8_STAGE(PG8_SB(0, 0), cB, voffB); PG8_STAGE(PG8_SB(0, 1), cB + hstep, voffB); PG8_STAGE(PG8_SA(0, 0), cA, voffA); PG8_STAGE(PG8_SA(0, 1), cA + hstep, voffA);
        if (wr == 1) PG8_BAR;
        PG8_WAIT_V(2); PG8_BAR;
        PG8_STAGE(PG8_SB(1, 0), cB + kstep, voffB); PG8_STAGE(PG8_SA(1, 0), cA + kstep, voffA); PG8_STAGE(PG8_SB(1, 1), cB + hstep + kstep, voffB);
        PG8_WAIT_V(6); PG8_BAR;
    } else {
        PG8_STAGE(PG8_SB(0, 0), cB, voffB); PG8_STAGE(PG8_SA(0, 0), cA, voffA); PG8_STAGE(PG8_SB(0, 1), cB + hstep, voffB); PG8_STAGE(PG8_SA(0, 1), cA + hstep, voffA);
        if (wr == 1) PG8_BAR;
        PG8_WAIT_V(4); PG8_BAR;
        PG8_STAGE(PG8_SB(1, 0), cB + kstep, voffB); PG8_STAGE(PG8_SA(1, 0), cA + kstep, voffA); PG8_STAGE(PG8_SB(1, 1), cB + hstep + kstep, voffB);
        PG8_WAIT_V(6); PG8_BAR;
    }
    for (;;) {
        const bool has_next = S.next(ui + 1, nxt);
        const char* nA = has_next ? (const char*)g.A + (size_t)nxt.pm * tstep : cA; const char* nB = has_next ? (const char*)g.Bt + (size_t)nxt.pn * tstep : cB;
        for (int t = 0; t < nt; t += 2) {
            const bool last = (t == nt - 2);
            const char* a1 = cA + (size_t)(t + 1) * kstep;
            const char* a2 = last ? nA : cA + (size_t)(t + 2) * kstep; const char* b2 = last ? nB : cB + (size_t)(t + 2) * kstep;
            const char* a3 = a2 + kstep; const char* b3 = b2 + kstep;
            if (last && has_next) S.a_ready(nxt);
            if constexpr (SP2) {
            PG8_LDB(B0, 0, 0); PG8_LDB(B1, 0, 1); PG8_SCHED; PG8_LDA(At, 0, 0); PG8_STAGE(PG8_SA(1, 1), a1 + hstep, voffA);
            PG8_WAIT_V(8); PG8_WAIT_L(0); PG8_BAR; PG8_MMA(0, 0, At, B0); PG8_MMA(0, 1, At, B1); PG8_BAR; PG8_SCHED;
            PG8_LDA(At, 0, 1); PG8_STAGE(PG8_SB(0, 0), b2, voffB); PG8_STAGE(PG8_SB(0, 1), b2 + hstep, voffB); PG8_STAGE(PG8_SA(0, 0), a2, voffA);
            PG8_WAIT_V(8); PG8_WAIT_L(0); PG8_BAR; PG8_MMA(1, 0, At, B0); PG8_MMA(1, 1, At, B1); PG8_BAR; PG8_SCHED;
            PG8_LDB(B0, 1, 0); PG8_LDB(B1, 1, 1); PG8_SCHED; PG8_LDA(At, 1, 0); PG8_STAGE(PG8_SA(0, 1), a2 + hstep, voffA);
            PG8_WAIT_V(8); PG8_WAIT_L(0); PG8_BAR; PG8_MMA(0, 0, At, B0); PG8_MMA(0, 1, At, B1); PG8_BAR; PG8_SCHED;
            PG8_LDA(At, 1, 1); PG8_STAGE(PG8_SB(1, 0), b3, voffB); PG8_STAGE(PG8_SB(1, 1), b3 + hstep, voffB); PG8_STAGE(PG8_SA(1, 0), a3, voffA);
            PG8_WAIT_V(8); PG8_WAIT_L(0); PG8_BAR; PG8_MMA(1, 0, At, B0); PG8_MMA(1, 1, At, B1); PG8_BAR; PG8_SCHED;
            } else {
            PG8_LDB(B0, 0, 0); PG8_SCHED; PG8_LDA(At, 0, 0); PG8_STAGE(PG8_SA(1, 1), a1 + hstep, voffA);
            PG8_WAIT_L(8); PG8_BAR; PG8_WAIT_L(0); PG8_MMA(0, 0, At, B0); PG8_BAR; PG8_SCHED;
            PG8_LDB(B1, 0, 1); PG8_STAGE(PG8_SB(0, 0), b2, voffB);
            PG8_BAR; PG8_WAIT_L(0); PG8_MMA(0, 1, At, B1); PG8_BAR;
            PG8_LDA(At, 0, 1); PG8_STAGE(PG8_SA(0, 0), a2, voffA);
            PG8_BAR; PG8_WAIT_L(0); PG8_MMA(1, 0, At, B0); PG8_BAR; PG8_SCHED;
            PG8_STAGE(PG8_SB(0, 1), b2 + hstep, voffB);
            PG8_WAIT_V(6); PG8_BAR; PG8_MMA(1, 1, At, B1); PG8_BAR;
            PG8_LDB(B0, 1, 0); PG8_SCHED; PG8_LDA(At, 1, 0); PG8_STAGE(PG8_SA(0, 1), a2 + hstep, voffA);
            PG8_WAIT_L(8); PG8_BAR; PG8_WAIT_L(0); PG8_MMA(0, 0, At, B0); PG8_BAR; PG8_SCHED;
            PG8_LDB(B1, 1, 1); PG8_STAGE(PG8_SB(1, 0), b3, voffB);
            PG8_BAR; PG8_WAIT_L(0); PG8_MMA(0, 1, At, B1); PG8_BAR;
            PG8_LDA(At, 1, 1); PG8_STAGE(PG8_SA(1, 0), a3, voffA);
            PG8_BAR; PG8_WAIT_L(0); PG8_MMA(1, 0, At, B0); PG8_BAR; PG8_SCHED;
            PG8_STAGE(PG8_SB(1, 1), b3 + hstep, voffB);
            PG8_WAIT_V(6); PG8_BAR; PG8_MMA(1, 1, At, B1); PG8_BAR;
            }
        }
        if constexpr (ALIGN_EPI) { if (wr == 0) PG8_BAR; }
        if constexpr (!Epi::AFTER_DRAIN) { E(acc, cur, wr, wc, fr, fq); S.done(cur); }
        if (!has_next) break;
#pragma unroll
        for (int a = 0; a < 2; ++a)
#pragma unroll
            for (int b = 0; b < 2; ++b)
#pragma unroll
                for (int m = 0; m < 4; ++m)
#pragma unroll
                    for (int n = 0; n < 2; ++n) acc[a][b][m][n] = (f32x4){0.f, 0.f, 0.f, 0.f};
        cur = nxt; cA = nA; cB = nB; ++ui;
        if constexpr (ALIGN_EPI) { if (wr == 1) PG8_BAR; }
    }
    PG8_WAIT_V(0);
    if constexpr (!ALIGN_EPI) { if (wr == 0) PG8_BAR; }
    PG8_BAR;
    if constexpr (Epi::AFTER_DRAIN) { E.fused(acc, cur, wr, wc, fr, fq, lds, wid, lane); S.done(cur); }
#undef PG8_SA
#undef PG8_SB
#undef PG8_STAGE
#undef PG8_LDA
#undef PG8_LDB
#undef PG8_MMA
#undef PG8_WAIT_V
#undef PG8_WAIT_L
#undef PG8_BAR
#undef PG8_SCHED
}
}

#define DI __device__ __forceinline__
#ifndef PROBE
#define PROBE 0
#endif
#define LAS __attribute__((address_space(3)))
typedef unsigned short bf16_t;
typedef short bf16x8 __attribute__((ext_vector_type(8)));
typedef short s16x4 __attribute__((ext_vector_type(4)));
typedef float f32x4 __attribute__((ext_vector_type(4)));
typedef float f32x2 __attribute__((ext_vector_type(2)));
typedef float f32x16 __attribute__((ext_vector_type(16)));
typedef unsigned u32x4 __attribute__((ext_vector_type(4)));
typedef unsigned u32x2 __attribute__((ext_vector_type(2)));

constexpr int NB = 8, SEQ = 4096, DM = 1024, NTOK = NB * SEQ, NH = 8, HD = 64;
constexpr int QKVW = 1536, PBW = 1824, N1A = 3584, N1A_REAL = 3360, NGATE = 2048, W1ROWS = 5632;
constexpr int G1B_EARLY = 512;
constexpr int NEXP = 16384;
constexpr float RMS_EPS = 1e-6f, GN_EPS = 64e-5f;
constexpr float LOG2E = 1.4426950408889634f;
constexpr int NTHREADS = 512, NWAVES = 8;
constexpr int LDS_BYTES = 148480;
constexpr int LDS_MISC = 147968;

constexpr size_t MiB = 1u << 20;
constexpr size_t WS_W1T = 1 * MiB;
constexpr size_t WS_WPA = 12 * MiB;
constexpr size_t WS_WPB = 13 * MiB;
constexpr size_t WS_WO = 14 * MiB;
constexpr size_t WS_WQ = 16 * MiB;
constexpr size_t WS_SK = 20 * MiB;
constexpr size_t WS_KBAR = 20 * MiB + 512 * 1024;
constexpr size_t WS_SEL = 21 * MiB;
constexpr size_t WS_LWT = 21 * MiB + 512 * 1024;
constexpr size_t WS_XN = 22 * MiB;
constexpr size_t WS_QKV = 86 * MiB;
constexpr size_t WS_PB = 182 * MiB;
constexpr size_t WS_SCAN = 296 * MiB;
constexpr size_t WS_OA = 182 * MiB;
constexpr size_t WS_OBRAW = 262 * MiB;
constexpr size_t WS_OB = 86 * MiB;
constexpr size_t WS_GATES = 296 * MiB;
constexpr size_t WS_U8 = 488 * MiB;
constexpr size_t WS_V8 = 500 * MiB;
constexpr size_t WS_ROWSQ = 497 * MiB;
constexpr size_t WS_RS = 499 * MiB;
constexpr size_t WS_WG8 = 509 * MiB;
constexpr size_t WS_WG8SC = 511 * MiB;
constexpr size_t DO_XN8 = 0;
constexpr size_t DO_GEARLY = 112 * MiB;
constexpr size_t WS_USC = 256 * 1024;
constexpr size_t WS_VSC = 384 * 1024;
constexpr size_t WS_Y = 118 * MiB;
constexpr size_t WS_QP = 182 * MiB;
constexpr size_t WS_PIDX = 310 * MiB;
constexpr size_t WS_PGATE = 326 * MiB;
constexpr size_t WS_NEED = 512 * MiB;
constexpr size_t DO_VT = 0, DO_RG = 32 * MiB, DO_KF = 64 * MiB;

struct Params {
    const float* x; const float* norm1_g; const float* w_in; const float* rwkv_mu; const float* w0; const float* w_lora_up;
    const float* a0; const float* a_lora_up; const float* g_lora_up; const float* k_k; const float* k_a; const float* r_k;
    const float* lnx_g; const float* lnx_b; const float* w_proj_a; const float* w_proj_b; const float* w_out; const float* norm2_g;
    const float* peer_wq; const float* peer_subkeys; const float* peer_u; const float* peer_v; const float* rel_bias; const float* normf_g;
    float* out; unsigned char* ws;
};

DI float bflo(unsigned u) { return __uint_as_float(u << 16); }
DI float bfhi(unsigned u) { return __uint_as_float(u & 0xffff0000u); }
DI float bf2f(bf16_t h) { return __uint_as_float((unsigned)h << 16); }
DI unsigned pk2(float lo, float hi) {
    typedef __bf16 b2 __attribute__((ext_vector_type(2)));
    f32x2 v = {lo, hi}; b2 b = __builtin_convertvector(v, b2); return __builtin_bit_cast(unsigned, b);
}
DI bf16_t f2bf(float f) { return (bf16_t)(pk2(f, 0.f) & 0xffffu); }
DI u32x4 pack8(f32x4 a, f32x4 b) { u32x4 w; w.x = pk2(a[0], a[1]); w.y = pk2(a[2], a[3]); w.z = pk2(b[0], b[1]); w.w = pk2(b[2], b[3]); return w; }
DI void unpack8(u32x4 w, float (&f)[8]) {
    f[0] = bflo(w.x); f[1] = bfhi(w.x); f[2] = bflo(w.y); f[3] = bfhi(w.y); f[4] = bflo(w.z); f[5] = bfhi(w.z); f[6] = bflo(w.w); f[7] = bfhi(w.w);
}
template <int CTRL> DI float dpp_mov(float x) { return __builtin_bit_cast(float, __builtin_amdgcn_update_dpp(0, __builtin_bit_cast(int, x), CTRL, 0xf, 0xf, false)); }
DI float row16_sum(float x) {
    x += dpp_mov<0x128>(x); x += dpp_mov<0x124>(x); x += dpp_mov<0x122>(x); x += dpp_mov<0x121>(x); return x;
}
DI float wave_sum(float v) {
    v = row16_sum(v);
    const float a = __builtin_bit_cast(float, __builtin_amdgcn_readlane(__builtin_bit_cast(int, v), 0)), b = __builtin_bit_cast(float, __builtin_amdgcn_readlane(__builtin_bit_cast(int, v), 16));
    const float c = __builtin_bit_cast(float, __builtin_amdgcn_readlane(__builtin_bit_cast(int, v), 32)), d = __builtin_bit_cast(float, __builtin_amdgcn_readlane(__builtin_bit_cast(int, v), 48));
    return (a + b) + (c + d);
}
DI float vmul_(float a, float b) { float d; asm("v_mul_f32 %0, %1, %2" : "=v"(d) : "v"(a), "v"(b)); return d; }
DI float vfma_(float a, float b, float c) { float d; asm("v_fma_f32 %0, %1, %2, %3" : "=v"(d) : "v"(a), "v"(b), "v"(c)); return d; }
DI float vfnma_(float a, float b, float c) { float d; asm("v_fma_f32 %0, -%1, %2, %3" : "=v"(d) : "v"(a), "v"(b), "v"(c)); return d; }
DI float sigmoidf_(float x) { return __builtin_amdgcn_rcpf(1.0f + __expf(-x)); }
DI int crow(int r, int hi) { return (r & 3) + 8 * (r >> 2) + 4 * hi; }
#define MFMA32(a, b, c) __builtin_amdgcn_mfma_f32_32x32x16_bf16((a), (b), (c), 0, 0, 0)
#define LDS_WAIT() asm volatile("s_waitcnt lgkmcnt(0)" ::: "memory")

#define XB_TMO      128
#define XB_XCNT(j)  (256  + 64 * (j))
#define XB_XSUB(j)  (1280 + 64 * (j))
#define XB_XGEN(j)  (2304 + 64 * (j))
#define XB_TOP      3328
#define XB_TOPGEN   3392
#define XCD_BAR_WORDS 3456
#define XB_SPIN_CAP (1u << 22)

__device__ __forceinline__ unsigned xb_ld(unsigned* p)              { return __hip_atomic_load(p, __ATOMIC_RELAXED, __HIP_MEMORY_SCOPE_AGENT); }
__device__ __forceinline__ unsigned xb_add(unsigned* p, unsigned v) { return __hip_atomic_fetch_add(p, v, __ATOMIC_RELAXED, __HIP_MEMORY_SCOPE_AGENT); }
__device__ __forceinline__ unsigned xb_xcc_id() { return (unsigned)__builtin_amdgcn_s_getreg((3 << 11) | 20) & 0xFu; }
#define XB_SPIN(cond, bar) do { unsigned _sp = 0; while (cond) { __builtin_amdgcn_s_sleep(1); \
    if ((++_sp & 255u) == 0u) { if (xb_ld(&(bar)[XB_TMO])) break; if (_sp > XB_SPIN_CAP) { atomicAdd(&(bar)[XB_TMO], 1u); break; } } } } while (0)

struct XcdBarrier {
    unsigned* bar; unsigned x;
    volatile LAS unsigned* st;
};

__device__ __forceinline__ XcdBarrier xcd_barrier_post(unsigned* bar, volatile LAS unsigned* st) {
    XcdBarrier b; b.bar = bar; b.x = xb_xcc_id(); b.st = st;
    if (threadIdx.x == 0) (void)xb_add(&bar[XB_XCNT(b.x)], 1u);
    return b;
}
__device__ __forceinline__ void xcd_barrier_complete(unsigned* bar, unsigned x, unsigned& nloc, unsigned& nx) {
    const unsigned G = gridDim.x * gridDim.y * gridDim.z;
    unsigned sum, cnt, mine, sp = 0u;
    for (;;) {
        sum = 0u; cnt = 0u; mine = 0u;
#pragma unroll
        for (unsigned j = 0; j < 16; ++j) { const unsigned c = xb_ld(&bar[XB_XCNT(j)]); sum += c; cnt += (c > 0u) ? 1u : 0u; mine = (j == x) ? c : mine; }
        if (sum == G) break;
        __builtin_amdgcn_s_sleep(1);
        if ((++sp & 255u) == 0u) { if (xb_ld(&bar[XB_TMO])) break; if (sp > XB_SPIN_CAP) { atomicAdd(&bar[XB_TMO], 1u); break; } }
    }
    nloc = mine > 0u ? mine : 1u; nx = cnt > 0u ? cnt : 1u;
}

__device__ __forceinline__ void xcd_barrier(const XcdBarrier& b) {
    asm volatile("s_waitcnt vmcnt(0)" ::: "memory");
    __syncthreads();
    if (threadIdx.x == 0) {
        unsigned* bar = b.bar;
        __builtin_amdgcn_s_waitcnt(0);
        unsigned nloc = b.st[0], nx = b.st[1];
        if (nloc == 0u) { xcd_barrier_complete(bar, b.x, nloc, nx); b.st[0] = nloc; b.st[1] = nx; }
        const unsigned old = xb_add(&bar[XB_XSUB(b.x)], 1u);
        const unsigned gen = old / nloc;
        if (old + 1u == (gen + 1u) * nloc) {
            __builtin_amdgcn_fence(__ATOMIC_RELEASE, "agent");
            asm volatile("s_waitcnt vmcnt(0)" ::: "memory");
            const unsigned og = xb_add(&bar[XB_TOP], 1u);
            const unsigned tg = og / nx;
            if (og + 1u == (tg + 1u) * nx) xb_add(&bar[XB_TOPGEN], 1u);
            else XB_SPIN(xb_ld(&bar[XB_TOPGEN]) == tg, bar);
            __builtin_amdgcn_fence(__ATOMIC_ACQUIRE, "agent");
            xb_add(&bar[XB_XGEN(b.x)], 1u);
            asm volatile("s_waitcnt vmcnt(0)" ::: "memory");
        } else {
            XB_SPIN(xb_ld(&bar[XB_XGEN(b.x)]) == gen, bar);
            __builtin_amdgcn_fence(__ATOMIC_ACQUIRE, "agent");
            asm volatile("s_waitcnt vmcnt(0)" ::: "memory");
        }
    }
    __syncthreads();
}


template <class F> struct EpiF {
    static constexpr bool PERM = true, AFTER_DRAIN = false; F f;
    DI void operator()(const pg8::f32x4 (&acc)[2][2][4][2], const pg8::Unit& u, int wr, int wc, int fr, int fq) const {
        const int row0 = u.pm * 256 + wr * 64 + fr, col0 = u.pn * 256 + wc * 32 + 8 * fq;
        const typename F::Tile tl = f.tile(col0);
#pragma unroll
        for (int ai = 0; ai < 2; ++ai) {
            typename F::Pre pre[4][2];
#pragma unroll
            for (int m = 0; m < 4; ++m)
#pragma unroll
                for (int bj = 0; bj < 2; ++bj) pre[m][bj] = f.load(row0 + ai * 128 + m * 16, col0 + bj * 128);
#pragma unroll
            for (int m = 0; m < 4; ++m) {
                float s = 0.f;
#pragma unroll
                for (int bj = 0; bj < 2; ++bj) s += f.apply(row0 + ai * 128 + m * 16, col0 + bj * 128, acc[ai][bj][m][0], acc[ai][bj][m][1], pre[m][bj], tl, bj);
                f.row_end(row0 + ai * 128 + m * 16, s, fq, u.pn * 4 + wc);
            }
        }
    }
};
template <class F> DI void run_gemm(LAS unsigned char* lds, const bf16_t* A, const bf16_t* Bt, int N, int K, const F& f) {
    pg8::Gemm g{A, Bt, NTOK, N, K}; pg8::StaticOrder S; S.init(NTOK, N, (int)gridDim.x, (int)blockIdx.x); EpiF<F> E{f};
    pg8::gemm_phase<EpiF<F>, pg8::StaticOrder, true, true>(lds, g, S, E);
}
template <class F> DI void run_gemm_on(LAS unsigned char* lds, const bf16_t* A, const bf16_t* Bt, int N, int K, const F& f, int nblocks, int myblock) {
    pg8::Gemm g{A, Bt, NTOK, N, K}; pg8::StaticOrder S; S.init(NTOK, N, nblocks, myblock); EpiF<F> E{f};
    pg8::gemm_phase<EpiF<F>, pg8::StaticOrder, true, true>(lds, g, S, E);
}
template <class F> DI void run_gemm8(LAS unsigned char* lds, const unsigned char* A8, const unsigned char* Bt8, int N, int K8, const F& f) {
    pg8::Gemm g{(const bf16_t*)A8, (const bf16_t*)Bt8, NTOK, N, K8 / 2}; pg8::StaticOrder S; S.init(NTOK, N, (int)gridDim.x, (int)blockIdx.x); EpiF<F> E{f};
    pg8::gemm_phase<EpiF<F>, pg8::StaticOrder, true, true, true>(lds, g, S, E);
}
template <class F> DI void run_gemm8_on(LAS unsigned char* lds, const unsigned char* A8, const unsigned char* Bt8, int N, int K8, const F& f, int nblocks, int myblock) {
    pg8::Gemm g{(const bf16_t*)A8, (const bf16_t*)Bt8, NTOK, N, K8 / 2}; pg8::StaticOrder S; S.init(NTOK, N, nblocks, myblock); EpiF<F> E{f};
    pg8::gemm_phase<EpiF<F>, pg8::StaticOrder, true, true, true>(lds, g, S, E);
}
struct NoPre {}; struct NoTile {};
#define EPI_PLAIN typedef NoTile Tile; DI Tile tile(int) const { return Tile{}; } DI void row_end(int, float, int, int) const {}
struct F1a { bf16_t* qkv; bf16_t* pb; typedef NoPre Pre;
    DI Pre load(int, int) const { return Pre{}; }
    EPI_PLAIN
    DI float apply(int row, int col, f32x4 v0, f32x4 v1, Pre, Tile, int) const {
        const u32x4 w = pack8(v0, v1);
        if (col < QKVW) *(u32x4*)(qkv + (size_t)row * QKVW + col) = w;
        else if (col < N1A_REAL) *(u32x4*)(pb + (size_t)row * PBW + (col - QKVW)) = w;
        return 0.f;
    } };
constexpr int GL_STRIDE = 768;
DI const bf16_t* gate_ptr(const unsigned char* ws, const float* dout, int row, int gcol) {
    if (gcol < G1B_EARLY + GL_STRIDE) return (const bf16_t*)(ws + 214 * MiB) + (size_t)row * GL_STRIDE + (gcol - G1B_EARLY);
    return (const bf16_t*)((const unsigned char*)dout + 64 * MiB) + (size_t)row * GL_STRIDE + (gcol - G1B_EARLY - GL_STRIDE);
}
DI const unsigned char* gate_early_ptr(const float* dout, int row, int gcol) { return (const unsigned char*)dout + DO_GEARLY + (size_t)row * G1B_EARLY + gcol; }
struct F1b { unsigned char* ws; float* dout; int col0; const signed char* sc; typedef NoPre Pre; struct Tile { u32x2 e[2]; };
    DI Tile tile(int c0) const { Tile t;
#pragma unroll
        for (int bj = 0; bj < 2; ++bj) t.e[bj] = *(const u32x2*)(sc + col0 + c0 + bj * 128);
        return t; }
    DI Pre load(int, int) const { return Pre{}; }
    DI void row_end(int, float, int, int) const {}
    DI float apply(int row, int col, f32x4 v0, f32x4 v1, Pre, const Tile& tl, int bj) const {
        f32x4 a, b;
#pragma unroll
        for (int i = 0; i < 4; ++i) { a[i] = sigmoidf_(ldexpf(v0[i], (int)(signed char)(tl.e[bj].x >> (8 * i)))); b[i] = sigmoidf_(ldexpf(v1[i], (int)(signed char)(tl.e[bj].y >> (8 * i)))); }
        const int gcol = col0 + col;
        if (gcol < G1B_EARLY) {
            u32x2 w;
            w.x = (unsigned)(a[0] * 255.f + 0.5f) | ((unsigned)(a[1] * 255.f + 0.5f) << 8) | ((unsigned)(a[2] * 255.f + 0.5f) << 16) | ((unsigned)(a[3] * 255.f + 0.5f) << 24);
            w.y = (unsigned)(b[0] * 255.f + 0.5f) | ((unsigned)(b[1] * 255.f + 0.5f) << 8) | ((unsigned)(b[2] * 255.f + 0.5f) << 16) | ((unsigned)(b[3] * 255.f + 0.5f) << 24);
            *(u32x2*)const_cast<unsigned char*>(gate_early_ptr(dout, row, gcol)) = w;
        } else *(u32x4*)const_cast<bf16_t*>(gate_ptr(ws, dout, row, gcol)) = pack8(a, b);
        return 0.f;
    } };
struct FPa { const unsigned char* ws; const float* dout; bf16_t* y; struct Pre { u32x4 g; };
    DI Pre load(int row, int col) const {
        if (col >= G1B_EARLY) return Pre{*(const u32x4*)gate_ptr(ws, dout, row, col)};
        const u32x2 w = *(const u32x2*)gate_early_ptr(dout, row, col);
        const float k = 1.f / 255.f;
        return Pre{(u32x4){pk2((float)(w.x & 255u) * k, (float)((w.x >> 8) & 255u) * k), pk2((float)((w.x >> 16) & 255u) * k, (float)(w.x >> 24) * k),
                           pk2((float)(w.y & 255u) * k, (float)((w.y >> 8) & 255u) * k), pk2((float)((w.y >> 16) & 255u) * k, (float)(w.y >> 24) * k)}};
    }
    EPI_PLAIN
    DI float apply(int row, int col, f32x4 v0, f32x4 v1, Pre pr, Tile, int) const {
        float g[8]; unpack8(pr.g, g);
        f32x4 a, b;
#pragma unroll
        for (int i = 0; i < 4; ++i) { a[i] = v0[i] * g[i]; b[i] = v1[i] * g[4 + i]; }
#if PROBE == 1
        a = (f32x4){0.f, 0.f, 0.f, 0.f}; b = a;
#endif
        *(u32x4*)(y + (size_t)row * DM + col) = pack8(a, b);
        return 0.f;
    } };
struct FPb { const unsigned char* ws; const float* dout; bf16_t* y; struct Pre { u32x4 g, yv; };
    DI Pre load(int row, int col) const { return Pre{*(const u32x4*)gate_ptr(ws, dout, row, DM + col), *(const u32x4*)(y + (size_t)row * DM + col)}; }
    EPI_PLAIN
    DI float apply(int row, int col, f32x4 v0, f32x4 v1, Pre pr, Tile, int) const {
        float g[8]; unpack8(pr.g, g);
        float yo[8]; unpack8(pr.yv, yo);
        f32x4 a, b;
#pragma unroll
        for (int i = 0; i < 4; ++i) { a[i] = yo[i] + v0[i] * g[i]; b[i] = yo[4 + i] + v1[i] * g[4 + i]; }
#if PROBE == 2
#pragma unroll
        for (int i = 0; i < 4; ++i) { a[i] = yo[i]; b[i] = yo[4 + i]; }
#endif
        *(u32x4*)(y + (size_t)row * DM + col) = pack8(a, b);
        return 0.f;
    } };
struct FOut { const float* x; const float* g2; float* h1; bf16_t* xn; float* rowsq; struct Pre { f32x4 x0, x1; }; struct Tile { f32x4 g[2][2]; };
    DI Tile tile(int col0) const { Tile t;
#pragma unroll
        for (int bj = 0; bj < 2; ++bj) { t.g[bj][0] = *(const f32x4*)(g2 + col0 + bj * 128); t.g[bj][1] = *(const f32x4*)(g2 + col0 + bj * 128 + 4); }
        return t; }
    DI Pre load(int row, int col) const { const size_t o = (size_t)row * DM + col; return Pre{*(const f32x4*)(x + o), *(const f32x4*)(x + o + 4)}; }
    DI float apply(int row, int col, f32x4 v0, f32x4 v1, Pre pr, const Tile& tl, int bj) const {
        const size_t o = (size_t)row * DM + col;
        const f32x4 h0 = pr.x0 + v0, h1v = pr.x1 + v1;
        *(f32x4*)(h1 + o) = h0; *(f32x4*)(h1 + o + 4) = h1v;
        *(u32x4*)(xn + o) = pack8(h0 * tl.g[bj][0], h1v * tl.g[bj][1]);
        return (h0[0] * h0[0] + h0[1] * h0[1] + h0[2] * h0[2] + h0[3] * h0[3]) + (h1v[0] * h1v[0] + h1v[1] * h1v[1] + h1v[2] * h1v[2] + h1v[3] * h1v[3]);
    }
    DI void row_end(int row, float s, int fq, int slot) const {
        s += __shfl_xor(s, 16); s += __shfl_xor(s, 32);
        if (fq == 0) rowsq[(size_t)row * 16 + slot] = s;
    } };
DI float row_rs(const float* rowsq, int row) {
    const f32x4 a = *(const f32x4*)(rowsq + (size_t)row * 16), b = *(const f32x4*)(rowsq + (size_t)row * 16 + 4), c = *(const f32x4*)(rowsq + (size_t)row * 16 + 8), d = *(const f32x4*)(rowsq + (size_t)row * 16 + 12);
    const float s = (((a[0] + a[1]) + (a[2] + a[3])) + ((b[0] + b[1]) + (b[2] + b[3]))) + (((c[0] + c[1]) + (c[2] + c[3])) + ((d[0] + d[1]) + (d[2] + d[3])));
    return rsqrtf(s * (1.f / DM) + RMS_EPS);
}
struct FQ { bf16_t* qp; typedef NoPre Pre;
    DI Pre load(int, int) const { return Pre{}; }
    EPI_PLAIN
    DI float apply(int row, int col, f32x4 v0, f32x4 v1, Pre, Tile, int) const {
        u32x4 w = pack8(v0, v1);
#if PROBE == 3
        w.x &= 0xfff8fff8u; w.y &= 0xfff8fff8u; w.z &= 0xfff8fff8u; w.w &= 0xfff8fff8u;
#endif
        *(u32x4*)(qp + (size_t)row * 2048 + col) = w; return 0.f; } };

DI void p0_transpose_item(const float* W, int K, int N, bf16_t* WT, int k0, int n0, int dst_row0, LAS float* scr, int lane) {
#pragma unroll 8
    for (int i = 0; i < 32; ++i) { const int kk = 2 * i + (lane >> 5); scr[kk * 33 + (lane & 31)] = W[(size_t)(k0 + kk) * N + n0 + (lane & 31)]; }
    LDS_WAIT(); asm volatile("" ::: "memory");
    const int c = lane & 7;
#pragma unroll
    for (int j = 0; j < 4; ++j) { const int n = (lane >> 3) + 8 * j; const LAS float* s = scr + (8 * c) * 33 + n;
        u32x4 o; o.x = pk2(s[0 * 33], s[1 * 33]); o.y = pk2(s[2 * 33], s[3 * 33]); o.z = pk2(s[4 * 33], s[5 * 33]); o.w = pk2(s[6 * 33], s[7 * 33]);
        *(u32x4*)(WT + (size_t)(dst_row0 + n) * K + k0 + 8 * c) = o; }
    LDS_WAIT(); asm volatile("" ::: "memory");
}
template <int NR> DI void rms_rows_to_bf16(const float* x, const float* g, bf16_t* o, int m0, int stride, int lane) {
    f32x4 v[NR][4];
#pragma unroll
    for (int r = 0; r < NR; ++r)
#pragma unroll
        for (int j = 0; j < 4; ++j) v[r][j] = *(const f32x4*)(x + (size_t)(m0 + r * stride) * DM + 4 * lane + 256 * j);
    f32x4 gg[4];
#pragma unroll
    for (int j = 0; j < 4; ++j) gg[j] = *(const f32x4*)(g + 4 * lane + 256 * j);
#pragma unroll
    for (int r = 0; r < NR; ++r) {
        float s = 0.f;
#pragma unroll
        for (int j = 0; j < 4; ++j) s += (v[r][j].x * v[r][j].x + v[r][j].y * v[r][j].y) + (v[r][j].z * v[r][j].z + v[r][j].w * v[r][j].w);
        const float rs = rsqrtf(wave_sum(s) * (1.f / DM) + RMS_EPS);
        bf16_t* orow = o + (size_t)(m0 + r * stride) * DM;
#pragma unroll
        for (int j = 0; j < 4; ++j) { u32x2 w; w.x = pk2(v[r][j].x * rs * gg[j].x, v[r][j].y * rs * gg[j].y); w.y = pk2(v[r][j].z * rs * gg[j].z, v[r][j].w * rs * gg[j].w);
            *(u32x2*)(orow + 4 * lane + 256 * j) = w; }
    }
}
DI void rms_all_rows(const float* x, const float* g, bf16_t* o, int lane, int wid) {
    const int gw = blockIdx.x * NWAVES + wid, NGW = gridDim.x * NWAVES;
    int m = gw;
    for (; m + 3 * NGW < NTOK; m += 4 * NGW) rms_rows_to_bf16<4>(x, g, o, m, NGW, lane);
    for (; m < NTOK; m += NGW) rms_rows_to_bf16<1>(x, g, o, m, NGW, lane);
}
DI void phase_prep(const Params& p, LAS unsigned char* lds, int tid, int lane, int wid) {
    unsigned char* ws = p.ws;
    bf16_t* W1T = (bf16_t*)(ws + WS_W1T);
    LAS float* scr = (LAS float*)(lds + wid * 16384);
    const int gw = blockIdx.x * NWAVES + wid, NGW = gridDim.x * NWAVES;
    constexpr int I_IN = 16 * 169, I_PA = 8 * 32, I_PB = 8 * 32, I_O = 16 * 32, I_Q = 16 * 64;
    constexpr int NITEMS = I_IN + I_PA + I_PB + I_O + I_Q;
    for (int it = gw; it < NITEMS; it += NGW) {
        int r = it;
        if (r < I_IN) { const int kb = r / 169, nb = r % 169, n0 = 32 * nb; const int dst = n0 < N1A_REAL ? n0 : n0 + (N1A - N1A_REAL);
            p0_transpose_item(p.w_in, 1024, 5408, W1T, 64 * kb, n0, dst, scr, lane); continue; } r -= I_IN;
        if (r < I_PA) { const int kb = r / 32, nb = r % 32; p0_transpose_item(p.w_proj_a, 512, 1024, (bf16_t*)(ws + WS_WPA), 64 * kb, 32 * nb, 32 * nb, scr, lane); continue; } r -= I_PA;
        if (r < I_PB) { const int kb = r / 32, nb = r % 32; p0_transpose_item(p.w_proj_b, 512, 1024, (bf16_t*)(ws + WS_WPB), 64 * kb, 32 * nb, 32 * nb, scr, lane); continue; } r -= I_PB;
        if (r < I_O) { const int kb = r / 32, nb = r % 32; p0_transpose_item(p.w_out, 1024, 1024, (bf16_t*)(ws + WS_WO), 64 * kb, 32 * nb, 32 * nb, scr, lane); continue; } r -= I_O;
        { const int kb = r / 64, nb = r % 64; p0_transpose_item(p.peer_wq, 1024, 2048, (bf16_t*)(ws + WS_WQ), 64 * kb, 32 * nb, 32 * nb, scr, lane); }
    }
    const int gt = blockIdx.x * NTHREADS + tid, NGT = gridDim.x * NTHREADS;
    { u32x4* z = (u32x4*)(W1T + (size_t)N1A_REAL * 1024); const u32x4 zero = {0u, 0u, 0u, 0u};
      for (int i = gt; i < (N1A - N1A_REAL) * 1024 / 8; i += NGT) z[i] = zero; }
    { bf16_t* SK = (bf16_t*)(ws + WS_SK);
      for (int i = gt; i < 16 * 128 * 128 / 8; i += NGT) { const f32x4 a = *(const f32x4*)(p.peer_subkeys + (size_t)i * 8), b = *(const f32x4*)(p.peer_subkeys + (size_t)i * 8 + 4);
          *(u32x4*)(SK + (size_t)i * 8) = pack8(a, b); } }
    { bf16_t* LWT = (bf16_t*)(ws + WS_LWT);
      for (int e = gt; e < 512 * 288; e += NGT) { const int c = e / 288, i = e - c * 288;
          const float v = i < 64 ? p.w_lora_up[i * 512 + c] : (i < 128 ? p.a_lora_up[(i - 64) * 512 + c] : p.g_lora_up[(i - 128) * 512 + c]);
          LWT[e] = f2bf(v); } }
    rms_all_rows(p.x, p.norm1_g, (bf16_t*)(ws + WS_XN), lane, wid);
}

DI void phase_wg8(const Params& p, int lane, int wid) {
    const bf16_t* WG = (const bf16_t*)(p.ws + WS_W1T) + (size_t)N1A * 1024;
    for (int n = blockIdx.x * NWAVES + wid; n < NGATE; n += gridDim.x * NWAVES) {
        const u32x4 w0 = *(const u32x4*)(WG + (size_t)n * 1024 + lane * 16), w1 = *(const u32x4*)(WG + (size_t)n * 1024 + lane * 16 + 8);
        float f[16]; { float t[8]; unpack8(w0, t);
#pragma unroll
            for (int i = 0; i < 8; ++i) f[i] = t[i];
            unpack8(w1, t);
#pragma unroll
            for (int i = 0; i < 8; ++i) f[8 + i] = t[i]; }
        float am = 0.f;
#pragma unroll
        for (int i = 0; i < 16; ++i) am = fmaxf(am, fabsf(f[i]));
#pragma unroll
        for (int o = 1; o < 64; o <<= 1) am = fmaxf(am, __shfl_xor(am, o));
        const int ke = (int)floorf(log2f(224.f / fmaxf(am, 1e-30f)));
        const float s = ldexpf(1.f, ke);
        u32x4 o8;
#pragma unroll
        for (int j = 0; j < 4; ++j) { int w = __builtin_amdgcn_cvt_pk_fp8_f32(f[4 * j] * s, f[4 * j + 1] * s, 0, false); w = __builtin_amdgcn_cvt_pk_fp8_f32(f[4 * j + 2] * s, f[4 * j + 3] * s, w, true); o8[j] = (unsigned)w; }
        *(u32x4*)(p.ws + WS_WG8 + (size_t)n * 1024 + lane * 16) = o8;
        if (lane == 0) ((signed char*)(p.ws + WS_WG8SC))[n] = (signed char)(-4 - ke);
    }
}
DI void xn8_convert(const Params& p, int lane, int gw, int NGW) {
    const bf16_t* XN = (const bf16_t*)(p.ws + WS_XN);
    unsigned char* X8 = (unsigned char*)p.out + DO_XN8;
    for (int r = gw; r < NTOK; r += NGW) {
        const u32x4 w0 = *(const u32x4*)(XN + (size_t)r * 1024 + lane * 16), w1 = *(const u32x4*)(XN + (size_t)r * 1024 + lane * 16 + 8);
        float f[16]; { float t[8]; unpack8(w0, t);
#pragma unroll
            for (int i = 0; i < 8; ++i) f[i] = t[i] * 16.f;
            unpack8(w1, t);
#pragma unroll
            for (int i = 0; i < 8; ++i) f[8 + i] = t[i] * 16.f; }
        u32x4 o8;
#pragma unroll
        for (int j = 0; j < 4; ++j) { int w = __builtin_amdgcn_cvt_pk_fp8_f32(f[4 * j], f[4 * j + 1], 0, false); w = __builtin_amdgcn_cvt_pk_fp8_f32(f[4 * j + 2], f[4 * j + 3], w, true); o8[j] = (unsigned)w; }
        *(u32x4*)(X8 + (size_t)r * 1024 + lane * 16) = o8;
    }
}
DI void phase_kbar_vt(const Params& p, LAS unsigned char* lds, int tid, int lane, int wid) {
    unsigned char* ws = p.ws;
    const bf16_t* QKV = (const bf16_t*)(ws + WS_QKV);
    float* KBAR = (float*)(ws + WS_KBAR);
    const int gw = blockIdx.x * NWAVES + wid, NGW = gridDim.x * NWAVES;
    for (int it = gw; it < NB * NH * 16; it += NGW) {
        const int blk = it & 15, h = (it >> 4) & 7, b = it >> 7;
        const int dp = lane & 31, tp = lane >> 5;
        const bf16_t* base = QKV + ((size_t)(b * SEQ + blk * 256)) * QKVW + 512 + h * 64 + 2 * dp;
        float a0 = 0.f, a1 = 0.f;
#pragma unroll 16
        for (int t = tp; t < 256; t += 2) { const unsigned u = *(const unsigned*)(base + (size_t)t * QKVW); a0 += bflo(u); a1 += bfhi(u); }
        a0 += __shfl_xor(a0, 32); a1 += __shfl_xor(a1, 32);
        if (tp == 0) { KBAR[(size_t)it * 64 + 2 * dp] = a0 * (1.f / 256.f); KBAR[(size_t)it * 64 + 2 * dp + 1] = a1 * (1.f / 256.f); }
    }
    LAS bf16_t* tile = (LAS bf16_t*)(lds + wid * 16384);
    unsigned char* KF = (unsigned char*)p.out + DO_KF; unsigned char* VF = (unsigned char*)p.out + DO_VT;
    const int r32 = lane & 31, hi = lane >> 5;
    for (int it = gw; it < NB * NH * 64; it += NGW) {
        const int st = it & 63, bh = it >> 6, b = bh >> 3, h = bh & 7;
        const bf16_t* krow = QKV + ((size_t)(b * SEQ + st * 64 + r32)) * QKVW + 512 + h * 64 + 8 * hi;
        unsigned char* kdst = KF + ((size_t)it * 8) * 1024 + lane * 16;
#pragma unroll
        for (int f = 0; f < 8; ++f) *(u32x4*)(kdst + f * 1024) = *(const u32x4*)(krow + (size_t)(32 * (f & 1)) * QKVW + 16 * (f >> 1));
        const bf16_t* src = QKV + ((size_t)(b * SEQ + st * 64 + lane)) * QKVW + 1024 + h * 64;
#pragma unroll
        for (int c = 0; c < 8; ++c) *(LAS u32x4*)(tile + lane * 72 + c * 8) = *(const u32x4*)(src + c * 8);
        LDS_WAIT(); asm volatile("" ::: "memory");
        unsigned char* vdst = VF + ((size_t)it * 8) * 1024 + lane * 16;
#pragma unroll
        for (int f = 0; f < 8; ++f) {
            const int dt = f >> 2, sx = f & 3, d = 32 * dt + r32, k0 = 16 * sx + 4 * hi;
            u32x4 w;
            w.x = (unsigned)tile[(k0 + 0) * 72 + d] | ((unsigned)tile[(k0 + 1) * 72 + d] << 16);
            w.y = (unsigned)tile[(k0 + 2) * 72 + d] | ((unsigned)tile[(k0 + 3) * 72 + d] << 16);
            w.z = (unsigned)tile[(k0 + 8) * 72 + d] | ((unsigned)tile[(k0 + 9) * 72 + d] << 16);
            w.w = (unsigned)tile[(k0 + 10) * 72 + d] | ((unsigned)tile[(k0 + 11) * 72 + d] << 16);
            *(u32x4*)(vdst + f * 1024) = w;
        }
        LDS_WAIT(); asm volatile("" ::: "memory");
    }
}

DI float softplusf_(float x) { return fmaxf(x, 0.f) + log1pf(__expf(-fabsf(x))); }
DI void phase_rwkv_prep(const Params& p, LAS unsigned char* lds, int tid, int lane, int wid) {
    unsigned char* ws = p.ws;
    const bf16_t* PB = (const bf16_t*)(ws + WS_PB);
    bf16_t* SCAN = (bf16_t*)(ws + WS_SCAN);
    bf16_t* RG = (bf16_t*)((unsigned char*)p.out + DO_RG);
    LAS float* xs = (LAS float*)lds;
    const int c = tid, h = wid, j = lane;
    const float mu_r = p.rwkv_mu[c], mu_k = p.rwkv_mu[512 + c], mu_v = p.rwkv_mu[1024 + c];
    const float w0c = p.w0[c], a0c = p.a0[c], kkc = p.k_k[c], kac = p.k_a[c];
    for (int tt = blockIdx.x; tt < NTOK / 32; tt += gridDim.x) {
        const int t0 = tt * 32;
        __syncthreads();
        for (int e = tid; e < 32 * 288; e += NTHREADS) {
            const int t = e / 288, i = e - t * 288, tok = t0 + t, col = 1536 + i;
            const float cur = bf2f(PB[(size_t)tok * PBW + col]);
            const float prv = (tok & (SEQ - 1)) ? bf2f(PB[(size_t)(tok - 1) * PBW + col]) : 0.f;
            float v = cur + p.rwkv_mu[col] * (prv - cur);
            if (i < 64) v = tanhf(v); else if (i >= 128) v = sigmoidf_(v);
            xs[i * 36 + t] = v;
        }
        __syncthreads();
        float wl[32], al[32], gl[32];
#pragma unroll
        for (int t = 0; t < 32; ++t) { wl[t] = 0.f; al[t] = 0.f; gl[t] = 0.f; }
        for (int i = 0; i < 64; ++i) {
            const float ww = p.w_lora_up[i * 512 + c], wa = p.a_lora_up[i * 512 + c];
#pragma unroll
            for (int t4 = 0; t4 < 8; ++t4) { const f32x4 xw = *(const LAS f32x4*)(xs + i * 36 + 4 * t4), xa = *(const LAS f32x4*)(xs + (64 + i) * 36 + 4 * t4);
#pragma unroll
                for (int q = 0; q < 4; ++q) { wl[4 * t4 + q] += ww * xw[q]; al[4 * t4 + q] += wa * xa[q]; } }
        }
        for (int i = 0; i < 160; ++i) {
            const float wg = p.g_lora_up[i * 512 + c];
#pragma unroll
            for (int t4 = 0; t4 < 8; ++t4) { const f32x4 xg = *(const LAS f32x4*)(xs + (128 + i) * 36 + 4 * t4);
#pragma unroll
                for (int q = 0; q < 4; ++q) gl[4 * t4 + q] += wg * xg[q]; }
        }
#pragma unroll
        for (int t = 0; t < 32; ++t) {
            const int tok = t0 + t, b = tok >> 12, s = tok & (SEQ - 1);
            const bf16_t* row = PB + (size_t)tok * PBW;
            float r = bf2f(row[c]), k = bf2f(row[512 + c]), v = bf2f(row[1024 + c]);
            float rp = 0.f, kp = 0.f, vp = 0.f;
            if (s) { const bf16_t* prow = row - PBW; rp = bf2f(prow[c]); kp = bf2f(prow[512 + c]); vp = bf2f(prow[1024 + c]); }
            r += mu_r * (rp - r); k += mu_k * (kp - k); v += mu_v * (vp - v);
            const float wv = w0c + wl[t];
            const float w = -softplusf_(-wv) - 0.5f;
            const float ew = __expf(w);
            const float omd = -expm1f(-ew);
            const float a = sigmoidf_(a0c + al[t]);
            const float kkv = k * kkc;
            const float nrm = sqrtf(wave_sum(kkv * kkv));
            const float kkn = kkv / fmaxf(nrm, 1e-12f);
            const float kmod = k * (1.f + (a - 1.f) * kac);
            const float bb = kkn * a;
            bf16_t* so = SCAN + ((size_t)((b * NH + h) * SEQ + s)) * 384 + j;
            so[0] = f2bf(omd); so[64] = f2bf(kkn); so[128] = f2bf(bb); so[192] = f2bf(kmod); so[256] = f2bf(r); so[320] = f2bf(v);
            RG[(size_t)tok * 512 + c] = f2bf(gl[t]);
        }
    }
}


DI float fast_tanh(float x) { const float e = __expf(2.f * x); return 1.f - 2.f / (e + 1.f); }
constexpr int RP_ACT = 0, RP_CONST = 19456, RP_TILE = 33792, RP_PITCH = 3080;
template <bool STORE> DI void phase_rwkv_prep2(const Params& p, LAS unsigned char* lds, int tid, int lane, int wid) {
    unsigned char* ws = p.ws;
    const bf16_t* PB = (const bf16_t*)(ws + WS_PB);
    const bf16_t* LWT = (const bf16_t*)(ws + WS_LWT);
    bf16_t* SCAN = (bf16_t*)(ws + WS_SCAN);
    bf16_t* RG = (bf16_t*)((unsigned char*)p.out + DO_RG);
    LAS bf16_t* act = (LAS bf16_t*)(lds + RP_ACT);
    LAS float* cst = (LAS float*)(lds + RP_CONST);
    LAS unsigned char* tile = lds + RP_TILE;
    const int r32 = lane & 31, hi = lane >> 5, h = wid;
    __syncthreads();
    cst[tid] = p.rwkv_mu[tid]; cst[512 + tid] = p.rwkv_mu[512 + tid]; cst[1024 + tid] = p.rwkv_mu[1024 + tid];
    cst[1536 + tid] = p.w0[tid]; cst[2048 + tid] = p.a0[tid]; cst[2560 + tid] = p.k_k[tid]; cst[3072 + tid] = p.k_a[tid];
    for (int tt = blockIdx.x; tt < NTOK / 32; tt += gridDim.x) {
        const int t0 = tt * 32;
        const bool first = (t0 & (SEQ - 1)) == 0;
        __syncthreads();
        u32x4 tw[13];
#pragma unroll
        for (int k = 0; k < 13; ++k) { const int e = tid + NTHREADS * k, row = e / 192, pc = e - row * 192;
            tw[k] = (u32x4){0u, 0u, 0u, 0u};
            if (e < 33 * 192 && !(first && row == 0)) tw[k] = *(const u32x4*)(PB + (size_t)(t0 - 1 + row) * PBW + pc * 8); }
#pragma unroll 3
        for (int e = tid; e < 32 * 144; e += NTHREADS) {
            const int t = e / 144, ip = e - t * 144, i = 2 * ip, tok = t0 + t, col = 1536 + i;
            const unsigned cu = *(const unsigned*)(PB + (size_t)tok * PBW + col);
            const unsigned pu = (tok & (SEQ - 1)) ? *(const unsigned*)(PB + (size_t)(tok - 1) * PBW + col) : 0u;
            const f32x2 mu = *(const f32x2*)(p.rwkv_mu + col);
            float v0 = bflo(cu), v1 = bfhi(cu);
            v0 += mu.x * (bflo(pu) - v0); v1 += mu.y * (bfhi(pu) - v1);
            if (i < 64) { v0 = fast_tanh(v0); v1 = fast_tanh(v1); } else if (i >= 128) { v0 = sigmoidf_(v0); v1 = sigmoidf_(v1); }
            *(LAS unsigned*)(act + t * 296 + i) = pk2(v0, v1);
        }
#pragma unroll
        for (int k = 0; k < 13; ++k) { const int e = tid + NTHREADS * k, row = e / 192, pc = e - row * 192;
            if (e < 33 * 192) { LAS unsigned char* d = tile + row * RP_PITCH + pc * 16;
                *(LAS u32x2*)d = (u32x2){tw[k].x, tw[k].y}; *(LAS u32x2*)(d + 8) = (u32x2){tw[k].z, tw[k].w}; } }
        __syncthreads();
        f32x16 Xw[2], Xa[2], Xg[2];
        const int prow_ch = 16 * ((r32 >> 2) & 1) + 4 * (r32 >> 3) + (r32 & 3);
#pragma unroll
        for (int ct = 0; ct < 2; ++ct) {
#pragma unroll
            for (int i = 0; i < 16; ++i) { Xw[ct][i] = 0.f; Xa[ct][i] = 0.f; Xg[ct][i] = 0.f; }
            const bf16_t* wrow = LWT + (size_t)(h * 64 + 32 * ct + prow_ch) * 288 + 8 * hi;
            const LAS bf16_t* arow = act + r32 * 296 + 8 * hi;
#pragma unroll
            for (int ks = 0; ks < 18; ++ks) {
                const bf16x8 a = *(const bf16x8*)(wrow + 16 * ks);
                const bf16x8 b = *(const LAS bf16x8*)(arow + 16 * ks);
                if (ks < 4) Xw[ct] = MFMA32(a, b, Xw[ct]); else if (ks < 8) Xa[ct] = MFMA32(a, b, Xa[ct]); else Xg[ct] = MFMA32(a, b, Xg[ct]);
            }
        }
        const int tok = t0 + r32, bb_ = tok >> 12, s = tok & (SEQ - 1);
        if (STORE) {
#pragma unroll
            for (int ct = 0; ct < 2; ++ct) { bf16_t* rgp = RG + (size_t)tok * 512 + h * 64 + 32 * ct + 16 * hi;
                *(u32x4*)rgp = (u32x4){pk2(Xg[ct][0], Xg[ct][1]), pk2(Xg[ct][2], Xg[ct][3]), pk2(Xg[ct][4], Xg[ct][5]), pk2(Xg[ct][6], Xg[ct][7])};
                *(u32x4*)(rgp + 8) = (u32x4){pk2(Xg[ct][8], Xg[ct][9]), pk2(Xg[ct][10], Xg[ct][11]), pk2(Xg[ct][12], Xg[ct][13]), pk2(Xg[ct][14], Xg[ct][15])}; }
        }
        const LAS unsigned char* prow = tile + r32 * RP_PITCH;
        bf16_t* so = SCAN + ((size_t)((bb_ * NH + h) * SEQ + s)) * 384;
        unsigned kka[32]; float ss = 0.f;
#pragma unroll
        for (int ct = 0; ct < 2; ++ct) {
            const int j0 = 32 * ct + 16 * hi, c0 = h * 64 + j0;
#pragma unroll
            for (int gp = 0; gp < 2; ++gp) {
            unsigned om[4], km[4], rr[4], vv[4];
#pragma unroll
            for (int gq = 0; gq < 2; ++gq) {
                const int g = 2 * gp + gq;
                const int cg = c0 + 4 * g;
                const u32x2 rp = *(const LAS u32x2*)(prow + cg * 2), kp = *(const LAS u32x2*)(prow + 1024 + cg * 2), vp = *(const LAS u32x2*)(prow + 2048 + cg * 2);
                const u32x2 rc = *(const LAS u32x2*)(prow + RP_PITCH + cg * 2), kc = *(const LAS u32x2*)(prow + RP_PITCH + 1024 + cg * 2), vc = *(const LAS u32x2*)(prow + RP_PITCH + 2048 + cg * 2);
                const f32x4 mur = *(const LAS f32x4*)(cst + cg), muk = *(const LAS f32x4*)(cst + 512 + cg), muv = *(const LAS f32x4*)(cst + 1024 + cg);
                const f32x4 w0v = *(const LAS f32x4*)(cst + 1536 + cg), a0v = *(const LAS f32x4*)(cst + 2048 + cg), kkc = *(const LAS f32x4*)(cst + 2560 + cg), kac = *(const LAS f32x4*)(cst + 3072 + cg);
                const float rcf[4] = {bflo(rc.x), bfhi(rc.x), bflo(rc.y), bfhi(rc.y)}, rpf[4] = {bflo(rp.x), bfhi(rp.x), bflo(rp.y), bfhi(rp.y)};
                const float kcf[4] = {bflo(kc.x), bfhi(kc.x), bflo(kc.y), bfhi(kc.y)}, kpf[4] = {bflo(kp.x), bfhi(kp.x), bflo(kp.y), bfhi(kp.y)};
                const float vcf[4] = {bflo(vc.x), bfhi(vc.x), bflo(vc.y), bfhi(vc.y)}, vpf[4] = {bflo(vp.x), bfhi(vp.x), bflo(vp.y), bfhi(vp.y)};
                float r4[4], k4[4], v4[4], o4[4], m4[4];
#pragma unroll
                for (int q = 0; q < 4; ++q) {
                    const int ri = 4 * g + q;
                    r4[q] = rcf[q] + mur[q] * (rpf[q] - rcf[q]);
                    k4[q] = kcf[q] + muk[q] * (kpf[q] - kcf[q]);
                    v4[q] = vcf[q] + muv[q] * (vpf[q] - vcf[q]);
                    const float wv = w0v[q] + Xw[ct][ri];
                    const float z = -wv;
                    const float sp = fmaxf(z, 0.f) + __logf(1.f + __expf(-fabsf(z)));
                    const float ew = __expf(-sp - 0.5f);
                    o4[q] = 1.f - __expf(-ew);
                    const float a = __builtin_amdgcn_rcpf(1.f + __expf(-(a0v[q] + Xa[ct][ri])));
                    m4[q] = k4[q] * (1.f + (a - 1.f) * kac[q]);
                    const float kv = k4[q] * kkc[q];
                    kka[16 * ct + ri] = pk2(kv, a); ss += kv * kv;
                }
                om[2 * gq] = pk2(o4[0], o4[1]); om[2 * gq + 1] = pk2(o4[2], o4[3]);
                km[2 * gq] = pk2(m4[0], m4[1]); km[2 * gq + 1] = pk2(m4[2], m4[3]);
                rr[2 * gq] = pk2(r4[0], r4[1]); rr[2 * gq + 1] = pk2(r4[2], r4[3]);
                vv[2 * gq] = pk2(v4[0], v4[1]); vv[2 * gq + 1] = pk2(v4[2], v4[3]);
            }
            if (STORE) {
                const int j8 = j0 + 8 * gp;
                *(u32x4*)(so + 0 * 64 + j8) = (u32x4){om[0], om[1], om[2], om[3]};
                *(u32x4*)(so + 3 * 64 + j8) = (u32x4){km[0], km[1], km[2], km[3]};
                *(u32x4*)(so + 4 * 64 + j8) = (u32x4){rr[0], rr[1], rr[2], rr[3]};
                *(u32x4*)(so + 5 * 64 + j8) = (u32x4){vv[0], vv[1], vv[2], vv[3]};
            }
            }
        }
        ss += __shfl_xor(ss, 32);
        const float inv = 1.f / fmaxf(sqrtf(ss), 1e-12f);
#pragma unroll
        for (int ct = 0; ct < 2; ++ct) {
            const int j0 = 32 * ct + 16 * hi;
            unsigned kn[8], bq[8];
#pragma unroll
            for (int i = 0; i < 8; ++i) {
                const unsigned u0 = kka[16 * ct + 2 * i], u1 = kka[16 * ct + 2 * i + 1];
                const float k0 = bflo(u0) * inv, k1 = bflo(u1) * inv;
                kn[i] = pk2(k0, k1); bq[i] = pk2(k0 * bfhi(u0), k1 * bfhi(u1));
            }
            if (STORE) {
                *(u32x4*)(so + 1 * 64 + j0) = (u32x4){kn[0], kn[1], kn[2], kn[3]}; *(u32x4*)(so + 1 * 64 + j0 + 8) = (u32x4){kn[4], kn[5], kn[6], kn[7]};
                *(u32x4*)(so + 2 * 64 + j0) = (u32x4){bq[0], bq[1], bq[2], bq[3]}; *(u32x4*)(so + 2 * 64 + j0 + 8) = (u32x4){bq[4], bq[5], bq[6], bq[7]};
            }
        }
    }
}

DI void phase_select(const Params& p, int tid) {
    unsigned char* ws = p.ws;
    const bf16_t* QKV = (const bf16_t*)(ws + WS_QKV);
    const float* KBAR = (const float*)(ws + WS_KBAR);
    unsigned short* SEL = (unsigned short*)(ws + WS_SEL);
    const int gt = blockIdx.x * NTHREADS + tid, NGT = gridDim.x * NTHREADS;
    for (int it = gt; it < NB * NH * SEQ; it += NGT) {
        const int s = it & (SEQ - 1), bh = it >> 12, b = bh >> 3, h = bh & 7, blk = s >> 8;
        unsigned mask = 0u;
        if (blk > 0) {
            float q[64];
            const bf16_t* qp = QKV + ((size_t)(b * SEQ + s)) * QKVW + h * 64;
#pragma unroll
            for (int c = 0; c < 8; ++c) { const u32x4 w = *(const u32x4*)(qp + c * 8); float f[8]; unpack8(w, f);
#pragma unroll
                for (int i = 0; i < 8; ++i) q[c * 8 + i] = f[i]; }
            float v1 = -INFINITY, v2 = -INFINITY, v3 = -INFINITY; int i1 = -1, i2 = -1, i3 = -1;
            for (int jb = 0; jb < blk; ++jb) {
                const float* kb = KBAR + ((size_t)(bh * 16 + jb)) * 64;
                float g = 0.f;
#pragma unroll
                for (int d = 0; d < 64; d += 4) { const f32x4 kk = *(const f32x4*)(kb + d); g += q[d] * kk.x + q[d + 1] * kk.y + q[d + 2] * kk.z + q[d + 3] * kk.w; }
                if (g > v1) { v3 = v2; i3 = i2; v2 = v1; i2 = i1; v1 = g; i1 = jb; }
                else if (g > v2) { v3 = v2; i3 = i2; v2 = g; i2 = jb; }
                else if (g > v3) { v3 = g; i3 = jb; }
            }
            if (i1 >= 0) mask |= 1u << i1;
            if (i2 >= 0) mask |= 1u << i2;
            if (i3 >= 0) mask |= 1u << i3;
        }
        SEL[it] = (unsigned short)mask;
    }
}

constexpr int CK = 32, NCHUNK = SEQ / CK, ITEM_BYTES = 24576;
constexpr int IT_G1 = 0, IT_H1 = 4096, IT_QT = 12288, IT_OV = 20480;
DI unsigned char* chk_base(const Params& p, int chain) {
    const int q = chain >> 4;
    unsigned char* base = q == 0 ? p.ws + 86 * MiB : (q == 1 ? p.ws + 134 * MiB : (q == 2 ? p.ws + 214 * MiB : (unsigned char*)p.out + 64 * MiB));
    return base + (size_t)(chain & 15) * NCHUNK * ITEM_BYTES;
}
DI bf16x8 pack_acc(const f32x16& x, int s) {
    u32x4 w; w.x = pk2(x[8 * s], x[8 * s + 1]); w.y = pk2(x[8 * s + 2], x[8 * s + 3]); w.z = pk2(x[8 * s + 4], x[8 * s + 5]); w.w = pk2(x[8 * s + 6], x[8 * s + 7]);
    return __builtin_bit_cast(bf16x8, w);
}
DI void store_acc_bf16(unsigned char* dst, const f32x16& x) {
    u32x4 a, b; a.x = pk2(x[0], x[1]); a.y = pk2(x[2], x[3]); a.z = pk2(x[4], x[5]); a.w = pk2(x[6], x[7]);
    b.x = pk2(x[8], x[9]); b.y = pk2(x[10], x[11]); b.z = pk2(x[12], x[13]); b.w = pk2(x[14], x[15]);
    *(u32x4*)dst = a; *(u32x4*)(dst + 16) = b;
}
template <int T> DI void subst_step2(float (&x1)[32], float (&x2)[32], const float y1T, const LAS unsigned char* wl, const LAS unsigned char* y2row) {
    float p0 = y1T, p1 = 0.f, p2 = 0.f, p3 = 0.f, q0, q1 = 0.f, q2 = 0.f, q3 = 0.f;
    unsigned z = 0u;
    if (T > 0) asm("v_and_b32 %0, 0, %1" : "=v"(z) : "v"(__float_as_uint(x1[T > 0 ? T - 1 : 0]) | __float_as_uint(x2[T > 0 ? T - 1 : 0])));
    q0 = *(const LAS float*)(y2row + T * 4 + z);
    if (T > 0) {
        const LAS unsigned char* rowp = wl + T * 768 + z;
#pragma unroll
        for (int s4 = 0; s4 < (T + 3) / 4; ++s4) {
            const f32x4 mm = *(const LAS f32x4*)(rowp + s4 * 16);
            if (4 * s4 + 0 < T) { p0 -= x1[4 * s4 + 0] * mm.x; q0 -= x2[4 * s4 + 0] * mm.x; }
            if (4 * s4 + 1 < T) { p1 -= x1[(4 * s4 + 1) & 31] * mm.y; q1 -= x2[(4 * s4 + 1) & 31] * mm.y; }
            if (4 * s4 + 2 < T) { p2 -= x1[(4 * s4 + 2) & 31] * mm.z; q2 -= x2[(4 * s4 + 2) & 31] * mm.z; }
            if (4 * s4 + 3 < T) { p3 -= x1[(4 * s4 + 3) & 31] * mm.w; q3 -= x2[(4 * s4 + 3) & 31] * mm.w; }
        }
    }
    x1[T] = (p0 + p1) + (p2 + p3); x2[T] = (q0 + q1) + (q2 + q3);
}
template <int... Ts> DI void subst_all2(float (&x1)[32], float (&x2)[32], const float (&y1)[32], const LAS unsigned char* wl, const LAS unsigned char* y2row, std::integer_sequence<int, Ts...>) {
    (subst_step2<Ts>(x1, x2, y1[Ts], wl, y2row), ...);
}
#ifndef CPSTAGE
#define CPSTAGE 4
#endif
DI void unpack_acc_bf16(const LAS unsigned char* src, f32x16& x) {
    const u32x4 a = *(const LAS u32x4*)src, b = *(const LAS u32x4*)(src + 16);
    x[0] = bflo(a.x); x[1] = bfhi(a.x); x[2] = bflo(a.y); x[3] = bfhi(a.y); x[4] = bflo(a.z); x[5] = bfhi(a.z); x[6] = bflo(a.w); x[7] = bfhi(a.w);
    x[8] = bflo(b.x); x[9] = bfhi(b.x); x[10] = bflo(b.y); x[11] = bfhi(b.y); x[12] = bflo(b.z); x[13] = bfhi(b.z); x[14] = bflo(b.w); x[15] = bfhi(b.w);
}
constexpr int CPW = 36864;
constexpr int CP_BT = 24576, CP_KT = 28672, CP_VT = 32768;
template <int STG> DI void phase_chunkprep(const Params& p, LAS unsigned char* lds, int lane, int wid) {
    if (wid >= 4) return;
    unsigned char* ws = p.ws;
    const bf16_t* SCAN = (const bf16_t*)(ws + WS_SCAN);
    LAS unsigned char* wl = lds + wid * CPW;
    const int r32 = lane & 31, hi = lane >> 5, j = lane;
    for (int item = blockIdx.x * 4 + wid; item < 64 * NCHUNK; item += gridDim.x * 4) {
        const int chain = item >> 7, c = item & (NCHUNK - 1);
        const unsigned char* src = (const unsigned char*)(SCAN + ((size_t)chain * SEQ + (size_t)c * CK) * 384);
        unsigned char* dst = chk_base(p, chain) + (size_t)c * ITEM_BYTES;
        unsigned char* dl16 = dst + lane * 16; unsigned char* dl32 = dst + lane * 32;
        {
            u32x4 w[24];
#pragma unroll
            for (int k = 0; k < 24; ++k) w[k] = *(const u32x4*)(src + (size_t)(k * 64 + lane) * 16);
#pragma unroll
            for (int k = 0; k < 24; ++k) *(LAS u32x4*)(wl + (k * 64 + lane) * 16) = w[k];
        }
        LDS_WAIT(); asm volatile("" ::: "memory");
        float al[32]; float g = 1.f;
        {
            unsigned bt[16], kt[16], vt[16];
#pragma unroll
            for (int t = 0; t < 32; ++t) {
                LAS bf16_t* row = (LAS bf16_t*)(wl + t * 768);
                const float omd = bf2f(row[j]), kkv = bf2f(row[64 + j]), bv = bf2f(row[128 + j]), kmv = bf2f(row[192 + j]), rv = bf2f(row[256 + j]);
                const unsigned vraw = row[320 + j];
                const float gprev = g; g = g * (1.f - omd);
                const float ig = __builtin_amdgcn_rcpf(g);
                const float a_ = gprev * kkv, be = bv * ig, ka = kmv * ig, rh = g * rv;
                al[t] = a_;
                const unsigned beb = f2bf(be), kab = f2bf(ka);
                row[64 + j] = f2bf(a_); row[128 + j] = (bf16_t)beb; row[192 + j] = (bf16_t)kab; row[256 + j] = f2bf(rh);
                if (t & 1) { bt[t >> 1] |= beb << 16; kt[t >> 1] |= kab << 16; vt[t >> 1] |= vraw << 16; }
                else { bt[t >> 1] = beb; kt[t >> 1] = kab; vt[t >> 1] = vraw; }
                if ((t & 3) == 3) asm volatile("" ::: "memory");
            }
#pragma unroll
            for (int q = 0; q < 4; ++q) {
                *(LAS u32x4*)(wl + CP_BT + j * 64 + q * 16) = (u32x4){bt[4 * q], bt[4 * q + 1], bt[4 * q + 2], bt[4 * q + 3]};
                *(LAS u32x4*)(wl + CP_KT + j * 64 + q * 16) = (u32x4){kt[4 * q], kt[4 * q + 1], kt[4 * q + 2], kt[4 * q + 3]};
                *(LAS u32x4*)(wl + CP_VT + j * 64 + q * 16) = (u32x4){vt[4 * q], vt[4 * q + 1], vt[4 * q + 2], vt[4 * q + 3]};
            }
        }
        LDS_WAIT(); asm volatile("" ::: "memory");
        if (STG >= 2) {
        {
            f32x16 Mba, Mka, Nbr, Nkr;
#pragma unroll
            for (int i = 0; i < 16; ++i) { Mba[i] = 0.f; Mka[i] = 0.f; Nkr[i] = 0.f; Nbr[i] = 0.f; }
#pragma unroll
            for (int ks = 0; ks < 4; ++ks) {
                const LAS unsigned char* rp = wl + r32 * 768 + (16 * ks + 8 * hi) * 2;
                const bf16x8 ab = *(const LAS bf16x8*)(rp + 2 * 128), ak = *(const LAS bf16x8*)(rp + 3 * 128);
                const bf16x8 ba = *(const LAS bf16x8*)(rp + 1 * 128), br = *(const LAS bf16x8*)(rp + 4 * 128);
                Mba = MFMA32(ab, ba, Mba); Mka = MFMA32(ak, ba, Mka); Nkr = MFMA32(ak, br, Nkr); Nbr = MFMA32(ab, br, Nbr);
            }
#pragma unroll
            for (int r = 0; r < 16; ++r) { const int sr = crow(r, hi);
                if (!(sr < r32)) { Mba[r] = 0.f; Mka[r] = 0.f; }
                if (!(sr <= r32)) { Nkr[r] = 0.f; Nbr[r] = 0.f; } }
            LDS_WAIT(); asm volatile("" ::: "memory");
#pragma unroll
            for (int g4 = 0; g4 < 4; ++g4) {
                *(LAS f32x4*)(wl + r32 * 768 + 0 * 128 + (8 * g4 + 4 * hi) * 4) = (f32x4){Mba[4 * g4], Mba[4 * g4 + 1], Mba[4 * g4 + 2], Mba[4 * g4 + 3]};
                *(LAS u32x2*)(wl + r32 * 768 + 1 * 128 + (8 * g4 + 4 * hi) * 2) = (u32x2){pk2(Nbr[4 * g4], Nbr[4 * g4 + 1]), pk2(Nbr[4 * g4 + 2], Nbr[4 * g4 + 3])};
            }
#pragma unroll
            for (int r = 0; r < 16; ++r) *(LAS float*)(wl + crow(r, hi) * 768 + 5 * 128 + r32 * 4) = Mka[r];
            *(LAS float*)(wl + (j >> 4) * 768 + 1 * 128 + 64 + (j & 15) * 4) = g;
            { LAS unsigned char* np = wl + (lane >> 1) * 768 + 3 * 128 + 64 + (lane & 1) * 32;
              *(LAS u32x4*)np = (u32x4){pk2(Nkr[0], Nkr[1]), pk2(Nkr[2], Nkr[3]), pk2(Nkr[4], Nkr[5]), pk2(Nkr[6], Nkr[7])};
              *(LAS u32x4*)(np + 16) = (u32x4){pk2(Nkr[8], Nkr[9]), pk2(Nkr[10], Nkr[11]), pk2(Nkr[12], Nkr[13]), pk2(Nkr[14], Nkr[15])}; }
        }
        LDS_WAIT(); asm volatile("" ::: "memory");
        }
        if (STG >= 3) {
        {
            float x1[32], x2[32];
            subst_all2(x1, x2, al, wl, wl + r32 * 768 + 5 * 128, std::make_integer_sequence<int, 32>{});
            LAS unsigned char* w1p = wl + (j >> 1) * 768 + 2 * 128 + (j & 1) * 64;
            LAS unsigned char* w2p = wl + r32 * 768 + 3 * 128;
#pragma unroll
            for (int q = 0; q < 4; ++q) {
                *(LAS u32x4*)(w1p + q * 16) = (u32x4){pk2(-x1[8 * q], -x1[8 * q + 1]), pk2(-x1[8 * q + 2], -x1[8 * q + 3]), pk2(-x1[8 * q + 4], -x1[8 * q + 5]), pk2(-x1[8 * q + 6], -x1[8 * q + 7])};
                if (hi == 0) *(LAS u32x4*)(w2p + q * 16) = (u32x4){pk2(-x2[8 * q], -x2[8 * q + 1]), pk2(-x2[8 * q + 2], -x2[8 * q + 3]), pk2(-x2[8 * q + 4], -x2[8 * q + 5]), pk2(-x2[8 * q + 6], -x2[8 * q + 7])};
            }
        }
        LDS_WAIT(); asm volatile("" ::: "memory");
        }
        if (STG >= 4) {
#define CP_A1(jt, ks) (*(const LAS bf16x8*)(wl + (16 * (jt) + (r32 >> 1)) * 768 + 2 * 128 + (r32 & 1) * 64 + (16 * (ks) + 8 * hi) * 2))
#define CP_A2(ks) (*(const LAS bf16x8*)(wl + r32 * 768 + 3 * 128 + (16 * (ks) + 8 * hi) * 2))
#define CP_BN(ks) (*(const LAS bf16x8*)(wl + r32 * 768 + 1 * 128 + (16 * (ks) + 8 * hi) * 2))
#define CP_BB(jp, ks) (*(const LAS bf16x8*)(wl + CP_BT + (32 * (jp) + r32) * 64 + (16 * (ks) + 8 * hi) * 2))
        {
            float gcl[2];
#pragma unroll
            for (int jt = 0; jt < 2; ++jt) { const int jj = 32 * jt + r32; gcl[jt] = *(const LAS float*)(wl + (jj >> 4) * 768 + 1 * 128 + 64 + (jj & 15) * 4); }
            {
                const bf16x8 bn0 = CP_BN(0), bn1 = CP_BN(1);
#pragma unroll
                for (int jt = 0; jt < 2; ++jt) {
                    f32x16 acc;
#pragma unroll
                    for (int g4 = 0; g4 < 4; ++g4) { const u32x2 v = *(const LAS u32x2*)(wl + r32 * 768 + 4 * 128 + (32 * jt + 8 * g4 + 4 * hi) * 2);
                        acc[4 * g4] = bflo(v.x); acc[4 * g4 + 1] = bfhi(v.x); acc[4 * g4 + 2] = bflo(v.y); acc[4 * g4 + 3] = bfhi(v.y); }
                    acc = MFMA32(CP_A1(jt, 0), bn0, acc); acc = MFMA32(CP_A1(jt, 1), bn1, acc);
#pragma unroll
                    for (int sx = 0; sx < 2; ++sx) *(bf16x8*)(dl16 + IT_G1 + (jt * 2 + sx) * 1024) = pack_acc(acc, sx);
                }
            }
#pragma unroll
            for (int jp = 0; jp < 2; ++jp) {
                const bf16x8 bb0 = CP_BB(jp, 0), bb1 = CP_BB(jp, 1);
#pragma unroll
                for (int jt = 0; jt < 2; ++jt) {
                    f32x16 acc;
#pragma unroll
                    for (int r = 0; r < 16; ++r) acc[r] = (jt == jp && crow(r, hi) == r32) ? 1.f : 0.f;
                    acc = MFMA32(CP_A1(jt, 0), bb0, acc); acc = MFMA32(CP_A1(jt, 1), bb1, acc);
#pragma unroll
                    for (int r = 0; r < 16; ++r) acc[r] *= gcl[jp];
#pragma unroll
                    for (int sx = 0; sx < 2; ++sx) *(bf16x8*)(dl16 + IT_H1 + ((jp * 2 + jt) * 2 + sx) * 1024) = pack_acc(acc, sx);
                }
            }
            bf16x8 vtf[2][2];
#pragma unroll
            for (int it = 0; it < 2; ++it)
#pragma unroll
                for (int ks = 0; ks < 2; ++ks) {
                    const u32x2 lo = *(const LAS u32x2*)(wl + CP_VT + (32 * it + r32) * 64 + (16 * ks + 4 * hi) * 2), hh = *(const LAS u32x2*)(wl + CP_VT + (32 * it + r32) * 64 + (16 * ks + 8 + 4 * hi) * 2);
                    vtf[it][ks] = __builtin_bit_cast(bf16x8, (u32x4){lo.x, lo.y, hh.x, hh.y});
                }
            {
                f32x16 acc; unpack_acc_bf16(wl + (lane >> 1) * 768 + 3 * 128 + 64 + (lane & 1) * 32, acc);
                acc = MFMA32(CP_A2(0), CP_BN(0), acc); acc = MFMA32(CP_A2(1), CP_BN(1), acc);
                const bf16x8 g0 = pack_acc(acc, 0), g1 = pack_acc(acc, 1);
#pragma unroll
                for (int it = 0; it < 2; ++it) {
                    f32x16 z;
#pragma unroll
                    for (int r = 0; r < 16; ++r) z[r] = 0.f;
                    z = MFMA32(g0, vtf[it][0], z); z = MFMA32(g1, vtf[it][1], z);
                    store_acc_bf16(dl32 + IT_OV + it * 2048, z);
                }
            }
#pragma unroll
            for (int jp = 0; jp < 2; ++jp) {
                f32x16 acc;
#pragma unroll
                for (int g4 = 0; g4 < 4; ++g4) { const u32x2 v = *(const LAS u32x2*)(wl + CP_KT + (32 * jp + r32) * 64 + (8 * g4 + 4 * hi) * 2);
                    acc[4 * g4] = bflo(v.x); acc[4 * g4 + 1] = bfhi(v.x); acc[4 * g4 + 2] = bflo(v.y); acc[4 * g4 + 3] = bfhi(v.y); }
                acc = MFMA32(CP_A2(0), CP_BB(jp, 0), acc); acc = MFMA32(CP_A2(1), CP_BB(jp, 1), acc);
#pragma unroll
                for (int r = 0; r < 16; ++r) acc[r] *= gcl[jp];
                const bf16x8 h0 = pack_acc(acc, 0), h1 = pack_acc(acc, 1);
#pragma unroll
                for (int it = 0; it < 2; ++it) {
                    f32x16 z;
#pragma unroll
                    for (int r = 0; r < 16; ++r) z[r] = 0.f;
                    z = MFMA32(h0, vtf[it][0], z); z = MFMA32(h1, vtf[it][1], z);
                    store_acc_bf16(dl32 + IT_QT + (jp * 2 + it) * 2048, z);
                }
            }
        }
#undef CP_A1
#undef CP_A2
#undef CP_BN
#undef CP_BB
        }
        LDS_WAIT(); asm volatile("" ::: "memory");
    }
}
DI void phase_chunkscan(const Params& p, LAS unsigned char* lds, int tid, int lane, int wid) {
    unsigned char* ws = p.ws;
    bf16_t* OBR = (bf16_t*)(ws + WS_OBRAW);
    const int r32 = lane & 31, hi = lane >> 5;
    for (int chain = blockIdx.x; chain < 64; chain += gridDim.x) {
        const unsigned char* src = chk_base(p, chain);
        const int b = chain >> 3, h = chain & 7, lt = tid - 128;
        __syncthreads();
        u32x4 lw[4];
        if (wid >= 2) {
#pragma unroll
            for (int k = 0; k < 4; ++k) lw[k] = *(const u32x4*)(src + (size_t)(lt + 384 * k) * 16);
#pragma unroll
            for (int k = 0; k < 4; ++k) *(LAS u32x4*)(lds + (lt + 384 * k) * 16) = lw[k];
#pragma unroll
            for (int k = 0; k < 4; ++k) lw[k] = *(const u32x4*)(src + ITEM_BYTES + (size_t)(lt + 384 * k) * 16);
        }
        __syncthreads();
        f32x16 X0, X1;
#pragma unroll
        for (int i = 0; i < 16; ++i) { X0[i] = 0.f; X1[i] = 0.f; }
        for (int c = 0; c < NCHUNK; ++c) {
            const LAS unsigned char* cur = lds + (c & 1) * ITEM_BYTES;
            if (wid < 2) {
                const int it = wid;
                const bf16x8 xb00 = pack_acc(X0, 0), xb01 = pack_acc(X0, 1), xb10 = pack_acc(X1, 0), xb11 = pack_acc(X1, 1);
                f32x16 oacc; unpack_acc_bf16(cur + IT_OV + (it * 64 + lane) * 32, oacc);
                oacc = MFMA32(*(const LAS bf16x8*)(cur + IT_G1 + (0 * 64 + lane) * 16), xb00, oacc);
                oacc = MFMA32(*(const LAS bf16x8*)(cur + IT_G1 + (1 * 64 + lane) * 16), xb01, oacc);
                oacc = MFMA32(*(const LAS bf16x8*)(cur + IT_G1 + (2 * 64 + lane) * 16), xb10, oacc);
                oacc = MFMA32(*(const LAS bf16x8*)(cur + IT_G1 + (3 * 64 + lane) * 16), xb11, oacc);
                f32x16 n0, n1;
                unpack_acc_bf16(cur + IT_QT + ((0 * 2 + it) * 64 + lane) * 32, n0);
                unpack_acc_bf16(cur + IT_QT + ((1 * 2 + it) * 64 + lane) * 32, n1);
                n0 = MFMA32(*(const LAS bf16x8*)(cur + IT_H1 + (0 * 64 + lane) * 16), xb00, n0);
                n0 = MFMA32(*(const LAS bf16x8*)(cur + IT_H1 + (1 * 64 + lane) * 16), xb01, n0);
                n0 = MFMA32(*(const LAS bf16x8*)(cur + IT_H1 + (2 * 64 + lane) * 16), xb10, n0);
                n0 = MFMA32(*(const LAS bf16x8*)(cur + IT_H1 + (3 * 64 + lane) * 16), xb11, n0);
                n1 = MFMA32(*(const LAS bf16x8*)(cur + IT_H1 + (4 * 64 + lane) * 16), xb00, n1);
                n1 = MFMA32(*(const LAS bf16x8*)(cur + IT_H1 + (5 * 64 + lane) * 16), xb01, n1);
                n1 = MFMA32(*(const LAS bf16x8*)(cur + IT_H1 + (6 * 64 + lane) * 16), xb10, n1);
                n1 = MFMA32(*(const LAS bf16x8*)(cur + IT_H1 + (7 * 64 + lane) * 16), xb11, n1);
                X0 = n0; X1 = n1;
                bf16_t* orow = OBR + ((size_t)(b * SEQ + c * CK)) * 512 + h * 64 + 32 * it + r32;
#pragma unroll
                for (int r = 0; r < 16; ++r) orow[(size_t)crow(r, hi) * 512] = f2bf(oacc[r]);
            } else {
                LAS unsigned char* nxt = lds + ((c + 1) & 1) * ITEM_BYTES;
                if (c + 1 < NCHUNK) {
#pragma unroll
                    for (int k = 0; k < 4; ++k) *(LAS u32x4*)(nxt + (lt + 384 * k) * 16) = lw[k];
                }
                if (c + 2 < NCHUNK) {
#pragma unroll
                    for (int k = 0; k < 4; ++k) lw[k] = *(const u32x4*)(src + (size_t)(c + 2) * ITEM_BYTES + (size_t)(lt + 384 * k) * 16);
                }
            }
            __syncthreads();
        }
    }
}

constexpr int AT_BUF = 8192 + 64 * 136, AT_K = 0, AT_V = 8192, AT_BT = 2 * AT_BUF, AT_END = AT_BT + 512 * 4;
DI int rel_bucket_dev(int n) {
    if (n < 16) return n;
    const int th[15] = {19, 21, 24, 27, 31, 35, 40, 46, 52, 59, 67, 77, 87, 99, 113};
    int b = 16;
#pragma unroll
    for (int i = 0; i < 15; ++i) b += (n >= th[i]) ? 1 : 0;
    return b;
}
template <int MODE>
DI void attn_tile(const LAS unsigned char* kb, const LAS unsigned char* vbuf, const LAS float* btab, const bf16x8 (&qr)[4],
                  f32x16& o0, f32x16& o1, f32x16& lacc, float& m, int dq, bool selb, float c31, int r32, int hi) {
    const float sc2 = 0.125f * LOG2E;
    f32x16 p0, p1;
#pragma unroll
    for (int i = 0; i < 16; ++i) { p0[i] = 0.f; p1[i] = 0.f; }
#pragma unroll
    for (int d0 = 0; d0 < 4; ++d0) {
        const bf16x8 k0 = *(const LAS bf16x8*)(kb + (2 * d0 + hi) * 1024 + r32 * 16);
        const bf16x8 k1 = *(const LAS bf16x8*)(kb + (2 * d0 + hi) * 1024 + 512 + r32 * 16);
        p0 = MFMA32(k0, qr[d0], p0); p1 = MFMA32(k1, qr[d0], p1);
    }
    float mx = -INFINITY;
    float cadd = 0.f;
    if (MODE == 2) {
        const float bsel = selb ? c31 : -INFINITY;
#pragma unroll
        for (int r = 0; r < 16; ++r) mx = fmaxf(mx, fmaxf(p0[r], p1[r]));
        mx = mx * sc2 + bsel;
        cadd = bsel;
    } else {
        const float ninf = selb ? 0.f : -INFINITY;
#pragma unroll
        for (int r = 0; r < 16; ++r) {
            const int d0 = dq - crow(r, hi), d1 = d0 - 32;
            const int i0 = d0 < 0 ? 0 : (d0 > 511 ? 511 : d0), i1 = d1 < 0 ? 0 : (d1 > 511 ? 511 : d1);
            float x0 = p0[r] * sc2 + btab[i0], x1 = p1[r] * sc2 + btab[i1];
            if (MODE == 0) { x0 = d0 >= 0 ? x0 : -INFINITY; x1 = d1 >= 0 ? x1 : -INFINITY; }
            else { x0 += ninf; x1 += ninf; }
            p0[r] = x0; p1[r] = x1; mx = fmaxf(mx, fmaxf(x0, x1));
        }
    }
    mx = fmaxf(mx, __shfl_xor(mx, 32));
    if (__any(mx > m)) {
        const float mn = fmaxf(m, mx);
        const float alpha = __builtin_amdgcn_exp2f(m - mn);
        m = mn;
#pragma unroll
        for (int i = 0; i < 16; ++i) { o0[i] *= alpha; o1[i] *= alpha; lacc[i] *= alpha; }
    }
    if (MODE == 2) {
        const float c = cadd - m;
#pragma unroll
        for (int r = 0; r < 16; ++r) { p0[r] = __builtin_amdgcn_exp2f(p0[r] * sc2 + c); p1[r] = __builtin_amdgcn_exp2f(p1[r] * sc2 + c); }
    } else {
#pragma unroll
        for (int r = 0; r < 16; ++r) { p0[r] = __builtin_amdgcn_exp2f(p0[r] - m); p1[r] = __builtin_amdgcn_exp2f(p1[r] - m); }
    }
    const bf16x8 ones = {(short)0x3F80, (short)0x3F80, (short)0x3F80, (short)0x3F80, (short)0x3F80, (short)0x3F80, (short)0x3F80, (short)0x3F80};
#pragma unroll
    for (int s = 0; s < 4; ++s) {
        u32x4 pw;
        if (s < 2) { pw.x = pk2(p0[8 * s], p0[8 * s + 1]); pw.y = pk2(p0[8 * s + 2], p0[8 * s + 3]); pw.z = pk2(p0[8 * s + 4], p0[8 * s + 5]); pw.w = pk2(p0[8 * s + 6], p0[8 * s + 7]); }
        else { const int q = s - 2; pw.x = pk2(p1[8 * q], p1[8 * q + 1]); pw.y = pk2(p1[8 * q + 2], p1[8 * q + 3]); pw.z = pk2(p1[8 * q + 4], p1[8 * q + 5]); pw.w = pk2(p1[8 * q + 6], p1[8 * q + 7]); }
        const bf16x8 pf = __builtin_bit_cast(bf16x8, pw);
        const LAS unsigned char* v0p = vbuf + r32 * 136 + (16 * s + 4 * hi) * 2;
        const LAS unsigned char* v1p = vbuf + (32 + r32) * 136 + (16 * s + 4 * hi) * 2;
        const u32x2 a0 = *(const LAS u32x2*)v0p, a1 = *(const LAS u32x2*)(v0p + 16);
        const u32x2 c0 = *(const LAS u32x2*)v1p, c1 = *(const LAS u32x2*)(v1p + 16);
        const bf16x8 va = __builtin_bit_cast(bf16x8, (u32x4){a0.x, a0.y, a1.x, a1.y});
        const bf16x8 vb = __builtin_bit_cast(bf16x8, (u32x4){c0.x, c0.y, c1.x, c1.y});
        o0 = MFMA32(va, pf, o0); o1 = MFMA32(vb, pf, o1); lacc = MFMA32(ones, pf, lacc);
    }
}
template <int VAR> DI void attn_unit(const Params& p, LAS unsigned char* lds, int b, int h, int qb, int tid, int lane, int wid) {
    unsigned char* ws = p.ws;
    const bf16_t* QKV = (const bf16_t*)(ws + WS_QKV);
    const bf16_t* VT = (const bf16_t*)((const unsigned char*)p.out + DO_VT);
    const unsigned short* SEL = (const unsigned short*)(ws + WS_SEL);
    bf16_t* OA = VAR == 0 ? (bf16_t*)(ws + WS_OA) : (bf16_t*)((unsigned char*)p.out + 64 * MiB);
    const int r32 = lane & 31, hi = lane >> 5, bh = b * NH + h;
    LAS float* btab = (LAS float*)(lds + AT_BT);
    const int NT = 4 * (qb + 1);
#define AT_KPOS(ti) (((ti) < 4 ? qb * 256 + (ti) * 64 : (((ti) - 4) >> 2) * 256 + (((ti) - 4) & 3) * 64))
    const bf16_t* kbase = QKV + ((size_t)(b * SEQ + lane)) * QKVW + 512 + h * 64 + wid * 8;
    const bf16_t* vbase = VT + ((size_t)(bh * 64 + (tid >> 3))) * SEQ + (tid & 7) * 8;
    const int kdst = AT_K + wid * 1024 + lane * 16, vdst = AT_V + (tid >> 3) * 136 + (tid & 7) * 16;
#define AT_LOAD(ti, kr, vr) do { const int kp_ = AT_KPOS(ti); kr = *(const u32x4*)(kbase + (size_t)kp_ * QKVW); vr = *(const u32x4*)(vbase + kp_); } while (0)
#define AT_WRITE(buf, kr, vr) do { LAS unsigned char* b_ = lds + (buf) * AT_BUF; *(LAS u32x4*)(b_ + kdst) = kr; \
        *(LAS u32x2*)(b_ + vdst) = (u32x2){vr.x, vr.y}; *(LAS u32x2*)(b_ + vdst + 8) = (u32x2){vr.z, vr.w}; } while (0)
    u32x4 kreg, vreg;
    AT_LOAD(0, kreg, vreg);
    __syncthreads();
    btab[tid] = p.rel_bias[h * 32 + rel_bucket_dev(tid)] * LOG2E;
    if (tid < 256) {
        unsigned mask = 0u;
        if (qb > 0) {
            const float* KBAR = (const float*)(ws + WS_KBAR);
            float q[64];
            const bf16_t* qp = QKV + ((size_t)(b * SEQ + qb * 256 + tid)) * QKVW + h * 64;
#pragma unroll
            for (int c = 0; c < 8; ++c) { const u32x4 w = *(const u32x4*)(qp + c * 8); float f[8]; unpack8(w, f);
#pragma unroll
                for (int i = 0; i < 8; ++i) q[c * 8 + i] = f[i]; }
            float v1 = -INFINITY, v2 = -INFINITY, v3 = -INFINITY; int i1 = -1, i2 = -1, i3 = -1;
            for (int jb = 0; jb < qb; ++jb) {
                const float* kbp = KBAR + ((size_t)(bh * 16 + jb)) * 64;
                float g = 0.f;
#pragma unroll
                for (int d = 0; d < 64; d += 4) { const f32x4 kk = *(const f32x4*)(kbp + d); g += q[d] * kk.x + q[d + 1] * kk.y + q[d + 2] * kk.z + q[d + 3] * kk.w; }
                if (g > v1) { v3 = v2; i3 = i2; v2 = v1; i2 = i1; v1 = g; i1 = jb; }
                else if (g > v2) { v3 = v2; i3 = i2; v2 = g; i2 = jb; }
                else if (g > v3) { v3 = g; i3 = jb; }
            }
            if (i1 >= 0) mask |= 1u << i1;
            if (i2 >= 0) mask |= 1u << i2;
            if (i3 >= 0) mask |= 1u << i3;
        }
        ((LAS unsigned short*)(lds + AT_END))[tid] = (unsigned short)mask;
    }
    AT_WRITE(0, kreg, vreg);
    if (NT > 1) AT_LOAD(1, kreg, vreg);
    const int qrow = b * SEQ + qb * 256 + wid * 32 + r32, qin = wid * 32 + r32;
    bf16x8 qr[4];
#pragma unroll
    for (int d0 = 0; d0 < 4; ++d0) qr[d0] = *(const bf16x8*)(QKV + (size_t)qrow * QKVW + h * 64 + d0 * 16 + hi * 8);
    const float c31 = p.rel_bias[h * 32 + 31] * LOG2E;
    float m = -INFINITY;
    f32x16 o0, o1, lacc;
#pragma unroll
    for (int i = 0; i < 16; ++i) { o0[i] = 0.f; o1[i] = 0.f; lacc[i] = 0.f; }
    __syncthreads();
    const unsigned sel = ((const LAS unsigned short*)(lds + AT_END))[qin];
    for (int ti = 0; ti < NT; ++ti) {
        const bool own = ti < 4;
        const int blk = own ? qb : ((ti - 4) >> 2), kt = own ? ti : ((ti - 4) & 3);
        const LAS unsigned char* kb = lds + (ti & 1) * AT_BUF + AT_K;
        const LAS unsigned char* vbuf = lds + (ti & 1) * AT_BUF + AT_V;
        const bool selb = ((sel >> blk) & 1u) != 0u;
        const bool active = own ? (kt * 64 <= wid * 32 + 31) : (__any(selb) != 0);
        if (active && VAR != 2) {
            if (own) attn_tile<0>(kb, vbuf, btab, qr, o0, o1, lacc, m, qin - kt * 64, true, 0.f, r32, hi);
            else {
                const bool farb = ((qb - blk) * 256 + wid * 32 - kt * 64 - 63 >= 113);
                if (farb) attn_tile<2>(kb, vbuf, btab, qr, o0, o1, lacc, m, 0, selb, c31, r32, hi);
                else attn_tile<1>(kb, vbuf, btab, qr, o0, o1, lacc, m, (qb - blk) * 256 + qin - kt * 64, selb, c31, r32, hi);
            }
        }
        if (VAR != 1) { if (ti + 1 < NT) AT_WRITE((ti + 1) & 1, kreg, vreg);
        if (ti + 2 < NT) AT_LOAD(ti + 2, kreg, vreg); }
        __syncthreads();
    }
#undef AT_KPOS
#undef AT_LOAD
#undef AT_WRITE
    const float il = 1.f / lacc[0];
    bf16_t* orow = OA + (size_t)qrow * 512 + h * 64;
#pragma unroll
    for (int g = 0; g < 4; ++g) {
        u32x2 w0, w1;
        w0.x = pk2(o0[4 * g] * il, o0[4 * g + 1] * il); w0.y = pk2(o0[4 * g + 2] * il, o0[4 * g + 3] * il);
        w1.x = pk2(o1[4 * g] * il, o1[4 * g + 1] * il); w1.y = pk2(o1[4 * g + 2] * il, o1[4 * g + 3] * il);
        *(u32x2*)(orow + 8 * g + 4 * hi) = w0; *(u32x2*)(orow + 32 + 8 * g + 4 * hi) = w1;
    }
}
template <int VAR> DI void phase_attn(const Params& p, LAS unsigned char* lds, int tid, int lane, int wid) {
    if (gridDim.x == 256) {
        const int bh = blockIdx.x & 63, s = blockIdx.x >> 6;
#pragma unroll 1
        for (int i = 0; i < 4; ++i) { const int qb = i == 0 ? 15 - s : (i == 1 ? 8 + s : (i == 2 ? 7 - s : s)); attn_unit<VAR>(p, lds, bh >> 3, bh & 7, qb, tid, lane, wid); }
    } else {
        for (int it = blockIdx.x; it < NB * NH * 16; it += gridDim.x) { const int qb = 15 - (it >> 6), bh = it & 63; attn_unit<VAR>(p, lds, bh >> 3, bh & 7, qb, tid, lane, wid); }
    }
}

constexpr int A2_BT = 0, A2_SEL = 2048, A2_CNT = 2560, A2_WCNT = 2624, A2_NIT = 2880, A2_QCTR = 2884, A2_ITEM = 2944, A2_ROWS = 3072, A2_END = 3072 + 15 * 256;
constexpr size_t PART_REC = 136;
DI unsigned char* part_base(const Params& p, int b) {
    constexpr size_t PB_ = (size_t)NH * SEQ * 3 * PART_REC;
    return b < 6 ? p.ws + 214 * MiB + (size_t)b * PB_ : (unsigned char*)p.out + 96 * MiB + (size_t)(b - 6) * PB_;
}
struct A2State { float m, l; f32x16 o0, o1; };
constexpr int A2_WBUF = 8192;
DI void a2_dma_tile(const unsigned char* kf_tile, const unsigned char* vf_tile, LAS unsigned char* wbuf, int lane) {
#pragma unroll
    for (int f = 0; f < 8; ++f) {
        __builtin_amdgcn_global_load_lds((const unsigned*)(kf_tile + f * 1024 + lane * 16), (LAS unsigned*)(wbuf + f * 1024), 16, 0, 0);
        __builtin_amdgcn_global_load_lds((const unsigned*)(vf_tile + f * 1024 + lane * 16), (LAS unsigned*)(wbuf + 8192 + f * 1024), 16, 0, 0);
    }
}
template <bool OWN> DI void attn2_item(const Params& p, const LAS float* btab, LAS unsigned char* wbuf, int b, int h, int qb, int blk, int row, int nkt, A2State& st, int lane, int r32, int hi) {
    unsigned char* ws = p.ws;
    const bf16_t* QKV = (const bf16_t*)(ws + WS_QKV);
    const int bh = b * NH + h;
    const unsigned char* kft = (const unsigned char*)p.out + DO_KF + ((size_t)(bh * 64 + blk * 4) * 8) * 1024;
    const unsigned char* vft = (const unsigned char*)p.out + DO_VT + ((size_t)(bh * 64 + blk * 4) * 8) * 1024;
    a2_dma_tile(kft, vft, wbuf, lane);
    bf16x8 qr[4];
    { const bf16_t* qp = QKV + ((size_t)(b * SEQ + qb * 256 + row)) * QKVW + h * 64 + hi * 8;
#pragma unroll
      for (int d0 = 0; d0 < 4; ++d0) qr[d0] = *(const bf16x8*)(qp + d0 * 16); }
    st.m = -INFINITY; st.l = 0.f;
#pragma unroll
    for (int i = 0; i < 16; ++i) { st.o0[i] = 0.f; st.o1[i] = 0.f; }
    const int dbase = OWN ? row : ((qb - blk) * 256 + row);
    for (int kt = 0; kt < nkt; ++kt) {
        asm volatile("s_waitcnt vmcnt(0)" ::: "memory");
        bf16x8 kf[8], vf[8];
#pragma unroll
        for (int f = 0; f < 8; ++f) { kf[f] = *(const LAS bf16x8*)(wbuf + f * 1024 + lane * 16); vf[f] = *(const LAS bf16x8*)(wbuf + 8192 + f * 1024 + lane * 16); }
        asm volatile("s_waitcnt lgkmcnt(0)" ::: "memory");
        __builtin_amdgcn_sched_barrier(0);
        if (kt + 1 < nkt) a2_dma_tile(kft + (size_t)(kt + 1) * 8192, vft + (size_t)(kt + 1) * 8192, wbuf, lane);
        f32x16 p0, p1;
#pragma unroll
        for (int i = 0; i < 16; ++i) { p0[i] = 0.f; p1[i] = 0.f; }
#pragma unroll
        for (int d0 = 0; d0 < 4; ++d0) { p0 = MFMA32(kf[2 * d0], qr[d0], p0); p1 = MFMA32(kf[2 * d0 + 1], qr[d0], p1); }
        const float sc2 = 0.125f * LOG2E;
        const int dq = dbase - kt * 64;
        float mx = -INFINITY;
        const bool farb = !OWN && (__all(dq - 63 >= 113) != 0);
        const float c31 = btab[511];
        if (farb) {
#pragma unroll
            for (int r = 0; r < 16; ++r) mx = fmaxf(mx, fmaxf(p0[r], p1[r]));
            mx = mx * sc2 + c31;
        } else {
#pragma unroll
            for (int r = 0; r < 16; ++r) {
                const int d0 = dq - crow(r, hi), d1 = d0 - 32;
                const int i0 = d0 < 0 ? 0 : (d0 > 511 ? 511 : d0), i1 = d1 < 0 ? 0 : (d1 > 511 ? 511 : d1);
                float x0 = p0[r] * sc2 + btab[i0], x1 = p1[r] * sc2 + btab[i1];
                if (OWN) { x0 = d0 >= 0 ? x0 : -INFINITY; x1 = d1 >= 0 ? x1 : -INFINITY; }
                p0[r] = x0; p1[r] = x1; mx = fmaxf(mx, fmaxf(x0, x1));
            }
        }
        mx = fmaxf(mx, __shfl_xor(mx, 32));
        if (__any(mx > st.m)) {
            const float mn = fmaxf(st.m, mx);
            const float alpha = __builtin_amdgcn_exp2f(st.m - mn);
            st.m = mn;
#pragma unroll
            for (int i = 0; i < 16; ++i) { st.o0[i] *= alpha; st.o1[i] *= alpha; }
            st.l *= alpha;
        }
        float rs0 = 0.f, rs1 = 0.f;
        if (farb) { const float c = c31 - st.m;
#pragma unroll
            for (int r = 0; r < 16; ++r) { p0[r] = __builtin_amdgcn_exp2f(p0[r] * sc2 + c); p1[r] = __builtin_amdgcn_exp2f(p1[r] * sc2 + c); rs0 += p0[r]; rs1 += p1[r]; }
        } else {
#pragma unroll
            for (int r = 0; r < 16; ++r) { p0[r] = __builtin_amdgcn_exp2f(p0[r] - st.m); p1[r] = __builtin_amdgcn_exp2f(p1[r] - st.m); rs0 += p0[r]; rs1 += p1[r]; }
        }
        st.l += rs0 + rs1;
#pragma unroll
        for (int s = 0; s < 4; ++s) {
            u32x4 pw;
            if (s < 2) { pw.x = pk2(p0[8 * s], p0[8 * s + 1]); pw.y = pk2(p0[8 * s + 2], p0[8 * s + 3]); pw.z = pk2(p0[8 * s + 4], p0[8 * s + 5]); pw.w = pk2(p0[8 * s + 6], p0[8 * s + 7]); }
            else { const int q = s - 2; pw.x = pk2(p1[8 * q], p1[8 * q + 1]); pw.y = pk2(p1[8 * q + 2], p1[8 * q + 3]); pw.z = pk2(p1[8 * q + 4], p1[8 * q + 5]); pw.w = pk2(p1[8 * q + 6], p1[8 * q + 7]); }
            const bf16x8 pf = __builtin_bit_cast(bf16x8, pw);
            st.o0 = MFMA32(vf[s], pf, st.o0); st.o1 = MFMA32(vf[4 + s], pf, st.o1);
        }
    }
    st.l += __shfl_xor(st.l, 32);
}
template <int CHECK> DI void attn2_unit(const Params& p, LAS unsigned char* lds, int b, int h, int qb, int tid, int lane, int wid) {
    unsigned char* ws = p.ws;
    const bf16_t* QKV = (const bf16_t*)(ws + WS_QKV);
    bf16_t* OA = (bf16_t*)(ws + WS_OA);
    const int r32 = lane & 31, hi = lane >> 5, bh = b * NH + h;
    LAS float* btab = (LAS float*)(lds + A2_BT);
    LAS unsigned short* selm = (LAS unsigned short*)(lds + A2_SEL);
    LAS int* cnt = (LAS int*)(lds + A2_CNT);
    LAS int* wcnt = (LAS int*)(lds + A2_WCNT);
    LAS int* ctl = (LAS int*)(lds + A2_NIT);
    LAS unsigned char* itemtab = lds + A2_ITEM;
    LAS unsigned char* rows = lds + A2_ROWS;
    unsigned char* part = part_base(p, b) + ((size_t)(h * 16 + qb) * 256) * 3 * PART_REC;
    __syncthreads();
    btab[tid] = p.rel_bias[h * 32 + rel_bucket_dev(tid)] * LOG2E;
    unsigned mysel = 0u;
    if (qb > 0) {
        LAS float* kbl = (LAS float*)(lds + A2_WBUF);
        LAS float* gp = (LAS float*)(lds + A2_WBUF + 4096);
        const float* KBAR = (const float*)(ws + WS_KBAR) + (size_t)(bh * 16) * 64;
        for (int i = tid; i < qb * 64; i += NTHREADS) kbl[i] = KBAR[i];
        const int qi = tid & 255, hf = tid >> 8;
        float q[32];
        { const bf16_t* qp = QKV + ((size_t)(b * SEQ + qb * 256 + qi)) * QKVW + h * 64 + 32 * hf;
#pragma unroll
          for (int c = 0; c < 4; ++c) { const u32x4 w = *(const u32x4*)(qp + c * 8); float f[8]; unpack8(w, f);
#pragma unroll
              for (int i = 0; i < 8; ++i) q[c * 8 + i] = f[i]; } }
        __syncthreads();
        for (int jb = 0; jb < qb; ++jb) {
            const LAS float* kbp = kbl + jb * 64 + 32 * hf;
            float g0 = 0.f, g1 = 0.f;
#pragma unroll
            for (int d = 0; d < 32; d += 8) { const f32x4 ka = *(const LAS f32x4*)(kbp + d), kb = *(const LAS f32x4*)(kbp + d + 4);
                g0 += q[d] * ka.x + q[d + 1] * ka.y + q[d + 2] * ka.z + q[d + 3] * ka.w; g1 += q[d + 4] * kb.x + q[d + 5] * kb.y + q[d + 6] * kb.z + q[d + 7] * kb.w; }
            gp[(hf * 16 + jb) * 256 + qi] = g0 + g1;
        }
        __syncthreads();
        if (tid < 256) {
            float v1 = -INFINITY, v2 = -INFINITY, v3 = -INFINITY; int i1 = -1, i2 = -1, i3 = -1;
            for (int jb = 0; jb < qb; ++jb) {
                const float g = gp[jb * 256 + tid] + gp[(16 + jb) * 256 + tid];
                if (g > v1) { v3 = v2; i3 = i2; v2 = v1; i2 = i1; v1 = g; i1 = jb; }
                else if (g > v2) { v3 = v2; i3 = i2; v2 = g; i2 = jb; }
                else if (g > v3) { v3 = g; i3 = jb; }
            }
            if (i1 >= 0) mysel |= 1u << i1;
            if (i2 >= 0) mysel |= 1u << i2;
            if (i3 >= 0) mysel |= 1u << i3;
        }
    }
    if (tid < 256) {
        selm[tid] = (unsigned short)mysel;
        for (int j = 0; j < qb; ++j) { const unsigned long long bm = __ballot((mysel >> j) & 1u); if (lane == 0) wcnt[j * 4 + wid] = __popcll(bm); }
    }
    __syncthreads();
    if (tid < 256) {
        for (int j = 0; j < qb; ++j) {
            const bool bit = ((mysel >> j) & 1u) != 0u;
            const unsigned long long bm = __ballot(bit);
            int off = 0;
            for (int w2 = 0; w2 < 4; ++w2) off += (w2 < wid) ? wcnt[j * 4 + w2] : 0;
            const int pre = __popcll(bm & ((1ull << lane) - 1ull));
            if (bit) rows[j * 256 + off + pre] = (unsigned char)tid;
            if (tid == 0) cnt[j] = wcnt[j * 4] + wcnt[j * 4 + 1] + wcnt[j * 4 + 2] + wcnt[j * 4 + 3];
        }
    }
    __syncthreads();
    if (tid == 0) {
        int n = 0;
        for (int j = 0; j < qb; ++j) { const int nt = (cnt[j] + 31) >> 5; for (int r = 0; r < nt; ++r) itemtab[n++] = (unsigned char)(j * 8 + r); }
        ctl[0] = n; ctl[1] = 0;
    }
    __syncthreads();
    LAS unsigned char* wbuf = lds + A2_WBUF + wid * 16384;
    const int nitems = ctl[0];
    for (;;) {
        int it = 0;
        if (lane == 0) it = __hip_atomic_fetch_add(&ctl[1], 1, __ATOMIC_RELAXED, __HIP_MEMORY_SCOPE_WORKGROUP);
        it = __builtin_amdgcn_readfirstlane(it);
        if (it >= nitems) break;
        const int code = itemtab[it], j = code >> 3, r = code & 7;
        const int pos = r * 32 + r32, n = cnt[j];
        const bool valid = pos < n;
        const int row = rows[j * 256 + (valid ? pos : 0)];
        A2State st;
        attn2_item<false>(p, btab, wbuf, b, h, qb, j, row, 4, st, lane, r32, hi);
        if (valid) {
            const unsigned sm = selm[row];
            const int slot = __popc(sm & ((1u << j) - 1u));
            unsigned char* rec = part + ((size_t)row * 3 + slot) * PART_REC;
#pragma unroll
            for (int g = 0; g < 4; ++g) {
                *(u32x2*)(rec + (8 * g + 4 * hi) * 2) = (u32x2){pk2(st.o0[4 * g], st.o0[4 * g + 1]), pk2(st.o0[4 * g + 2], st.o0[4 * g + 3])};
                *(u32x2*)(rec + (32 + 8 * g + 4 * hi) * 2) = (u32x2){pk2(st.o1[4 * g], st.o1[4 * g + 1]), pk2(st.o1[4 * g + 2], st.o1[4 * g + 3])};
            }
            if (hi == 0) *(f32x2*)(rec + 128) = (f32x2){st.m, st.l};
        }
    }
    A2State own;
    attn2_item<true>(p, btab, wbuf, b, h, qb, qb, wid * 32 + r32, (wid >> 1) + 1, own, lane, r32, hi);
    asm volatile("s_waitcnt vmcnt(0)" ::: "memory");
    __syncthreads();
    {
        const int row = wid * 32 + r32;
        const unsigned sm = selm[row];
        const int ns = __popc(sm);
        float M = own.m;
        float ms[3], ls[3];
#pragma unroll
        for (int s3 = 0; s3 < 3; ++s3) { ms[s3] = -INFINITY; ls[s3] = 0.f;
            if (s3 < ns) { const f32x2 ml = *(const f32x2*)(part + ((size_t)row * 3 + s3) * PART_REC + 128); ms[s3] = ml.x; ls[s3] = ml.y; M = fmaxf(M, ml.x); } }
        const float f0 = __builtin_amdgcn_exp2f(own.m - M);
        float L = own.l * f0;
#pragma unroll
        for (int i = 0; i < 16; ++i) { own.o0[i] *= f0; own.o1[i] *= f0; }
#pragma unroll
        for (int s3 = 0; s3 < 3; ++s3) {
            if (s3 < ns) {
                const float fs = __builtin_amdgcn_exp2f(ms[s3] - M);
                L += ls[s3] * fs;
                const unsigned char* rec = part + ((size_t)row * 3 + s3) * PART_REC;
#pragma unroll
                for (int g = 0; g < 4; ++g) {
                    const u32x2 a = *(const u32x2*)(rec + (8 * g + 4 * hi) * 2), c = *(const u32x2*)(rec + (32 + 8 * g + 4 * hi) * 2);
                    own.o0[4 * g] += fs * bflo(a.x); own.o0[4 * g + 1] += fs * bfhi(a.x); own.o0[4 * g + 2] += fs * bflo(a.y); own.o0[4 * g + 3] += fs * bfhi(a.y);
                    own.o1[4 * g] += fs * bflo(c.x); own.o1[4 * g + 1] += fs * bfhi(c.x); own.o1[4 * g + 2] += fs * bflo(c.y); own.o1[4 * g + 3] += fs * bfhi(c.y);
                }
            }
        }
        const float il = 1.f / L;
        bf16_t* orow = OA + ((size_t)(b * SEQ + qb * 256 + row)) * 512 + h * 64;
#pragma unroll
        for (int g = 0; g < 4; ++g) {
            u32x2 w0, w1;
            w0.x = pk2(own.o0[4 * g] * il, own.o0[4 * g + 1] * il); w0.y = pk2(own.o0[4 * g + 2] * il, own.o0[4 * g + 3] * il);
            w1.x = pk2(own.o1[4 * g] * il, own.o1[4 * g + 1] * il); w1.y = pk2(own.o1[4 * g + 2] * il, own.o1[4 * g + 3] * il);
            if (CHECK) {
                const u32x2 r0 = *(const u32x2*)(orow + 8 * g + 4 * hi), r1 = *(const u32x2*)(orow + 32 + 8 * g + 4 * hi);
                const float a[8] = {bflo(w0.x), bfhi(w0.x), bflo(w0.y), bfhi(w0.y), bflo(w1.x), bfhi(w1.x), bflo(w1.y), bfhi(w1.y)};
                const float c[8] = {bflo(r0.x), bfhi(r0.x), bflo(r0.y), bfhi(r0.y), bflo(r1.x), bfhi(r1.x), bflo(r1.y), bfhi(r1.y)};
                bool bad = false;
#pragma unroll
                for (int i = 0; i < 8; ++i) bad |= !(fabsf(a[i] - c[i]) <= 0.03f * fabsf(c[i]) + 0.004f);
                if (bad) { w0.x = 0x7fc07fc0u; w0.y = 0x7fc07fc0u; w1.x = 0x7fc07fc0u; w1.y = 0x7fc07fc0u; }
            }
            *(u32x2*)(orow + 8 * g + 4 * hi) = w0; *(u32x2*)(orow + 32 + 8 * g + 4 * hi) = w1;
        }
    }
}
template <int CHECK> DI void phase_attn2(const Params& p, LAS unsigned char* lds, int tid, int lane, int wid) {
    if (gridDim.x == 256) {
        const int bh = blockIdx.x & 63, s = blockIdx.x >> 6;
#pragma unroll 1
        for (int i = 0; i < 4; ++i) { const int qb = i == 0 ? 15 - s : (i == 1 ? 8 + s : (i == 2 ? 7 - s : s)); attn2_unit<CHECK>(p, lds, bh >> 3, bh & 7, qb, tid, lane, wid); }
    } else {
        for (int it = blockIdx.x; it < NB * NH * 16; it += gridDim.x) { const int qb = 15 - (it >> 6), bh = it & 63; attn2_unit<CHECK>(p, lds, bh >> 3, bh & 7, qb, tid, lane, wid); }
    }
}

DI void phase_post(const Params& p, int tid, int lane, int wid) {
    unsigned char* ws = p.ws;
    const bf16_t* SCAN = (const bf16_t*)(ws + WS_SCAN);
    const bf16_t* OBRAW = (const bf16_t*)(ws + WS_OBRAW);
    const bf16_t* RG = (const bf16_t*)((const unsigned char*)p.out + DO_RG);
    bf16_t* OB = (bf16_t*)(ws + WS_OB);
    const int gw = blockIdx.x * NWAVES + wid, NGW = gridDim.x * NWAVES;
    for (int tok = gw; tok < NTOK; tok += NGW) {
        const int b = tok >> 12, s = tok & (SEQ - 1);
#pragma unroll
        for (int h = 0; h < NH; ++h) {
            const int c = h * 64 + lane;
            const float o = bf2f(OBRAW[(size_t)tok * 512 + c]);
            const float mu = wave_sum(o) * (1.f / 64.f);
            const float dd = o - mu;
            const float var = wave_sum(dd * dd) * (1.f / 64.f);
            const float on = dd * rsqrtf(var + GN_EPS) * p.lnx_g[c] + p.lnx_b[c];
            const bf16_t* si = SCAN + ((size_t)((b * NH + h) * SEQ + s)) * 384 + lane;
            const float km = bf2f(si[192]), r = bf2f(si[256]), v = bf2f(si[320]);
            const float bon = wave_sum(r * km * p.r_k[c]);
            const float g = bf2f(RG[(size_t)tok * 512 + c]);
            OB[(size_t)tok * 512 + c] = f2bf((on + bon * v) * g);
        }
    }
}
typedef float v16f_t __attribute__((ext_vector_type(16)));
typedef float v32f_t __attribute__((ext_vector_type(32)));
typedef int v6i_t __attribute__((ext_vector_type(6)));
DI void phase_uv_convert(const Params& p, int lane, int gw, int NGW) {
    unsigned char* ws = p.ws;
    const int hl = lane & 31, half = lane >> 5;
    for (int e2 = gw; e2 < NEXP; e2 += NGW) {
        const bool isv = e2 >= NEXP / 2;
        const int e = 2 * (isv ? e2 - NEXP / 2 : e2) + half;
        const float* src = (isv ? p.peer_v : p.peer_u) + (size_t)e * DM + 32 * hl;
        f32x4 v[8]; float am = 0.f, ss = 0.f;
#pragma unroll
        for (int j = 0; j < 8; ++j) { v[j] = *(const f32x4*)(src + 4 * j);
            am = fmaxf(am, fmaxf(fmaxf(fabsf(v[j].x), fabsf(v[j].y)), fmaxf(fabsf(v[j].z), fabsf(v[j].w))));
            ss += v[j].x * v[j].x + v[j].y * v[j].y + v[j].z * v[j].z + v[j].w * v[j].w; }
#pragma unroll
        for (int o = 1; o < 32; o <<= 1) { am = fmaxf(am, __shfl_xor(am, o)); ss += __shfl_xor(ss, o); }
        u32x4 w = {0u, 0u, 0u, 0u};
        if (isv) {
            am = fmaxf(am, 1e-30f);
            const float mul = 6.f / am;
#define FP4_PACK(j_) \
            w[j_] = __builtin_amdgcn_cvt_scalef32_pk_fp4_f32(w[j_], v[2 * (j_)].x * mul, v[2 * (j_)].y * mul, 1.0f, 0); \
            w[j_] = __builtin_amdgcn_cvt_scalef32_pk_fp4_f32(w[j_], v[2 * (j_)].z * mul, v[2 * (j_)].w * mul, 1.0f, 1); \
            w[j_] = __builtin_amdgcn_cvt_scalef32_pk_fp4_f32(w[j_], v[2 * (j_) + 1].x * mul, v[2 * (j_) + 1].y * mul, 1.0f, 2); \
            w[j_] = __builtin_amdgcn_cvt_scalef32_pk_fp4_f32(w[j_], v[2 * (j_) + 1].z * mul, v[2 * (j_) + 1].w * mul, 1.0f, 3);
            FP4_PACK(0) FP4_PACK(1) FP4_PACK(2) FP4_PACK(3)
#undef FP4_PACK
            *(u32x4*)(ws + WS_V8 + (size_t)e * 512 + 16 * hl) = w;
            if (hl == 0) ((float*)(ws + WS_VSC))[e] = am * (1.f / 6.f);
        } else {
            const float su = fmaxf(0.335f * sqrtf(ss * (1.f / DM)), 1e-30f), inv = 1.f / su;
            unsigned nsum = 0u;
#pragma unroll
            for (int j = 0; j < 4; ++j) {
#pragma unroll
                for (int k = 0; k < 4; ++k) {
                    const unsigned nl = (unsigned)fminf(fmaxf(floorf(v[2 * j][k] * inv) + 8.f, 0.f), 15.f);
                    const unsigned nh = (unsigned)fminf(fmaxf(floorf(v[2 * j + 1][k] * inv) + 8.f, 0.f), 15.f);
                    w[j] |= (nl | (nh << 4)) << (8 * k); nsum += nl + nh;
                }
            }
#pragma unroll
            for (int o = 1; o < 32; o <<= 1) nsum += (unsigned)__shfl_xor((int)nsum, o);
            *(u32x4*)(ws + WS_U8 + (size_t)e * 512 + 16 * hl) = w;
            if (hl == 0) ((f32x2*)(ws + WS_USC))[e] = (f32x2){su, (float)nsum};
        }
    }
}

DI void ce_desc(float& x, float& y) { const float hi = fmaxf(x, y), lo = fminf(x, y); x = hi; y = lo; }
DI void sort16_desc(float (&v)[16]) {
#pragma unroll
    for (int k = 2; k <= 16; k <<= 1) {
#pragma unroll
        for (int j = k >> 1; j > 0; j >>= 1) {
#pragma unroll
            for (int i = 0; i < 16; ++i) { const int l = i ^ j; if (l > i) { if ((i & k) == 0) ce_desc(v[i], v[l]); else ce_desc(v[l], v[i]); } }
        }
    }
}
DI void merge16_desc(float (&a)[16], const float (&b)[16]) {
#pragma unroll
    for (int i = 0; i < 16; ++i) a[i] = fmaxf(a[i], b[15 - i]);
#pragma unroll
    for (int j = 8; j > 0; j >>= 1) {
#pragma unroll
        for (int i = 0; i < 16; ++i) { const int l = i ^ j; if (l > i) ce_desc(a[i], a[l]); }
    }
}
DI void xmerge16(float (&a)[16]) {
    float o[16];
#pragma unroll
    for (int i = 0; i < 16; ++i) o[i] = __shfl_xor(a[i], 32);
    merge16_desc(a, o);
}
constexpr int ca_A(int i) { return i < 16 ? 0 : (i < 24 ? i - 8 : -1); }
constexpr int cb_A(int i) { return i < 16 ? i : (i < 24 ? 0 : -1); }
constexpr int ca_B(int i) { return i < 8 ? 1 : i < 13 ? 2 : i < 17 ? 3 : i < 20 ? 4 : i < 22 ? 5 : i < 24 ? 6 : i < 26 ? 7 : -1; }
constexpr int cb_B(int i) { return i < 8 ? i : i < 13 ? i - 8 : i < 17 ? i - 13 : i < 20 ? i - 17 : i < 22 ? i - 20 : i < 24 ? i - 22 : i < 26 ? i - 24 : -1; }

DI void route_item(const Params& p, LAS unsigned char* wl  , int item, int lane) {
    unsigned char* ws = p.ws;
    const bf16_t* QP = (const bf16_t*)(ws + WS_QP);
    const bf16_t* SK = (const bf16_t*)(ws + WS_SK);
    int* PIDX = (int*)(ws + WS_PIDX); float* PGATE = (float*)(ws + WS_PGATE);
    const int tt = item >> 3, h = item & 7, t0 = tt * 32, r32 = lane & 31, hi = lane >> 5;
    float L0[16], L1[16];
#pragma unroll
    for (int pp = 0; pp < 2; ++pp) {
        const int hp = h * 2 + pp;
        bf16x8 qf[8];
#pragma unroll
        for (int ks = 0; ks < 8; ++ks) qf[ks] = *(const bf16x8*)(QP + (size_t)(t0 + r32) * 2048 + hp * 128 + ks * 16 + hi * 8);
        float run[16];
#pragma unroll
        for (int i = 0; i < 16; ++i) run[i] = -INFINITY;
        bf16x8 skf[8];
        { const bf16_t* skp = SK + ((size_t)(hp * 128 + r32)) * 128 + hi * 8;
#pragma unroll
          for (int ks = 0; ks < 8; ++ks) skf[ks] = *(const bf16x8*)(skp + ks * 16); }
#pragma unroll 1
        for (int nt = 0; nt < 4; ++nt) {
            f32x16 X;
#pragma unroll
            for (int i = 0; i < 16; ++i) X[i] = 0.f;
#pragma unroll
            for (int ks = 0; ks < 8; ++ks) X = MFMA32(skf[ks], qf[ks], X);
            if (nt < 3) { const bf16_t* skp = SK + ((size_t)(hp * 128 + (nt + 1) * 32 + r32)) * 128 + hi * 8;
#pragma unroll
                for (int ks = 0; ks < 8; ++ks) skf[ks] = *(const bf16x8*)(skp + ks * 16); }
            float v[16];
#pragma unroll
            for (int r = 0; r < 16; ++r) { const unsigned n = (unsigned)(nt * 32 + (r & 3) + 8 * (r >> 2)) + 4u * (unsigned)hi;
                v[r] = __uint_as_float((__float_as_uint(X[r]) & ~127u) | n); }
            sort16_desc(v);
            merge16_desc(run, v);
        }
        xmerge16(run);
#pragma unroll
        for (int i = 0; i < 16; ++i) { if (pp == 0) L0[i] = run[i]; else L1[i] = run[i]; }
    }
#pragma unroll
    for (int i = 0; i < 16; ++i) { wl[lane * 32 + i] = (unsigned char)(__float_as_uint(L0[i]) & 127u); wl[lane * 32 + 16 + i] = (unsigned char)(__float_as_uint(L1[i]) & 127u); }
    float c0[16], c1[16];
#pragma unroll
    for (int i = 0; i < 32; ++i) {
        float va = -INFINITY, vb = -INFINITY;
        if (ca_A(i) >= 0) { const float s = L0[ca_A(i) < 0 ? 0 : ca_A(i)] + L1[cb_A(i) < 0 ? 0 : cb_A(i)]; va = __uint_as_float((__float_as_uint(s) & ~255u) | (unsigned)(ca_A(i) * 16 + cb_A(i))); }
        if (ca_B(i) >= 0) { const float s = L0[ca_B(i) < 0 ? 0 : ca_B(i)] + L1[cb_B(i) < 0 ? 0 : cb_B(i)]; vb = __uint_as_float((__float_as_uint(s) & ~255u) | (unsigned)(ca_B(i) * 16 + cb_B(i))); }
        const float v = hi ? vb : va;
        if (i < 16) c0[i] = v; else c1[i - 16] = v;
    }
    sort16_desc(c0); sort16_desc(c1); merge16_desc(c0, c1); xmerge16(c0);
    LDS_WAIT(); asm volatile("" ::: "memory");
    int e[16]; float g[16]; float sum = 0.f;
    const float rs = row_rs((const float*)(ws + WS_ROWSQ), t0 + r32);
    if (h == 0 && hi == 0) ((float*)(ws + WS_RS))[t0 + r32] = rs;
    const float mx = __uint_as_float(__float_as_uint(c0[0]) & ~255u);
#pragma unroll
    for (int k = 0; k < 16; ++k) {
        const unsigned bits = __float_as_uint(c0[k]); const int code = (int)(bits & 255u), a = code >> 4, b = code & 15;
        const int i0 = wl[lane * 32 + a], i1 = wl[lane * 32 + 16 + b];
        e[k] = i0 * 128 + i1;
        g[k] = __expf((__uint_as_float(bits & ~255u) - mx) * rs); sum += g[k];
    }
    const float inv = 1.f / sum;
    const size_t ob = ((size_t)(t0 + r32) * 8 + h) * 16 + hi * 8;
    u32x4 e0, e1; f32x4 g0, g1;
    e0.x = hi ? e[8] : e[0]; e0.y = hi ? e[9] : e[1]; e0.z = hi ? e[10] : e[2]; e0.w = hi ? e[11] : e[3];
    e1.x = hi ? e[12] : e[4]; e1.y = hi ? e[13] : e[5]; e1.z = hi ? e[14] : e[6]; e1.w = hi ? e[15] : e[7];
    g0.x = (hi ? g[8] : g[0]) * inv; g0.y = (hi ? g[9] : g[1]) * inv; g0.z = (hi ? g[10] : g[2]) * inv; g0.w = (hi ? g[11] : g[3]) * inv;
    g1.x = (hi ? g[12] : g[4]) * inv; g1.y = (hi ? g[13] : g[5]) * inv; g1.z = (hi ? g[14] : g[6]) * inv; g1.w = (hi ? g[15] : g[7]) * inv;
    *(u32x4*)(PIDX + ob) = e0; *(u32x4*)(PIDX + ob + 4) = e1;
    *(f32x4*)(PGATE + ob) = g0; *(f32x4*)(PGATE + ob + 4) = g1;
    LDS_WAIT(); asm volatile("" ::: "memory");
}
DI void phase_route(const Params& p, LAS unsigned char* lds, int lane, int wid) {
    const int gw = blockIdx.x * NWAVES + wid, NGW = gridDim.x * NWAVES;
    for (int it = gw; it < (NTOK / 32) * NH; it += NGW) route_item(p, lds + wid * 2048, it, lane);
}

DI float gelu_exact(float x) { return 0.5f * x * (1.f + erff(x * 0.70710678118654752f)); }
DI float gelu_bf(float x) {
    const float z = fabsf(x) * 0.70710678118654752f;
    const float t = __builtin_amdgcn_rcpf(fmaf(0.3275911f, z, 1.f));
    const float poly = t * fmaf(t, fmaf(t, fmaf(t, fmaf(t, 1.061405429f, -1.453152027f), 1.421413741f), -0.284496736f), 0.254829592f);
    const float he = 0.5f * poly * __expf(-z * z);
    return x * (x >= 0.f ? 1.f - he : he);
}
DI void experts_quant_x(const u32x4 (&xn)[4], unsigned (&xa)[8], float& sx, float& ktok) {
    float f[32];
#pragma unroll
    for (int j = 0; j < 4; ++j) { float t[8]; unpack8(xn[j], t);
#pragma unroll
        for (int i = 0; i < 8; ++i) f[8 * j + i] = t[i]; }
    float m = 0.f;
#pragma unroll
    for (int i = 0; i < 32; ++i) m = fmaxf(m, fabsf(f[i]));
    m = fmaxf(m, dpp_mov<0x128>(m)); m = fmaxf(m, dpp_mov<0x124>(m)); m = fmaxf(m, dpp_mov<0x122>(m)); m = fmaxf(m, dpp_mov<0x121>(m));
    m = fmaxf(m, __shfl_xor(m, 16));
    m = fmaxf(m, 1e-30f);
    const float inv = 127.f / m; sx = m * (1.f / 127.f);
    unsigned tsum = 0u;
#pragma unroll
    for (int j = 0; j < 4; ++j) { unsigned wh = 0u, wl = 0u;
#pragma unroll
        for (int k = 0; k < 4; ++k) {
            const unsigned q0 = (unsigned)(rintf(f[8 * j + k] * inv) + 128.f), q1 = (unsigned)(rintf(f[8 * j + 4 + k] * inv) + 128.f);
            wh |= ((q0 >> 4) | ((q1 >> 4) << 4)) << (8 * k); wl |= ((q0 & 15u) | ((q1 & 15u) << 4)) << (8 * k); tsum += q0 + q1; }
        xa[j] = wh; xa[4 + j] = wl; }
    float tf = row16_sum((float)tsum);
    tf += __shfl_xor(tf, 16);
    ktok = 983040.f - 7.5f * tf;
}
DI void phase_experts(const Params& p, LAS unsigned char* ldsw  , int lane, int wid, float* outp, const int IDMASK) {
    unsigned char* ws = p.ws;
    const bf16_t* XN = (const bf16_t*)(ws + WS_XN);
    const unsigned char* U8 = ws + WS_U8; const unsigned char* V8 = ws + WS_V8;
    const f32x2* USC = (const f32x2*)(ws + WS_USC); const float* VSC = (const float*)(ws + WS_VSC);
    const int* PIDX = (const int*)(ws + WS_PIDX); const float* PGATE = (const float*)(ws + WS_PGATE); const float* RS = (const float*)(ws + WS_RS);
    float* H1 = p.out;
    const int hl = lane & 31; const bool hi = lane >= 32;
    const bool b0 = (lane & 1) != 0, b1 = (lane & 2) != 0;
    const int ntile = ((NTOK / 32) - (int)blockIdx.x + (int)gridDim.x - 1) / (int)gridDim.x;
    if (ntile <= 0) return;
    const int ntw = ntile * 4;
    auto tokof = [&](int t) { const int tc = t < ntw ? t : ntw - 1; return 32 * ((int)blockIdx.x + (tc >> 2) * (int)gridDim.x) + 4 * wid + (tc & 3); };
    unsigned xa[8]; float sx, ktok;
    typedef int v8i_t __attribute__((ext_vector_type(8)));
    float nfg[16];
#pragma unroll
    for (int r = 0; r < 16; ++r) nfg[r] = p.normf_g[32 * crow(r, hi) + hl];
    f32x16 D, D2;
#pragma unroll
    for (int i = 0; i < 16; ++i) { D[i] = 0.f; D2[i] = 0.f; }
    unsigned bmask[4];
#pragma unroll
    for (int r = 0; r < 4; ++r) bmask[r] = ((hi ? 1 : 0) == ((hl >> 4) & 1) && r == ((hl & 15) >> 2)) ? (0xFFu << (8 * (hl & 3))) : 0u;
    int iA1, iB1, iA2, iB2; float gA1, gB1, gA2, gB2, vA1, vB1; f32x2 uA1, uB1;
    auto ld_ids = [&](int t, int& iA, int& iB, float& gA, float& gB) { const size_t b = (size_t)tokof(t) * 128 + lane;
        iA = PIDX[b] & IDMASK; iB = PIDX[b + 64] & IDMASK; gA = PGATE[b]; gB = PGATE[b + 64]; };
    auto wr_rec = [&](int t, int iA, int iB, float gA, float gB, f32x2 uA, f32x2 uB, float vA, float vB) {
        LAS unsigned char* buf = ldsw + (t & 1) * 2048;
        *(LAS u32x4*)(buf + lane * 16) = (u32x4){(unsigned)iA, __float_as_uint(gA * vA), __float_as_uint(uA.x), __float_as_uint(uA.y)};
        *(LAS u32x4*)(buf + 1024 + lane * 16) = (u32x4){(unsigned)iB, __float_as_uint(gB * vB), __float_as_uint(uB.x), __float_as_uint(uB.y)};
    };
    LAS unsigned char* hvbuf = ldsw + 4096;
    auto prime = [&](int t0) {
        ld_ids(t0, iA1, iB1, gA1, gB1);
        uA1 = USC[iA1]; uB1 = USC[iB1]; vA1 = VSC[iA1]; vB1 = VSC[iB1];
        wr_rec(t0, iA1, iB1, gA1, gB1, uA1, uB1, vA1, vB1);
        ld_ids(t0 + 1, iA1, iB1, gA1, gB1);
        uA1 = USC[iA1]; uB1 = USC[iB1]; vA1 = VSC[iA1]; vB1 = VSC[iB1];
        ld_ids(t0 + 2, iA2, iB2, gA2, gB2);
    };
    auto advance = [&](int t) {
        wr_rec(t + 1, iA1, iB1, gA1, gB1, uA1, uB1, vA1, vB1);
        iA1 = iA2; iB1 = iB2; gA1 = gA2; gB1 = gB2;
        uA1 = USC[iA1]; uB1 = USC[iB1]; vA1 = VSC[iA1]; vB1 = VSC[iB1];
        ld_ids(t + 3, iA2, iB2, gA2, gB2);
    };
    const bool b2 = (lane & 4) != 0;
#pragma unroll 1
    for (int tc = 0; tc < ntw; tc += 16) {
        const int tend = tc + 16 < ntw ? tc + 16 : ntw;
        prime(tc);
        { u32x4 xn[4];
#pragma unroll
          for (int j = 0; j < 4; ++j) xn[j] = *(const u32x4*)(XN + (size_t)tokof(tc) * DM + 32 * hl + 8 * j);
          experts_quant_x(xn, xa, sx, ktok); sx *= RS[tokof(tc)]; }
        u32x4 uw[8];
#pragma unroll
        for (int q = 0; q < 8; ++q) { const int id = *(LAS const int*)(ldsw + (tc & 1) * 2048 + ((hi ? 1 : 0) + 2 * q) * 16); uw[q] = *(const u32x4*)(U8 + (size_t)id * 512 + 16 * hl); }
#pragma unroll 1
        for (int t = tc; t < tend; ++t) {
            advance(t);
            auto groupU = [&](int g) {
                const LAS unsigned char* rc_cur = ldsw + (t & 1) * 2048 + (g * 16 + (hi ? 1 : 0)) * 16;
                const int gn = g + 1;
                const LAS unsigned char* rc_nxt = ldsw + ((t + (gn >> 3)) & 1) * 2048 + ((gn & 7) * 16 + (hi ? 1 : 0)) * 16;
                float d[8]; int idn[8];
                const u32x4 rl = *(LAS const u32x4*)(rc_cur + 32 * (lane & 7));
#pragma unroll
                for (int q = 0; q < 8; ++q) idn[q] = *(LAS const int*)(rc_nxt + 32 * q);
#pragma unroll
                for (int q = 0; q < 8; ++q) {
                    __builtin_amdgcn_sched_barrier(0);
                    const u32x4 w = uw[q];
                    unsigned h0 = __builtin_amdgcn_udot8(w[0], xa[0], 0u, false), l0 = __builtin_amdgcn_udot8(w[0], xa[4], 0u, false);
                    unsigned h1 = __builtin_amdgcn_udot8(w[1], xa[1], 0u, false), l1 = __builtin_amdgcn_udot8(w[1], xa[5], 0u, false);
                    h0 = __builtin_amdgcn_udot8(w[2], xa[2], h0, false); l0 = __builtin_amdgcn_udot8(w[2], xa[6], l0, false);
                    h1 = __builtin_amdgcn_udot8(w[3], xa[3], h1, false); l1 = __builtin_amdgcn_udot8(w[3], xa[7], l1, false);
                    d[q] = (float)(((h0 + h1) << 4) + (l0 + l1));
                    __builtin_amdgcn_sched_barrier(0);
                    uw[q] = *(const u32x4*)(U8 + (size_t)idn[q] * 512 + 16 * hl);
                }
                __builtin_amdgcn_sched_barrier(0);
                float a[4], c2[2];
#pragma unroll
                for (int i = 0; i < 4; ++i) { const float keep = b0 ? d[2 * i + 1] : d[2 * i], send = b0 ? d[2 * i] : d[2 * i + 1]; a[i] = keep + dpp_mov<0xB1>(send); }
#pragma unroll
                for (int i = 0; i < 2; ++i) { const float keep = b1 ? a[2 * i + 1] : a[2 * i], send = b1 ? a[2 * i] : a[2 * i + 1]; c2[i] = keep + dpp_mov<0x4E>(send); }
                float c;
                { const float keep = b2 ? c2[1] : c2[0], send = b2 ? c2[0] : c2[1]; c = keep + dpp_mov<0x124>(send); }
                c += dpp_mov<0x128>(c);
                c += __shfl_xor(c, 16);
                const float gtl = __uint_as_float(rl.y), usl = __uint_as_float(rl.z), rcl = __uint_as_float(rl.w);
                const float dq = ((c - 128.f * rcl) + ktok) * (usl * sx);
#if PROBE == 50
                const float hvl = 0.f * gelu_bf(dq) * gtl;
#else
                const float hvl = gelu_bf(dq) * gtl;
#endif
                const unsigned code = (unsigned)__builtin_amdgcn_cvt_pk_fp8_f32(hvl * 128.f, 0.f, 0, false) & 0xffu;
                if ((lane & 0x18) == 0) hvbuf[((t - tc) * 8 + g) * 16 + 2 * (lane & 7) + (hi ? 1 : 0)] = (unsigned char)code;
            };
#pragma unroll 1
            for (int g = 0; g < 7; ++g) groupU(g);
            u32x4 xn[4];
#pragma unroll
            for (int j = 0; j < 4; ++j) xn[j] = *(const u32x4*)(XN + (size_t)tokof(t + 1) * DM + 32 * hl + 8 * j);
            groupU(7);
            experts_quant_x(xn, xa, sx, ktok); sx *= RS[tokof(t + 1)];
        }
        prime(tc);
        u32x4 vw[8];
#pragma unroll
        for (int q = 0; q < 8; ++q) { const int id = *(LAS const int*)(ldsw + (tc & 1) * 2048 + ((hi ? 1 : 0) + 2 * q) * 16); vw[q] = *(const u32x4*)(V8 + (size_t)id * 512 + 16 * hl); }
#pragma unroll 1
        for (int t = tc; t < tend; ++t) {
            advance(t);
            auto groupV = [&](int g) {
                const int gn = g + 1;
                const LAS unsigned char* rc_nxt = ldsw + ((t + (gn >> 3)) & 1) * 2048 + ((gn & 7) * 16 + (hi ? 1 : 0)) * 16;
                int idn[8];
#pragma unroll
                for (int q = 0; q < 8; ++q) idn[q] = *(LAS const int*)(rc_nxt + 32 * q);
                const u32x4 hb = *(LAS const u32x4*)(hvbuf + ((t - tc) * 8 + g) * 16);
#pragma unroll
                for (int q = 0; q < 8; ++q) {
                    __builtin_amdgcn_sched_barrier(0);
                    const unsigned wq = hb[q >> 1] >> (16 * (q & 1));
                    const unsigned bb0 = (wq & 0xffu) * 0x01010101u, bb1 = ((wq >> 8) & 0xffu) * 0x01010101u;
                    v8i_t Bv, Av;
#pragma unroll
                    for (int r = 0; r < 4; ++r) { Bv[r] = (int)(bb0 & bmask[r]); Bv[4 + r] = (int)(bb1 & bmask[r]); }
                    Av[0] = (int)vw[q].x; Av[1] = (int)vw[q].y; Av[2] = (int)vw[q].z; Av[3] = (int)vw[q].w; Av[4] = 0; Av[5] = 0; Av[6] = 0; Av[7] = 0;
                    if (q & 1) D2 = __builtin_amdgcn_mfma_scale_f32_32x32x64_f8f6f4(Av, Bv, D2, 4  , 0  , 0, 0, 0, 0  );
                    else D = __builtin_amdgcn_mfma_scale_f32_32x32x64_f8f6f4(Av, Bv, D, 4, 0, 0, 0, 0, 0);
                    __builtin_amdgcn_sched_barrier(0);
                    vw[q] = *(const u32x4*)(V8 + (size_t)idn[q] * 512 + 16 * hl);
                }
            };
#pragma unroll 1
            for (int g = 0; g < 7; ++g) groupV(g);
            const int tok = tokof(t);
            float o[16];
            { const float* hr0 = H1 + (size_t)tok * DM + hl;
#pragma unroll
              for (int r = 0; r < 16; ++r) o[r] = __builtin_nontemporal_load(hr0 + 32 * crow(r, hi)); }
            groupV(7);
            float ss = 0.f;
#pragma unroll
            for (int r = 0; r < 16; ++r) { o[r] += (D[r] + D2[r]) * (1.f / 128.f); ss += o[r] * o[r]; D[r] = 0.f; D2[r] = 0.f; }
            const float rs = rsqrtf(wave_sum(ss) * (1.f / DM) + RMS_EPS);
            float* orow = outp + (size_t)tok * DM + hl;
#pragma unroll
            for (int r = 0; r < 16; ++r) __builtin_nontemporal_store(o[r] * rs * nfg[r], orow + 32 * crow(r, hi));
        }
    }
}

__global__ void __launch_bounds__(NTHREADS, 2) mega_fwd(Params p) {
    extern __shared__ __attribute__((aligned(16))) unsigned char lds_raw[];
    LAS unsigned char* lds = (LAS unsigned char*)lds_raw;
    const int tid = threadIdx.x, lane = tid & 63, wid = __builtin_amdgcn_readfirstlane(tid >> 6);
    unsigned char* ws = p.ws;
    bf16_t* XN = (bf16_t*)(ws + WS_XN);
    bf16_t* W1T = (bf16_t*)(ws + WS_W1T);
    volatile LAS unsigned* MISC = (volatile LAS unsigned*)(lds + LDS_MISC);
    if (tid < 64) MISC[tid] = 0u;
    __syncthreads();
    const XcdBarrier bar = xcd_barrier_post((unsigned*)ws, MISC + 8);
#define GSYNC() xcd_barrier(bar)

#ifndef ONLY
#define ONLY -1
#endif
#define PH(k) if (ONLY < 0 || ONLY == (k))
#define IDS() int tid = (int)threadIdx.x; asm volatile("" : "+v"(tid)); const int lane = tid & 63, wid = __builtin_amdgcn_readfirstlane(tid >> 6); (void)lane; (void)wid;
    PH(0) { IDS(); phase_prep(p, lds, tid, lane, wid); }
#if PROBE == 13
    phase_prep(p, lds, tid, lane, wid);
#endif
    GSYNC();
    PH(1) { IDS(); { F1a f{(bf16_t*)(ws + WS_QKV), (bf16_t*)(ws + WS_PB)}; run_gemm(lds, XN, W1T, N1A, 1024, f); } }
#if PROBE == 11
    { F1a f{(bf16_t*)(ws + WS_QKV), (bf16_t*)(ws + WS_PB)}; run_gemm(lds, XN, W1T, N1A, 1024, f); }
#endif
    GSYNC();
    PH(2) { IDS(); phase_wg8(p, lane, wid); phase_kbar_vt(p, lds, tid, lane, wid); }
#if PROBE == 14 || PROBE == 61
    phase_kbar_vt(p, lds, tid, lane, wid);
#endif
    PH(3) { IDS(); phase_rwkv_prep2<true>(p, lds, tid, lane, wid); }
#if PROBE == 8 || PROBE == 61
    phase_rwkv_prep2<true>(p, lds, tid, lane, wid);
#endif

    GSYNC();
    PH(6) { IDS(); phase_attn2<0>(p, lds, tid, lane, wid); }
#if PROBE == 63 || PROBE == 61
    __syncthreads();
    phase_attn2<0>(p, lds, tid, lane, wid);
#endif
    GSYNC();
    PH(5) { IDS(); phase_chunkprep<4>(p, lds, lane, wid); }
    PH(8) { IDS(); if (wid >= 4) { phase_uv_convert(p, lane, (int)blockIdx.x * 4 + wid - 4, (int)gridDim.x * 4); xn8_convert(p, lane, (int)blockIdx.x * 4 + wid - 4, (int)gridDim.x * 4); } }
#if PROBE == 31 || PROBE == 61
    phase_chunkprep<4>(p, lds, lane, wid);
#endif
#if PROBE == 33
    phase_chunkprep<1>(p, lds, lane, wid);
#endif
#if PROBE == 34
    phase_chunkprep<2>(p, lds, lane, wid);
#endif
#if PROBE == 35
    phase_chunkprep<3>(p, lds, lane, wid);
#endif
    GSYNC();
    PH(17) { IDS(); phase_chunkscan(p, lds, tid, lane, wid); }
    PH(9) { IDS(); if (gridDim.x > 64 && (int)blockIdx.x >= 64) { F1b f{ws, p.out, 0, (const signed char*)(ws + WS_WG8SC)}; run_gemm8_on(lds, (const unsigned char*)p.out + DO_XN8, ws + WS_WG8, G1B_EARLY, 1024, f, (int)gridDim.x - 64, (int)blockIdx.x - 64); } }
#if PROBE == 32 || PROBE == 62
    phase_chunkscan(p, lds, tid, lane, wid);
#endif
    GSYNC();
    PH(7) { IDS(); phase_post(p, tid, lane, wid); }
#if PROBE == 62
    phase_post(p, tid, lane, wid);
#endif
    PH(9) { IDS(); { const int e = gridDim.x > 64 ? G1B_EARLY : 0; F1b f{ws, p.out, e, (const signed char*)(ws + WS_WG8SC)}; run_gemm8(lds, (const unsigned char*)p.out + DO_XN8, ws + WS_WG8 + (size_t)e * 1024, NGATE - e, 1024, f); } }
#if PROBE == 64 || PROBE == 66
    { const int e = gridDim.x > 64 ? G1B_EARLY : 0; F1b f{ws, p.out, e, (const signed char*)(ws + WS_WG8SC)}; run_gemm8(lds, (const unsigned char*)p.out + DO_XN8, ws + WS_WG8 + (size_t)e * 1024, NGATE - e, 1024, f); }
#endif
    GSYNC();
    PH(10) { IDS(); { FPa f{ws, p.out, (bf16_t*)(ws + WS_Y)}; run_gemm(lds, (const bf16_t*)(ws + WS_OA), (const bf16_t*)(ws + WS_WPA), 1024, 512, f); } }
#if PROBE == 19 || PROBE == 66
    { FPa f{ws, p.out, (bf16_t*)(ws + WS_Y)}; run_gemm(lds, (const bf16_t*)(ws + WS_OA), (const bf16_t*)(ws + WS_WPA), 1024, 512, f); }
#endif
    __builtin_amdgcn_fence(__ATOMIC_ACQ_REL, "workgroup"); __syncthreads();
    PH(11) { IDS(); { FPb f{ws, p.out, (bf16_t*)(ws + WS_Y)}; run_gemm(lds, (const bf16_t*)(ws + WS_OB), (const bf16_t*)(ws + WS_WPB), 1024, 512, f); } }
    GSYNC();
    PH(12) { IDS(); { FOut f{p.x, p.norm2_g, p.out, XN, (float*)(ws + WS_ROWSQ)}; run_gemm(lds, (const bf16_t*)(ws + WS_Y), (const bf16_t*)(ws + WS_WO), 1024, 1024, f); } }
#if PROBE == 65 || PROBE == 66
    { FOut f{p.x, p.norm2_g, p.out, XN, (float*)(ws + WS_ROWSQ)}; run_gemm(lds, (const bf16_t*)(ws + WS_Y), (const bf16_t*)(ws + WS_WO), 1024, 1024, f); }
#endif
    GSYNC();
    PH(14) { IDS(); { FQ f{(bf16_t*)(ws + WS_QP)}; run_gemm(lds, XN, (const bf16_t*)(ws + WS_WQ), 2048, 1024, f); } }
#if PROBE == 12 || PROBE == 62
    { FQ f{(bf16_t*)(ws + WS_QP)}; run_gemm(lds, XN, (const bf16_t*)(ws + WS_WQ), 2048, 1024, f); }
#endif
    GSYNC();
    PH(15) { IDS(); phase_route(p, lds, lane, wid); }
#if PROBE == 7 || PROBE == 62
    phase_route(p, lds, lane, wid);
#endif
    __builtin_amdgcn_fence(__ATOMIC_ACQ_REL, "workgroup"); __syncthreads();
#if PROBE == 4 || PROBE == 52
#pragma unroll 1
    for (int rep = 0; rep < 2; ++rep) { IDS(); phase_experts(p, lds + wid * 6144, lane, wid, rep == 0 ? (float*)(ws + WS_QKV) : p.out, (rep == 0 && PROBE == 52) ? 2047 : -1); }
#else
    PH(16) { IDS(); phase_experts(p, lds + wid * 6144, lane, wid, p.out, -1); }
#endif
}

extern "C" void kernel_launch(void* const* d_in, const int* in_sizes, int n_in, void* d_out, int out_size, void* d_ws, size_t ws_size, hipStream_t stream) {
    static int grid = 0;
    if (grid == 0) {
        if (n_in != 24 || out_size != NTOK * DM || ws_size < WS_NEED) { fprintf(stderr, "kernel_launch: unexpected problem (n_in %d, out %d, ws %zu)\n", n_in, out_size, ws_size); grid = -1; return; }
        int dev = 0, cus = 0, per_cu = 0;
        if (hipGetDevice(&dev) != hipSuccess || hipDeviceGetAttribute(&cus, hipDeviceAttributeMultiprocessorCount, dev) != hipSuccess) { grid = -1; return; }
        if (hipFuncSetAttribute((const void*)mega_fwd, hipFuncAttributeMaxDynamicSharedMemorySize, LDS_BYTES) != hipSuccess) { fprintf(stderr, "kernel_launch: hipFuncSetAttribute failed\n"); grid = -1; return; }
        if (hipOccupancyMaxActiveBlocksPerMultiprocessor(&per_cu, (const void*)mega_fwd, NTHREADS, LDS_BYTES) != hipSuccess || per_cu < 1) { fprintf(stderr, "kernel_launch: occupancy query says %d\n", per_cu); per_cu = 0; }
        (void)hipGetLastError();
        if (per_cu < 1) { grid = -1; return; }
        grid = cus * 1;
        if (grid < 1) grid = -1;
    }
    if (grid < 0) return;
    Params p{};
    p.x = (const float*)d_in[0]; p.norm1_g = (const float*)d_in[1]; p.w_in = (const float*)d_in[2]; p.rwkv_mu = (const float*)d_in[3];
    p.w0 = (const float*)d_in[4]; p.w_lora_up = (const float*)d_in[5]; p.a0 = (const float*)d_in[6]; p.a_lora_up = (const float*)d_in[7];
    p.g_lora_up = (const float*)d_in[8]; p.k_k = (const float*)d_in[9]; p.k_a = (const float*)d_in[10]; p.r_k = (const float*)d_in[11];
    p.lnx_g = (const float*)d_in[12]; p.lnx_b = (const float*)d_in[13]; p.w_proj_a = (const float*)d_in[14]; p.w_proj_b = (const float*)d_in[15];
    p.w_out = (const float*)d_in[16]; p.norm2_g = (const float*)d_in[17]; p.peer_wq = (const float*)d_in[18]; p.peer_subkeys = (const float*)d_in[19];
    p.peer_u = (const float*)d_in[20]; p.peer_v = (const float*)d_in[21]; p.rel_bias = (const float*)d_in[22]; p.normf_g = (const float*)d_in[23];
    p.out = (float*)d_out; p.ws = (unsigned char*)d_ws;
    if (hipMemsetAsync(d_ws, 0, 65536, stream) != hipSuccess) { fprintf(stderr, "kernel_launch: memset failed\n"); return; }
    void* args[] = {&p};
    hipError_t e = hipLaunchCooperativeKernel((const void*)mega_fwd, dim3(grid), dim3(NTHREADS), args, LDS_BYTES, stream);
    if (e != hipSuccess) fprintf(stderr, "kernel_launch: cooperative launch failed: %s (grid %d)\n", hipGetErrorString(e), grid);
}
```

```cpp
#include <hip/hip_runtime.h>
#include <hip/hip_cooperative_groups.h>
#include <cstdio>
#include <cstdint>
#include <utility>
namespace cg = cooperative_groups;
namespace pg8 {
#define PG8_LAS __attribute__((address_space(3)))
typedef unsigned short bf16_t;
typedef short bf16x8 __attribute__((ext_vector_type(8)));
typedef float f32x4 __attribute__((ext_vector_type(4)));
typedef unsigned u32x4 __attribute__((ext_vector_type(4)));
constexpr int BM = 256, BK = 64, HALF = 128, HTB = HALF * BK * 2  , STAGE_BYTES = 8 * HTB, NXCD = 8, WGM = 8;

__host__ __device__ __forceinline__ int lds_byte(int r, int c) { const int st = (r >> 4) * 2 + (c >> 5), rr = r & 15, cc = c & 31, ob = rr * 64 + cc * 2; return st * 1024 + (ob ^ (((ob >> 9) & 1) << 5)); }
__host__ __device__ __forceinline__ void stage_rc(int b, int& R, int& C) { const int st = b / 1024, sb = b % 1024, swz = sb ^ (((sb >> 9) & 1) << 5); R = (st >> 1) * 16 + swz / 64; C = (st & 1) * 32 + (swz % 64) / 2; }
__host__ __device__ __forceinline__ int perm32(int rho) { const int n = rho >> 4, i = rho & 15; return 8 * (i >> 2) + 4 * n + (i & 3); }

struct Unit { int pm, pn; };
struct Gemm { const bf16_t* A; const bf16_t* Bt; int M, N, K; };

struct StaticOrder {
    int nM, nN, nwg, G, c;
    __host__ __device__ void init(int M, int N, int G_, int c_) { nM = M / BM; nN = N / BM; nwg = nM * nN; G = G_; c = c_; }
    __host__ __device__ bool next(int i, Unit& u) const {
        const long L = (long)i * G + c; if (L >= nwg) return false;
        int wgid = (int)L; { const int q = nwg / NXCD, r = nwg % NXCD, xcd = wgid % NXCD, off = wgid / NXCD; wgid = (xcd < r ? xcd * (q + 1) : r * (q + 1) + (xcd - r) * q) + off; }
        const int nig = WGM * nN, gid = wgid / nig, fm = gid * WGM, gsz = (nM - fm) < WGM ? (nM - fm) : WGM;
        u.pm = fm + ((wgid % nig) % gsz); u.pn = (wgid % nig) / gsz; return true;
    }
    __device__ __forceinline__ void a_ready(const Unit&) const {}
    __device__ __forceinline__ void done(const Unit&) const {}
};
typedef int pg8_v8i __attribute__((ext_vector_type(8)));
__device__ __forceinline__ pg8_v8i pg8_cat8(bf16x8 lo, bf16x8 hi) {
    typedef int v4i_ __attribute__((ext_vector_type(4)));
    const v4i_ a = __builtin_bit_cast(v4i_, lo), b = __builtin_bit_cast(v4i_, hi);
    return (pg8_v8i){a[0], a[1], a[2], a[3], b[0], b[1], b[2], b[3]};
}
template <class Epi, class Sched, bool ALIGN_EPI = false, bool SP2 = false, bool FP8 = false>
__device__ __forceinline__ void gemm_phase(PG8_LAS unsigned char* lds, const Gemm g, const Sched& S, const Epi& E) {
    int tid_ = (int)threadIdx.x; asm volatile("" : "+v"(tid_));
    const int tid = tid_, wid = __builtin_amdgcn_readfirstlane(tid >> 6), lane = tid & 63, wr = wid >> 2, wc = wid & 3, fr = lane & 15, fq = lane >> 4;
    const int K = g.K, nt = K / BK;
    unsigned voffA[2], voffB[2];
#pragma unroll
    for (int i = 0; i < 2; ++i) { int R, C; stage_rc(tid * 16 + i * 8192, R, C); const int Rb = Epi::PERM ? ((R & ~31) + perm32(R & 31)) : R;
        voffA[i] = (unsigned)(R * K + C) * 2u; voffB[i] = (unsigned)(Rb * K + C) * 2u; }
    const size_t kstep = (size_t)(BK * 2);
    const size_t hstep = (size_t)HALF * K * 2;
    const size_t tstep = 2 * hstep;
    const unsigned ldsw = (unsigned)wid * 1024u;
    const int aoff = lds_byte(wr * 64 + fr, fq * 8), boff = lds_byte(wc * 32 + fr, fq * 8);
#define PG8_SA(b, h) (((b) * 2 + (h)) * HTB)
#define PG8_SB(b, h) ((4 + (b) * 2 + (h)) * HTB)
#define PG8_STAGE(bufoff, gbase, voff) do { _Pragma("unroll") for (int _i = 0; _i < 2; ++_i) \
        __builtin_amdgcn_global_load_lds((const unsigned*)((const char*)(gbase) + (voff)[_i]), (PG8_LAS unsigned*)(lds + (bufoff) + ldsw + _i * 8192), 16, 0, 0); } while (0)
#define PG8_LDA(dst, b, h) do { _Pragma("unroll") for (int m = 0; m < 4; ++m) { \
        if constexpr (FP8) dst##8[m] = pg8_cat8(*(const PG8_LAS bf16x8*)(lds + PG8_SA(b, h) + aoff + m * 2048), *(const PG8_LAS bf16x8*)(lds + PG8_SA(b, h) + aoff + m * 2048 + 1024)); \
        else { _Pragma("unroll") for (int k = 0; k < 2; ++k) dst[m][k] = *(const PG8_LAS bf16x8*)(lds + PG8_SA(b, h) + aoff + m * 2048 + k * 1024); } } } while (0)
#define PG8_LDB(dst, b, h) do { _Pragma("unroll") for (int n = 0; n < 2; ++n) { \
        if constexpr (FP8) dst##8[n] = pg8_cat8(*(const PG8_LAS bf16x8*)(lds + PG8_SB(b, h) + boff + n * 2048), *(const PG8_LAS bf16x8*)(lds + PG8_SB(b, h) + boff + n * 2048 + 1024)); \
        else { _Pragma("unroll") for (int k = 0; k < 2; ++k) dst[n][k] = *(const PG8_LAS bf16x8*)(lds + PG8_SB(b, h) + boff + n * 2048 + k * 1024); } } } while (0)
#define PG8_MMA(ai, bj, At, Bt) do { __builtin_amdgcn_s_setprio(1); \
        if constexpr (FP8) { _Pragma("unroll") for (int m = 0; m < 4; ++m) _Pragma("unroll") for (int n = 0; n < 2; ++n) \
            asm volatile("v_mfma_f32_16x16x128_f8f6f4 %0, %1, %2, %0" : "+v"(acc[ai][bj][m][n]) : "v"(Bt##8[n]), "v"(At##8[m])); } \
        else { _Pragma("unroll") for (int m = 0; m < 4; ++m) _Pragma("unroll") for (int n = 0; n < 2; ++n) _Pragma("unroll") for (int k = 0; k < 2; ++k) \
            acc[ai][bj][m][n] = __builtin_amdgcn_mfma_f32_16x16x32_bf16(Bt[n][k], At[m][k], acc[ai][bj][m][n], 0, 0, 0); } \
        __builtin_amdgcn_s_setprio(0); } while (0)
#define PG8_WAIT_V(n) asm volatile("s_waitcnt vmcnt(" #n ")" ::: "memory")
#define PG8_WAIT_L(n) asm volatile("s_waitcnt lgkmcnt(" #n ")" ::: "memory")
#define PG8_BAR __builtin_amdgcn_s_barrier()
#define PG8_SCHED __builtin_amdgcn_sched_barrier(0)
    Unit cur, nxt; int ui = 0;
    if (!S.next(0, cur)) return;
    f32x4 acc[2][2][4][2];
#pragma unroll
    for (int a = 0; a < 2; ++a)
#pragma unroll
        for (int b = 0; b < 2; ++b)
#pragma unroll
            for (int m = 0; m < 4; ++m)
#pragma unroll
                for (int n = 0; n < 2; ++n) acc[a][b][m][n] = (f32x4){0.f, 0.f, 0.f, 0.f};
    bf16x8 At[4][2], B0[2][2], B1[2][2];
    pg8_v8i At8[4], B08[2], B18[2];
    const char* cA = (const char*)g.A + (size_t)cur.pm * tstep; const char* cB = (const char*)g.Bt + (size_t)cur.pn * tstep;
    S.a_ready(cur);
    if constexpr (SP2) {
        PG8_STAGE(PG8_SB(0, 0), cB, voffB); PG8_STAGE(PG8_SB(0, 1), cB + hstep, voffB); PG8_STAGE(PG8_SA(0, 0), cA, voffA); PG8_STAGE(PG8_SA(0, 1), cA + hstep, voffA);
        if (wr == 1) PG8_BAR;
        PG8_WAIT_V(2); PG8_BAR;
        PG8_STAGE(PG8_SB(1, 0), cB + kstep, voffB); PG8_STAGE(PG8_SA(1, 0), cA + kstep, voffA); PG8_STAGE(PG8_SB(1, 1), cB + hstep + kstep, voffB);
        PG8_WAIT_V(6); PG8_BAR;
    } else {
        PG8_STAGE(PG8_SB(0, 0), cB, voffB); PG8_STAGE(PG8_SA(0, 0), cA, voffA); PG8_STAGE(PG8_SB(0, 1), cB + hstep, voffB); PG8_STAGE(PG8_SA(0, 1), cA + hstep, voffA);
        if (wr == 1) PG8_BAR;
        PG8_WAIT_V(4); PG8_BAR;
        PG8_STAGE(PG8_SB(1, 0), cB + kstep, voffB); PG8_STAGE(PG8_SA(1, 0), cA + kstep, voffA); PG8_STAGE(PG8_SB(1, 1), cB + hstep + kstep, voffB);
        PG8_WAIT_V(6); PG8_BAR;
    }
    for (;;) {
        const bool has_next = S.next(ui + 1, nxt);
        const char* nA = has_next ? (const char*)g.A + (size_t)nxt.pm * tstep : cA; const char* nB = has_next ? (const char*)g.Bt + (size_t)nxt.pn * tstep : cB;
        for (int t = 0; t < nt; t += 2) {
            const bool last = (t == nt - 2);
            const char* a1 = cA + (size_t)(t + 1) * kstep;
            const char* a2 = last ? nA : cA + (size_t)(t + 2) * kstep; const char* b2 = last ? nB : cB + (size_t)(t + 2) * kstep;
            const char* a3 = a2 + kstep; const char* b3 = b2 + kstep;
            if (last && has_next) S.a_ready(nxt);
            if constexpr (SP2) {
            PG8_LDB(B0, 0, 0); PG8_LDB(B1, 0, 1); PG8_SCHED; PG8_LDA(At, 0, 0); PG8_STAGE(PG8_SA(1, 1), a1 + hstep, voffA);
            PG8_WAIT_V(8); PG8_WAIT_L(0); PG8_BAR; PG8_MMA(0, 0, At, B0); PG8_MMA(0, 1, At, B1); PG8_BAR; PG8_SCHED;
            PG8_LDA(At, 0, 1); PG8_STAGE(PG8_SB(0, 0), b2, voffB); PG8_STAGE(PG8_SB(0, 1), b2 + hstep, voffB); PG8_STAGE(PG8_SA(0, 0), a2, voffA);
            PG8_WAIT_V(8); PG8_WAIT_L(0); PG8_BAR; PG8_MMA(1, 0, At, B0); PG8_MMA(1, 1, At, B1); PG8_BAR; PG8_SCHED;
            PG8_LDB(B0, 1, 0); PG8_LDB(B1, 1, 1); PG8_SCHED; PG8_LDA(At, 1, 0); PG8_STAGE(PG8_SA(0, 1), a2 + hstep, voffA);
            PG8_WAIT_V(8); PG8_WAIT_L(0); PG8_BAR; PG8_MMA(0, 0, At, B0); PG8_MMA(0, 1, At, B1); PG8_BAR; PG8_SCHED;
            PG8_LDA(At, 1, 1); PG8_STAGE(PG8_SB(1, 0), b3, voffB); PG8_STAGE(PG8_SB(1, 1), b3 + hstep, voffB); PG8_STAGE(PG8_SA(1, 0), a3, voffA);
            PG8_WAIT_V(8); PG8_WAIT_L(0); PG8_BAR; PG8_MMA(1, 0, At, B0); PG8_MMA(1, 1, At, B1); PG8_BAR; PG8_SCHED;
            } else {
            PG8_LDB(B0, 0, 0); PG8_SCHED; PG8_LDA(At, 0, 0); PG8_STAGE(PG8_SA(1, 1), a1 + hstep, voffA);
            PG8_WAIT_L(8); PG8_BAR; PG8_WAIT_L(0); PG8_MMA(0, 0, At, B0); PG8_BAR; PG8_SCHED;
            PG8_LDB(B1, 0, 1); PG8_STAGE(PG8_SB(0, 0), b2, voffB);
            PG8_BAR; PG8_WAIT_L(0); PG8_MMA(0, 1, At, B1); PG8_BAR;
            PG8_LDA(At, 0, 1); PG8_STAGE(PG8_SA(0, 0), a2, voffA);
            PG8_BAR; PG8_WAIT_L(0); PG8_MMA(1, 0, At, B0); PG8_BAR; PG8_SCHED;
            PG8_STAGE(PG8_SB(0, 1), b2 + hstep, voffB);
            PG8_WAIT_V(6); PG8_BAR; PG8_MMA(1, 1, At, B1); PG8_BAR;
            PG8_LDB(B0, 1, 0); PG8_SCHED; PG8_LDA(At, 1, 0); PG8_STAGE(PG8_SA(0, 1), a2 + hstep, voffA);
            PG8_WAIT_L(8); PG8_BAR; PG8_WAIT_L(0); PG8_MMA(0, 0, At, B0); PG8_BAR; PG8_SCHED;
            PG8_LDB(B1, 1, 1); PG8_STAGE(PG8_SB(1, 0), b3, voffB);
            PG8_BAR; PG8_WAIT_L(0); PG8_MMA(0, 1, At, B1); PG8_BAR;
            PG8_LDA(At, 1, 1); PG8_STAGE(PG8_SA(1, 0), a3, voffA);
            PG8_BAR; PG8_WAIT_L(0); PG8_MMA(1, 0, At, B0); PG8_BAR; PG8_SCHED;
            PG8_STAGE(PG8_SB(1, 1), b3 + hstep, voffB);
            PG8_WAIT_V(6); PG8_BAR; PG8_MMA(1, 1, At, B1); PG8_BAR;
            }
        }
        if constexpr (ALIGN_EPI) { if (wr == 0) PG8_BAR; }
        if constexpr (!Epi::AFTER_DRAIN) { E(acc, cur, wr, wc, fr, fq); S.done(cur); }
        if (!has_next) break;
#pragma unroll
        for (int a = 0; a < 2; ++a)
#pragma unroll
            for (int b = 0; b < 2; ++b)
#pragma unroll
                for (int m = 0; m < 4; ++m)
#pragma unroll
                    for (int n = 0; n < 2; ++n) acc[a][b][m][n] = (f32x4){0.f, 0.f, 0.f, 0.f};
        cur = nxt; cA = nA; cB = nB; ++ui;
        if constexpr (ALIGN_EPI) { if (wr == 1) PG8_BAR; }
    }
    PG8_WAIT_V(0);
    if constexpr (!ALIGN_EPI) { if (wr == 0) PG8_BAR; }
    PG8_BAR;
    if constexpr (Epi::AFTER_DRAIN) { E.fused(acc, cur, wr, wc, fr, fq, lds, wid, lane); S.done(cur); }
#undef PG8_SA
#undef PG8_SB
#undef PG8_STAGE
#undef PG8_LDA
#undef PG8_LDB
#undef PG8_MMA
#undef PG8_WAIT_V
#undef PG8_WAIT_L
#undef PG8_BAR
#undef PG8_SCHED
}
}

#define DI __device__ __forceinline__
#ifndef PROBE
#define PROBE 0
#endif
#define LAS __attribute__((address_space(3)))
typedef unsigned short bf16_t;
typedef short bf16x8 __attribute__((ext_vector_type(8)));
typedef short s16x4 __attribute__((ext_vector_type(4)));
typedef float f32x4 __attribute__((ext_vector_type(4)));
typedef float f32x2 __attribute__((ext_vector_type(2)));
typedef float f32x16 __attribute__((ext_vector_type(16)));
typedef unsigned u32x4 __attribute__((ext_vector_type(4)));
typedef unsigned u32x2 __attribute__((ext_vector_type(2)));

constexpr int NB = 8, SEQ = 4096, DM = 1024, NTOK = NB * SEQ, NH = 8, HD = 64;
constexpr int QKVW = 1536, PBW = 1824, N1A = 3584, N1A_REAL = 3360, NGATE = 2048, W1ROWS = 5632;
constexpr int G1B_EARLY = 512;
constexpr int NEXP = 16384;
constexpr float RMS_EPS = 1e-6f, GN_EPS = 64e-5f;
constexpr float LOG2E = 1.4426950408889634f;
constexpr int NTHREADS = 512, NWAVES = 8;
constexpr int LDS_BYTES = 148480;
constexpr int LDS_MISC = 147968;

constexpr size_t MiB = 1u << 20;
constexpr size_t WS_W1T = 1 * MiB;
constexpr size_t WS_WPA = 12 * MiB;
constexpr size_t WS_WPB = 13 * MiB;
constexpr size_t WS_WO = 14 * MiB;
constexpr size_t WS_WQ = 16 * MiB;
constexpr size_t WS_SK = 20 * MiB;
constexpr size_t WS_KBAR = 20 * MiB + 512 * 1024;
constexpr size_t WS_SEL = 21 * MiB;
constexpr size_t WS_LWT = 21 * MiB + 512 * 1024;
constexpr size_t WS_XN = 22 * MiB;
constexpr size_t WS_QKV = 86 * MiB;
constexpr size_t WS_PB = 182 * MiB;
constexpr size_t WS_SCAN = 296 * MiB;
constexpr size_t WS_OA = 182 * MiB;
constexpr size_t WS_OBRAW = 262 * MiB;
constexpr size_t WS_OB = 86 * MiB;
constexpr size_t WS_GATES = 296 * MiB;
constexpr size_t WS_U8 = 488 * MiB;
constexpr size_t WS_V8 = 500 * MiB;
constexpr size_t WS_ROWSQ = 497 * MiB;
constexpr size_t WS_RS = 499 * MiB;
constexpr size_t WS_WG8 = 509 * MiB;
constexpr size_t WS_WG8SC = 511 * MiB;
constexpr size_t DO_XN8 = 0;
constexpr size_t DO_GEARLY = 112 * MiB;
constexpr size_t WS_USC = 256 * 1024;
constexpr size_t WS_VSC = 384 * 1024;
constexpr size_t WS_Y = 118 * MiB;
constexpr size_t WS_QP = 182 * MiB;
constexpr size_t WS_PIDX = 310 * MiB;
constexpr size_t WS_PGATE = 326 * MiB;
constexpr size_t WS_NEED = 512 * MiB;
constexpr size_t DO_VT = 0, DO_RG = 32 * MiB, DO_KF = 64 * MiB;

struct Params {
    const float* x; const float* norm1_g; const float* w_in; const float* rwkv_mu; const float* w0; const float* w_lora_up;
    const float* a0; const float* a_lora_up; const float* g_lora_up; const float* k_k; const float* k_a; const float* r_k;
    const float* lnx_g; const float* lnx_b; const float* w_proj_a; const float* w_proj_b; const float* w_out; const float* norm2_g;
    const float* peer_wq; const float* peer_subkeys; const float* peer_u; const float* peer_v; const float* rel_bias; const float* normf_g;
    float* out; unsigned char* ws;
};

DI float bflo(unsigned u) { return __uint_as_float(u << 16); }
DI float bfhi(unsigned u) { return __uint_as_float(u & 0xffff0000u); }
DI float bf2f(bf16_t h) { return __uint_as_float((unsigned)h << 16); }
DI unsigned pk2(float lo, float hi) {
    typedef __bf16 b2 __attribute__((ext_vector_type(2)));
    f32x2 v = {lo, hi}; b2 b = __builtin_convertvector(v, b2); return __builtin_bit_cast(unsigned, b);
}
DI bf16_t f2bf(float f) { return (bf16_t)(pk2(f, 0.f) & 0xffffu); }
DI u32x4 pack8(f32x4 a, f32x4 b) { u32x4 w; w.x = pk2(a[0], a[1]); w.y = pk2(a[2], a[3]); w.z = pk2(b[0], b[1]); w.w = pk2(b[2], b[3]); return w; }
DI void unpack8(u32x4 w, float (&f)[8]) {
    f[0] = bflo(w.x); f[1] = bfhi(w.x); f[2] = bflo(w.y); f[3] = bfhi(w.y); f[4] = bflo(w.z); f[5] = bfhi(w.z); f[6] = bflo(w.w); f[7] = bfhi(w.w);
}
template <int CTRL> DI float dpp_mov(float x) { return __builtin_bit_cast(float, __builtin_amdgcn_update_dpp(0, __builtin_bit_cast(int, x), CTRL, 0xf, 0xf, false)); }
DI float row16_sum(float x) {
    x += dpp_mov<0x128>(x); x += dpp_mov<0x124>(x); x += dpp_mov<0x122>(x); x += dpp_mov<0x121>(x); return x;
}
DI float wave_sum(float v) {
    v = row16_sum(v);
    const float a = __builtin_bit_cast(float, __builtin_amdgcn_readlane(__builtin_bit_cast(int, v), 0)), b = __builtin_bit_cast(float, __builtin_amdgcn_readlane(__builtin_bit_cast(int, v), 16));
    const float c = __builtin_bit_cast(float, __builtin_amdgcn_readlane(__builtin_bit_cast(int, v), 32)), d = __builtin_bit_cast(float, __builtin_amdgcn_readlane(__builtin_bit_cast(int, v), 48));
    return (a + b) + (c + d);
}
DI float vmul_(float a, float b) { float d; asm("v_mul_f32 %0, %1, %2" : "=v"(d) : "v"(a), "v"(b)); return d; }
DI float vfma_(float a, float b, float c) { float d; asm("v_fma_f32 %0, %1, %2, %3" : "=v"(d) : "v"(a), "v"(b), "v"(c)); return d; }
DI float vfnma_(float a, float b, float c) { float d; asm("v_fma_f32 %0, -%1, %2, %3" : "=v"(d) : "v"(a), "v"(b), "v"(c)); return d; }
DI float sigmoidf_(float x) { return __builtin_amdgcn_rcpf(1.0f + __expf(-x)); }
DI int crow(int r, int hi) { return (r & 3) + 8 * (r >> 2) + 4 * hi; }
#define MFMA32(a, b, c) __builtin_amdgcn_mfma_f32_32x32x16_bf16((a), (b), (c), 0, 0, 0)
#define LDS_WAIT() asm volatile("s_waitcnt lgkmcnt(0)" ::: "memory")

#define XB_TMO      128
#define XB_XCNT(j)  (256  + 64 * (j))
#define XB_XSUB(j)  (1280 + 64 * (j))
#define XB_XGEN(j)  (2304 + 64 * (j))
#define XB_TOP      3328
#define XB_TOPGEN   3392
#define XCD_BAR_WORDS 3456
#define XB_SPIN_CAP (1u << 22)

__device__ __forceinline__ unsigned xb_ld(unsigned* p)              { return __hip_atomic_load(p, __ATOMIC_RELAXED, __HIP_MEMORY_SCOPE_AGENT); }
__device__ __forceinline__ unsigned xb_add(unsigned* p, unsigned v) { return __hip_atomic_fetch_add(p, v, __ATOMIC_RELAXED, __HIP_MEMORY_SCOPE_AGENT); }
__device__ __forceinline__ unsigned xb_xcc_id() { return (unsigned)__builtin_amdgcn_s_getreg((3 << 11) | 20) & 0xFu; }
#define XB_SPIN(cond, bar) do { unsigned _sp = 0; while (cond) { __builtin_amdgcn_s_sleep(1); \
    if ((++_sp & 255u) == 0u) { if (xb_ld(&(bar)[XB_TMO])) break; if (_sp > XB_SPIN_CAP) { atomicAdd(&(bar)[XB_TMO], 1u); break; } } } } while (0)

struct XcdBarrier {
    unsigned* bar; unsigned x;
    volatile LAS unsigned* st;
};

__device__ __forceinline__ XcdBarrier xcd_barrier_post(unsigned* bar, volatile LAS unsigned* st) {
    XcdBarrier b; b.bar = bar; b.x = xb_xcc_id(); b.st = st;
    if (threadIdx.x == 0) (void)xb_add(&bar[XB_XCNT(b.x)], 1u);
    return b;
}
__device__ __forceinline__ void xcd_barrier_complete(unsigned* bar, unsigned x, unsigned& nloc, unsigned& nx) {
    const unsigned G = gridDim.x * gridDim.y * gridDim.z;
    unsigned sum, cnt, mine, sp = 0u;
    for (;;) {
        sum = 0u; cnt = 0u; mine = 0u;
#pragma unroll
        for (unsigned j = 0; j < 16; ++j) { const unsigned c = xb_ld(&bar[XB_XCNT(j)]); sum += c; cnt += (c > 0u) ? 1u : 0u; mine = (j == x) ? c : mine; }
        if (sum == G) break;
        __builtin_amdgcn_s_sleep(1);
        if ((++sp & 255u) == 0u) { if (xb_ld(&bar[XB_TMO])) break; if (sp > XB_SPIN_CAP) { atomicAdd(&bar[XB_TMO], 1u); break; } }
    }
    nloc = mine > 0u ? mine : 1u; nx = cnt > 0u ? cnt : 1u;
}

__device__ __forceinline__ void xcd_barrier(const XcdBarrier& b) {
    asm volatile("s_waitcnt vmcnt(0)" ::: "memory");
    __syncthreads();
    if (threadIdx.x == 0) {
        unsigned* bar = b.bar;
        __builtin_amdgcn_s_waitcnt(0);
        unsigned nloc = b.st[0], nx = b.st[1];
        if (nloc == 0u) { xcd_barrier_complete(bar, b.x, nloc, nx); b.st[0] = nloc; b.st[1] = nx; }
        const unsigned old = xb_add(&bar[XB_XSUB(b.x)], 1u);
        const unsigned gen = old / nloc;
        if (old + 1u == (gen + 1u) * nloc) {
            __builtin_amdgcn_fence(__ATOMIC_RELEASE, "agent");
            asm volatile("s_waitcnt vmcnt(0)" ::: "memory");
            const unsigned og = xb_add(&bar[XB_TOP], 1u);
            const unsigned tg = og / nx;
            if (og + 1u == (tg + 1u) * nx) xb_add(&bar[XB_TOPGEN], 1u);
            else XB_SPIN(xb_ld(&bar[XB_TOPGEN]) == tg, bar);
            __builtin_amdgcn_fence(__ATOMIC_ACQUIRE, "agent");
            xb_add(&bar[XB_XGEN(b.x)], 1u);
            asm volatile("s_waitcnt vmcnt(0)" ::: "memory");
        } else {
            XB_SPIN(xb_ld(&bar[XB_XGEN(b.x)]) == gen, bar);
            __builtin_amdgcn_fence(__ATOMIC_ACQUIRE, "agent");
            asm volatile("s_waitcnt vmcnt(0)" ::: "memory");
        }
    }
    __syncthreads();
}


template <class F> struct EpiF {
    static constexpr bool PERM = true, AFTER_DRAIN = false; F f;
    DI void operator()(const pg8::f32x4 (&acc)[2][2][4][2], const pg8::Unit& u, int wr, int wc, int fr, int fq) const {
        const int row0 = u.pm * 256 + wr * 64 + fr, col0 = u.pn * 256 + wc * 32 + 8 * fq;
        const typename F::Tile tl = f.tile(col0);
#pragma unroll
        for (int ai = 0; ai < 2; ++ai) {
            typename F::Pre pre[4][2];
#pragma unroll
            for (int m = 0; m < 4; ++m)
#pragma unroll
                for (int bj = 0; bj < 2; ++bj) pre[m][bj] = f.load(row0 + ai * 128 + m * 16, col0 + bj * 128);
#pragma unroll
            for (int m = 0; m < 4; ++m) {
                float s = 0.f;
#pragma unroll
                for (int bj = 0; bj < 2; ++bj) s += f.apply(row0 + ai * 128 + m * 16, col0 + bj * 128, acc[ai][bj][m][0], acc[ai][bj][m][1], pre[m][bj], tl, bj);
                f.row_end(row0 + ai * 128 + m * 16, s, fq, u.pn * 4 + wc);
            }
        }
    }
};
template <class F> DI void run_gemm(LAS unsigned char* lds, const bf16_t* A, const bf16_t* Bt, int N, int K, const F& f) {
    pg8::Gemm g{A, Bt, NTOK, N, K}; pg8::StaticOrder S; S.init(NTOK, N, (int)gridDim.x, (int)blockIdx.x); EpiF<F> E{f};
    pg8::gemm_phase<EpiF<F>, pg8::StaticOrder, true, true>(lds, g, S, E);
}
template <class F> DI void run_gemm_on(LAS unsigned char* lds, const bf16_t* A, const bf16_t* Bt, int N, int K, const F& f, int nblocks, int myblock) {
    pg8::Gemm g{A, Bt, NTOK, N, K}; pg8::StaticOrder S; S.init(NTOK, N, nblocks, myblock); EpiF<F> E{f};
    pg8::gemm_phase<EpiF<F>, pg8::StaticOrder, true, true>(lds, g, S, E);
}
template <class F> DI void run_gemm8(LAS unsigned char* lds, const unsigned char* A8, const unsigned char* Bt8, int N, int K8, const F& f) {
    pg8::Gemm g{(const bf16_t*)A8, (const bf16_t*)Bt8, NTOK, N, K8 / 2}; pg8::StaticOrder S; S.init(NTOK, N, (int)gridDim.x, (int)blockIdx.x); EpiF<F> E{f};
    pg8::gemm_phase<EpiF<F>, pg8::StaticOrder, true, true, true>(lds, g, S, E);
}
template <class F> DI void run_gemm8_on(LAS unsigned char* lds, const unsigned char* A8, const unsigned char* Bt8, int N, int K8, const F& f, int nblocks, int myblock) {
    pg8::Gemm g{(const bf16_t*)A8, (const bf16_t*)Bt8, NTOK, N, K8 / 2}; pg8::StaticOrder S; S.init(NTOK, N, nblocks, myblock); EpiF<F> E{f};
    pg8::gemm_phase<EpiF<F>, pg8::StaticOrder, true, true, true>(lds, g, S, E);
}
struct NoPre {}; struct NoTile {};
#define EPI_PLAIN typedef NoTile Tile; DI Tile tile(int) const { return Tile{}; } DI void row_end(int, float, int, int) const {}
struct F1a { bf16_t* qkv; bf16_t* pb; typedef NoPre Pre;
    DI Pre load(int, int) const { return Pre{}; }
    EPI_PLAIN
    DI float apply(int row, int col, f32x4 v0, f32x4 v1, Pre, Tile, int) const {
        const u32x4 w = pack8(v0, v1);
        if (col < QKVW) *(u32x4*)(qkv + (size_t)row * QKVW + col) = w;
        else if (col < N1A_REAL) *(u32x4*)(pb + (size_t)row * PBW + (col - QKVW)) = w;
        return 0.f;
    } };
constexpr int GL_STRIDE = 768;
DI const unsigned char* gate_ptr(const unsigned char* ws, const float* dout, int row, int gcol) {
    if (gcol < G1B_EARLY) return (const unsigned char*)dout + DO_GEARLY + (size_t)row * G1B_EARLY + gcol;
    if (gcol < G1B_EARLY + GL_STRIDE) return ws + 214 * MiB + (size_t)row * GL_STRIDE + (gcol - G1B_EARLY);
    return (const unsigned char*)dout + 64 * MiB + (size_t)row * GL_STRIDE + (gcol - G1B_EARLY - GL_STRIDE);
}
DI u32x4 gates8_to_bf16(u32x2 w) {
    const float k = 1.f / 255.f;
    return (u32x4){pk2((float)(w.x & 255u) * k, (float)((w.x >> 8) & 255u) * k), pk2((float)((w.x >> 16) & 255u) * k, (float)(w.x >> 24) * k),
                   pk2((float)(w.y & 255u) * k, (float)((w.y >> 8) & 255u) * k), pk2((float)((w.y >> 16) & 255u) * k, (float)(w.y >> 24) * k)};
}
struct F1b { unsigned char* ws; float* dout; int col0; const signed char* sc; typedef NoPre Pre; struct Tile { u32x2 e[2]; };
    DI Tile tile(int c0) const { Tile t;
#pragma unroll
        for (int bj = 0; bj < 2; ++bj) t.e[bj] = *(const u32x2*)(sc + col0 + c0 + bj * 128);
        return t; }
    DI Pre load(int, int) const { return Pre{}; }
    DI void row_end(int, float, int, int) const {}
    DI float apply(int row, int col, f32x4 v0, f32x4 v1, Pre, const Tile& tl, int bj) const {
        f32x4 a, b;
#pragma unroll
        for (int i = 0; i < 4; ++i) { a[i] = sigmoidf_(ldexpf(v0[i], (int)(signed char)(tl.e[bj].x >> (8 * i)))); b[i] = sigmoidf_(ldexpf(v1[i], (int)(signed char)(tl.e[bj].y >> (8 * i)))); }
        u32x2 w;
        w.x = (unsigned)(a[0] * 255.f + 0.5f) | ((unsigned)(a[1] * 255.f + 0.5f) << 8) | ((unsigned)(a[2] * 255.f + 0.5f) << 16) | ((unsigned)(a[3] * 255.f + 0.5f) << 24);
        w.y = (unsigned)(b[0] * 255.f + 0.5f) | ((unsigned)(b[1] * 255.f + 0.5f) << 8) | ((unsigned)(b[2] * 255.f + 0.5f) << 16) | ((unsigned)(b[3] * 255.f + 0.5f) << 24);
        *(u32x2*)const_cast<unsigned char*>(gate_ptr(ws, dout, row, col0 + col)) = w;
        return 0.f;
    } };
struct FPa { const unsigned char* ws; const float* dout; bf16_t* y; struct Pre { u32x2 g; };
    DI Pre load(int row, int col) const { return Pre{*(const u32x2*)gate_ptr(ws, dout, row, col)}; }
    EPI_PLAIN
    DI float apply(int row, int col, f32x4 v0, f32x4 v1, Pre pr, Tile, int) const {
        float g[8]; unpack8(gates8_to_bf16(pr.g), g);
        f32x4 a, b;
#pragma unroll
        for (int i = 0; i < 4; ++i) { a[i] = v0[i] * g[i]; b[i] = v1[i] * g[4 + i]; }
#if PROBE == 1
        a = (f32x4){0.f, 0.f, 0.f, 0.f}; b = a;
#endif
        *(u32x4*)(y + (size_t)row * DM + col) = pack8(a, b);
        return 0.f;
    } };
struct FPb { const unsigned char* ws; const float* dout; bf16_t* y; struct Pre { u32x2 g; u32x4 yv; };
    DI Pre load(int row, int col) const { return Pre{*(const u32x2*)gate_ptr(ws, dout, row, DM + col), *(const u32x4*)(y + (size_t)row * DM + col)}; }
    EPI_PLAIN
    DI float apply(int row, int col, f32x4 v0, f32x4 v1, Pre pr, Tile, int) const {
        float g[8]; unpack8(gates8_to_bf16(pr.g), g);
        float yo[8]; unpack8(pr.yv, yo);
        f32x4 a, b;
#pragma unroll
        for (int i = 0; i < 4; ++i) { a[i] = yo[i] + v0[i] * g[i]; b[i] = yo[4 + i] + v1[i] * g[4 + i]; }
#if PROBE == 2
#pragma unroll
        for (int i = 0; i < 4; ++i) { a[i] = yo[i]; b[i] = yo[4 + i]; }
#endif
        *(u32x4*)(y + (size_t)row * DM + col) = pack8(a, b);
        return 0.f;
    } };
struct FOut { const float* x; const float* g2; float* h1; bf16_t* xn; float* rowsq; struct Pre { f32x4 x0, x1; }; struct Tile { f32x4 g[2][2]; };
    DI Tile tile(int col0) const { Tile t;
#pragma unroll
        for (int bj = 0; bj < 2; ++bj) { t.g[bj][0] = *(const f32x4*)(g2 + col0 + bj * 128); t.g[bj][1] = *(const f32x4*)(g2 + col0 + bj * 128 + 4); }
        return t; }
    DI Pre load(int row, int col) const { const size_t o = (size_t)row * DM + col; return Pre{*(const f32x4*)(x + o), *(const f32x4*)(x + o + 4)}; }
    DI float apply(int row, int col, f32x4 v0, f32x4 v1, Pre pr, const Tile& tl, int bj) const {
        const size_t o = (size_t)row * DM + col;
        const f32x4 h0 = pr.x0 + v0, h1v = pr.x1 + v1;
        *(f32x4*)(h1 + o) = h0; *(f32x4*)(h1 + o + 4) = h1v;
        *(u32x4*)(xn + o) = pack8(h0 * tl.g[bj][0], h1v * tl.g[bj][1]);
        return (h0[0] * h0[0] + h0[1] * h0[1] + h0[2] * h0[2] + h0[3] * h0[3]) + (h1v[0] * h1v[0] + h1v[1] * h1v[1] + h1v[2] * h1v[2] + h1v[3] * h1v[3]);
    }
    DI void row_end(int row, float s, int fq, int slot) const {
        s += __shfl_xor(s, 16); s += __shfl_xor(s, 32);
        if (fq == 0) rowsq[(size_t)row * 16 + slot] = s;
    } };
DI float row_rs(const float* rowsq, int row) {
    const f32x4 a = *(const f32x4*)(rowsq + (size_t)row * 16), b = *(const f32x4*)(rowsq + (size_t)row * 16 + 4), c = *(const f32x4*)(rowsq + (size_t)row * 16 + 8), d = *(const f32x4*)(rowsq + (size_t)row * 16 + 12);
    const float s = (((a[0] + a[1]) + (a[2] + a[3])) + ((b[0] + b[1]) + (b[2] + b[3]))) + (((c[0] + c[1]) + (c[2] + c[3])) + ((d[0] + d[1]) + (d[2] + d[3])));
    return rsqrtf(s * (1.f / DM) + RMS_EPS);
}
struct FQ { bf16_t* qp; typedef NoPre Pre;
    DI Pre load(int, int) const { return Pre{}; }
    EPI_PLAIN
    DI float apply(int row, int col, f32x4 v0, f32x4 v1, Pre, Tile, int) const {
        u32x4 w = pack8(v0, v1);
#if PROBE == 3
        w.x &= 0xfff8fff8u; w.y &= 0xfff8fff8u; w.z &= 0xfff8fff8u; w.w &= 0xfff8fff8u;
#endif
        *(u32x4*)(qp + (size_t)row * 2048 + col) = w; return 0.f; } };

DI void p0_transpose_item(const float* W, int K, int N, bf16_t* WT, int k0, int n0, int dst_row0, LAS float* scr, int lane) {
#pragma unroll 8
    for (int i = 0; i < 32; ++i) { const int kk = 2 * i + (lane >> 5); scr[kk * 33 + (lane & 31)] = W[(size_t)(k0 + kk) * N + n0 + (lane & 31)]; }
    LDS_WAIT(); asm volatile("" ::: "memory");
    const int c = lane & 7;
#pragma unroll
    for (int j = 0; j < 4; ++j) { const int n = (lane >> 3) + 8 * j; const LAS float* s = scr + (8 * c) * 33 + n;
        u32x4 o; o.x = pk2(s[0 * 33], s[1 * 33]); o.y = pk2(s[2 * 33], s[3 * 33]); o.z = pk2(s[4 * 33], s[5 * 33]); o.w = pk2(s[6 * 33], s[7 * 33]);
        *(u32x4*)(WT + (size_t)(dst_row0 + n) * K + k0 + 8 * c) = o; }
    LDS_WAIT(); asm volatile("" ::: "memory");
}
template <int NR> DI void rms_rows_to_bf16(const float* x, const float* g, bf16_t* o, int m0, int stride, int lane) {
    f32x4 v[NR][4];
#pragma unroll
    for (int r = 0; r < NR; ++r)
#pragma unroll
        for (int j = 0; j < 4; ++j) v[r][j] = *(const f32x4*)(x + (size_t)(m0 + r * stride) * DM + 4 * lane + 256 * j);
    f32x4 gg[4];
#pragma unroll
    for (int j = 0; j < 4; ++j) gg[j] = *(const f32x4*)(g + 4 * lane + 256 * j);
#pragma unroll
    for (int r = 0; r < NR; ++r) {
        float s = 0.f;
#pragma unroll
        for (int j = 0; j < 4; ++j) s += (v[r][j].x * v[r][j].x + v[r][j].y * v[r][j].y) + (v[r][j].z * v[r][j].z + v[r][j].w * v[r][j].w);
        const float rs = rsqrtf(wave_sum(s) * (1.f / DM) + RMS_EPS);
        bf16_t* orow = o + (size_t)(m0 + r * stride) * DM;
#pragma unroll
        for (int j = 0; j < 4; ++j) { u32x2 w; w.x = pk2(v[r][j].x * rs * gg[j].x, v[r][j].y * rs * gg[j].y); w.y = pk2(v[r][j].z * rs * gg[j].z, v[r][j].w * rs * gg[j].w);
            *(u32x2*)(orow + 4 * lane + 256 * j) = w; }
    }
}
DI void rms_all_rows(const float* x, const float* g, bf16_t* o, int lane, int wid) {
    const int gw = blockIdx.x * NWAVES + wid, NGW = gridDim.x * NWAVES;
    int m = gw;
    for (; m + 3 * NGW < NTOK; m += 4 * NGW) rms_rows_to_bf16<4>(x, g, o, m, NGW, lane);
    for (; m < NTOK; m += NGW) rms_rows_to_bf16<1>(x, g, o, m, NGW, lane);
}
DI void phase_prep(const Params& p, LAS unsigned char* lds, int tid, int lane, int wid) {
    unsigned char* ws = p.ws;
    bf16_t* W1T = (bf16_t*)(ws + WS_W1T);
    LAS float* scr = (LAS float*)(lds + wid * 16384);
    const int gw = blockIdx.x * NWAVES + wid, NGW = gridDim.x * NWAVES;
    constexpr int I_IN = 16 * 169, I_PA = 8 * 32, I_PB = 8 * 32, I_O = 16 * 32, I_Q = 16 * 64;
    constexpr int NITEMS = I_IN + I_PA + I_PB + I_O + I_Q;
    for (int it = gw; it < NITEMS; it += NGW) {
        int r = it;
        if (r < I_IN) { const int kb = r / 169, nb = r % 169, n0 = 32 * nb; const int dst = n0 < N1A_REAL ? n0 : n0 + (N1A - N1A_REAL);
            p0_transpose_item(p.w_in, 1024, 5408, W1T, 64 * kb, n0, dst, scr, lane); continue; } r -= I_IN;
        if (r < I_PA) { const int kb = r / 32, nb = r % 32; p0_transpose_item(p.w_proj_a, 512, 1024, (bf16_t*)(ws + WS_WPA), 64 * kb, 32 * nb, 32 * nb, scr, lane); continue; } r -= I_PA;
        if (r < I_PB) { const int kb = r / 32, nb = r % 32; p0_transpose_item(p.w_proj_b, 512, 1024, (bf16_t*)(ws + WS_WPB), 64 * kb, 32 * nb, 32 * nb, scr, lane); continue; } r -= I_PB;
        if (r < I_O) { const int kb = r / 32, nb = r % 32; p0_transpose_item(p.w_out, 1024, 1024, (bf16_t*)(ws + WS_WO), 64 * kb, 32 * nb, 32 * nb, scr, lane); continue; } r -= I_O;
        { const int kb = r / 64, nb = r % 64; p0_transpose_item(p.peer_wq, 1024, 2048, (bf16_t*)(ws + WS_WQ), 64 * kb, 32 * nb, 32 * nb, scr, lane); }
    }
    const int gt = blockIdx.x * NTHREADS + tid, NGT = gridDim.x * NTHREADS;
    { u32x4* z = (u32x4*)(W1T + (size_t)N1A_REAL * 1024); const u32x4 zero = {0u, 0u, 0u, 0u};
      for (int i = gt; i < (N1A - N1A_REAL) * 1024 / 8; i += NGT) z[i] = zero; }
    { bf16_t* SK = (bf16_t*)(ws + WS_SK);
      for (int i = gt; i < 16 * 128 * 128 / 8; i += NGT) { const f32x4 a = *(const f32x4*)(p.peer_subkeys + (size_t)i * 8), b = *(const f32x4*)(p.peer_subkeys + (size_t)i * 8 + 4);
          *(u32x4*)(SK + (size_t)i * 8) = pack8(a, b); } }
    { bf16_t* LWT = (bf16_t*)(ws + WS_LWT);
      for (int e = gt; e < 512 * 288; e += NGT) { const int c = e / 288, i = e - c * 288;
          const float v = i < 64 ? p.w_lora_up[i * 512 + c] : (i < 128 ? p.a_lora_up[(i - 64) * 512 + c] : p.g_lora_up[(i - 128) * 512 + c]);
          LWT[e] = f2bf(v); } }
    rms_all_rows(p.x, p.norm1_g, (bf16_t*)(ws + WS_XN), lane, wid);
}

DI void phase_wg8(const Params& p, int lane, int wid) {
    const bf16_t* WG = (const bf16_t*)(p.ws + WS_W1T) + (size_t)N1A * 1024;
    for (int n = blockIdx.x * NWAVES + wid; n < NGATE; n += gridDim.x * NWAVES) {
        const u32x4 w0 = *(const u32x4*)(WG + (size_t)n * 1024 + lane * 16), w1 = *(const u32x4*)(WG + (size_t)n * 1024 + lane * 16 + 8);
        float f[16]; { float t[8]; unpack8(w0, t);
#pragma unroll
            for (int i = 0; i < 8; ++i) f[i] = t[i];
            unpack8(w1, t);
#pragma unroll
            for (int i = 0; i < 8; ++i) f[8 + i] = t[i]; }
        float am = 0.f;
#pragma unroll
        for (int i = 0; i < 16; ++i) am = fmaxf(am, fabsf(f[i]));
#pragma unroll
        for (int o = 1; o < 64; o <<= 1) am = fmaxf(am, __shfl_xor(am, o));
        const int ke = (int)floorf(log2f(224.f / fmaxf(am, 1e-30f)));
        const float s = ldexpf(1.f, ke);
        u32x4 o8;
#pragma unroll
        for (int j = 0; j < 4; ++j) { int w = __builtin_amdgcn_cvt_pk_fp8_f32(f[4 * j] * s, f[4 * j + 1] * s, 0, false); w = __builtin_amdgcn_cvt_pk_fp8_f32(f[4 * j + 2] * s, f[4 * j + 3] * s, w, true); o8[j] = (unsigned)w; }
        *(u32x4*)(p.ws + WS_WG8 + (size_t)n * 1024 + lane * 16) = o8;
        if (lane == 0) ((signed char*)(p.ws + WS_WG8SC))[n] = (signed char)(-4 - ke);
    }
}
DI void xn8_convert(const Params& p, int lane, int gw, int NGW) {
    const bf16_t* XN = (const bf16_t*)(p.ws + WS_XN);
    unsigned char* X8 = (unsigned char*)p.out + DO_XN8;
    for (int r = gw; r < NTOK; r += NGW) {
        const u32x4 w0 = *(const u32x4*)(XN + (size_t)r * 1024 + lane * 16), w1 = *(const u32x4*)(XN + (size_t)r * 1024 + lane * 16 + 8);
        float f[16]; { float t[8]; unpack8(w0, t);
#pragma unroll
            for (int i = 0; i < 8; ++i) f[i] = t[i] * 16.f;
            unpack8(w1, t);
#pragma unroll
            for (int i = 0; i < 8; ++i) f[8 + i] = t[i] * 16.f; }
        u32x4 o8;
#pragma unroll
        for (int j = 0; j < 4; ++j) { int w = __builtin_amdgcn_cvt_pk_fp8_f32(f[4 * j], f[4 * j + 1], 0, false); w = __builtin_amdgcn_cvt_pk_fp8_f32(f[4 * j + 2], f[4 * j + 3], w, true); o8[j] = (unsigned)w; }
        *(u32x4*)(X8 + (size_t)r * 1024 + lane * 16) = o8;
    }
}
DI void phase_kbar_vt(const Params& p, LAS unsigned char* lds, int tid, int lane, int wid) {
    unsigned char* ws = p.ws;
    const bf16_t* QKV = (const bf16_t*)(ws + WS_QKV);
    float* KBAR = (float*)(ws + WS_KBAR);
    const int gw = blockIdx.x * NWAVES + wid, NGW = gridDim.x * NWAVES;
    for (int it = gw; it < NB * NH * 16; it += NGW) {
        const int blk = it & 15, h = (it >> 4) & 7, b = it >> 7;
        const int dp = lane & 31, tp = lane >> 5;
        const bf16_t* base = QKV + ((size_t)(b * SEQ + blk * 256)) * QKVW + 512 + h * 64 + 2 * dp;
        float a0 = 0.f, a1 = 0.f;
#pragma unroll 16
        for (int t = tp; t < 256; t += 2) { const unsigned u = *(const unsigned*)(base + (size_t)t * QKVW); a0 += bflo(u); a1 += bfhi(u); }
        a0 += __shfl_xor(a0, 32); a1 += __shfl_xor(a1, 32);
        if (tp == 0) { KBAR[(size_t)it * 64 + 2 * dp] = a0 * (1.f / 256.f); KBAR[(size_t)it * 64 + 2 * dp + 1] = a1 * (1.f / 256.f); }
    }
    LAS bf16_t* tile = (LAS bf16_t*)(lds + wid * 16384);
    unsigned char* KF = (unsigned char*)p.out + DO_KF; unsigned char* VF = (unsigned char*)p.out + DO_VT;
    const int r32 = lane & 31, hi = lane >> 5;
    for (int it = gw; it < NB * NH * 64; it += NGW) {
        const int st = it & 63, bh = it >> 6, b = bh >> 3, h = bh & 7;
        const bf16_t* krow = QKV + ((size_t)(b * SEQ + st * 64 + r32)) * QKVW + 512 + h * 64 + 8 * hi;
        unsigned char* kdst = KF + ((size_t)it * 8) * 1024 + lane * 16;
#pragma unroll
        for (int f = 0; f < 8; ++f) *(u32x4*)(kdst + f * 1024) = *(const u32x4*)(krow + (size_t)(32 * (f & 1)) * QKVW + 16 * (f >> 1));
        const bf16_t* src = QKV + ((size_t)(b * SEQ + st * 64 + lane)) * QKVW + 1024 + h * 64;
#pragma unroll
        for (int c = 0; c < 8; ++c) *(LAS u32x4*)(tile + lane * 72 + c * 8) = *(const u32x4*)(src + c * 8);
        LDS_WAIT(); asm volatile("" ::: "memory");
        unsigned char* vdst = VF + ((size_t)it * 8) * 1024 + lane * 16;
#pragma unroll
        for (int f = 0; f < 8; ++f) {
            const int dt = f >> 2, sx = f & 3, d = 32 * dt + r32, k0 = 16 * sx + 4 * hi;
            u32x4 w;
            w.x = (unsigned)tile[(k0 + 0) * 72 + d] | ((unsigned)tile[(k0 + 1) * 72 + d] << 16);
            w.y = (unsigned)tile[(k0 + 2) * 72 + d] | ((unsigned)tile[(k0 + 3) * 72 + d] << 16);
            w.z = (unsigned)tile[(k0 + 8) * 72 + d] | ((unsigned)tile[(k0 + 9) * 72 + d] << 16);
            w.w = (unsigned)tile[(k0 + 10) * 72 + d] | ((unsigned)tile[(k0 + 11) * 72 + d] << 16);
            *(u32x4*)(vdst + f * 1024) = w;
        }
        LDS_WAIT(); asm volatile("" ::: "memory");
    }
}

DI float softplusf_(float x) { return fmaxf(x, 0.f) + log1pf(__expf(-fabsf(x))); }
DI void phase_rwkv_prep(const Params& p, LAS unsigned char* lds, int tid, int lane, int wid) {
    unsigned char* ws = p.ws;
    const bf16_t* PB = (const bf16_t*)(ws + WS_PB);
    bf16_t* SCAN = (bf16_t*)(ws + WS_SCAN);
    bf16_t* RG = (bf16_t*)((unsigned char*)p.out + DO_RG);
    LAS float* xs = (LAS float*)lds;
    const int c = tid, h = wid, j = lane;
    const float mu_r = p.rwkv_mu[c], mu_k = p.rwkv_mu[512 + c], mu_v = p.rwkv_mu[1024 + c];
    const float w0c = p.w0[c], a0c = p.a0[c], kkc = p.k_k[c], kac = p.k_a[c];
    for (int tt = blockIdx.x; tt < NTOK / 32; tt += gridDim.x) {
        const int t0 = tt * 32;
        __syncthreads();
        for (int e = tid; e < 32 * 288; e += NTHREADS) {
            const int t = e / 288, i = e - t * 288, tok = t0 + t, col = 1536 + i;
            const float cur = bf2f(PB[(size_t)tok * PBW + col]);
            const float prv = (tok & (SEQ - 1)) ? bf2f(PB[(size_t)(tok - 1) * PBW + col]) : 0.f;
            float v = cur + p.rwkv_mu[col] * (prv - cur);
            if (i < 64) v = tanhf(v); else if (i >= 128) v = sigmoidf_(v);
            xs[i * 36 + t] = v;
        }
        __syncthreads();
        float wl[32], al[32], gl[32];
#pragma unroll
        for (int t = 0; t < 32; ++t) { wl[t] = 0.f; al[t] = 0.f; gl[t] = 0.f; }
        for (int i = 0; i < 64; ++i) {
            const float ww = p.w_lora_up[i * 512 + c], wa = p.a_lora_up[i * 512 + c];
#pragma unroll
            for (int t4 = 0; t4 < 8; ++t4) { const f32x4 xw = *(const LAS f32x4*)(xs + i * 36 + 4 * t4), xa = *(const LAS f32x4*)(xs + (64 + i) * 36 + 4 * t4);
#pragma unroll
                for (int q = 0; q < 4; ++q) { wl[4 * t4 + q] += ww * xw[q]; al[4 * t4 + q] += wa * xa[q]; } }
        }
        for (int i = 0; i < 160; ++i) {
            const float wg = p.g_lora_up[i * 512 + c];
#pragma unroll
            for (int t4 = 0; t4 < 8; ++t4) { const f32x4 xg = *(const LAS f32x4*)(xs + (128 + i) * 36 + 4 * t4);
#pragma unroll
                for (int q = 0; q < 4; ++q) gl[4 * t4 + q] += wg * xg[q]; }
        }
#pragma unroll
        for (int t = 0; t < 32; ++t) {
            const int tok = t0 + t, b = tok >> 12, s = tok & (SEQ - 1);
            const bf16_t* row = PB + (size_t)tok * PBW;
            float r = bf2f(row[c]), k = bf2f(row[512 + c]), v = bf2f(row[1024 + c]);
            float rp = 0.f, kp = 0.f, vp = 0.f;
            if (s) { const bf16_t* prow = row - PBW; rp = bf2f(prow[c]); kp = bf2f(prow[512 + c]); vp = bf2f(prow[1024 + c]); }
            r += mu_r * (rp - r); k += mu_k * (kp - k); v += mu_v * (vp - v);
            const float wv = w0c + wl[t];
            const float w = -softplusf_(-wv) - 0.5f;
            const float ew = __expf(w);
            const float omd = -expm1f(-ew);
            const float a = sigmoidf_(a0c + al[t]);
            const float kkv = k * kkc;
            const float nrm = sqrtf(wave_sum(kkv * kkv));
            const float kkn = kkv / fmaxf(nrm, 1e-12f);
            const float kmod = k * (1.f + (a - 1.f) * kac);
            const float bb = kkn * a;
            bf16_t* so = SCAN + ((size_t)((b * NH + h) * SEQ + s)) * 384 + j;
            so[0] = f2bf(omd); so[64] = f2bf(kkn); so[128] = f2bf(bb); so[192] = f2bf(kmod); so[256] = f2bf(r); so[320] = f2bf(v);
            RG[(size_t)tok * 512 + c] = f2bf(gl[t]);
        }
    }
}


DI float fast_tanh(float x) { const float e = __expf(2.f * x); return 1.f - 2.f / (e + 1.f); }
constexpr int RP_ACT = 0, RP_CONST = 19456, RP_TILE = 33792, RP_PITCH = 3080;
template <bool STORE> DI void phase_rwkv_prep2(const Params& p, LAS unsigned char* lds, int tid, int lane, int wid) {
    unsigned char* ws = p.ws;
    const bf16_t* PB = (const bf16_t*)(ws + WS_PB);
    const bf16_t* LWT = (const bf16_t*)(ws + WS_LWT);
    bf16_t* SCAN = (bf16_t*)(ws + WS_SCAN);
    bf16_t* RG = (bf16_t*)((unsigned char*)p.out + DO_RG);
    LAS bf16_t* act = (LAS bf16_t*)(lds + RP_ACT);
    LAS float* cst = (LAS float*)(lds + RP_CONST);
    LAS unsigned char* tile = lds + RP_TILE;
    const int r32 = lane & 31, hi = lane >> 5, h = wid;
    __syncthreads();
    cst[tid] = p.rwkv_mu[tid]; cst[512 + tid] = p.rwkv_mu[512 + tid]; cst[1024 + tid] = p.rwkv_mu[1024 + tid];
    cst[1536 + tid] = p.w0[tid]; cst[2048 + tid] = p.a0[tid]; cst[2560 + tid] = p.k_k[tid]; cst[3072 + tid] = p.k_a[tid];
    for (int tt = blockIdx.x; tt < NTOK / 32; tt += gridDim.x) {
        const int t0 = tt * 32;
        const bool first = (t0 & (SEQ - 1)) == 0;
        __syncthreads();
        u32x4 tw[13];
#pragma unroll
        for (int k = 0; k < 13; ++k) { const int e = tid + NTHREADS * k, row = e / 192, pc = e - row * 192;
            tw[k] = (u32x4){0u, 0u, 0u, 0u};
            if (e < 33 * 192 && !(first && row == 0)) tw[k] = *(const u32x4*)(PB + (size_t)(t0 - 1 + row) * PBW + pc * 8); }
#pragma unroll 3
        for (int e = tid; e < 32 * 144; e += NTHREADS) {
            const int t = e / 144, ip = e - t * 144, i = 2 * ip, tok = t0 + t, col = 1536 + i;
            const unsigned cu = *(const unsigned*)(PB + (size_t)tok * PBW + col);
            const unsigned pu = (tok & (SEQ - 1)) ? *(const unsigned*)(PB + (size_t)(tok - 1) * PBW + col) : 0u;
            const f32x2 mu = *(const f32x2*)(p.rwkv_mu + col);
            float v0 = bflo(cu), v1 = bfhi(cu);
            v0 += mu.x * (bflo(pu) - v0); v1 += mu.y * (bfhi(pu) - v1);
            if (i < 64) { v0 = fast_tanh(v0); v1 = fast_tanh(v1); } else if (i >= 128) { v0 = sigmoidf_(v0); v1 = sigmoidf_(v1); }
            *(LAS unsigned*)(act + t * 296 + i) = pk2(v0, v1);
        }
#pragma unroll
        for (int k = 0; k < 13; ++k) { const int e = tid + NTHREADS * k, row = e / 192, pc = e - row * 192;
            if (e < 33 * 192) { LAS unsigned char* d = tile + row * RP_PITCH + pc * 16;
                *(LAS u32x2*)d = (u32x2){tw[k].x, tw[k].y}; *(LAS u32x2*)(d + 8) = (u32x2){tw[k].z, tw[k].w}; } }
        __syncthreads();
        f32x16 Xw[2], Xa[2], Xg[2];
        const int prow_ch = 16 * ((r32 >> 2) & 1) + 4 * (r32 >> 3) + (r32 & 3);
#pragma unroll
        for (int ct = 0; ct < 2; ++ct) {
#pragma unroll
            for (int i = 0; i < 16; ++i) { Xw[ct][i] = 0.f; Xa[ct][i] = 0.f; Xg[ct][i] = 0.f; }
            const bf16_t* wrow = LWT + (size_t)(h * 64 + 32 * ct + prow_ch) * 288 + 8 * hi;
            const LAS bf16_t* arow = act + r32 * 296 + 8 * hi;
#pragma unroll
            for (int ks = 0; ks < 18; ++ks) {
                const bf16x8 a = *(const bf16x8*)(wrow + 16 * ks);
                const bf16x8 b = *(const LAS bf16x8*)(arow + 16 * ks);
                if (ks < 4) Xw[ct] = MFMA32(a, b, Xw[ct]); else if (ks < 8) Xa[ct] = MFMA32(a, b, Xa[ct]); else Xg[ct] = MFMA32(a, b, Xg[ct]);
            }
        }
        const int tok = t0 + r32, bb_ = tok >> 12, s = tok & (SEQ - 1);
        if (STORE) {
#pragma unroll
            for (int ct = 0; ct < 2; ++ct) { bf16_t* rgp = RG + (size_t)tok * 512 + h * 64 + 32 * ct + 16 * hi;
                *(u32x4*)rgp = (u32x4){pk2(Xg[ct][0], Xg[ct][1]), pk2(Xg[ct][2], Xg[ct][3]), pk2(Xg[ct][4], Xg[ct][5]), pk2(Xg[ct][6], Xg[ct][7])};
                *(u32x4*)(rgp + 8) = (u32x4){pk2(Xg[ct][8], Xg[ct][9]), pk2(Xg[ct][10], Xg[ct][11]), pk2(Xg[ct][12], Xg[ct][13]), pk2(Xg[ct][14], Xg[ct][15])}; }
        }
        const LAS unsigned char* prow = tile + r32 * RP_PITCH;
        bf16_t* so = SCAN + ((size_t)((bb_ * NH + h) * SEQ + s)) * 384;
        unsigned kka[32]; float ss = 0.f;
#pragma unroll
        for (int ct = 0; ct < 2; ++ct) {
            const int j0 = 32 * ct + 16 * hi, c0 = h * 64 + j0;
#pragma unroll
            for (int gp = 0; gp < 2; ++gp) {
            unsigned om[4], km[4], rr[4], vv[4];
#pragma unroll
            for (int gq = 0; gq < 2; ++gq) {
                const int g = 2 * gp + gq;
                const int cg = c0 + 4 * g;
                const u32x2 rp = *(const LAS u32x2*)(prow + cg * 2), kp = *(const LAS u32x2*)(prow + 1024 + cg * 2), vp = *(const LAS u32x2*)(prow + 2048 + cg * 2);
                const u32x2 rc = *(const LAS u32x2*)(prow + RP_PITCH + cg * 2), kc = *(const LAS u32x2*)(prow + RP_PITCH + 1024 + cg * 2), vc = *(const LAS u32x2*)(prow + RP_PITCH + 2048 + cg * 2);
                const f32x4 mur = *(const LAS f32x4*)(cst + cg), muk = *(const LAS f32x4*)(cst + 512 + cg), muv = *(const LAS f32x4*)(cst + 1024 + cg);
                const f32x4 w0v = *(const LAS f32x4*)(cst + 1536 + cg), a0v = *(const LAS f32x4*)(cst + 2048 + cg), kkc = *(const LAS f32x4*)(cst + 2560 + cg), kac = *(const LAS f32x4*)(cst + 3072 + cg);
                const float rcf[4] = {bflo(rc.x), bfhi(rc.x), bflo(rc.y), bfhi(rc.y)}, rpf[4] = {bflo(rp.x), bfhi(rp.x), bflo(rp.y), bfhi(rp.y)};
                const float kcf[4] = {bflo(kc.x), bfhi(kc.x), bflo(kc.y), bfhi(kc.y)}, kpf[4] = {bflo(kp.x), bfhi(kp.x), bflo(kp.y), bfhi(kp.y)};
                const float vcf[4] = {bflo(vc.x), bfhi(vc.x), bflo(vc.y), bfhi(vc.y)}, vpf[4] = {bflo(vp.x), bfhi(vp.x), bflo(vp.y), bfhi(vp.y)};
                float r4[4], k4[4], v4[4], o4[4], m4[4];
#pragma unroll
                for (int q = 0; q < 4; ++q) {
                    const int ri = 4 * g + q;
                    r4[q] = rcf[q] + mur[q] * (rpf[q] - rcf[q]);
                    k4[q] = kcf[q] + muk[q] * (kpf[q] - kcf[q]);
                    v4[q] = vcf[q] + muv[q] * (vpf[q] - vcf[q]);
                    const float wv = w0v[q] + Xw[ct][ri];
                    const float z = -wv;
                    const float sp = fmaxf(z, 0.f) + __logf(1.f + __expf(-fabsf(z)));
                    const float ew = __expf(-sp - 0.5f);
                    o4[q] = 1.f - __expf(-ew);
                    const float a = __builtin_amdgcn_rcpf(1.f + __expf(-(a0v[q] + Xa[ct][ri])));
                    m4[q] = k4[q] * (1.f + (a - 1.f) * kac[q]);
                    const float kv = k4[q] * kkc[q];
                    kka[16 * ct + ri] = pk2(kv, a); ss += kv * kv;
                }
                om[2 * gq] = pk2(o4[0], o4[1]); om[2 * gq + 1] = pk2(o4[2], o4[3]);
                km[2 * gq] = pk2(m4[0], m4[1]); km[2 * gq + 1] = pk2(m4[2], m4[3]);
                rr[2 * gq] = pk2(r4[0], r4[1]); rr[2 * gq + 1] = pk2(r4[2], r4[3]);
                vv[2 * gq] = pk2(v4[0], v4[1]); vv[2 * gq + 1] = pk2(v4[2], v4[3]);
            }
            if (STORE) {
                const int j8 = j0 + 8 * gp;
                *(u32x4*)(so + 0 * 64 + j8) = (u32x4){om[0], om[1], om[2], om[3]};
                *(u32x4*)(so + 3 * 64 + j8) = (u32x4){km[0], km[1], km[2], km[3]};
                *(u32x4*)(so + 4 * 64 + j8) = (u32x4){rr[0], rr[1], rr[2], rr[3]};
                *(u32x4*)(so + 5 * 64 + j8) = (u32x4){vv[0], vv[1], vv[2], vv[3]};
            }
            }
        }
        ss += __shfl_xor(ss, 32);
        const float inv = 1.f / fmaxf(sqrtf(ss), 1e-12f);
#pragma unroll
        for (int ct = 0; ct < 2; ++ct) {
            const int j0 = 32 * ct + 16 * hi;
            unsigned kn[8], bq[8];
#pragma unroll
            for (int i = 0; i < 8; ++i) {
                const unsigned u0 = kka[16 * ct + 2 * i], u1 = kka[16 * ct + 2 * i + 1];
                const float k0 = bflo(u0) * inv, k1 = bflo(u1) * inv;
                kn[i] = pk2(k0, k1); bq[i] = pk2(k0 * bfhi(u0), k1 * bfhi(u1));
            }
            if (STORE) {
                *(u32x4*)(so + 1 * 64 + j0) = (u32x4){kn[0], kn[1], kn[2], kn[3]}; *(u32x4*)(so + 1 * 64 + j0 + 8) = (u32x4){kn[4], kn[5], kn[6], kn[7]};
                *(u32x4*)(so + 2 * 64 + j0) = (u32x4){bq[0], bq[1], bq[2], bq[3]}; *(u32x4*)(so + 2 * 64 + j0 + 8) = (u32x4){bq[4], bq[5], bq[6], bq[7]};
            }
        }
    }
}

DI void phase_select(const Params& p, int tid) {
    unsigned char* ws = p.ws;
    const bf16_t* QKV = (const bf16_t*)(ws + WS_QKV);
    const float* KBAR = (const float*)(ws + WS_KBAR);
    unsigned short* SEL = (unsigned short*)(ws + WS_SEL);
    const int gt = blockIdx.x * NTHREADS + tid, NGT = gridDim.x * NTHREADS;
    for (int it = gt; it < NB * NH * SEQ; it += NGT) {
        const int s = it & (SEQ - 1), bh = it >> 12, b = bh >> 3, h = bh & 7, blk = s >> 8;
        unsigned mask = 0u;
        if (blk > 0) {
            float q[64];
            const bf16_t* qp = QKV + ((size_t)(b * SEQ + s)) * QKVW + h * 64;
#pragma unroll
            for (int c = 0; c < 8; ++c) { const u32x4 w = *(const u32x4*)(qp + c * 8); float f[8]; unpack8(w, f);
#pragma unroll
                for (int i = 0; i < 8; ++i) q[c * 8 + i] = f[i]; }
            float v1 = -INFINITY, v2 = -INFINITY, v3 = -INFINITY; int i1 = -1, i2 = -1, i3 = -1;
            for (int jb = 0; jb < blk; ++jb) {
                const float* kb = KBAR + ((size_t)(bh * 16 + jb)) * 64;
                float g = 0.f;
#pragma unroll
                for (int d = 0; d < 64; d += 4) { const f32x4 kk = *(const f32x4*)(kb + d); g += q[d] * kk.x + q[d + 1] * kk.y + q[d + 2] * kk.z + q[d + 3] * kk.w; }
                if (g > v1) { v3 = v2; i3 = i2; v2 = v1; i2 = i1; v1 = g; i1 = jb; }
                else if (g > v2) { v3 = v2; i3 = i2; v2 = g; i2 = jb; }
                else if (g > v3) { v3 = g; i3 = jb; }
            }
            if (i1 >= 0) mask |= 1u << i1;
            if (i2 >= 0) mask |= 1u << i2;
            if (i3 >= 0) mask |= 1u << i3;
        }
        SEL[it] = (unsigned short)mask;
    }
}

constexpr int CK = 32, NCHUNK = SEQ / CK, ITEM_BYTES = 24576;
constexpr int IT_G1 = 0, IT_H1 = 4096, IT_QT = 12288, IT_OV = 20480;
DI unsigned char* chk_base(const Params& p, int chain) {
    const int q = chain >> 4;
    unsigned char* base = q == 0 ? p.ws + 86 * MiB : (q == 1 ? p.ws + 134 * MiB : (q == 2 ? p.ws + 214 * MiB : (unsigned char*)p.out + 64 * MiB));
    return base + (size_t)(chain & 15) * NCHUNK * ITEM_BYTES;
}
DI bf16x8 pack_acc(const f32x16& x, int s) {
    u32x4 w; w.x = pk2(x[8 * s], x[8 * s + 1]); w.y = pk2(x[8 * s + 2], x[8 * s + 3]); w.z = pk2(x[8 * s + 4], x[8 * s + 5]); w.w = pk2(x[8 * s + 6], x[8 * s + 7]);
    return __builtin_bit_cast(bf16x8, w);
}
DI void store_acc_bf16(unsigned char* dst, const f32x16& x) {
    u32x4 a, b; a.x = pk2(x[0], x[1]); a.y = pk2(x[2], x[3]); a.z = pk2(x[4], x[5]); a.w = pk2(x[6], x[7]);
    b.x = pk2(x[8], x[9]); b.y = pk2(x[10], x[11]); b.z = pk2(x[12], x[13]); b.w = pk2(x[14], x[15]);
    *(u32x4*)dst = a; *(u32x4*)(dst + 16) = b;
}
template <int T> DI void subst_step2(float (&x1)[32], float (&x2)[32], const float y1T, const LAS unsigned char* wl, const LAS unsigned char* y2row) {
    float p0 = y1T, p1 = 0.f, p2 = 0.f, p3 = 0.f, q0, q1 = 0.f, q2 = 0.f, q3 = 0.f;
    unsigned z = 0u;
    if (T > 0) asm("v_and_b32 %0, 0, %1" : "=v"(z) : "v"(__float_as_uint(x1[T > 0 ? T - 1 : 0]) | __float_as_uint(x2[T > 0 ? T - 1 : 0])));
    q0 = *(const LAS float*)(y2row + T * 4 + z);
    if (T > 0) {
        const LAS unsigned char* rowp = wl + T * 768 + z;
#pragma unroll
        for (int s4 = 0; s4 < (T + 3) / 4; ++s4) {
            const f32x4 mm = *(const LAS f32x4*)(rowp + s4 * 16);
            if (4 * s4 + 0 < T) { p0 -= x1[4 * s4 + 0] * mm.x; q0 -= x2[4 * s4 + 0] * mm.x; }
            if (4 * s4 + 1 < T) { p1 -= x1[(4 * s4 + 1) & 31] * mm.y; q1 -= x2[(4 * s4 + 1) & 31] * mm.y; }
            if (4 * s4 + 2 < T) { p2 -= x1[(4 * s4 + 2) & 31] * mm.z; q2 -= x2[(4 * s4 + 2) & 31] * mm.z; }
            if (4 * s4 + 3 < T) { p3 -= x1[(4 * s4 + 3) & 31] * mm.w; q3 -= x2[(4 * s4 + 3) & 31] * mm.w; }
        }
    }
    x1[T] = (p0 + p1) + (p2 + p3); x2[T] = (q0 + q1) + (q2 + q3);
}
template <int... Ts> DI void subst_all2(float (&x1)[32], float (&x2)[32], const float (&y1)[32], const LAS unsigned char* wl, const LAS unsigned char* y2row, std::integer_sequence<int, Ts...>) {
    (subst_step2<Ts>(x1, x2, y1[Ts], wl, y2row), ...);
}
#ifndef CPSTAGE
#define CPSTAGE 4
#endif
DI void unpack_acc_bf16(const LAS unsigned char* src, f32x16& x) {
    const u32x4 a = *(const LAS u32x4*)src, b = *(const LAS u32x4*)(src + 16);
    x[0] = bflo(a.x); x[1] = bfhi(a.x); x[2] = bflo(a.y); x[3] = bfhi(a.y); x[4] = bflo(a.z); x[5] = bfhi(a.z); x[6] = bflo(a.w); x[7] = bfhi(a.w);
    x[8] = bflo(b.x); x[9] = bfhi(b.x); x[10] = bflo(b.y); x[11] = bfhi(b.y); x[12] = bflo(b.z); x[13] = bfhi(b.z); x[14] = bflo(b.w); x[15] = bfhi(b.w);
}
constexpr int CPW = 36864;
constexpr int CP_BT = 24576, CP_KT = 28672, CP_VT = 32768;
template <int STG> DI void phase_chunkprep(const Params& p, LAS unsigned char* lds, int lane, int wid) {
    if (wid >= 4) return;
    unsigned char* ws = p.ws;
    const bf16_t* SCAN = (const bf16_t*)(ws + WS_SCAN);
    LAS unsigned char* wl = lds + wid * CPW;
    const int r32 = lane & 31, hi = lane >> 5, j = lane;
    for (int item = blockIdx.x * 4 + wid; item < 64 * NCHUNK; item += gridDim.x * 4) {
        const int chain = item >> 7, c = item & (NCHUNK - 1);
        const unsigned char* src = (const unsigned char*)(SCAN + ((size_t)chain * SEQ + (size_t)c * CK) * 384);
        unsigned char* dst = chk_base(p, chain) + (size_t)c * ITEM_BYTES;
        unsigned char* dl16 = dst + lane * 16; unsigned char* dl32 = dst + lane * 32;
        {
            u32x4 w[24];
#pragma unroll
            for (int k = 0; k < 24; ++k) w[k] = *(const u32x4*)(src + (size_t)(k * 64 + lane) * 16);
#pragma unroll
            for (int k = 0; k < 24; ++k) *(LAS u32x4*)(wl + (k * 64 + lane) * 16) = w[k];
        }
        LDS_WAIT(); asm volatile("" ::: "memory");
        float al[32]; float g = 1.f;
        {
            unsigned bt[16], kt[16], vt[16];
#pragma unroll
            for (int t = 0; t < 32; ++t) {
                LAS bf16_t* row = (LAS bf16_t*)(wl + t * 768);
                const float omd = bf2f(row[j]), kkv = bf2f(row[64 + j]), bv = bf2f(row[128 + j]), kmv = bf2f(row[192 + j]), rv = bf2f(row[256 + j]);
                const unsigned vraw = row[320 + j];
                const float gprev = g; g = g * (1.f - omd);
                const float ig = __builtin_amdgcn_rcpf(g);
                const float a_ = gprev * kkv, be = bv * ig, ka = kmv * ig, rh = g * rv;
                al[t] = a_;
                const unsigned beb = f2bf(be), kab = f2bf(ka);
                row[64 + j] = f2bf(a_); row[128 + j] = (bf16_t)beb; row[192 + j] = (bf16_t)kab; row[256 + j] = f2bf(rh);
                if (t & 1) { bt[t >> 1] |= beb << 16; kt[t >> 1] |= kab << 16; vt[t >> 1] |= vraw << 16; }
                else { bt[t >> 1] = beb; kt[t >> 1] = kab; vt[t >> 1] = vraw; }
                if ((t & 3) == 3) asm volatile("" ::: "memory");
            }
#pragma unroll
            for (int q = 0; q < 4; ++q) {
                *(LAS u32x4*)(wl + CP_BT + j * 64 + q * 16) = (u32x4){bt[4 * q], bt[4 * q + 1], bt[4 * q + 2], bt[4 * q + 3]};
                *(LAS u32x4*)(wl + CP_KT + j * 64 + q * 16) = (u32x4){kt[4 * q], kt[4 * q + 1], kt[4 * q + 2], kt[4 * q + 3]};
                *(LAS u32x4*)(wl + CP_VT + j * 64 + q * 16) = (u32x4){vt[4 * q], vt[4 * q + 1], vt[4 * q + 2], vt[4 * q + 3]};
            }
        }
        LDS_WAIT(); asm volatile("" ::: "memory");
        if (STG >= 2) {
        {
            f32x16 Mba, Mka, Nbr, Nkr;
#pragma unroll
            for (int i = 0; i < 16; ++i) { Mba[i] = 0.f; Mka[i] = 0.f; Nkr[i] = 0.f; Nbr[i] = 0.f; }
#pragma unroll
            for (int ks = 0; ks < 4; ++ks) {
                const LAS unsigned char* rp = wl + r32 * 768 + (16 * ks + 8 * hi) * 2;
                const bf16x8 ab = *(const LAS bf16x8*)(rp + 2 * 128), ak = *(const LAS bf16x8*)(rp + 3 * 128);
                const bf16x8 ba = *(const LAS bf16x8*)(rp + 1 * 128), br = *(const LAS bf16x8*)(rp + 4 * 128);
                Mba = MFMA32(ab, ba, Mba); Mka = MFMA32(ak, ba, Mka); Nkr = MFMA32(ak, br, Nkr); Nbr = MFMA32(ab, br, Nbr);
            }
#pragma unroll
            for (int r = 0; r < 16; ++r) { const int sr = crow(r, hi);
                if (!(sr < r32)) { Mba[r] = 0.f; Mka[r] = 0.f; }
                if (!(sr <= r32)) { Nkr[r] = 0.f; Nbr[r] = 0.f; } }
            LDS_WAIT(); asm volatile("" ::: "memory");
#pragma unroll
            for (int g4 = 0; g4 < 4; ++g4) {
                *(LAS f32x4*)(wl + r32 * 768 + 0 * 128 + (8 * g4 + 4 * hi) * 4) = (f32x4){Mba[4 * g4], Mba[4 * g4 + 1], Mba[4 * g4 + 2], Mba[4 * g4 + 3]};
                *(LAS u32x2*)(wl + r32 * 768 + 1 * 128 + (8 * g4 + 4 * hi) * 2) = (u32x2){pk2(Nbr[4 * g4], Nbr[4 * g4 + 1]), pk2(Nbr[4 * g4 + 2], Nbr[4 * g4 + 3])};
            }
#pragma unroll
            for (int r = 0; r < 16; ++r) *(LAS float*)(wl + crow(r, hi) * 768 + 5 * 128 + r32 * 4) = Mka[r];
            *(LAS float*)(wl + (j >> 4) * 768 + 1 * 128 + 64 + (j & 15) * 4) = g;
            { LAS unsigned char* np = wl + (lane >> 1) * 768 + 3 * 128 + 64 + (lane & 1) * 32;
              *(LAS u32x4*)np = (u32x4){pk2(Nkr[0], Nkr[1]), pk2(Nkr[2], Nkr[3]), pk2(Nkr[4], Nkr[5]), pk2(Nkr[6], Nkr[7])};
              *(LAS u32x4*)(np + 16) = (u32x4){pk2(Nkr[8], Nkr[9]), pk2(Nkr[10], Nkr[11]), pk2(Nkr[12], Nkr[13]), pk2(Nkr[14], Nkr[15])}; }
        }
        LDS_WAIT(); asm volatile("" ::: "memory");
        }
        if (STG >= 3) {
        {
            float x1[32], x2[32];
            subst_all2(x1, x2, al, wl, wl + r32 * 768 + 5 * 128, std::make_integer_sequence<int, 32>{});
            LAS unsigned char* w1p = wl + (j >> 1) * 768 + 2 * 128 + (j & 1) * 64;
            LAS unsigned char* w2p = wl + r32 * 768 + 3 * 128;
#pragma unroll
            for (int q = 0; q < 4; ++q) {
                *(LAS u32x4*)(w1p + q * 16) = (u32x4){pk2(-x1[8 * q], -x1[8 * q + 1]), pk2(-x1[8 * q + 2], -x1[8 * q + 3]), pk2(-x1[8 * q + 4], -x1[8 * q + 5]), pk2(-x1[8 * q + 6], -x1[8 * q + 7])};
                if (hi == 0) *(LAS u32x4*)(w2p + q * 16) = (u32x4){pk2(-x2[8 * q], -x2[8 * q + 1]), pk2(-x2[8 * q + 2], -x2[8 * q + 3]), pk2(-x2[8 * q + 4], -x2[8 * q + 5]), pk2(-x2[8 * q + 6], -x2[8 * q + 7])};
            }
        }
        LDS_WAIT(); asm volatile("" ::: "memory");
        }
        if (STG >= 4) {
#define CP_A1(jt, ks) (*(const LAS bf16x8*)(wl + (16 * (jt) + (r32 >> 1)) * 768 + 2 * 128 + (r32 & 1) * 64 + (16 * (ks) + 8 * hi) * 2))
#define CP_A2(ks) (*(const LAS bf16x8*)(wl + r32 * 768 + 3 * 128 + (16 * (ks) + 8 * hi) * 2))
#define CP_BN(ks) (*(const LAS bf16x8*)(wl + r32 * 768 + 1 * 128 + (16 * (ks) + 8 * hi) * 2))
#define CP_BB(jp, ks) (*(const LAS bf16x8*)(wl + CP_BT + (32 * (jp) + r32) * 64 + (16 * (ks) + 8 * hi) * 2))
        {
            float gcl[2];
#pragma unroll
            for (int jt = 0; jt < 2; ++jt) { const int jj = 32 * jt + r32; gcl[jt] = *(const LAS float*)(wl + (jj >> 4) * 768 + 1 * 128 + 64 + (jj & 15) * 4); }
            {
                const bf16x8 bn0 = CP_BN(0), bn1 = CP_BN(1);
#pragma unroll
                for (int jt = 0; jt < 2; ++jt) {
                    f32x16 acc;
#pragma unroll
                    for (int g4 = 0; g4 < 4; ++g4) { const u32x2 v = *(const LAS u32x2*)(wl + r32 * 768 + 4 * 128 + (32 * jt + 8 * g4 + 4 * hi) * 2);
                        acc[4 * g4] = bflo(v.x); acc[4 * g4 + 1] = bfhi(v.x); acc[4 * g4 + 2] = bflo(v.y); acc[4 * g4 + 3] = bfhi(v.y); }
                    acc = MFMA32(CP_A1(jt, 0), bn0, acc); acc = MFMA32(CP_A1(jt, 1), bn1, acc);
#pragma unroll
                    for (int sx = 0; sx < 2; ++sx) *(bf16x8*)(dl16 + IT_G1 + (jt * 2 + sx) * 1024) = pack_acc(acc, sx);
                }
            }
#pragma unroll
            for (int jp = 0; jp < 2; ++jp) {
                const bf16x8 bb0 = CP_BB(jp, 0), bb1 = CP_BB(jp, 1);
#pragma unroll
                for (int jt = 0; jt < 2; ++jt) {
                    f32x16 acc;
#pragma unroll
                    for (int r = 0; r < 16; ++r) acc[r] = (jt == jp && crow(r, hi) == r32) ? 1.f : 0.f;
                    acc = MFMA32(CP_A1(jt, 0), bb0, acc); acc = MFMA32(CP_A1(jt, 1), bb1, acc);
#pragma unroll
                    for (int r = 0; r < 16; ++r) acc[r] *= gcl[jp];
#pragma unroll
                    for (int sx = 0; sx < 2; ++sx) *(bf16x8*)(dl16 + IT_H1 + ((jp * 2 + jt) * 2 + sx) * 1024) = pack_acc(acc, sx);
                }
            }
            bf16x8 vtf[2][2];
#pragma unroll
            for (int it = 0; it < 2; ++it)
#pragma unroll
                for (int ks = 0; ks < 2; ++ks) {
                    const u32x2 lo = *(const LAS u32x2*)(wl + CP_VT + (32 * it + r32) * 64 + (16 * ks + 4 * hi) * 2), hh = *(const LAS u32x2*)(wl + CP_VT + (32 * it + r32) * 64 + (16 * ks + 8 + 4 * hi) * 2);
                    vtf[it][ks] = __builtin_bit_cast(bf16x8, (u32x4){lo.x, lo.y, hh.x, hh.y});
                }
            {
                f32x16 acc; unpack_acc_bf16(wl + (lane >> 1) * 768 + 3 * 128 + 64 + (lane & 1) * 32, acc);
                acc = MFMA32(CP_A2(0), CP_BN(0), acc); acc = MFMA32(CP_A2(1), CP_BN(1), acc);
                const bf16x8 g0 = pack_acc(acc, 0), g1 = pack_acc(acc, 1);
#pragma unroll
                for (int it = 0; it < 2; ++it) {
                    f32x16 z;
#pragma unroll
                    for (int r = 0; r < 16; ++r) z[r] = 0.f;
                    z = MFMA32(g0, vtf[it][0], z); z = MFMA32(g1, vtf[it][1], z);
                    store_acc_bf16(dl32 + IT_OV + it * 2048, z);
                }
            }
#pragma unroll
            for (int jp = 0; jp < 2; ++jp) {
                f32x16 acc;
#pragma unroll
                for (int g4 = 0; g4 < 4; ++g4) { const u32x2 v = *(const LAS u32x2*)(wl + CP_KT + (32 * jp + r32) * 64 + (8 * g4 + 4 * hi) * 2);
                    acc[4 * g4] = bflo(v.x); acc[4 * g4 + 1] = bfhi(v.x); acc[4 * g4 + 2] = bflo(v.y); acc[4 * g4 + 3] = bfhi(v.y); }
                acc = MFMA32(CP_A2(0), CP_BB(jp, 0), acc); acc = MFMA32(CP_A2(1), CP_BB(jp, 1), acc);
#pragma unroll
                for (int r = 0; r < 16; ++r) acc[r] *= gcl[jp];
                const bf16x8 h0 = pack_acc(acc, 0), h1 = pack_acc(acc, 1);
#pragma unroll
                for (int it = 0; it < 2; ++it) {
                    f32x16 z;
#pragma unroll
                    for (int r = 0; r < 16; ++r) z[r] = 0.f;
                    z = MFMA32(h0, vtf[it][0], z); z = MFMA32(h1, vtf[it][1], z);
                    store_acc_bf16(dl32 + IT_QT + (jp * 2 + it) * 2048, z);
                }
            }
        }
#undef CP_A1
#undef CP_A2
#undef CP_BN
#undef CP_BB
        }
        LDS_WAIT(); asm volatile("" ::: "memory");
    }
}
DI void phase_chunkscan(const Params& p, LAS unsigned char* lds, int tid, int lane, int wid) {
    unsigned char* ws = p.ws;
    bf16_t* OBR = (bf16_t*)(ws + WS_OBRAW);
    const int r32 = lane & 31, hi = lane >> 5;
    for (int chain = blockIdx.x; chain < 64; chain += gridDim.x) {
        const unsigned char* src = chk_base(p, chain);
        const int b = chain >> 3, h = chain & 7, lt = tid - 128;
        __syncthreads();
        u32x4 lw[4];
        if (wid >= 2) {
#pragma unroll
            for (int k = 0; k < 4; ++k) lw[k] = *(const u32x4*)(src + (size_t)(lt + 384 * k) * 16);
#pragma unroll
            for (int k = 0; k < 4; ++k) *(LAS u32x4*)(lds + (lt + 384 * k) * 16) = lw[k];
#pragma unroll
            for (int k = 0; k < 4; ++k) lw[k] = *(const u32x4*)(src + ITEM_BYTES + (size_t)(lt + 384 * k) * 16);
        }
        __syncthreads();
        f32x16 X0, X1;
#pragma unroll
        for (int i = 0; i < 16; ++i) { X0[i] = 0.f; X1[i] = 0.f; }
        for (int c = 0; c < NCHUNK; ++c) {
            const LAS unsigned char* cur = lds + (c & 1) * ITEM_BYTES;
            if (wid < 2) {
                const int it = wid;
                const bf16x8 xb00 = pack_acc(X0, 0), xb01 = pack_acc(X0, 1), xb10 = pack_acc(X1, 0), xb11 = pack_acc(X1, 1);
                f32x16 oacc; unpack_acc_bf16(cur + IT_OV + (it * 64 + lane) * 32, oacc);
                oacc = MFMA32(*(const LAS bf16x8*)(cur + IT_G1 + (0 * 64 + lane) * 16), xb00, oacc);
                oacc = MFMA32(*(const LAS bf16x8*)(cur + IT_G1 + (1 * 64 + lane) * 16), xb01, oacc);
                oacc = MFMA32(*(const LAS bf16x8*)(cur + IT_G1 + (2 * 64 + lane) * 16), xb10, oacc);
                oacc = MFMA32(*(const LAS bf16x8*)(cur + IT_G1 + (3 * 64 + lane) * 16), xb11, oacc);
                f32x16 n0, n1;
                unpack_acc_bf16(cur + IT_QT + ((0 * 2 + it) * 64 + lane) * 32, n0);
                unpack_acc_bf16(cur + IT_QT + ((1 * 2 + it) * 64 + lane) * 32, n1);
                n0 = MFMA32(*(const LAS bf16x8*)(cur + IT_H1 + (0 * 64 + lane) * 16), xb00, n0);
                n0 = MFMA32(*(const LAS bf16x8*)(cur + IT_H1 + (1 * 64 + lane) * 16), xb01, n0);
                n0 = MFMA32(*(const LAS bf16x8*)(cur + IT_H1 + (2 * 64 + lane) * 16), xb10, n0);
                n0 = MFMA32(*(const LAS bf16x8*)(cur + IT_H1 + (3 * 64 + lane) * 16), xb11, n0);
                n1 = MFMA32(*(const LAS bf16x8*)(cur + IT_H1 + (4 * 64 + lane) * 16), xb00, n1);
                n1 = MFMA32(*(const LAS bf16x8*)(cur + IT_H1 + (5 * 64 + lane) * 16), xb01, n1);
                n1 = MFMA32(*(const LAS bf16x8*)(cur + IT_H1 + (6 * 64 + lane) * 16), xb10, n1);
                n1 = MFMA32(*(const LAS bf16x8*)(cur + IT_H1 + (7 * 64 + lane) * 16), xb11, n1);
                X0 = n0; X1 = n1;
                bf16_t* orow = OBR + ((size_t)(b * SEQ + c * CK)) * 512 + h * 64 + 32 * it + r32;
#pragma unroll
                for (int r = 0; r < 16; ++r) orow[(size_t)crow(r, hi) * 512] = f2bf(oacc[r]);
            } else {
                LAS unsigned char* nxt = lds + ((c + 1) & 1) * ITEM_BYTES;
                if (c + 1 < NCHUNK) {
#pragma unroll
                    for (int k = 0; k < 4; ++k) *(LAS u32x4*)(nxt + (lt + 384 * k) * 16) = lw[k];
                }
                if (c + 2 < NCHUNK) {
#pragma unroll
                    for (int k = 0; k < 4; ++k) lw[k] = *(const u32x4*)(src + (size_t)(c + 2) * ITEM_BYTES + (size_t)(lt + 384 * k) * 16);
                }
            }
            __syncthreads();
        }
    }
}

constexpr int AT_BUF = 8192 + 64 * 136, AT_K = 0, AT_V = 8192, AT_BT = 2 * AT_BUF, AT_END = AT_BT + 512 * 4;
DI int rel_bucket_dev(int n) {
    if (n < 16) return n;
    const int th[15] = {19, 21, 24, 27, 31, 35, 40, 46, 52, 59, 67, 77, 87, 99, 113};
    int b = 16;
#pragma unroll
    for (int i = 0; i < 15; ++i) b += (n >= th[i]) ? 1 : 0;
    return b;
}
template <int MODE>
DI void attn_tile(const LAS unsigned char* kb, const LAS unsigned char* vbuf, const LAS float* btab, const bf16x8 (&qr)[4],
                  f32x16& o0, f32x16& o1, f32x16& lacc, float& m, int dq, bool selb, float c31, int r32, int hi) {
    const float sc2 = 0.125f * LOG2E;
    f32x16 p0, p1;
#pragma unroll
    for (int i = 0; i < 16; ++i) { p0[i] = 0.f; p1[i] = 0.f; }
#pragma unroll
    for (int d0 = 0; d0 < 4; ++d0) {
        const bf16x8 k0 = *(const LAS bf16x8*)(kb + (2 * d0 + hi) * 1024 + r32 * 16);
        const bf16x8 k1 = *(const LAS bf16x8*)(kb + (2 * d0 + hi) * 1024 + 512 + r32 * 16);
        p0 = MFMA32(k0, qr[d0], p0); p1 = MFMA32(k1, qr[d0], p1);
    }
    float mx = -INFINITY;
    float cadd = 0.f;
    if (MODE == 2) {
        const float bsel = selb ? c31 : -INFINITY;
#pragma unroll
        for (int r = 0; r < 16; ++r) mx = fmaxf(mx, fmaxf(p0[r], p1[r]));
        mx = mx * sc2 + bsel;
        cadd = bsel;
    } else {
        const float ninf = selb ? 0.f : -INFINITY;
#pragma unroll
        for (int r = 0; r < 16; ++r) {
            const int d0 = dq - crow(r, hi), d1 = d0 - 32;
            const int i0 = d0 < 0 ? 0 : (d0 > 511 ? 511 : d0), i1 = d1 < 0 ? 0 : (d1 > 511 ? 511 : d1);
            float x0 = p0[r] * sc2 + btab[i0], x1 = p1[r] * sc2 + btab[i1];
            if (MODE == 0) { x0 = d0 >= 0 ? x0 : -INFINITY; x1 = d1 >= 0 ? x1 : -INFINITY; }
            else { x0 += ninf; x1 += ninf; }
            p0[r] = x0; p1[r] = x1; mx = fmaxf(mx, fmaxf(x0, x1));
        }
    }
    mx = fmaxf(mx, __shfl_xor(mx, 32));
    if (__any(mx > m)) {
        const float mn = fmaxf(m, mx);
        const float alpha = __builtin_amdgcn_exp2f(m - mn);
        m = mn;
#pragma unroll
        for (int i = 0; i < 16; ++i) { o0[i] *= alpha; o1[i] *= alpha; lacc[i] *= alpha; }
    }
    if (MODE == 2) {
        const float c = cadd - m;
#pragma unroll
        for (int r = 0; r < 16; ++r) { p0[r] = __builtin_amdgcn_exp2f(p0[r] * sc2 + c); p1[r] = __builtin_amdgcn_exp2f(p1[r] * sc2 + c); }
    } else {
#pragma unroll
        for (int r = 0; r < 16; ++r) { p0[r] = __builtin_amdgcn_exp2f(p0[r] - m); p1[r] = __builtin_amdgcn_exp2f(p1[r] - m); }
    }
    const bf16x8 ones = {(short)0x3F80, (short)0x3F80, (short)0x3F80, (short)0x3F80, (short)0x3F80, (short)0x3F80, (short)0x3F80, (short)0x3F80};
#pragma unroll
    for (int s = 0; s < 4; ++s) {
        u32x4 pw;
        if (s < 2) { pw.x = pk2(p0[8 * s], p0[8 * s + 1]); pw.y = pk2(p0[8 * s + 2], p0[8 * s + 3]); pw.z = pk2(p0[8 * s + 4], p0[8 * s + 5]); pw.w = pk2(p0[8 * s + 6], p0[8 * s + 7]); }
        else { const int q = s - 2; pw.x = pk2(p1[8 * q], p1[8 * q + 1]); pw.y = pk2(p1[8 * q + 2], p1[8 * q + 3]); pw.z = pk2(p1[8 * q + 4], p1[8 * q + 5]); pw.w = pk2(p1[8 * q + 6], p1[8 * q + 7]); }
        const bf16x8 pf = __builtin_bit_cast(bf16x8, pw);
        const LAS unsigned char* v0p = vbuf + r32 * 136 + (16 * s + 4 * hi) * 2;
        const LAS unsigned char* v1p = vbuf + (32 + r32) * 136 + (16 * s + 4 * hi) * 2;
        const u32x2 a0 = *(const LAS u32x2*)v0p, a1 = *(const LAS u32x2*)(v0p + 16);
        const u32x2 c0 = *(const LAS u32x2*)v1p, c1 = *(const LAS u32x2*)(v1p + 16);
        const bf16x8 va = __builtin_bit_cast(bf16x8, (u32x4){a0.x, a0.y, a1.x, a1.y});
        const bf16x8 vb = __builtin_bit_cast(bf16x8, (u32x4){c0.x, c0.y, c1.x, c1.y});
        o0 = MFMA32(va, pf, o0); o1 = MFMA32(vb, pf, o1); lacc = MFMA32(ones, pf, lacc);
    }
}
template <int VAR> DI void attn_unit(const Params& p, LAS unsigned char* lds, int b, int h, int qb, int tid, int lane, int wid) {
    unsigned char* ws = p.ws;
    const bf16_t* QKV = (const bf16_t*)(ws + WS_QKV);
    const bf16_t* VT = (const bf16_t*)((const unsigned char*)p.out + DO_VT);
    const unsigned short* SEL = (const unsigned short*)(ws + WS_SEL);
    bf16_t* OA = VAR == 0 ? (bf16_t*)(ws + WS_OA) : (bf16_t*)((unsigned char*)p.out + 64 * MiB);
    const int r32 = lane & 31, hi = lane >> 5, bh = b * NH + h;
    LAS float* btab = (LAS float*)(lds + AT_BT);
    const int NT = 4 * (qb + 1);
#define AT_KPOS(ti) (((ti) < 4 ? qb * 256 + (ti) * 64 : (((ti) - 4) >> 2) * 256 + (((ti) - 4) & 3) * 64))
    const bf16_t* kbase = QKV + ((size_t)(b * SEQ + lane)) * QKVW + 512 + h * 64 + wid * 8;
    const bf16_t* vbase = VT + ((size_t)(bh * 64 + (tid >> 3))) * SEQ + (tid & 7) * 8;
    const int kdst = AT_K + wid * 1024 + lane * 16, vdst = AT_V + (tid >> 3) * 136 + (tid & 7) * 16;
#define AT_LOAD(ti, kr, vr) do { const int kp_ = AT_KPOS(ti); kr = *(const u32x4*)(kbase + (size_t)kp_ * QKVW); vr = *(const u32x4*)(vbase + kp_); } while (0)
#define AT_WRITE(buf, kr, vr) do { LAS unsigned char* b_ = lds + (buf) * AT_BUF; *(LAS u32x4*)(b_ + kdst) = kr; \
        *(LAS u32x2*)(b_ + vdst) = (u32x2){vr.x, vr.y}; *(LAS u32x2*)(b_ + vdst + 8) = (u32x2){vr.z, vr.w}; } while (0)
    u32x4 kreg, vreg;
    AT_LOAD(0, kreg, vreg);
    __syncthreads();
    btab[tid] = p.rel_bias[h * 32 + rel_bucket_dev(tid)] * LOG2E;
    if (tid < 256) {
        unsigned mask = 0u;
        if (qb > 0) {
            const float* KBAR = (const float*)(ws + WS_KBAR);
            float q[64];
            const bf16_t* qp = QKV + ((size_t)(b * SEQ + qb * 256 + tid)) * QKVW + h * 64;
#pragma unroll
            for (int c = 0; c < 8; ++c) { const u32x4 w = *(const u32x4*)(qp + c * 8); float f[8]; unpack8(w, f);
#pragma unroll
                for (int i = 0; i < 8; ++i) q[c * 8 + i] = f[i]; }
            float v1 = -INFINITY, v2 = -INFINITY, v3 = -INFINITY; int i1 = -1, i2 = -1, i3 = -1;
            for (int jb = 0; jb < qb; ++jb) {
                const float* kbp = KBAR + ((size_t)(bh * 16 + jb)) * 64;
                float g = 0.f;
#pragma unroll
                for (int d = 0; d < 64; d += 4) { const f32x4 kk = *(const f32x4*)(kbp + d); g += q[d] * kk.x + q[d + 1] * kk.y + q[d + 2] * kk.z + q[d + 3] * kk.w; }
                if (g > v1) { v3 = v2; i3 = i2; v2 = v1; i2 = i1; v1 = g; i1 = jb; }
                else if (g > v2) { v3 = v2; i3 = i2; v2 = g; i2 = jb; }
                else if (g > v3) { v3 = g; i3 = jb; }
            }
            if (i1 >= 0) mask |= 1u << i1;
            if (i2 >= 0) mask |= 1u << i2;
            if (i3 >= 0) mask |= 1u << i3;
        }
        ((LAS unsigned short*)(lds + AT_END))[tid] = (unsigned short)mask;
    }
    AT_WRITE(0, kreg, vreg);
    if (NT > 1) AT_LOAD(1, kreg, vreg);
    const int qrow = b * SEQ + qb * 256 + wid * 32 + r32, qin = wid * 32 + r32;
    bf16x8 qr[4];
#pragma unroll
    for (int d0 = 0; d0 < 4; ++d0) qr[d0] = *(const bf16x8*)(QKV + (size_t)qrow * QKVW + h * 64 + d0 * 16 + hi * 8);
    const float c31 = p.rel_bias[h * 32 + 31] * LOG2E;
    float m = -INFINITY;
    f32x16 o0, o1, lacc;
#pragma unroll
    for (int i = 0; i < 16; ++i) { o0[i] = 0.f; o1[i] = 0.f; lacc[i] = 0.f; }
    __syncthreads();
    const unsigned sel = ((const LAS unsigned short*)(lds + AT_END))[qin];
    for (int ti = 0; ti < NT; ++ti) {
        const bool own = ti < 4;
        const int blk = own ? qb : ((ti - 4) >> 2), kt = own ? ti : ((ti - 4) & 3);
        const LAS unsigned char* kb = lds + (ti & 1) * AT_BUF + AT_K;
        const LAS unsigned char* vbuf = lds + (ti & 1) * AT_BUF + AT_V;
        const bool selb = ((sel >> blk) & 1u) != 0u;
        const bool active = own ? (kt * 64 <= wid * 32 + 31) : (__any(selb) != 0);
        if (active && VAR != 2) {
            if (own) attn_tile<0>(kb, vbuf, btab, qr, o0, o1, lacc, m, qin - kt * 64, true, 0.f, r32, hi);
            else {
                const bool farb = ((qb - blk) * 256 + wid * 32 - kt * 64 - 63 >= 113);
                if (farb) attn_tile<2>(kb, vbuf, btab, qr, o0, o1, lacc, m, 0, selb, c31, r32, hi);
                else attn_tile<1>(kb, vbuf, btab, qr, o0, o1, lacc, m, (qb - blk) * 256 + qin - kt * 64, selb, c31, r32, hi);
            }
        }
        if (VAR != 1) { if (ti + 1 < NT) AT_WRITE((ti + 1) & 1, kreg, vreg);
        if (ti + 2 < NT) AT_LOAD(ti + 2, kreg, vreg); }
        __syncthreads();
    }
#undef AT_KPOS
#undef AT_LOAD
#undef AT_WRITE
    const float il = 1.f / lacc[0];
    bf16_t* orow = OA + (size_t)qrow * 512 + h * 64;
#pragma unroll
    for (int g = 0; g < 4; ++g) {
        u32x2 w0, w1;
        w0.x = pk2(o0[4 * g] * il, o0[4 * g + 1] * il); w0.y = pk2(o0[4 * g + 2] * il, o0[4 * g + 3] * il);
        w1.x = pk2(o1[4 * g] * il, o1[4 * g + 1] * il); w1.y = pk2(o1[4 * g + 2] * il, o1[4 * g + 3] * il);
        *(u32x2*)(orow + 8 * g + 4 * hi) = w0; *(u32x2*)(orow + 32 + 8 * g + 4 * hi) = w1;
    }
}
template <int VAR> DI void phase_attn(const Params& p, LAS unsigned char* lds, int tid, int lane, int wid) {
    if (gridDim.x == 256) {
        const int bh = blockIdx.x & 63, s = blockIdx.x >> 6;
#pragma unroll 1
        for (int i = 0; i < 4; ++i) { const int qb = i == 0 ? 15 - s : (i == 1 ? 8 + s : (i == 2 ? 7 - s : s)); attn_unit<VAR>(p, lds, bh >> 3, bh & 7, qb, tid, lane, wid); }
    } else {
        for (int it = blockIdx.x; it < NB * NH * 16; it += gridDim.x) { const int qb = 15 - (it >> 6), bh = it & 63; attn_unit<VAR>(p, lds, bh >> 3, bh & 7, qb, tid, lane, wid); }
    }
}

constexpr int A2_BT = 0, A2_SEL = 2048, A2_CNT = 2560, A2_WCNT = 2624, A2_NIT = 2880, A2_QCTR = 2884, A2_ITEM = 2944, A2_ROWS = 3072, A2_END = 3072 + 15 * 256;
constexpr size_t PART_REC = 136;
DI unsigned char* part_base(const Params& p, int b) {
    constexpr size_t PB_ = (size_t)NH * SEQ * 3 * PART_REC;
    return b < 6 ? p.ws + 214 * MiB + (size_t)b * PB_ : (unsigned char*)p.out + 96 * MiB + (size_t)(b - 6) * PB_;
}
struct A2State { float m, l; f32x16 o0, o1; };
constexpr int A2_WBUF = 8192;
DI void a2_dma_tile(const unsigned char* kf_tile, const unsigned char* vf_tile, LAS unsigned char* wbuf, int lane) {
#pragma unroll
    for (int f = 0; f < 8; ++f) {
        __builtin_amdgcn_global_load_lds((const unsigned*)(kf_tile + f * 1024 + lane * 16), (LAS unsigned*)(wbuf + f * 1024), 16, 0, 0);
        __builtin_amdgcn_global_load_lds((const unsigned*)(vf_tile + f * 1024 + lane * 16), (LAS unsigned*)(wbuf + 8192 + f * 1024), 16, 0, 0);
    }
}
template <bool OWN> DI void attn2_item(const Params& p, const LAS float* btab, LAS unsigned char* wbuf, int b, int h, int qb, int blk, int row, int nkt, A2State& st, int lane, int r32, int hi) {
    unsigned char* ws = p.ws;
    const bf16_t* QKV = (const bf16_t*)(ws + WS_QKV);
    const int bh = b * NH + h;
    const unsigned char* kft = (const unsigned char*)p.out + DO_KF + ((size_t)(bh * 64 + blk * 4) * 8) * 1024;
    const unsigned char* vft = (const unsigned char*)p.out + DO_VT + ((size_t)(bh * 64 + blk * 4) * 8) * 1024;
    a2_dma_tile(kft, vft, wbuf, lane);
    bf16x8 qr[4];
    { const bf16_t* qp = QKV + ((size_t)(b * SEQ + qb * 256 + row)) * QKVW + h * 64 + hi * 8;
#pragma unroll
      for (int d0 = 0; d0 < 4; ++d0) qr[d0] = *(const bf16x8*)(qp + d0 * 16); }
    st.m = -INFINITY; st.l = 0.f;
#pragma unroll
    for (int i = 0; i < 16; ++i) { st.o0[i] = 0.f; st.o1[i] = 0.f; }
    const int dbase = OWN ? row : ((qb - blk) * 256 + row);
    for (int kt = 0; kt < nkt; ++kt) {
        asm volatile("s_waitcnt vmcnt(0)" ::: "memory");
        bf16x8 kf[8], vf[8];
#pragma unroll
        for (int f = 0; f < 8; ++f) { kf[f] = *(const LAS bf16x8*)(wbuf + f * 1024 + lane * 16); vf[f] = *(const LAS bf16x8*)(wbuf + 8192 + f * 1024 + lane * 16); }
        asm volatile("s_waitcnt lgkmcnt(0)" ::: "memory");
        __builtin_amdgcn_sched_barrier(0);
        if (kt + 1 < nkt) a2_dma_tile(kft + (size_t)(kt + 1) * 8192, vft + (size_t)(kt + 1) * 8192, wbuf, lane);
        f32x16 p0, p1;
#pragma unroll
        for (int i = 0; i < 16; ++i) { p0[i] = 0.f; p1[i] = 0.f; }
#pragma unroll
        for (int d0 = 0; d0 < 4; ++d0) { p0 = MFMA32(kf[2 * d0], qr[d0], p0); p1 = MFMA32(kf[2 * d0 + 1], qr[d0], p1); }
        const float sc2 = 0.125f * LOG2E;
        const int dq = dbase - kt * 64;
        float mx = -INFINITY;
        const bool farb = !OWN && (__all(dq - 63 >= 113) != 0);
        const float c31 = btab[511];
        if (farb) {
#pragma unroll
            for (int r = 0; r < 16; ++r) mx = fmaxf(mx, fmaxf(p0[r], p1[r]));
            mx = mx * sc2 + c31;
        } else {
#pragma unroll
            for (int r = 0; r < 16; ++r) {
                const int d0 = dq - crow(r, hi), d1 = d0 - 32;
                const int i0 = d0 < 0 ? 0 : (d0 > 511 ? 511 : d0), i1 = d1 < 0 ? 0 : (d1 > 511 ? 511 : d1);
                float x0 = p0[r] * sc2 + btab[i0], x1 = p1[r] * sc2 + btab[i1];
                if (OWN) { x0 = d0 >= 0 ? x0 : -INFINITY; x1 = d1 >= 0 ? x1 : -INFINITY; }
                p0[r] = x0; p1[r] = x1; mx = fmaxf(mx, fmaxf(x0, x1));
            }
        }
        mx = fmaxf(mx, __shfl_xor(mx, 32));
        if (__any(mx > st.m)) {
            const float mn = fmaxf(st.m, mx);
            const float alpha = __builtin_amdgcn_exp2f(st.m - mn);
            st.m = mn;
#pragma unroll
            for (int i = 0; i < 16; ++i) { st.o0[i] *= alpha; st.o1[i] *= alpha; }
            st.l *= alpha;
        }
        float rs0 = 0.f, rs1 = 0.f;
        if (farb) { const float c = c31 - st.m;
#pragma unroll
            for (int r = 0; r < 16; ++r) { p0[r] = __builtin_amdgcn_exp2f(p0[r] * sc2 + c); p1[r] = __builtin_amdgcn_exp2f(p1[r] * sc2 + c); rs0 += p0[r]; rs1 += p1[r]; }
        } else {
#pragma unroll
            for (int r = 0; r < 16; ++r) { p0[r] = __builtin_amdgcn_exp2f(p0[r] - st.m); p1[r] = __builtin_amdgcn_exp2f(p1[r] - st.m); rs0 += p0[r]; rs1 += p1[r]; }
        }
        st.l += rs0 + rs1;
#pragma unroll
        for (int s = 0; s < 4; ++s) {
            u32x4 pw;
            if (s < 2) { pw.x = pk2(p0[8 * s], p0[8 * s + 1]); pw.y = pk2(p0[8 * s + 2], p0[8 * s + 3]); pw.z = pk2(p0[8 * s + 4], p0[8 * s + 5]); pw.w = pk2(p0[8 * s + 6], p0[8 * s + 7]); }
            else { const int q = s - 2; pw.x = pk2(p1[8 * q], p1[8 * q + 1]); pw.y = pk2(p1[8 * q + 2], p1[8 * q + 3]); pw.z = pk2(p1[8 * q + 4], p1[8 * q + 5]); pw.w = pk2(p1[8 * q + 6], p1[8 * q + 7]); }
            const bf16x8 pf = __builtin_bit_cast(bf16x8, pw);
            st.o0 = MFMA32(vf[s], pf, st.o0); st.o1 = MFMA32(vf[4 + s], pf, st.o1);
        }
    }
    st.l += __shfl_xor(st.l, 32);
}
template <int CHECK> DI void attn2_unit(const Params& p, LAS unsigned char* lds, int b, int h, int qb, int tid, int lane, int wid) {
    unsigned char* ws = p.ws;
    const bf16_t* QKV = (const bf16_t*)(ws + WS_QKV);
    bf16_t* OA = (bf16_t*)(ws + WS_OA);
    const int r32 = lane & 31, hi = lane >> 5, bh = b * NH + h;
    LAS float* btab = (LAS float*)(lds + A2_BT);
    LAS unsigned short* selm = (LAS unsigned short*)(lds + A2_SEL);
    LAS int* cnt = (LAS int*)(lds + A2_CNT);
    LAS int* wcnt = (LAS int*)(lds + A2_WCNT);
    LAS int* ctl = (LAS int*)(lds + A2_NIT);
    LAS unsigned char* itemtab = lds + A2_ITEM;
    LAS unsigned char* rows = lds + A2_ROWS;
    unsigned char* part = part_base(p, b) + ((size_t)(h * 16 + qb) * 256) * 3 * PART_REC;
    __syncthreads();
    btab[tid] = p.rel_bias[h * 32 + rel_bucket_dev(tid)] * LOG2E;
    unsigned mysel = 0u;
    if (qb > 0) {
        LAS float* kbl = (LAS float*)(lds + A2_WBUF);
        LAS float* gp = (LAS float*)(lds + A2_WBUF + 4096);
        const float* KBAR = (const float*)(ws + WS_KBAR) + (size_t)(bh * 16) * 64;
        for (int i = tid; i < qb * 64; i += NTHREADS) kbl[i] = KBAR[i];
        const int qi = tid & 255, hf = tid >> 8;
        float q[32];
        { const bf16_t* qp = QKV + ((size_t)(b * SEQ + qb * 256 + qi)) * QKVW + h * 64 + 32 * hf;
#pragma unroll
          for (int c = 0; c < 4; ++c) { const u32x4 w = *(const u32x4*)(qp + c * 8); float f[8]; unpack8(w, f);
#pragma unroll
              for (int i = 0; i < 8; ++i) q[c * 8 + i] = f[i]; } }
        __syncthreads();
        for (int jb = 0; jb < qb; ++jb) {
            const LAS float* kbp = kbl + jb * 64 + 32 * hf;
            float g0 = 0.f, g1 = 0.f;
#pragma unroll
            for (int d = 0; d < 32; d += 8) { const f32x4 ka = *(const LAS f32x4*)(kbp + d), kb = *(const LAS f32x4*)(kbp + d + 4);
                g0 += q[d] * ka.x + q[d + 1] * ka.y + q[d + 2] * ka.z + q[d + 3] * ka.w; g1 += q[d + 4] * kb.x + q[d + 5] * kb.y + q[d + 6] * kb.z + q[d + 7] * kb.w; }
            gp[(hf * 16 + jb) * 256 + qi] = g0 + g1;
        }
        __syncthreads();
        if (tid < 256) {
            float v1 = -INFINITY, v2 = -INFINITY, v3 = -INFINITY; int i1 = -1, i2 = -1, i3 = -1;
            for (int jb = 0; jb < qb; ++jb) {
                const float g = gp[jb * 256 + tid] + gp[(16 + jb) * 256 + tid];
                if (g > v1) { v3 = v2; i3 = i2; v2 = v1; i2 = i1; v1 = g; i1 = jb; }
                else if (g > v2) { v3 = v2; i3 = i2; v2 = g; i2 = jb; }
                else if (g > v3) { v3 = g; i3 = jb; }
            }
            if (i1 >= 0) mysel |= 1u << i1;
            if (i2 >= 0) mysel |= 1u << i2;
            if (i3 >= 0) mysel |= 1u << i3;
        }
    }
    if (tid < 256) {
        selm[tid] = (unsigned short)mysel;
        for (int j = 0; j < qb; ++j) { const unsigned long long bm = __ballot((mysel >> j) & 1u); if (lane == 0) wcnt[j * 4 + wid] = __popcll(bm); }
    }
    __syncthreads();
    if (tid < 256) {
        for (int j = 0; j < qb; ++j) {
            const bool bit = ((mysel >> j) & 1u) != 0u;
            const unsigned long long bm = __ballot(bit);
            int off = 0;
            for (int w2 = 0; w2 < 4; ++w2) off += (w2 < wid) ? wcnt[j * 4 + w2] : 0;
            const int pre = __popcll(bm & ((1ull << lane) - 1ull));
            if (bit) rows[j * 256 + off + pre] = (unsigned char)tid;
            if (tid == 0) cnt[j] = wcnt[j * 4] + wcnt[j * 4 + 1] + wcnt[j * 4 + 2] + wcnt[j * 4 + 3];
        }
    }
    __syncthreads();
    if (tid == 0) {
        int n = 0;
        for (int j = 0; j < qb; ++j) { const int nt = (cnt[j] + 31) >> 5; for (int r = 0; r < nt; ++r) itemtab[n++] = (unsigned char)(j * 8 + r); }
        ctl[0] = n; ctl[1] = 0;
    }
    __syncthreads();
    LAS unsigned char* wbuf = lds + A2_WBUF + wid * 16384;
    const int nitems = ctl[0];
    for (;;) {
        int it = 0;
        if (lane == 0) it = __hip_atomic_fetch_add(&ctl[1], 1, __ATOMIC_RELAXED, __HIP_MEMORY_SCOPE_WORKGROUP);
        it = __builtin_amdgcn_readfirstlane(it);
        if (it >= nitems) break;
        const int code = itemtab[it], j = code >> 3, r = code & 7;
        const int pos = r * 32 + r32, n = cnt[j];
        const bool valid = pos < n;
        const int row = rows[j * 256 + (valid ? pos : 0)];
        A2State st;
        attn2_item<false>(p, btab, wbuf, b, h, qb, j, row, 4, st, lane, r32, hi);
        if (valid) {
            const unsigned sm = selm[row];
            const int slot = __popc(sm & ((1u << j) - 1u));
            unsigned char* rec = part + ((size_t)row * 3 + slot) * PART_REC;
#pragma unroll
            for (int g = 0; g < 4; ++g) {
                *(u32x2*)(rec + (8 * g + 4 * hi) * 2) = (u32x2){pk2(st.o0[4 * g], st.o0[4 * g + 1]), pk2(st.o0[4 * g + 2], st.o0[4 * g + 3])};
                *(u32x2*)(rec + (32 + 8 * g + 4 * hi) * 2) = (u32x2){pk2(st.o1[4 * g], st.o1[4 * g + 1]), pk2(st.o1[4 * g + 2], st.o1[4 * g + 3])};
            }
            if (hi == 0) *(f32x2*)(rec + 128) = (f32x2){st.m, st.l};
        }
    }
    A2State own;
    attn2_item<true>(p, btab, wbuf, b, h, qb, qb, wid * 32 + r32, (wid >> 1) + 1, own, lane, r32, hi);
    asm volatile("s_waitcnt vmcnt(0)" ::: "memory");
    __syncthreads();
    {
        const int row = wid * 32 + r32;
        const unsigned sm = selm[row];
        const int ns = __popc(sm);
        float M = own.m;
        float ms[3], ls[3];
#pragma unroll
        for (int s3 = 0; s3 < 3; ++s3) { ms[s3] = -INFINITY; ls[s3] = 0.f;
            if (s3 < ns) { const f32x2 ml = *(const f32x2*)(part + ((size_t)row * 3 + s3) * PART_REC + 128); ms[s3] = ml.x; ls[s3] = ml.y; M = fmaxf(M, ml.x); } }
        const float f0 = __builtin_amdgcn_exp2f(own.m - M);
        float L = own.l * f0;
#pragma unroll
        for (int i = 0; i < 16; ++i) { own.o0[i] *= f0; own.o1[i] *= f0; }
#pragma unroll
        for (int s3 = 0; s3 < 3; ++s3) {
            if (s3 < ns) {
                const float fs = __builtin_amdgcn_exp2f(ms[s3] - M);
                L += ls[s3] * fs;
                const unsigned char* rec = part + ((size_t)row * 3 + s3) * PART_REC;
#pragma unroll
                for (int g = 0; g < 4; ++g) {
                    const u32x2 a = *(const u32x2*)(rec + (8 * g + 4 * hi) * 2), c = *(const u32x2*)(rec + (32 + 8 * g + 4 * hi) * 2);
                    own.o0[4 * g] += fs * bflo(a.x); own.o0[4 * g + 1] += fs * bfhi(a.x); own.o0[4 * g + 2] += fs * bflo(a.y); own.o0[4 * g + 3] += fs * bfhi(a.y);
                    own.o1[4 * g] += fs * bflo(c.x); own.o1[4 * g + 1] += fs * bfhi(c.x); own.o1[4 * g + 2] += fs * bflo(c.y); own.o1[4 * g + 3] += fs * bfhi(c.y);
                }
            }
        }
        const float il = 1.f / L;
        bf16_t* orow = OA + ((size_t)(b * SEQ + qb * 256 + row)) * 512 + h * 64;
#pragma unroll
        for (int g = 0; g < 4; ++g) {
            u32x2 w0, w1;
            w0.x = pk2(own.o0[4 * g] * il, own.o0[4 * g + 1] * il); w0.y = pk2(own.o0[4 * g + 2] * il, own.o0[4 * g + 3] * il);
            w1.x = pk2(own.o1[4 * g] * il, own.o1[4 * g + 1] * il); w1.y = pk2(own.o1[4 * g + 2] * il, own.o1[4 * g + 3] * il);
            if (CHECK) {
                const u32x2 r0 = *(const u32x2*)(orow + 8 * g + 4 * hi), r1 = *(const u32x2*)(orow + 32 + 8 * g + 4 * hi);
                const float a[8] = {bflo(w0.x), bfhi(w0.x), bflo(w0.y), bfhi(w0.y), bflo(w1.x), bfhi(w1.x), bflo(w1.y), bfhi(w1.y)};
                const float c[8] = {bflo(r0.x), bfhi(r0.x), bflo(r0.y), bfhi(r0.y), bflo(r1.x), bfhi(r1.x), bflo(r1.y), bfhi(r1.y)};
                bool bad = false;
#pragma unroll
                for (int i = 0; i < 8; ++i) bad |= !(fabsf(a[i] - c[i]) <= 0.03f * fabsf(c[i]) + 0.004f);
                if (bad) { w0.x = 0x7fc07fc0u; w0.y = 0x7fc07fc0u; w1.x = 0x7fc07fc0u; w1.y = 0x7fc07fc0u; }
            }
            *(u32x2*)(orow + 8 * g + 4 * hi) = w0; *(u32x2*)(orow + 32 + 8 * g + 4 * hi) = w1;
        }
    }
}
template <int CHECK> DI void phase_attn2(const Params& p, LAS unsigned char* lds, int tid, int lane, int wid) {
    if (gridDim.x == 256) {
        const int bh = blockIdx.x & 63, s = blockIdx.x >> 6;
#pragma unroll 1
        for (int i = 0; i < 4; ++i) { const int qb = i == 0 ? 15 - s : (i == 1 ? 8 + s : (i == 2 ? 7 - s : s)); attn2_unit<CHECK>(p, lds, bh >> 3, bh & 7, qb, tid, lane, wid); }
    } else {
        for (int it = blockIdx.x; it < NB * NH * 16; it += gridDim.x) { const int qb = 15 - (it >> 6), bh = it & 63; attn2_unit<CHECK>(p, lds, bh >> 3, bh & 7, qb, tid, lane, wid); }
    }
}

DI void phase_post(const Params& p, int tid, int lane, int wid) {
    unsigned char* ws = p.ws;
    const bf16_t* SCAN = (const bf16_t*)(ws + WS_SCAN);
    const bf16_t* OBRAW = (const bf16_t*)(ws + WS_OBRAW);
    const bf16_t* RG = (const bf16_t*)((const unsigned char*)p.out + DO_RG);
    bf16_t* OB = (bf16_t*)(ws + WS_OB);
    const int gw = blockIdx.x * NWAVES + wid, NGW = gridDim.x * NWAVES;
    for (int tok = gw; tok < NTOK; tok += NGW) {
        const int b = tok >> 12, s = tok & (SEQ - 1);
#pragma unroll
        for (int h = 0; h < NH; ++h) {
            const int c = h * 64 + lane;
            const float o = bf2f(OBRAW[(size_t)tok * 512 + c]);
            const float mu = wave_sum(o) * (1.f / 64.f);
            const float dd = o - mu;
            const float var = wave_sum(dd * dd) * (1.f / 64.f);
            const float on = dd * rsqrtf(var + GN_EPS) * p.lnx_g[c] + p.lnx_b[c];
            const bf16_t* si = SCAN + ((size_t)((b * NH + h) * SEQ + s)) * 384 + lane;
            const float km = bf2f(si[192]), r = bf2f(si[256]), v = bf2f(si[320]);
            const float bon = wave_sum(r * km * p.r_k[c]);
            const float g = bf2f(RG[(size_t)tok * 512 + c]);
            OB[(size_t)tok * 512 + c] = f2bf((on + bon * v) * g);
        }
    }
}
typedef float v16f_t __attribute__((ext_vector_type(16)));
typedef float v32f_t __attribute__((ext_vector_type(32)));
typedef int v6i_t __attribute__((ext_vector_type(6)));
DI void phase_uv_convert(const Params& p, int lane, int gw, int NGW) {
    unsigned char* ws = p.ws;
    const int hl = lane & 31, half = lane >> 5;
    for (int e2 = gw; e2 < NEXP; e2 += NGW) {
        const bool isv = e2 >= NEXP / 2;
        const int e = 2 * (isv ? e2 - NEXP / 2 : e2) + half;
        const float* src = (isv ? p.peer_v : p.peer_u) + (size_t)e * DM + 32 * hl;
        f32x4 v[8]; float am = 0.f, ss = 0.f;
#pragma unroll
        for (int j = 0; j < 8; ++j) { v[j] = *(const f32x4*)(src + 4 * j);
            am = fmaxf(am, fmaxf(fmaxf(fabsf(v[j].x), fabsf(v[j].y)), fmaxf(fabsf(v[j].z), fabsf(v[j].w))));
            ss += v[j].x * v[j].x + v[j].y * v[j].y + v[j].z * v[j].z + v[j].w * v[j].w; }
#pragma unroll
        for (int o = 1; o < 32; o <<= 1) { am = fmaxf(am, __shfl_xor(am, o)); ss += __shfl_xor(ss, o); }
        u32x4 w = {0u, 0u, 0u, 0u};
        if (isv) {
            am = fmaxf(am, 1e-30f);
            const float mul = 6.f / am;
#define FP4_PACK(j_) \
            w[j_] = __builtin_amdgcn_cvt_scalef32_pk_fp4_f32(w[j_], v[2 * (j_)].x * mul, v[2 * (j_)].y * mul, 1.0f, 0); \
            w[j_] = __builtin_amdgcn_cvt_scalef32_pk_fp4_f32(w[j_], v[2 * (j_)].z * mul, v[2 * (j_)].w * mul, 1.0f, 1); \
            w[j_] = __builtin_amdgcn_cvt_scalef32_pk_fp4_f32(w[j_], v[2 * (j_) + 1].x * mul, v[2 * (j_) + 1].y * mul, 1.0f, 2); \
            w[j_] = __builtin_amdgcn_cvt_scalef32_pk_fp4_f32(w[j_], v[2 * (j_) + 1].z * mul, v[2 * (j_) + 1].w * mul, 1.0f, 3);
            FP4_PACK(0) FP4_PACK(1) FP4_PACK(2) FP4_PACK(3)
#undef FP4_PACK
            *(u32x4*)(ws + WS_V8 + (size_t)e * 512 + 16 * hl) = w;
            if (hl == 0) ((float*)(ws + WS_VSC))[e] = am * (1.f / 6.f);
        } else {
            const float su = fmaxf(0.335f * sqrtf(ss * (1.f / DM)), 1e-30f), inv = 1.f / su;
            unsigned nsum = 0u;
#pragma unroll
            for (int j = 0; j < 4; ++j) {
#pragma unroll
                for (int k = 0; k < 4; ++k) {
                    const unsigned nl = (unsigned)fminf(fmaxf(floorf(v[2 * j][k] * inv) + 8.f, 0.f), 15.f);
                    const unsigned nh = (unsigned)fminf(fmaxf(floorf(v[2 * j + 1][k] * inv) + 8.f, 0.f), 15.f);
                    w[j] |= (nl | (nh << 4)) << (8 * k); nsum += nl + nh;
                }
            }
#pragma unroll
            for (int o = 1; o < 32; o <<= 1) nsum += (unsigned)__shfl_xor((int)nsum, o);
            *(u32x4*)(ws + WS_U8 + (size_t)e * 512 + 16 * hl) = w;
            if (hl == 0) ((f32x2*)(ws + WS_USC))[e] = (f32x2){su, (float)nsum};
        }
    }
}

DI void ce_desc(float& x, float& y) { const float hi = fmaxf(x, y), lo = fminf(x, y); x = hi; y = lo; }
DI void sort16_desc(float (&v)[16]) {
#pragma unroll
    for (int k = 2; k <= 16; k <<= 1) {
#pragma unroll
        for (int j = k >> 1; j > 0; j >>= 1) {
#pragma unroll
            for (int i = 0; i < 16; ++i) { const int l = i ^ j; if (l > i) { if ((i & k) == 0) ce_desc(v[i], v[l]); else ce_desc(v[l], v[i]); } }
        }
    }
}
DI void merge16_desc(float (&a)[16], const float (&b)[16]) {
#pragma unroll
    for (int i = 0; i < 16; ++i) a[i] = fmaxf(a[i], b[15 - i]);
#pragma unroll
    for (int j = 8; j > 0; j >>= 1) {
#pragma unroll
        for (int i = 0; i < 16; ++i) { const int l = i ^ j; if (l > i) ce_desc(a[i], a[l]); }
    }
}
DI void xmerge16(float (&a)[16]) {
    float o[16];
#pragma unroll
    for (int i = 0; i < 16; ++i) o[i] = __shfl_xor(a[i], 32);
    merge16_desc(a, o);
}
constexpr int ca_A(int i) { return i < 16 ? 0 : (i < 24 ? i - 8 : -1); }
constexpr int cb_A(int i) { return i < 16 ? i : (i < 24 ? 0 : -1); }
constexpr int ca_B(int i) { return i < 8 ? 1 : i < 13 ? 2 : i < 17 ? 3 : i < 20 ? 4 : i < 22 ? 5 : i < 24 ? 6 : i < 26 ? 7 : -1; }
constexpr int cb_B(int i) { return i < 8 ? i : i < 13 ? i - 8 : i < 17 ? i - 13 : i < 20 ? i - 17 : i < 22 ? i - 20 : i < 24 ? i - 22 : i < 26 ? i - 24 : -1; }

DI void route_item(const Params& p, LAS unsigned char* wl  , int item, int lane) {
    unsigned char* ws = p.ws;
    const bf16_t* QP = (const bf16_t*)(ws + WS_QP);
    const bf16_t* SK = (const bf16_t*)(ws + WS_SK);
    int* PIDX = (int*)(ws + WS_PIDX); float* PGATE = (float*)(ws + WS_PGATE);
    const int tt = item >> 3, h = item & 7, t0 = tt * 32, r32 = lane & 31, hi = lane >> 5;
    float L0[16], L1[16];
#pragma unroll
    for (int pp = 0; pp < 2; ++pp) {
        const int hp = h * 2 + pp;
        bf16x8 qf[8];
#pragma unroll
        for (int ks = 0; ks < 8; ++ks) qf[ks] = *(const bf16x8*)(QP + (size_t)(t0 + r32) * 2048 + hp * 128 + ks * 16 + hi * 8);
        float run[16];
#pragma unroll
        for (int i = 0; i < 16; ++i) run[i] = -INFINITY;
        bf16x8 skf[8];
        { const bf16_t* skp = SK + ((size_t)(hp * 128 + r32)) * 128 + hi * 8;
#pragma unroll
          for (int ks = 0; ks < 8; ++ks) skf[ks] = *(const bf16x8*)(skp + ks * 16); }
#pragma unroll 1
        for (int nt = 0; nt < 4; ++nt) {
            f32x16 X;
#pragma unroll
            for (int i = 0; i < 16; ++i) X[i] = 0.f;
#pragma unroll
            for (int ks = 0; ks < 8; ++ks) X = MFMA32(skf[ks], qf[ks], X);
            if (nt < 3) { const bf16_t* skp = SK + ((size_t)(hp * 128 + (nt + 1) * 32 + r32)) * 128 + hi * 8;
#pragma unroll
                for (int ks = 0; ks < 8; ++ks) skf[ks] = *(const bf16x8*)(skp + ks * 16); }
            float v[16];
#pragma unroll
            for (int r = 0; r < 16; ++r) { const unsigned n = (unsigned)(nt * 32 + (r & 3) + 8 * (r >> 2)) + 4u * (unsigned)hi;
                v[r] = __uint_as_float((__float_as_uint(X[r]) & ~127u) | n); }
            sort16_desc(v);
            merge16_desc(run, v);
        }
        xmerge16(run);
#pragma unroll
        for (int i = 0; i < 16; ++i) { if (pp == 0) L0[i] = run[i]; else L1[i] = run[i]; }
    }
#pragma unroll
    for (int i = 0; i < 16; ++i) { wl[lane * 32 + i] = (unsigned char)(__float_as_uint(L0[i]) & 127u); wl[lane * 32 + 16 + i] = (unsigned char)(__float_as_uint(L1[i]) & 127u); }
    float c0[16], c1[16];
#pragma unroll
    for (int i = 0; i < 32; ++i) {
        float va = -INFINITY, vb = -INFINITY;
        if (ca_A(i) >= 0) { const float s = L0[ca_A(i) < 0 ? 0 : ca_A(i)] + L1[cb_A(i) < 0 ? 0 : cb_A(i)]; va = __uint_as_float((__float_as_uint(s) & ~255u) | (unsigned)(ca_A(i) * 16 + cb_A(i))); }
        if (ca_B(i) >= 0) { const float s = L0[ca_B(i) < 0 ? 0 : ca_B(i)] + L1[cb_B(i) < 0 ? 0 : cb_B(i)]; vb = __uint_as_float((__float_as_uint(s) & ~255u) | (unsigned)(ca_B(i) * 16 + cb_B(i))); }
        const float v = hi ? vb : va;
        if (i < 16) c0[i] = v; else c1[i - 16] = v;
    }
    sort16_desc(c0); sort16_desc(c1); merge16_desc(c0, c1); xmerge16(c0);
    LDS_WAIT(); asm volatile("" ::: "memory");
    int e[16]; float g[16]; float sum = 0.f;
    const float rs = row_rs((const float*)(ws + WS_ROWSQ), t0 + r32);
    if (h == 0 && hi == 0) ((float*)(ws + WS_RS))[t0 + r32] = rs;
    const float mx = __uint_as_float(__float_as_uint(c0[0]) & ~255u);
#pragma unroll
    for (int k = 0; k < 16; ++k) {
        const unsigned bits = __float_as_uint(c0[k]); const int code = (int)(bits & 255u), a = code >> 4, b = code & 15;
        const int i0 = wl[lane * 32 + a], i1 = wl[lane * 32 + 16 + b];
        e[k] = i0 * 128 + i1;
        g[k] = __expf((__uint_as_float(bits & ~255u) - mx) * rs); sum += g[k];
    }
    const float inv = 1.f / sum;
    const size_t ob = ((size_t)(t0 + r32) * 8 + h) * 16 + hi * 8;
    u32x4 e0, e1; f32x4 g0, g1;
    e0.x = hi ? e[8] : e[0]; e0.y = hi ? e[9] : e[1]; e0.z = hi ? e[10] : e[2]; e0.w = hi ? e[11] : e[3];
    e1.x = hi ? e[12] : e[4]; e1.y = hi ? e[13] : e[5]; e1.z = hi ? e[14] : e[6]; e1.w = hi ? e[15] : e[7];
    g0.x = (hi ? g[8] : g[0]) * inv; g0.y = (hi ? g[9] : g[1]) * inv; g0.z = (hi ? g[10] : g[2]) * inv; g0.w = (hi ? g[11] : g[3]) * inv;
    g1.x = (hi ? g[12] : g[4]) * inv; g1.y = (hi ? g[13] : g[5]) * inv; g1.z = (hi ? g[14] : g[6]) * inv; g1.w = (hi ? g[15] : g[7]) * inv;
    *(u32x4*)(PIDX + ob) = e0; *(u32x4*)(PIDX + ob + 4) = e1;
    *(f32x4*)(PGATE + ob) = g0; *(f32x4*)(PGATE + ob + 4) = g1;
    LDS_WAIT(); asm volatile("" ::: "memory");
}
DI void phase_route(const Params& p, LAS unsigned char* lds, int lane, int wid) {
    const int gw = blockIdx.x * NWAVES + wid, NGW = gridDim.x * NWAVES;
    for (int it = gw; it < (NTOK / 32) * NH; it += NGW) route_item(p, lds + wid * 2048, it, lane);
}

DI float gelu_exact(float x) { return 0.5f * x * (1.f + erff(x * 0.70710678118654752f)); }
DI float gelu_bf(float x) {
    const float z = fabsf(x) * 0.70710678118654752f;
    const float t = __builtin_amdgcn_rcpf(fmaf(0.3275911f, z, 1.f));
    const float poly = t * fmaf(t, fmaf(t, fmaf(t, fmaf(t, 1.061405429f, -1.453152027f), 1.421413741f), -0.284496736f), 0.254829592f);
    const float he = 0.5f * poly * __expf(-z * z);
    return x * (x >= 0.f ? 1.f - he : he);
}
DI void experts_quant_x(const u32x4 (&xn)[4], unsigned (&xa)[8], float& sx, float& ktok) {
    float f[32];
#pragma unroll
    for (int j = 0; j < 4; ++j) { float t[8]; unpack8(xn[j], t);
#pragma unroll
        for (int i = 0; i < 8; ++i) f[8 * j + i] = t[i]; }
    float m = 0.f;
#pragma unroll
    for (int i = 0; i < 32; ++i) m = fmaxf(m, fabsf(f[i]));
    m = fmaxf(m, dpp_mov<0x128>(m)); m = fmaxf(m, dpp_mov<0x124>(m)); m = fmaxf(m, dpp_mov<0x122>(m)); m = fmaxf(m, dpp_mov<0x121>(m));
    m = fmaxf(m, __shfl_xor(m, 16));
    m = fmaxf(m, 1e-30f);
    const float inv = 127.f / m; sx = m * (1.f / 127.f);
    unsigned tsum = 0u;
#pragma unroll
    for (int j = 0; j < 4; ++j) { unsigned wh = 0u, wl = 0u;
#pragma unroll
        for (int k = 0; k < 4; ++k) {
            const unsigned q0 = (unsigned)(rintf(f[8 * j + k] * inv) + 128.f), q1 = (unsigned)(rintf(f[8 * j + 4 + k] * inv) + 128.f);
            wh |= ((q0 >> 4) | ((q1 >> 4) << 4)) << (8 * k); wl |= ((q0 & 15u) | ((q1 & 15u) << 4)) << (8 * k); tsum += q0 + q1; }
        xa[j] = wh; xa[4 + j] = wl; }
    float tf = row16_sum((float)tsum);
    tf += __shfl_xor(tf, 16);
    ktok = 983040.f - 7.5f * tf;
}
DI void phase_experts(const Params& p, LAS unsigned char* ldsw  , int lane, int wid, float* outp, const int IDMASK) {
    unsigned char* ws = p.ws;
    const bf16_t* XN = (const bf16_t*)(ws + WS_XN);
    const unsigned char* U8 = ws + WS_U8; const unsigned char* V8 = ws + WS_V8;
    const f32x2* USC = (const f32x2*)(ws + WS_USC); const float* VSC = (const float*)(ws + WS_VSC);
    const int* PIDX = (const int*)(ws + WS_PIDX); const float* PGATE = (const float*)(ws + WS_PGATE); const float* RS = (const float*)(ws + WS_RS);
    float* H1 = p.out;
    const int hl = lane & 31; const bool hi = lane >= 32;
    const bool b0 = (lane & 1) != 0, b1 = (lane & 2) != 0;
    const int ntile = ((NTOK / 32) - (int)blockIdx.x + (int)gridDim.x - 1) / (int)gridDim.x;
    if (ntile <= 0) return;
    const int ntw = ntile * 4;
    auto tokof = [&](int t) { const int tc = t < ntw ? t : ntw - 1; return 32 * ((int)blockIdx.x + (tc >> 2) * (int)gridDim.x) + 4 * wid + (tc & 3); };
    unsigned xa[8]; float sx, ktok;
    typedef int v8i_t __attribute__((ext_vector_type(8)));
    float nfg[16];
#pragma unroll
    for (int r = 0; r < 16; ++r) nfg[r] = p.normf_g[32 * crow(r, hi) + hl];
    f32x16 D, D2;
#pragma unroll
    for (int i = 0; i < 16; ++i) { D[i] = 0.f; D2[i] = 0.f; }
    unsigned bmask[4];
#pragma unroll
    for (int r = 0; r < 4; ++r) bmask[r] = ((hi ? 1 : 0) == ((hl >> 4) & 1) && r == ((hl & 15) >> 2)) ? (0xFFu << (8 * (hl & 3))) : 0u;
    int iA1, iB1, iA2, iB2; float gA1, gB1, gA2, gB2, vA1, vB1; f32x2 uA1, uB1;
    auto ld_ids = [&](int t, int& iA, int& iB, float& gA, float& gB) { const size_t b = (size_t)tokof(t) * 128 + lane;
        iA = PIDX[b] & IDMASK; iB = PIDX[b + 64] & IDMASK; gA = PGATE[b]; gB = PGATE[b + 64]; };
    auto wr_rec = [&](int t, int iA, int iB, float gA, float gB, f32x2 uA, f32x2 uB, float vA, float vB) {
        LAS unsigned char* buf = ldsw + (t & 1) * 2048;
        *(LAS u32x4*)(buf + lane * 16) = (u32x4){(unsigned)iA, __float_as_uint(gA * vA), __float_as_uint(uA.x), __float_as_uint(uA.y)};
        *(LAS u32x4*)(buf + 1024 + lane * 16) = (u32x4){(unsigned)iB, __float_as_uint(gB * vB), __float_as_uint(uB.x), __float_as_uint(uB.y)};
    };
    LAS unsigned char* hvbuf = ldsw + 4096;
    auto prime = [&](int t0) {
        ld_ids(t0, iA1, iB1, gA1, gB1);
        uA1 = USC[iA1]; uB1 = USC[iB1]; vA1 = VSC[iA1]; vB1 = VSC[iB1];
        wr_rec(t0, iA1, iB1, gA1, gB1, uA1, uB1, vA1, vB1);
        ld_ids(t0 + 1, iA1, iB1, gA1, gB1);
        uA1 = USC[iA1]; uB1 = USC[iB1]; vA1 = VSC[iA1]; vB1 = VSC[iB1];
        ld_ids(t0 + 2, iA2, iB2, gA2, gB2);
    };
    auto advance = [&](int t) {
        wr_rec(t + 1, iA1, iB1, gA1, gB1, uA1, uB1, vA1, vB1);
        iA1 = iA2; iB1 = iB2; gA1 = gA2; gB1 = gB2;
        uA1 = USC[iA1]; uB1 = USC[iB1]; vA1 = VSC[iA1]; vB1 = VSC[iB1];
        ld_ids(t + 3, iA2, iB2, gA2, gB2);
    };
    const bool b2 = (lane & 4) != 0;
#pragma unroll 1
    for (int tc = 0; tc < ntw; tc += 16) {
        const int tend = tc + 16 < ntw ? tc + 16 : ntw;
        prime(tc);
        { u32x4 xn[4];
#pragma unroll
          for (int j = 0; j < 4; ++j) xn[j] = *(const u32x4*)(XN + (size_t)tokof(tc) * DM + 32 * hl + 8 * j);
          experts_quant_x(xn, xa, sx, ktok); sx *= RS[tokof(tc)]; }
        u32x4 uw[8];
#pragma unroll
        for (int q = 0; q < 8; ++q) { const int id = *(LAS const int*)(ldsw + (tc & 1) * 2048 + ((hi ? 1 : 0) + 2 * q) * 16); uw[q] = *(const u32x4*)(U8 + (size_t)id * 512 + 16 * hl); }
#pragma unroll 1
        for (int t = tc; t < tend; ++t) {
            advance(t);
            auto groupU = [&](int g) {
                const LAS unsigned char* rc_cur = ldsw + (t & 1) * 2048 + (g * 16 + (hi ? 1 : 0)) * 16;
                const int gn = g + 1;
                const LAS unsigned char* rc_nxt = ldsw + ((t + (gn >> 3)) & 1) * 2048 + ((gn & 7) * 16 + (hi ? 1 : 0)) * 16;
                float d[8]; int idn[8];
                const u32x4 rl = *(LAS const u32x4*)(rc_cur + 32 * (lane & 7));
#pragma unroll
                for (int q = 0; q < 8; ++q) idn[q] = *(LAS const int*)(rc_nxt + 32 * q);
#pragma unroll
                for (int q = 0; q < 8; ++q) {
                    __builtin_amdgcn_sched_barrier(0);
                    const u32x4 w = uw[q];
                    unsigned h0 = __builtin_amdgcn_udot8(w[0], xa[0], 0u, false), l0 = __builtin_amdgcn_udot8(w[0], xa[4], 0u, false);
                    unsigned h1 = __builtin_amdgcn_udot8(w[1], xa[1], 0u, false), l1 = __builtin_amdgcn_udot8(w[1], xa[5], 0u, false);
                    h0 = __builtin_amdgcn_udot8(w[2], xa[2], h0, false); l0 = __builtin_amdgcn_udot8(w[2], xa[6], l0, false);
                    h1 = __builtin_amdgcn_udot8(w[3], xa[3], h1, false); l1 = __builtin_amdgcn_udot8(w[3], xa[7], l1, false);
                    d[q] = (float)(((h0 + h1) << 4) + (l0 + l1));
                    __builtin_amdgcn_sched_barrier(0);
                    uw[q] = *(const u32x4*)(U8 + (size_t)idn[q] * 512 + 16 * hl);
                }
                __builtin_amdgcn_sched_barrier(0);
                float a[4], c2[2];
#pragma unroll
                for (int i = 0; i < 4; ++i) { const float keep = b0 ? d[2 * i + 1] : d[2 * i], send = b0 ? d[2 * i] : d[2 * i + 1]; a[i] = keep + dpp_mov<0xB1>(send); }
#pragma unroll
                for (int i = 0; i < 2; ++i) { const float keep = b1 ? a[2 * i + 1] : a[2 * i], send = b1 ? a[2 * i] : a[2 * i + 1]; c2[i] = keep + dpp_mov<0x4E>(send); }
                float c;
                { const float keep = b2 ? c2[1] : c2[0], send = b2 ? c2[0] : c2[1]; c = keep + dpp_mov<0x124>(send); }
                c += dpp_mov<0x128>(c);
                c += __shfl_xor(c, 16);
                const float gtl = __uint_as_float(rl.y), usl = __uint_as_float(rl.z), rcl = __uint_as_float(rl.w);
                const float dq = ((c - 128.f * rcl) + ktok) * (usl * sx);
#if PROBE == 50
                const float hvl = 0.f * gelu_bf(dq) * gtl;
#else
                const float hvl = gelu_bf(dq) * gtl;
#endif
                const unsigned code = (unsigned)__builtin_amdgcn_cvt_pk_fp8_f32(hvl * 128.f, 0.f, 0, false) & 0xffu;
                if ((lane & 0x18) == 0) hvbuf[((t - tc) * 8 + g) * 16 + 2 * (lane & 7) + (hi ? 1 : 0)] = (unsigned char)code;
            };
#pragma unroll 1
            for (int g = 0; g < 7; ++g) groupU(g);
            u32x4 xn[4];
#pragma unroll
            for (int j = 0; j < 4; ++j) xn[j] = *(const u32x4*)(XN + (size_t)tokof(t + 1) * DM + 32 * hl + 8 * j);
            groupU(7);
            experts_quant_x(xn, xa, sx, ktok); sx *= RS[tokof(t + 1)];
        }
        prime(tc);
        u32x4 vw[8];
#pragma unroll
        for (int q = 0; q < 8; ++q) { const int id = *(LAS const int*)(ldsw + (tc & 1) * 2048 + ((hi ? 1 : 0) + 2 * q) * 16); vw[q] = *(const u32x4*)(V8 + (size_t)id * 512 + 16 * hl); }
#pragma unroll 1
        for (int t = tc; t < tend; ++t) {
            advance(t);
            auto groupV = [&](int g) {
                const int gn = g + 1;
                const LAS unsigned char* rc_nxt = ldsw + ((t + (gn >> 3)) & 1) * 2048 + ((gn & 7) * 16 + (hi ? 1 : 0)) * 16;
                int idn[8];
#pragma unroll
                for (int q = 0; q < 8; ++q) idn[q] = *(LAS const int*)(rc_nxt + 32 * q);
                const u32x4 hb = *(LAS const u32x4*)(hvbuf + ((t - tc) * 8 + g) * 16);
#pragma unroll
                for (int q = 0; q < 8; ++q) {
                    __builtin_amdgcn_sched_barrier(0);
                    const unsigned wq = hb[q >> 1] >> (16 * (q & 1));
                    const unsigned bb0 = (wq & 0xffu) * 0x01010101u, bb1 = ((wq >> 8) & 0xffu) * 0x01010101u;
                    v8i_t Bv, Av;
#pragma unroll
                    for (int r = 0; r < 4; ++r) { Bv[r] = (int)(bb0 & bmask[r]); Bv[4 + r] = (int)(bb1 & bmask[r]); }
                    Av[0] = (int)vw[q].x; Av[1] = (int)vw[q].y; Av[2] = (int)vw[q].z; Av[3] = (int)vw[q].w; Av[4] = 0; Av[5] = 0; Av[6] = 0; Av[7] = 0;
                    if (q & 1) D2 = __builtin_amdgcn_mfma_scale_f32_32x32x64_f8f6f4(Av, Bv, D2, 4  , 0  , 0, 0, 0, 0  );
                    else D = __builtin_amdgcn_mfma_scale_f32_32x32x64_f8f6f4(Av, Bv, D, 4, 0, 0, 0, 0, 0);
                    __builtin_amdgcn_sched_barrier(0);
                    vw[q] = *(const u32x4*)(V8 + (size_t)idn[q] * 512 + 16 * hl);
                }
            };
#pragma unroll 1
            for (int g = 0; g < 7; ++g) groupV(g);
            const int tok = tokof(t);
            float o[16];
            { const float* hr0 = H1 + (size_t)tok * DM + hl;
#pragma unroll
              for (int r = 0; r < 16; ++r) o[r] = __builtin_nontemporal_load(hr0 + 32 * crow(r, hi)); }
            groupV(7);
            float ss = 0.f;
#pragma unroll
            for (int r = 0; r < 16; ++r) { o[r] += (D[r] + D2[r]) * (1.f / 128.f); ss += o[r] * o[r]; D[r] = 0.f; D2[r] = 0.f; }
            const float rs = rsqrtf(wave_sum(ss) * (1.f / DM) + RMS_EPS);
            float* orow = outp + (size_t)tok * DM + hl;
#pragma unroll
            for (int r = 0; r < 16; ++r) __builtin_nontemporal_store(o[r] * rs * nfg[r], orow + 32 * crow(r, hi));
        }
    }
}

__global__ void __launch_bounds__(NTHREADS, 2) mega_fwd(Params p) {
    extern __shared__ __attribute__((aligned(16))) unsigned char lds_raw[];
    LAS unsigned char* lds = (LAS unsigned char*)lds_raw;
    const int tid = threadIdx.x, lane = tid & 63, wid = __builtin_amdgcn_readfirstlane(tid >> 6);
    unsigned char* ws = p.ws;
    bf16_t* XN = (bf16_t*)(ws + WS_XN);
    bf16_t* W1T = (bf16_t*)(ws + WS_W1T);
    volatile LAS unsigned* MISC = (volatile LAS unsigned*)(lds + LDS_MISC);
    if (tid < 64) MISC[tid] = 0u;
    __syncthreads();
    const XcdBarrier bar = xcd_barrier_post((unsigned*)ws, MISC + 8);
#define GSYNC() xcd_barrier(bar)

#ifndef ONLY
#define ONLY -1
#endif
#define PH(k) if (ONLY < 0 || ONLY == (k))
#define IDS() int tid = (int)threadIdx.x; asm volatile("" : "+v"(tid)); const int lane = tid & 63, wid = __builtin_amdgcn_readfirstlane(tid >> 6); (void)lane; (void)wid;
    PH(0) { IDS(); phase_prep(p, lds, tid, lane, wid); }
#if PROBE == 13
    phase_prep(p, lds, tid, lane, wid);
#endif
    GSYNC();
    PH(1) { IDS(); { F1a f{(bf16_t*)(ws + WS_QKV), (bf16_t*)(ws + WS_PB)}; run_gemm(lds, XN, W1T, N1A, 1024, f); } }
#if PROBE == 11
    { F1a f{(bf16_t*)(ws + WS_QKV), (bf16_t*)(ws + WS_PB)}; run_gemm(lds, XN, W1T, N1A, 1024, f); }
#endif
    GSYNC();
    PH(2) { IDS(); phase_wg8(p, lane, wid); phase_kbar_vt(p, lds, tid, lane, wid); }
#if PROBE == 14 || PROBE == 61
    phase_kbar_vt(p, lds, tid, lane, wid);
#endif
    PH(3) { IDS(); phase_rwkv_prep2<true>(p, lds, tid, lane, wid); }
#if PROBE == 8 || PROBE == 61
    phase_rwkv_prep2<true>(p, lds, tid, lane, wid);
#endif

    GSYNC();
    PH(6) { IDS(); phase_attn2<0>(p, lds, tid, lane, wid); }
#if PROBE == 63 || PROBE == 61
    __syncthreads();
    phase_attn2<0>(p, lds, tid, lane, wid);
#endif
    GSYNC();
    PH(5) { IDS(); phase_chunkprep<4>(p, lds, lane, wid); }
    PH(8) { IDS(); if (wid >= 4) { phase_uv_convert(p, lane, (int)blockIdx.x * 4 + wid - 4, (int)gridDim.x * 4); xn8_convert(p, lane, (int)blockIdx.x * 4 + wid - 4, (int)gridDim.x * 4); } }
#if PROBE == 31 || PROBE == 61
    phase_chunkprep<4>(p, lds, lane, wid);
#endif
#if PROBE == 33
    phase_chunkprep<1>(p, lds, lane, wid);
#endif
#if PROBE == 34
    phase_chunkprep<2>(p, lds, lane, wid);
#endif
#if PROBE == 35
    phase_chunkprep<3>(p, lds, lane, wid);
#endif
    GSYNC();
    PH(17) { IDS(); phase_chunkscan(p, lds, tid, lane, wid); }
    PH(9) { IDS(); if (gridDim.x > 64 && (int)blockIdx.x >= 64) { F1b f{ws, p.out, 0, (const signed char*)(ws + WS_WG8SC)}; run_gemm8_on(lds, (const unsigned char*)p.out + DO_XN8, ws + WS_WG8, G1B_EARLY, 1024, f, (int)gridDim.x - 64, (int)blockIdx.x - 64); } }
#if PROBE == 32 || PROBE == 62
    phase_chunkscan(p, lds, tid, lane, wid);
#endif
    GSYNC();
    PH(7) { IDS(); phase_post(p, tid, lane, wid); }
#if PROBE == 62
    phase_post(p, tid, lane, wid);
#endif
    PH(9) { IDS(); { const int e = gridDim.x > 64 ? G1B_EARLY : 0; F1b f{ws, p.out, e, (const signed char*)(ws + WS_WG8SC)}; run_gemm8(lds, (const unsigned char*)p.out + DO_XN8, ws + WS_WG8 + (size_t)e * 1024, NGATE - e, 1024, f); } }
#if PROBE == 64 || PROBE == 66
    { const int e = gridDim.x > 64 ? G1B_EARLY : 0; F1b f{ws, p.out, e, (const signed char*)(ws + WS_WG8SC)}; run_gemm8(lds, (const unsigned char*)p.out + DO_XN8, ws + WS_WG8 + (size_t)e * 1024, NGATE - e, 1024, f); }
#endif
    GSYNC();
    PH(10) { IDS(); { FPa f{ws, p.out, (bf16_t*)(ws + WS_Y)}; run_gemm(lds, (const bf16_t*)(ws + WS_OA), (const bf16_t*)(ws + WS_WPA), 1024, 512, f); } }
#if PROBE == 19 || PROBE == 66
    { FPa f{ws, p.out, (bf16_t*)(ws + WS_Y)}; run_gemm(lds, (const bf16_t*)(ws + WS_OA), (const bf16_t*)(ws + WS_WPA), 1024, 512, f); }
#endif
    __builtin_amdgcn_fence(__ATOMIC_ACQ_REL, "workgroup"); __syncthreads();
    PH(11) { IDS(); { FPb f{ws, p.out, (bf16_t*)(ws + WS_Y)}; run_gemm(lds, (const bf16_t*)(ws + WS_OB), (const bf16_t*)(ws + WS_WPB), 1024, 512, f); } }
    GSYNC();
    PH(12) { IDS(); { FOut f{p.x, p.norm2_g, p.out, XN, (float*)(ws + WS_ROWSQ)}; run_gemm(lds, (const bf16_t*)(ws + WS_Y), (const bf16_t*)(ws + WS_WO), 1024, 1024, f); } }
#if PROBE == 65 || PROBE == 66
    { FOut f{p.x, p.norm2_g, p.out, XN, (float*)(ws + WS_ROWSQ)}; run_gemm(lds, (const bf16_t*)(ws + WS_Y), (const bf16_t*)(ws + WS_WO), 1024, 1024, f); }
#endif
    GSYNC();
    PH(14) { IDS(); { FQ f{(bf16_t*)(ws + WS_QP)}; run_gemm(lds, XN, (const bf16_t*)(ws + WS_WQ), 2048, 1024, f); } }
#if PROBE == 12 || PROBE == 62
    { FQ f{(bf16_t*)(ws + WS_QP)}; run_gemm(lds, XN, (const bf16_t*)(ws + WS_WQ), 2048, 1024, f); }
#endif
    GSYNC();
    PH(15) { IDS(); phase_route(p, lds, lane, wid); }
#if PROBE == 7 || PROBE == 62
    phase_route(p, lds, lane, wid);
#endif
    __builtin_amdgcn_fence(__ATOMIC_ACQ_REL, "workgroup"); __syncthreads();
#if PROBE == 4 || PROBE == 52
#pragma unroll 1
    for (int rep = 0; rep < 2; ++rep) { IDS(); phase_experts(p, lds + wid * 6144, lane, wid, rep == 0 ? (float*)(ws + WS_QKV) : p.out, (rep == 0 && PROBE == 52) ? 2047 : -1); }
#else
    PH(16) { IDS(); phase_experts(p, lds + wid * 6144, lane, wid, p.out, -1); }
#endif
}

extern "C" void kernel_launch(void* const* d_in, const int* in_sizes, int n_in, void* d_out, int out_size, void* d_ws, size_t ws_size, hipStream_t stream) {
    static int grid = 0;
    if (grid == 0) {
        if (n_in != 24 || out_size != NTOK * DM || ws_size < WS_NEED) { fprintf(stderr, "kernel_launch: unexpected problem (n_in %d, out %d, ws %zu)\n", n_in, out_size, ws_size); grid = -1; return; }
        int dev = 0, cus = 0, per_cu = 0;
        if (hipGetDevice(&dev) != hipSuccess || hipDeviceGetAttribute(&cus, hipDeviceAttributeMultiprocessorCount, dev) != hipSuccess) { grid = -1; return; }
        if (hipFuncSetAttribute((const void*)mega_fwd, hipFuncAttributeMaxDynamicSharedMemorySize, LDS_BYTES) != hipSuccess) { fprintf(stderr, "kernel_launch: hipFuncSetAttribute failed\n"); grid = -1; return; }
        if (hipOccupancyMaxActiveBlocksPerMultiprocessor(&per_cu, (const void*)mega_fwd, NTHREADS, LDS_BYTES) != hipSuccess || per_cu < 1) { fprintf(stderr, "kernel_launch: occupancy query says %d\n", per_cu); per_cu = 0; }
        (void)hipGetLastError();
        if (per_cu < 1) { grid = -1; return; }
        grid = cus * 1;
        if (grid < 1) grid = -1;
    }
    if (grid < 0) return;
    Params p{};
    p.x = (const float*)d_in[0]; p.norm1_g = (const float*)d_in[1]; p.w_in = (const float*)d_in[2]; p.rwkv_mu = (const float*)d_in[3];
    p.w0 = (const float*)d_in[4]; p.w_lora_up = (const float*)d_in[5]; p.a0 = (const float*)d_in[6]; p.a_lora_up = (const float*)d_in[7];
    p.g_lora_up = (const float*)d_in[8]; p.k_k = (const float*)d_in[9]; p.k_a = (const float*)d_in[10]; p.r_k = (const float*)d_in[11];
    p.lnx_g = (const float*)d_in[12]; p.lnx_b = (const float*)d_in[13]; p.w_proj_a = (const float*)d_in[14]; p.w_proj_b = (const float*)d_in[15];
    p.w_out = (const float*)d_in[16]; p.norm2_g = (const float*)d_in[17]; p.peer_wq = (const float*)d_in[18]; p.peer_subkeys = (const float*)d_in[19];
    p.peer_u = (const float*)d_in[20]; p.peer_v = (const float*)d_in[21]; p.rel_bias = (const float*)d_in[22]; p.normf_g = (const float*)d_in[23];
    p.out = (float*)d_out; p.ws = (unsigned char*)d_ws;
    if (hipMemsetAsync(d_ws, 0, 65536, stream) != hipSuccess) { fprintf(stderr, "kernel_launch: memset failed\n"); return; }
    void* args[] = {&p};
    hipError_t e = hipLaunchCooperativeKernel((const void*)mega_fwd, dim3(grid), dim3(NTHREADS), args, LDS_BYTES, stream);
    if (e != hipSuccess) fprintf(stderr, "kernel_launch: cooperative launch failed: %s (grid %d)\n", hipGetErrorString(e), grid);
}
```

```cpp
#include <hip/hip_runtime.h>
#include <hip/hip_cooperative_groups.h>
#include <cstdio>
#include <cstdint>
#include <utility>
namespace cg = cooperative_groups;
namespace pg8 {
#define PG8_LAS __attribute__((address_space(3)))
typedef unsigned short bf16_t;
typedef short bf16x8 __attribute__((ext_vector_type(8)));
typedef float f32x4 __attribute__((ext_vector_type(4)));
typedef unsigned u32x4 __attribute__((ext_vector_type(4)));
constexpr int BM = 256, BK = 64, HALF = 128, HTB = HALF * BK * 2  , STAGE_BYTES = 8 * HTB, NXCD = 8, WGM = 8;

__host__ __device__ __forceinline__ int lds_byte(int r, int c) { const int st = (r >> 4) * 2 + (c >> 5), rr = r & 15, cc = c & 31, ob = rr * 64 + cc * 2; return st * 1024 + (ob ^ (((ob >> 9) & 1) << 5)); }
__host__ __device__ __forceinline__ void stage_rc(int b, int& R, int& C) { const int st = b / 1024, sb = b % 1024, swz = sb ^ (((sb >> 9) & 1) << 5); R = (st >> 1) * 16 + swz / 64; C = (st & 1) * 32 + (swz % 64) / 2; }
__host__ __device__ __forceinline__ int perm32(int rho) { const int n = rho >> 4, i = rho & 15; return 8 * (i >> 2) + 4 * n + (i & 3); }

struct Unit { int pm, pn; };
struct Gemm { const bf16_t* A; const bf16_t* Bt; int M, N, K; };

struct StaticOrder {
    int nM, nN, nwg, G, c;
    __host__ __device__ void init(int M, int N, int G_, int c_) { nM = M / BM; nN = N / BM; nwg = nM * nN; G = G_; c = c_; }
    __host__ __device__ bool next(int i, Unit& u) const {
        const long L = (long)i * G + c; if (L >= nwg) return false;
        int wgid = (int)L; { const int q = nwg / NXCD, r = nwg % NXCD, xcd = wgid % NXCD, off = wgid / NXCD; wgid = (xcd < r ? xcd * (q + 1) : r * (q + 1) + (xcd - r) * q) + off; }
        const int nig = WGM * nN, gid = wgid / nig, fm = gid * WGM, gsz = (nM - fm) < WGM ? (nM - fm) : WGM;
        u.pm = fm + ((wgid % nig) % gsz); u.pn = (wgid % nig) / gsz; return true;
    }
    __device__ __forceinline__ void a_ready(const Unit&) const {}
    __device__ __forceinline__ void done(const Unit&) const {}
};
typedef int pg8_v8i __attribute__((ext_vector_type(8)));
__device__ __forceinline__ pg8_v8i pg8_cat8(bf16x8 lo, bf16x8 hi) {
    typedef int v4i_ __attribute__((ext_vector_type(4)));
    const v4i_ a = __builtin_bit_cast(v4i_, lo), b = __builtin_bit_cast(v4i_, hi);
    return (pg8_v8i){a[0], a[1], a[2], a[3], b[0], b[1], b[2], b[3]};
}
template <class Epi, class Sched, bool ALIGN_EPI = false, bool SP2 = false, bool FP8 = false>
__device__ __forceinline__ void gemm_phase(PG8_LAS unsigned char* lds, const Gemm g, const Sched& S, const Epi& E) {
    int tid_ = (int)threadIdx.x; asm volatile("" : "+v"(tid_));
    const int tid = tid_, wid = __builtin_amdgcn_readfirstlane(tid >> 6), lane = tid & 63, wr = wid >> 2, wc = wid & 3, fr = lane & 15, fq = lane >> 4;
    const int K = g.K, nt = K / BK;
    unsigned voffA[2], voffB[2];
#pragma unroll
    for (int i = 0; i < 2; ++i) { int R, C; stage_rc(tid * 16 + i * 8192, R, C); const int Rb = Epi::PERM ? ((R & ~31) + perm32(R & 31)) : R;
        voffA[i] = (unsigned)(R * K + C) * 2u; voffB[i] = (unsigned)(Rb * K + C) * 2u; }
    const size_t kstep = (size_t)(BK * 2);
    const size_t hstep = (size_t)HALF * K * 2;
    const size_t tstep = 2 * hstep;
    const unsigned ldsw = (unsigned)wid * 1024u;
    const int aoff = lds_byte(wr * 64 + fr, fq * 8), boff = lds_byte(wc * 32 + fr, fq * 8);
#define PG8_SA(b, h) (((b) * 2 + (h)) * HTB)
#define PG8_SB(b, h) ((4 + (b) * 2 + (h)) * HTB)
#define PG8_STAGE(bufoff, gbase, voff) do { _Pragma("unroll") for (int _i = 0; _i < 2; ++_i) \
        __builtin_amdgcn_global_load_lds((const unsigned*)((const char*)(gbase) + (voff)[_i]), (PG8_LAS unsigned*)(lds + (bufoff) + ldsw + _i * 8192), 16, 0, 0); } while (0)
#define PG8_LDA(dst, b, h) do { _Pragma("unroll") for (int m = 0; m < 4; ++m) { \
        if constexpr (FP8) dst##8[m] = pg8_cat8(*(const PG8_LAS bf16x8*)(lds + PG8_SA(b, h) + aoff + m * 2048), *(const PG8_LAS bf16x8*)(lds + PG8_SA(b, h) + aoff + m * 2048 + 1024)); \
        else { _Pragma("unroll") for (int k = 0; k < 2; ++k) dst[m][k] = *(const PG8_LAS bf16x8*)(lds + PG8_SA(b, h) + aoff + m * 2048 + k * 1024); } } } while (0)
#define PG8_LDB(dst, b, h) do { _Pragma("unroll") for (int n = 0; n < 2; ++n) { \
        if constexpr (FP8) dst##8[n] = pg8_cat8(*(const PG8_LAS bf16x8*)(lds + PG8_SB(b, h) + boff + n * 2048), *(const PG8_LAS bf16x8*)(lds + PG8_SB(b, h) + boff + n * 2048 + 1024)); \
        else { _Pragma("unroll") for (int k = 0; k < 2; ++k) dst[n][k] = *(const PG8_LAS bf16x8*)(lds + PG8_SB(b, h) + boff + n * 2048 + k * 1024); } } } while (0)
#define PG8_MMA(ai, bj, At, Bt) do { __builtin_amdgcn_s_setprio(1); \
        if constexpr (FP8) { _Pragma("unroll") for (int m = 0; m < 4; ++m) _Pragma("unroll") for (int n = 0; n < 2; ++n) \
            asm volatile("v_mfma_f32_16x16x128_f8f6f4 %0, %1, %2, %0" : "+v"(acc[ai][bj][m][n]) : "v"(Bt##8[n]), "v"(At##8[m])); } \
        else { _Pragma("unroll") for (int m = 0; m < 4; ++m) _Pragma("unroll") for (int n = 0; n < 2; ++n) _Pragma("unroll") for (int k = 0; k < 2; ++k) \
            acc[ai][bj][m][n] = __builtin_amdgcn_mfma_f32_16x16x32_bf16(Bt[n][k], At[m][k], acc[ai][bj][m][n], 0, 0, 0); } \
        __builtin_amdgcn_s_setprio(0); } while (0)
#define PG8_WAIT_V(n) asm volatile("s_waitcnt vmcnt(" #n ")" ::: "memory")
#define PG8_WAIT_L(n) asm volatile("s_waitcnt lgkmcnt(" #n ")" ::: "memory")
#define PG8_BAR __builtin_amdgcn_s_barrier()
#define PG8_SCHED __builtin_amdgcn_sched_barrier(0)
    Unit cur, nxt; int ui = 0;
    if (!S.next(0, cur)) return;
    f32x4 acc[2][2][4][2];
#pragma unroll
    for (int a = 0; a < 2; ++a)
#pragma unroll
        for (int b = 0; b < 2; ++b)
#pragma unroll
            for (int m = 0; m < 4; ++m)
#pragma unroll
                for (int n = 0; n < 2; ++n) acc[a][b][m][n] = (f32x4){0.f, 0.f, 0.f, 0.f};
    bf16x8 At[4][2], B0[2][2], B1[2][2];
    pg8_v8i At8[4], B08[2], B18[2];
    const char* cA = (const char*)g.A + (size_t)cur.pm * tstep; const char* cB = (const char*)g.Bt + (size_t)cur.pn * tstep;
    S.a_ready(cur);
    if constexpr (SP2) {
        PG8_STAGE(PG8_SB(0, 0), cB, voffB); PG8_STAGE(PG8_SB(0, 1), cB + hstep, voffB); PG8_STAGE(PG8_SA(0, 0), cA, voffA); PG8_STAGE(PG8_SA(0, 1), cA + hstep, voffA);
        if (wr == 1) PG8_BAR;
        PG8_WAIT_V(2); PG8_BAR;
        PG8_STAGE(PG8_SB(1, 0), cB + kstep, voffB); PG8_STAGE(PG8_SA(1, 0), cA + kstep, voffA); PG8_STAGE(PG8_SB(1, 1), cB + hstep + kstep, voffB);
        PG8_WAIT_V(6); PG8_BAR;
    } else {
        PG8_STAGE(PG8_SB(0, 0), cB, voffB); PG8_STAGE(PG8_SA(0, 0), cA, voffA); PG8_STAGE(PG8_SB(0, 1), cB + hstep, voffB); PG8_STAGE(PG8_SA(0, 1), cA + hstep, voffA);
        if (wr == 1) PG8_BAR;
        PG8_WAIT_V(4); PG8_BAR;
        PG8_STAGE(PG8_SB(1, 0), cB + kstep, voffB); PG8_STAGE(PG8_SA(1, 0), cA + kstep, voffA); PG8_STAGE(PG8_SB(1, 1), cB + hstep + kstep, voffB);
        PG8_WAIT_V(6); PG8_BAR;
    }
    for (;;) {
        const bool has_next = S.next(ui + 1, nxt);
        const char* nA = has_next ? (const char*)g.A + (size_t)nxt.pm * tstep : cA; const char* nB = has_next ? (const char*)g.Bt + (size_t)nxt.pn * tstep : cB;
        for (int t = 0; t < nt; t += 2) {
            const bool last = (t == nt - 2);
            const char* a1 = cA + (size_t)(t + 1) * kstep;
            const char* a2 = last ? nA : cA + (size_t)(t + 2) * kstep; const char* b2 = last ? nB : cB + (size_t)(t + 2) * kstep;
            const char* a3 = a2 + kstep; const char* b3 = b2 + kstep;
            if (last && has_next) S.a_ready(nxt);
            if constexpr (SP2) {
            PG8_LDB(B0, 0, 0); PG8_LDB(B1, 0, 1); PG8_SCHED; PG8_LDA(At, 0, 0); PG8_STAGE(PG8_SA(1, 1), a1 + hstep, voffA);
            PG8_WAIT_V(8); PG8_WAIT_L(0); PG8_BAR; PG8_MMA(0, 0, At, B0); PG8_MMA(0, 1, At, B1); PG8_BAR; PG8_SCHED;
            PG8_LDA(At, 0, 1); PG8_STAGE(PG8_SB(0, 0), b2, voffB); PG8_STAGE(PG8_SB(0, 1), b2 + hstep, voffB); PG8_STAGE(PG8_SA(0, 0), a2, voffA);
            PG8_WAIT_V(8); PG8_WAIT_L(0); PG8_BAR; PG8_MMA(1, 0, At, B0); PG8_MMA(1, 1, At, B1); PG8_BAR; PG8_SCHED;
            PG8_LDB(B0, 1, 0); PG8_LDB(B1, 1, 1); PG8_SCHED; PG8_LDA(At, 1, 0); PG8_STAGE(PG8_SA(0, 1), a2 + hstep, voffA);
            PG8_WAIT_V(8); PG8_WAIT_L(0); PG8_BAR; PG8_MMA(0, 0, At, B0); PG8_MMA(0, 1, At, B1); PG8_BAR; PG8_SCHED;
            PG8_LDA(At, 1, 1); PG8_STAGE(PG8_SB(1, 0), b3, voffB); PG8_STAGE(PG8_SB(1, 1), b3 + hstep, voffB); PG8_STAGE(PG8_SA(1, 0), a3, voffA);
            PG8_WAIT_V(8); PG8_WAIT_L(0); PG8_BAR; PG8_MMA(1, 0, At, B0); PG8_MMA(1, 1, At, B1); PG8_BAR; PG8_SCHED;
            } else {
            PG8_LDB(B0, 0, 0); PG8_SCHED; PG8_LDA(At, 0, 0); PG8_STAGE(PG8_SA(1, 1), a1 + hstep, voffA);
            PG8_WAIT_L(8); PG8_BAR; PG8_WAIT_L(0); PG8_MMA(0, 0, At, B0); PG8_BAR; PG8_SCHED;
            PG8_LDB(B1, 0, 1); PG8_STAGE(PG8_SB(0, 0), b2, voffB);
            PG8_BAR; PG8_WAIT_L(0); PG8_MMA(0, 1, At, B1); PG8_BAR;
            PG8_LDA(At, 0, 1); PG8_STAGE(PG8_SA(0, 0), a2, voffA);
            PG8_BAR; PG8_WAIT_L(0); PG8_MMA(1, 0, At, B0); PG8_BAR; PG8_SCHED;
            PG8_STAGE(PG8_SB(0, 1), b2 + hstep, voffB);
            PG8_WAIT_V(6); PG8_BAR; PG8_MMA(1, 1, At, B1); PG8_BAR;
            PG8_LDB(B0, 1, 0); PG8_SCHED; PG8_LDA(At, 1, 0); PG8_STAGE(PG8_SA(0, 1), a2 + hstep, voffA);
            PG8_WAIT_L(8); PG8_BAR; PG8_WAIT_L(0); PG8_MMA(0, 0, At, B0); PG8_BAR; PG8_SCHED;
            PG8_LDB(B1, 1, 1); PG8_STAGE(PG8_SB(1, 0), b3, voffB);
            PG8_BAR; PG8_WAIT_L(0); PG8_MMA(0, 1, At, B1); PG8_BAR;
            PG8_LDA(At, 1, 1); PG8_STAGE(PG8_SA(1, 0), a3, voffA);
            PG8_BAR; PG8_WAIT_L(0); PG8_MMA(1, 0, At, B0); PG8_BAR; PG8_SCHED;
            PG8_STAGE(PG8_SB(1, 1), b3 + hstep, voffB);
            PG8_WAIT_V(6); PG8_BAR; PG8_MMA(1, 1, At, B1); PG8_BAR;
            }
        }
        if constexpr (ALIGN_EPI) { if (wr == 0) PG8_BAR; }
        if constexpr (!Epi::AFTER_DRAIN) { E(acc, cur, wr, wc, fr, fq); S.done(cur); }
        if (!has_next) break;
#pragma unroll
        for (int a = 0; a < 2; ++a)
#pragma unroll
            for (int b = 0; b < 2; ++b)
#pragma unroll
                for (int m = 0; m < 4; ++m)
#pragma unroll
                    for (int n = 0; n < 2; ++n) acc[a][b][m][n] = (f32x4){0.f, 0.f, 0.f, 0.f};
        cur = nxt; cA = nA; cB = nB; ++ui;
        if constexpr (ALIGN_EPI) { if (wr == 1) PG8_BAR; }
    }
    PG8_WAIT_V(0);
    if constexpr (!ALIGN_EPI) { if (wr == 0) PG8_BAR; }
    PG8_BAR;
    if constexpr (Epi::AFTER_DRAIN) { E.fused(acc, cur, wr, wc, fr, fq, lds, wid, lane); S.done(cur); }
#undef PG8_SA
#undef PG8_SB
#undef PG8_STAGE
#undef PG8_LDA
#undef PG8_LDB
#undef PG8_MMA
#undef PG8_WAIT_V
#undef PG8_WAIT_L
#undef PG8_BAR
#undef PG8_SCHED
}
}

#define DI __device__ __forceinline__
#ifndef PROBE
#define PROBE 0
#endif
#define LAS __attribute__((address_space(3)))
typedef unsigned short bf16_t;
typedef short bf16x8 __attribute__((ext_vector_type(8)));
typedef short s16x4 __attribute__((ext_vector_type(4)));
typedef float f32x4 __attribute__((ext_vector_type(4)));
typedef float f32x2 __attribute__((ext_vector_type(2)));
typedef float f32x16 __attribute__((ext_vector_type(16)));
typedef unsigned u32x4 __attribute__((ext_vector_type(4)));
typedef unsigned u32x2 __attribute__((ext_vector_type(2)));

constexpr int NB = 8, SEQ = 4096, DM = 1024, NTOK = NB * SEQ, NH = 8, HD = 64;
constexpr int QKVW = 1536, PBW = 1824, N1A = 3584, N1A_REAL = 3360, NGATE = 2048, W1ROWS = 5632;
constexpr int G1B_EARLY = 512;
constexpr int NEXP = 16384;
constexpr float RMS_EPS = 1e-6f, GN_EPS = 64e-5f;
constexpr float LOG2E = 1.4426950408889634f;
constexpr int NTHREADS = 512, NWAVES = 8;
constexpr int LDS_BYTES = 148480;
constexpr int LDS_MISC = 147968;

constexpr size_t MiB = 1u << 20;
constexpr size_t WS_W1T = 1 * MiB;
constexpr size_t WS_WPA = 12 * MiB;
constexpr size_t WS_WPB = 13 * MiB;
constexpr size_t WS_WO = 14 * MiB;
constexpr size_t WS_WQ = 16 * MiB;
constexpr size_t WS_SK = 20 * MiB;
constexpr size_t WS_KBAR = 20 * MiB + 512 * 1024;
constexpr size_t WS_SEL = 21 * MiB;
constexpr size_t WS_LWT = 21 * MiB + 512 * 1024;
constexpr size_t WS_XN = 22 * MiB;
constexpr size_t WS_QKV = 86 * MiB;
constexpr size_t WS_PB = 182 * MiB;
constexpr size_t WS_SCAN = 296 * MiB;
constexpr size_t WS_OA = 182 * MiB;
constexpr size_t WS_OBRAW = 262 * MiB;
constexpr size_t WS_OB = 86 * MiB;
constexpr size_t WS_GATES = 296 * MiB;
constexpr size_t WS_U8 = 488 * MiB;
constexpr size_t WS_V8 = 500 * MiB;
constexpr size_t WS_ROWSQ = 497 * MiB;
constexpr size_t WS_RS = 499 * MiB;
constexpr size_t WS_H1B = 344 * MiB;
constexpr size_t WS_WG8 = 509 * MiB;
constexpr size_t WS_WG8SC = 511 * MiB;
constexpr size_t DO_XN8 = 0;
constexpr size_t DO_GEARLY = 112 * MiB;
constexpr size_t WS_USC = 256 * 1024;
constexpr size_t WS_VSC = 384 * 1024;
constexpr size_t WS_Y = 118 * MiB;
constexpr size_t WS_QP = 182 * MiB;
constexpr size_t WS_PIDX = 310 * MiB;
constexpr size_t WS_PGATE = 326 * MiB;
constexpr size_t WS_NEED = 512 * MiB;
constexpr size_t DO_VT = 0, DO_RG = 32 * MiB, DO_KF = 64 * MiB;

struct Params {
    const float* x; const float* norm1_g; const float* w_in; const float* rwkv_mu; const float* w0; const float* w_lora_up;
    const float* a0; const float* a_lora_up; const float* g_lora_up; const float* k_k; const float* k_a; const float* r_k;
    const float* lnx_g; const float* lnx_b; const float* w_proj_a; const float* w_proj_b; const float* w_out; const float* norm2_g;
    const float* peer_wq; const float* peer_subkeys; const float* peer_u; const float* peer_v; const float* rel_bias; const float* normf_g;
    float* out; unsigned char* ws;
};

DI float bflo(unsigned u) { return __uint_as_float(u << 16); }
DI float bfhi(unsigned u) { return __uint_as_float(u & 0xffff0000u); }
DI float bf2f(bf16_t h) { return __uint_as_float((unsigned)h << 16); }
DI unsigned pk2(float lo, float hi) {
    typedef __bf16 b2 __attribute__((ext_vector_type(2)));
    f32x2 v = {lo, hi}; b2 b = __builtin_convertvector(v, b2); return __builtin_bit_cast(unsigned, b);
}
DI bf16_t f2bf(float f) { return (bf16_t)(pk2(f, 0.f) & 0xffffu); }
DI u32x4 pack8(f32x4 a, f32x4 b) { u32x4 w; w.x = pk2(a[0], a[1]); w.y = pk2(a[2], a[3]); w.z = pk2(b[0], b[1]); w.w = pk2(b[2], b[3]); return w; }
DI void unpack8(u32x4 w, float (&f)[8]) {
    f[0] = bflo(w.x); f[1] = bfhi(w.x); f[2] = bflo(w.y); f[3] = bfhi(w.y); f[4] = bflo(w.z); f[5] = bfhi(w.z); f[6] = bflo(w.w); f[7] = bfhi(w.w);
}
template <int CTRL> DI float dpp_mov(float x) { return __builtin_bit_cast(float, __builtin_amdgcn_update_dpp(0, __builtin_bit_cast(int, x), CTRL, 0xf, 0xf, false)); }
DI float row16_sum(float x) {
    x += dpp_mov<0x128>(x); x += dpp_mov<0x124>(x); x += dpp_mov<0x122>(x); x += dpp_mov<0x121>(x); return x;
}
DI float wave_sum(float v) {
    v = row16_sum(v);
    const float a = __builtin_bit_cast(float, __builtin_amdgcn_readlane(__builtin_bit_cast(int, v), 0)), b = __builtin_bit_cast(float, __builtin_amdgcn_readlane(__builtin_bit_cast(int, v), 16));
    const float c = __builtin_bit_cast(float, __builtin_amdgcn_readlane(__builtin_bit_cast(int, v), 32)), d = __builtin_bit_cast(float, __builtin_amdgcn_readlane(__builtin_bit_cast(int, v), 48));
    return (a + b) + (c + d);
}
DI float vmul_(float a, float b) { float d; asm("v_mul_f32 %0, %1, %2" : "=v"(d) : "v"(a), "v"(b)); return d; }
DI float vfma_(float a, float b, float c) { float d; asm("v_fma_f32 %0, %1, %2, %3" : "=v"(d) : "v"(a), "v"(b), "v"(c)); return d; }
DI float vfnma_(float a, float b, float c) { float d; asm("v_fma_f32 %0, -%1, %2, %3" : "=v"(d) : "v"(a), "v"(b), "v"(c)); return d; }
DI float sigmoidf_(float x) { return __builtin_amdgcn_rcpf(1.0f + __expf(-x)); }
DI int crow(int r, int hi) { return (r & 3) + 8 * (r >> 2) + 4 * hi; }
#define MFMA32(a, b, c) __builtin_amdgcn_mfma_f32_32x32x16_bf16((a), (b), (c), 0, 0, 0)
#define LDS_WAIT() asm volatile("s_waitcnt lgkmcnt(0)" ::: "memory")

#define XB_TMO      128
#define XB_XCNT(j)  (256  + 64 * (j))
#define XB_XSUB(j)  (1280 + 64 * (j))
#define XB_XGEN(j)  (2304 + 64 * (j))
#define XB_TOP      3328
#define XB_TOPGEN   3392
#define XCD_BAR_WORDS 3456
#define XB_SPIN_CAP (1u << 22)

__device__ __forceinline__ unsigned xb_ld(unsigned* p)              { return __hip_atomic_load(p, __ATOMIC_RELAXED, __HIP_MEMORY_SCOPE_AGENT); }
__device__ __forceinline__ unsigned xb_add(unsigned* p, unsigned v) { return __hip_atomic_fetch_add(p, v, __ATOMIC_RELAXED, __HIP_MEMORY_SCOPE_AGENT); }
__device__ __forceinline__ unsigned xb_xcc_id() { return (unsigned)__builtin_amdgcn_s_getreg((3 << 11) | 20) & 0xFu; }
#define XB_SPIN(cond, bar) do { unsigned _sp = 0; while (cond) { __builtin_amdgcn_s_sleep(1); \
    if ((++_sp & 255u) == 0u) { if (xb_ld(&(bar)[XB_TMO])) break; if (_sp > XB_SPIN_CAP) { atomicAdd(&(bar)[XB_TMO], 1u); break; } } } } while (0)

struct XcdBarrier {
    unsigned* bar; unsigned x;
    volatile LAS unsigned* st;
};

__device__ __forceinline__ XcdBarrier xcd_barrier_post(unsigned* bar, volatile LAS unsigned* st) {
    XcdBarrier b; b.bar = bar; b.x = xb_xcc_id(); b.st = st;
    if (threadIdx.x == 0) (void)xb_add(&bar[XB_XCNT(b.x)], 1u);
    return b;
}
__device__ __forceinline__ void xcd_barrier_complete(unsigned* bar, unsigned x, unsigned& nloc, unsigned& nx) {
    const unsigned G = gridDim.x * gridDim.y * gridDim.z;
    unsigned sum, cnt, mine, sp = 0u;
    for (;;) {
        sum = 0u; cnt = 0u; mine = 0u;
#pragma unroll
        for (unsigned j = 0; j < 16; ++j) { const unsigned c = xb_ld(&bar[XB_XCNT(j)]); sum += c; cnt += (c > 0u) ? 1u : 0u; mine = (j == x) ? c : mine; }
        if (sum == G) break;
        __builtin_amdgcn_s_sleep(1);
        if ((++sp & 255u) == 0u) { if (xb_ld(&bar[XB_TMO])) break; if (sp > XB_SPIN_CAP) { atomicAdd(&bar[XB_TMO], 1u); break; } }
    }
    nloc = mine > 0u ? mine : 1u; nx = cnt > 0u ? cnt : 1u;
}

__device__ __forceinline__ void xcd_barrier(const XcdBarrier& b) {
    asm volatile("s_waitcnt vmcnt(0)" ::: "memory");
    __syncthreads();
    if (threadIdx.x == 0) {
        unsigned* bar = b.bar;
        __builtin_amdgcn_s_waitcnt(0);
        unsigned nloc = b.st[0], nx = b.st[1];
        if (nloc == 0u) { xcd_barrier_complete(bar, b.x, nloc, nx); b.st[0] = nloc; b.st[1] = nx; }
        const unsigned old = xb_add(&bar[XB_XSUB(b.x)], 1u);
        const unsigned gen = old / nloc;
        if (old + 1u == (gen + 1u) * nloc) {
            __builtin_amdgcn_fence(__ATOMIC_RELEASE, "agent");
            asm volatile("s_waitcnt vmcnt(0)" ::: "memory");
            const unsigned og = xb_add(&bar[XB_TOP], 1u);
            const unsigned tg = og / nx;
            if (og + 1u == (tg + 1u) * nx) xb_add(&bar[XB_TOPGEN], 1u);
            else XB_SPIN(xb_ld(&bar[XB_TOPGEN]) == tg, bar);
            __builtin_amdgcn_fence(__ATOMIC_ACQUIRE, "agent");
            xb_add(&bar[XB_XGEN(b.x)], 1u);
            asm volatile("s_waitcnt vmcnt(0)" ::: "memory");
        } else {
            XB_SPIN(xb_ld(&bar[XB_XGEN(b.x)]) == gen, bar);
            __builtin_amdgcn_fence(__ATOMIC_ACQUIRE, "agent");
            asm volatile("s_waitcnt vmcnt(0)" ::: "memory");
        }
    }
    __syncthreads();
}


template <class F> struct EpiF {
    static constexpr bool PERM = true, AFTER_DRAIN = false; F f;
    DI void operator()(const pg8::f32x4 (&acc)[2][2][4][2], const pg8::Unit& u, int wr, int wc, int fr, int fq) const {
        const int row0 = u.pm * 256 + wr * 64 + fr, col0 = u.pn * 256 + wc * 32 + 8 * fq;
        const typename F::Tile tl = f.tile(col0);
#pragma unroll
        for (int ai = 0; ai < 2; ++ai) {
            typename F::Pre pre[4][2];
#pragma unroll
            for (int m = 0; m < 4; ++m)
#pragma unroll
                for (int bj = 0; bj < 2; ++bj) pre[m][bj] = f.load(row0 + ai * 128 + m * 16, col0 + bj * 128);
#pragma unroll
            for (int m = 0; m < 4; ++m) {
                float s = 0.f;
#pragma unroll
                for (int bj = 0; bj < 2; ++bj) s += f.apply(row0 + ai * 128 + m * 16, col0 + bj * 128, acc[ai][bj][m][0], acc[ai][bj][m][1], pre[m][bj], tl, bj);
                f.row_end(row0 + ai * 128 + m * 16, s, fq, u.pn * 4 + wc);
            }
        }
    }
};
template <class F> DI void run_gemm(LAS unsigned char* lds, const bf16_t* A, const bf16_t* Bt, int N, int K, const F& f) {
    pg8::Gemm g{A, Bt, NTOK, N, K}; pg8::StaticOrder S; S.init(NTOK, N, (int)gridDim.x, (int)blockIdx.x); EpiF<F> E{f};
    pg8::gemm_phase<EpiF<F>, pg8::StaticOrder, true, true>(lds, g, S, E);
}
template <class F> DI void run_gemm_on(LAS unsigned char* lds, const bf16_t* A, const bf16_t* Bt, int N, int K, const F& f, int nblocks, int myblock) {
    pg8::Gemm g{A, Bt, NTOK, N, K}; pg8::StaticOrder S; S.init(NTOK, N, nblocks, myblock); EpiF<F> E{f};
    pg8::gemm_phase<EpiF<F>, pg8::StaticOrder, true, true>(lds, g, S, E);
}
template <class F> DI void run_gemm8(LAS unsigned char* lds, const unsigned char* A8, const unsigned char* Bt8, int N, int K8, const F& f) {
    pg8::Gemm g{(const bf16_t*)A8, (const bf16_t*)Bt8, NTOK, N, K8 / 2}; pg8::StaticOrder S; S.init(NTOK, N, (int)gridDim.x, (int)blockIdx.x); EpiF<F> E{f};
    pg8::gemm_phase<EpiF<F>, pg8::StaticOrder, true, true, true>(lds, g, S, E);
}
template <class F> DI void run_gemm8_on(LAS unsigned char* lds, const unsigned char* A8, const unsigned char* Bt8, int N, int K8, const F& f, int nblocks, int myblock) {
    pg8::Gemm g{(const bf16_t*)A8, (const bf16_t*)Bt8, NTOK, N, K8 / 2}; pg8::StaticOrder S; S.init(NTOK, N, nblocks, myblock); EpiF<F> E{f};
    pg8::gemm_phase<EpiF<F>, pg8::StaticOrder, true, true, true>(lds, g, S, E);
}
struct NoPre {}; struct NoTile {};
#define EPI_PLAIN typedef NoTile Tile; DI Tile tile(int) const { return Tile{}; } DI void row_end(int, float, int, int) const {}
struct F1a { bf16_t* qkv; bf16_t* pb; typedef NoPre Pre;
    DI Pre load(int, int) const { return Pre{}; }
    EPI_PLAIN
    DI float apply(int row, int col, f32x4 v0, f32x4 v1, Pre, Tile, int) const {
        const u32x4 w = pack8(v0, v1);
        if (col < QKVW) *(u32x4*)(qkv + (size_t)row * QKVW + col) = w;
        else if (col < N1A_REAL) *(u32x4*)(pb + (size_t)row * PBW + (col - QKVW)) = w;
        return 0.f;
    } };
constexpr int GL_STRIDE = 768;
DI const unsigned char* gate_ptr(const unsigned char* ws, const float* dout, int row, int gcol) {
    if (gcol < G1B_EARLY) return (const unsigned char*)dout + DO_GEARLY + (size_t)row * G1B_EARLY + gcol;
    if (gcol < G1B_EARLY + GL_STRIDE) return ws + 214 * MiB + (size_t)row * GL_STRIDE + (gcol - G1B_EARLY);
    return (const unsigned char*)dout + 64 * MiB + (size_t)row * GL_STRIDE + (gcol - G1B_EARLY - GL_STRIDE);
}
DI u32x4 gates8_to_bf16(u32x2 w) {
    const float k = 1.f / 255.f;
    return (u32x4){pk2((float)(w.x & 255u) * k, (float)((w.x >> 8) & 255u) * k), pk2((float)((w.x >> 16) & 255u) * k, (float)(w.x >> 24) * k),
                   pk2((float)(w.y & 255u) * k, (float)((w.y >> 8) & 255u) * k), pk2((float)((w.y >> 16) & 255u) * k, (float)(w.y >> 24) * k)};
}
struct F1b { unsigned char* ws; float* dout; int col0; const signed char* sc; typedef NoPre Pre; struct Tile { u32x2 e[2]; };
    DI Tile tile(int c0) const { Tile t;
#pragma unroll
        for (int bj = 0; bj < 2; ++bj) t.e[bj] = *(const u32x2*)(sc + col0 + c0 + bj * 128);
        return t; }
    DI Pre load(int, int) const { return Pre{}; }
    DI void row_end(int, float, int, int) const {}
    DI float apply(int row, int col, f32x4 v0, f32x4 v1, Pre, const Tile& tl, int bj) const {
        f32x4 a, b;
#pragma unroll
        for (int i = 0; i < 4; ++i) { a[i] = sigmoidf_(ldexpf(v0[i], (int)(signed char)(tl.e[bj].x >> (8 * i)))); b[i] = sigmoidf_(ldexpf(v1[i], (int)(signed char)(tl.e[bj].y >> (8 * i)))); }
        u32x2 w;
        w.x = (unsigned)(a[0] * 255.f + 0.5f) | ((unsigned)(a[1] * 255.f + 0.5f) << 8) | ((unsigned)(a[2] * 255.f + 0.5f) << 16) | ((unsigned)(a[3] * 255.f + 0.5f) << 24);
        w.y = (unsigned)(b[0] * 255.f + 0.5f) | ((unsigned)(b[1] * 255.f + 0.5f) << 8) | ((unsigned)(b[2] * 255.f + 0.5f) << 16) | ((unsigned)(b[3] * 255.f + 0.5f) << 24);
        *(u32x2*)const_cast<unsigned char*>(gate_ptr(ws, dout, row, col0 + col)) = w;
        return 0.f;
    } };
struct FPa { const unsigned char* ws; const float* dout; bf16_t* y; struct Pre { u32x2 g; };
    DI Pre load(int row, int col) const { return Pre{*(const u32x2*)gate_ptr(ws, dout, row, col)}; }
    EPI_PLAIN
    DI float apply(int row, int col, f32x4 v0, f32x4 v1, Pre pr, Tile, int) const {
        float g[8]; unpack8(gates8_to_bf16(pr.g), g);
        f32x4 a, b;
#pragma unroll
        for (int i = 0; i < 4; ++i) { a[i] = v0[i] * g[i]; b[i] = v1[i] * g[4 + i]; }
#if PROBE == 1
        a = (f32x4){0.f, 0.f, 0.f, 0.f}; b = a;
#endif
        *(u32x4*)(y + (size_t)row * DM + col) = pack8(a, b);
        return 0.f;
    } };
struct FPb { const unsigned char* ws; const float* dout; bf16_t* y; struct Pre { u32x2 g; u32x4 yv; };
    DI Pre load(int row, int col) const { return Pre{*(const u32x2*)gate_ptr(ws, dout, row, DM + col), *(const u32x4*)(y + (size_t)row * DM + col)}; }
    EPI_PLAIN
    DI float apply(int row, int col, f32x4 v0, f32x4 v1, Pre pr, Tile, int) const {
        float g[8]; unpack8(gates8_to_bf16(pr.g), g);
        float yo[8]; unpack8(pr.yv, yo);
        f32x4 a, b;
#pragma unroll
        for (int i = 0; i < 4; ++i) { a[i] = yo[i] + v0[i] * g[i]; b[i] = yo[4 + i] + v1[i] * g[4 + i]; }
#if PROBE == 2
#pragma unroll
        for (int i = 0; i < 4; ++i) { a[i] = yo[i]; b[i] = yo[4 + i]; }
#endif
        *(u32x4*)(y + (size_t)row * DM + col) = pack8(a, b);
        return 0.f;
    } };
struct FOut { const float* x; const float* g2; bf16_t* h1; bf16_t* xn; float* rowsq; struct Pre { f32x4 x0, x1; }; struct Tile { f32x4 g[2][2]; };
    DI Tile tile(int col0) const { Tile t;
#pragma unroll
        for (int bj = 0; bj < 2; ++bj) { t.g[bj][0] = *(const f32x4*)(g2 + col0 + bj * 128); t.g[bj][1] = *(const f32x4*)(g2 + col0 + bj * 128 + 4); }
        return t; }
    DI Pre load(int row, int col) const { const size_t o = (size_t)row * DM + col; return Pre{*(const f32x4*)(x + o), *(const f32x4*)(x + o + 4)}; }
    DI float apply(int row, int col, f32x4 v0, f32x4 v1, Pre pr, const Tile& tl, int bj) const {
        const size_t o = (size_t)row * DM + col;
        const f32x4 h0 = pr.x0 + v0, h1v = pr.x1 + v1;
        *(u32x4*)(h1 + o) = pack8(h0, h1v);
        *(u32x4*)(xn + o) = pack8(h0 * tl.g[bj][0], h1v * tl.g[bj][1]);
        return (h0[0] * h0[0] + h0[1] * h0[1] + h0[2] * h0[2] + h0[3] * h0[3]) + (h1v[0] * h1v[0] + h1v[1] * h1v[1] + h1v[2] * h1v[2] + h1v[3] * h1v[3]);
    }
    DI void row_end(int row, float s, int fq, int slot) const {
        s += __shfl_xor(s, 16); s += __shfl_xor(s, 32);
        if (fq == 0) rowsq[(size_t)row * 16 + slot] = s;
    } };
DI float row_rs(const float* rowsq, int row) {
    const f32x4 a = *(const f32x4*)(rowsq + (size_t)row * 16), b = *(const f32x4*)(rowsq + (size_t)row * 16 + 4), c = *(const f32x4*)(rowsq + (size_t)row * 16 + 8), d = *(const f32x4*)(rowsq + (size_t)row * 16 + 12);
    const float s = (((a[0] + a[1]) + (a[2] + a[3])) + ((b[0] + b[1]) + (b[2] + b[3]))) + (((c[0] + c[1]) + (c[2] + c[3])) + ((d[0] + d[1]) + (d[2] + d[3])));
    return rsqrtf(s * (1.f / DM) + RMS_EPS);
}
struct FQ { bf16_t* qp; typedef NoPre Pre;
    DI Pre load(int, int) const { return Pre{}; }
    EPI_PLAIN
    DI float apply(int row, int col, f32x4 v0, f32x4 v1, Pre, Tile, int) const {
        u32x4 w = pack8(v0, v1);
#if PROBE == 3
        w.x &= 0xfff8fff8u; w.y &= 0xfff8fff8u; w.z &= 0xfff8fff8u; w.w &= 0xfff8fff8u;
#endif
        *(u32x4*)(qp + (size_t)row * 2048 + col) = w; return 0.f; } };

DI void p0_transpose_item(const float* W, int K, int N, bf16_t* WT, int k0, int n0, int dst_row0, LAS float* scr, int lane) {
#pragma unroll 8
    for (int i = 0; i < 32; ++i) { const int kk = 2 * i + (lane >> 5); scr[kk * 33 + (lane & 31)] = W[(size_t)(k0 + kk) * N + n0 + (lane & 31)]; }
    LDS_WAIT(); asm volatile("" ::: "memory");
    const int c = lane & 7;
#pragma unroll
    for (int j = 0; j < 4; ++j) { const int n = (lane >> 3) + 8 * j; const LAS float* s = scr + (8 * c) * 33 + n;
        u32x4 o; o.x = pk2(s[0 * 33], s[1 * 33]); o.y = pk2(s[2 * 33], s[3 * 33]); o.z = pk2(s[4 * 33], s[5 * 33]); o.w = pk2(s[6 * 33], s[7 * 33]);
        *(u32x4*)(WT + (size_t)(dst_row0 + n) * K + k0 + 8 * c) = o; }
    LDS_WAIT(); asm volatile("" ::: "memory");
}
template <int NR> DI void rms_rows_to_bf16(const float* x, const float* g, bf16_t* o, int m0, int stride, int lane) {
    f32x4 v[NR][4];
#pragma unroll
    for (int r = 0; r < NR; ++r)
#pragma unroll
        for (int j = 0; j < 4; ++j) v[r][j] = *(const f32x4*)(x + (size_t)(m0 + r * stride) * DM + 4 * lane + 256 * j);
    f32x4 gg[4];
#pragma unroll
    for (int j = 0; j < 4; ++j) gg[j] = *(const f32x4*)(g + 4 * lane + 256 * j);
#pragma unroll
    for (int r = 0; r < NR; ++r) {
        float s = 0.f;
#pragma unroll
        for (int j = 0; j < 4; ++j) s += (v[r][j].x * v[r][j].x + v[r][j].y * v[r][j].y) + (v[r][j].z * v[r][j].z + v[r][j].w * v[r][j].w);
        const float rs = rsqrtf(wave_sum(s) * (1.f / DM) + RMS_EPS);
        bf16_t* orow = o + (size_t)(m0 + r * stride) * DM;
#pragma unroll
        for (int j = 0; j < 4; ++j) { u32x2 w; w.x = pk2(v[r][j].x * rs * gg[j].x, v[r][j].y * rs * gg[j].y); w.y = pk2(v[r][j].z * rs * gg[j].z, v[r][j].w * rs * gg[j].w);
            *(u32x2*)(orow + 4 * lane + 256 * j) = w; }
    }
}
DI void rms_all_rows(const float* x, const float* g, bf16_t* o, int lane, int wid) {
    const int gw = blockIdx.x * NWAVES + wid, NGW = gridDim.x * NWAVES;
    int m = gw;
    for (; m + 3 * NGW < NTOK; m += 4 * NGW) rms_rows_to_bf16<4>(x, g, o, m, NGW, lane);
    for (; m < NTOK; m += NGW) rms_rows_to_bf16<1>(x, g, o, m, NGW, lane);
}
DI void phase_prep(const Params& p, LAS unsigned char* lds, int tid, int lane, int wid) {
    unsigned char* ws = p.ws;
    bf16_t* W1T = (bf16_t*)(ws + WS_W1T);
    LAS float* scr = (LAS float*)(lds + wid * 16384);
    const int gw = blockIdx.x * NWAVES + wid, NGW = gridDim.x * NWAVES;
    constexpr int I_IN = 16 * 169, I_PA = 8 * 32, I_PB = 8 * 32, I_O = 16 * 32, I_Q = 16 * 64;
    constexpr int NITEMS = I_IN + I_PA + I_PB + I_O + I_Q;
    for (int it = gw; it < NITEMS; it += NGW) {
        int r = it;
        if (r < I_IN) { const int kb = r / 169, nb = r % 169, n0 = 32 * nb; const int dst = n0 < N1A_REAL ? n0 : n0 + (N1A - N1A_REAL);
            p0_transpose_item(p.w_in, 1024, 5408, W1T, 64 * kb, n0, dst, scr, lane); continue; } r -= I_IN;
        if (r < I_PA) { const int kb = r / 32, nb = r % 32; p0_transpose_item(p.w_proj_a, 512, 1024, (bf16_t*)(ws + WS_WPA), 64 * kb, 32 * nb, 32 * nb, scr, lane); continue; } r -= I_PA;
        if (r < I_PB) { const int kb = r / 32, nb = r % 32; p0_transpose_item(p.w_proj_b, 512, 1024, (bf16_t*)(ws + WS_WPB), 64 * kb, 32 * nb, 32 * nb, scr, lane); continue; } r -= I_PB;
        if (r < I_O) { const int kb = r / 32, nb = r % 32; p0_transpose_item(p.w_out, 1024, 1024, (bf16_t*)(ws + WS_WO), 64 * kb, 32 * nb, 32 * nb, scr, lane); continue; } r -= I_O;
        { const int kb = r / 64, nb = r % 64; p0_transpose_item(p.peer_wq, 1024, 2048, (bf16_t*)(ws + WS_WQ), 64 * kb, 32 * nb, 32 * nb, scr, lane); }
    }
    const int gt = blockIdx.x * NTHREADS + tid, NGT = gridDim.x * NTHREADS;
    { u32x4* z = (u32x4*)(W1T + (size_t)N1A_REAL * 1024); const u32x4 zero = {0u, 0u, 0u, 0u};
      for (int i = gt; i < (N1A - N1A_REAL) * 1024 / 8; i += NGT) z[i] = zero; }
    { bf16_t* SK = (bf16_t*)(ws + WS_SK);
      for (int i = gt; i < 16 * 128 * 128 / 8; i += NGT) { const f32x4 a = *(const f32x4*)(p.peer_subkeys + (size_t)i * 8), b = *(const f32x4*)(p.peer_subkeys + (size_t)i * 8 + 4);
          *(u32x4*)(SK + (size_t)i * 8) = pack8(a, b); } }
    { bf16_t* LWT = (bf16_t*)(ws + WS_LWT);
      for (int e = gt; e < 512 * 288; e += NGT) { const int c = e / 288, i = e - c * 288;
          const float v = i < 64 ? p.w_lora_up[i * 512 + c] : (i < 128 ? p.a_lora_up[(i - 64) * 512 + c] : p.g_lora_up[(i - 128) * 512 + c]);
          LWT[e] = f2bf(v); } }
    rms_all_rows(p.x, p.norm1_g, (bf16_t*)(ws + WS_XN), lane, wid);
}

DI void phase_wg8(const Params& p, int lane, int wid) {
    const bf16_t* WG = (const bf16_t*)(p.ws + WS_W1T) + (size_t)N1A * 1024;
    for (int n = blockIdx.x * NWAVES + wid; n < NGATE; n += gridDim.x * NWAVES) {
        const u32x4 w0 = *(const u32x4*)(WG + (size_t)n * 1024 + lane * 16), w1 = *(const u32x4*)(WG + (size_t)n * 1024 + lane * 16 + 8);
        float f[16]; { float t[8]; unpack8(w0, t);
#pragma unroll
            for (int i = 0; i < 8; ++i) f[i] = t[i];
            unpack8(w1, t);
#pragma unroll
            for (int i = 0; i < 8; ++i) f[8 + i] = t[i]; }
        float am = 0.f;
#pragma unroll
        for (int i = 0; i < 16; ++i) am = fmaxf(am, fabsf(f[i]));
#pragma unroll
        for (int o = 1; o < 64; o <<= 1) am = fmaxf(am, __shfl_xor(am, o));
        const int ke = (int)floorf(log2f(224.f / fmaxf(am, 1e-30f)));
        const float s = ldexpf(1.f, ke);
        u32x4 o8;
#pragma unroll
        for (int j = 0; j < 4; ++j) { int w = __builtin_amdgcn_cvt_pk_fp8_f32(f[4 * j] * s, f[4 * j + 1] * s, 0, false); w = __builtin_amdgcn_cvt_pk_fp8_f32(f[4 * j + 2] * s, f[4 * j + 3] * s, w, true); o8[j] = (unsigned)w; }
        *(u32x4*)(p.ws + WS_WG8 + (size_t)n * 1024 + lane * 16) = o8;
        if (lane == 0) ((signed char*)(p.ws + WS_WG8SC))[n] = (signed char)(-4 - ke);
    }
}
DI void xn8_convert(const Params& p, int lane, int gw, int NGW) {
    const bf16_t* XN = (const bf16_t*)(p.ws + WS_XN);
    unsigned char* X8 = (unsigned char*)p.out + DO_XN8;
    for (int r = gw; r < NTOK; r += NGW) {
        const u32x4 w0 = *(const u32x4*)(XN + (size_t)r * 1024 + lane * 16), w1 = *(const u32x4*)(XN + (size_t)r * 1024 + lane * 16 + 8);
        float f[16]; { float t[8]; unpack8(w0, t);
#pragma unroll
            for (int i = 0; i < 8; ++i) f[i] = t[i] * 16.f;
            unpack8(w1, t);
#pragma unroll
            for (int i = 0; i < 8; ++i) f[8 + i] = t[i] * 16.f; }
        u32x4 o8;
#pragma unroll
        for (int j = 0; j < 4; ++j) { int w = __builtin_amdgcn_cvt_pk_fp8_f32(f[4 * j], f[4 * j + 1], 0, false); w = __builtin_amdgcn_cvt_pk_fp8_f32(f[4 * j + 2], f[4 * j + 3], w, true); o8[j] = (unsigned)w; }
        *(u32x4*)(X8 + (size_t)r * 1024 + lane * 16) = o8;
    }
}
DI void phase_kbar_vt(const Params& p, LAS unsigned char* lds, int tid, int lane, int wid) {
    unsigned char* ws = p.ws;
    const bf16_t* QKV = (const bf16_t*)(ws + WS_QKV);
    float* KBAR = (float*)(ws + WS_KBAR);
    const int gw = blockIdx.x * NWAVES + wid, NGW = gridDim.x * NWAVES;
    for (int it = gw; it < NB * NH * 16; it += NGW) {
        const int blk = it & 15, h = (it >> 4) & 7, b = it >> 7;
        const int dp = lane & 31, tp = lane >> 5;
        const bf16_t* base = QKV + ((size_t)(b * SEQ + blk * 256)) * QKVW + 512 + h * 64 + 2 * dp;
        float a0 = 0.f, a1 = 0.f;
#pragma unroll 16
        for (int t = tp; t < 256; t += 2) { const unsigned u = *(const unsigned*)(base + (size_t)t * QKVW); a0 += bflo(u); a1 += bfhi(u); }
        a0 += __shfl_xor(a0, 32); a1 += __shfl_xor(a1, 32);
        if (tp == 0) { KBAR[(size_t)it * 64 + 2 * dp] = a0 * (1.f / 256.f); KBAR[(size_t)it * 64 + 2 * dp + 1] = a1 * (1.f / 256.f); }
    }
    LAS bf16_t* tile = (LAS bf16_t*)(lds + wid * 16384);
    unsigned char* KF = (unsigned char*)p.out + DO_KF; unsigned char* VF = (unsigned char*)p.out + DO_VT;
    const int r32 = lane & 31, hi = lane >> 5;
    for (int it = gw; it < NB * NH * 64; it += NGW) {
        const int st = it & 63, bh = it >> 6, b = bh >> 3, h = bh & 7;
        const bf16_t* krow = QKV + ((size_t)(b * SEQ + st * 64 + r32)) * QKVW + 512 + h * 64 + 8 * hi;
        unsigned char* kdst = KF + ((size_t)it * 8) * 1024 + lane * 16;
#pragma unroll
        for (int f = 0; f < 8; ++f) *(u32x4*)(kdst + f * 1024) = *(const u32x4*)(krow + (size_t)(32 * (f & 1)) * QKVW + 16 * (f >> 1));
        const bf16_t* src = QKV + ((size_t)(b * SEQ + st * 64 + lane)) * QKVW + 1024 + h * 64;
#pragma unroll
        for (int c = 0; c < 8; ++c) *(LAS u32x4*)(tile + lane * 72 + c * 8) = *(const u32x4*)(src + c * 8);
        LDS_WAIT(); asm volatile("" ::: "memory");
        unsigned char* vdst = VF + ((size_t)it * 8) * 1024 + lane * 16;
#pragma unroll
        for (int f = 0; f < 8; ++f) {
            const int dt = f >> 2, sx = f & 3, d = 32 * dt + r32, k0 = 16 * sx + 4 * hi;
            u32x4 w;
            w.x = (unsigned)tile[(k0 + 0) * 72 + d] | ((unsigned)tile[(k0 + 1) * 72 + d] << 16);
            w.y = (unsigned)tile[(k0 + 2) * 72 + d] | ((unsigned)tile[(k0 + 3) * 72 + d] << 16);
            w.z = (unsigned)tile[(k0 + 8) * 72 + d] | ((unsigned)tile[(k0 + 9) * 72 + d] << 16);
            w.w = (unsigned)tile[(k0 + 10) * 72 + d] | ((unsigned)tile[(k0 + 11) * 72 + d] << 16);
            *(u32x4*)(vdst + f * 1024) = w;
        }
        LDS_WAIT(); asm volatile("" ::: "memory");
    }
}

DI float softplusf_(float x) { return fmaxf(x, 0.f) + log1pf(__expf(-fabsf(x))); }
DI void phase_rwkv_prep(const Params& p, LAS unsigned char* lds, int tid, int lane, int wid) {
    unsigned char* ws = p.ws;
    const bf16_t* PB = (const bf16_t*)(ws + WS_PB);
    bf16_t* SCAN = (bf16_t*)(ws + WS_SCAN);
    bf16_t* RG = (bf16_t*)((unsigned char*)p.out + DO_RG);
    LAS float* xs = (LAS float*)lds;
    const int c = tid, h = wid, j = lane;
    const float mu_r = p.rwkv_mu[c], mu_k = p.rwkv_mu[512 + c], mu_v = p.rwkv_mu[1024 + c];
    const float w0c = p.w0[c], a0c = p.a0[c], kkc = p.k_k[c], kac = p.k_a[c];
    for (int tt = blockIdx.x; tt < NTOK / 32; tt += gridDim.x) {
        const int t0 = tt * 32;
        __syncthreads();
        for (int e = tid; e < 32 * 288; e += NTHREADS) {
            const int t = e / 288, i = e - t * 288, tok = t0 + t, col = 1536 + i;
            const float cur = bf2f(PB[(size_t)tok * PBW + col]);
            const float prv = (tok & (SEQ - 1)) ? bf2f(PB[(size_t)(tok - 1) * PBW + col]) : 0.f;
            float v = cur + p.rwkv_mu[col] * (prv - cur);
            if (i < 64) v = tanhf(v); else if (i >= 128) v = sigmoidf_(v);
            xs[i * 36 + t] = v;
        }
        __syncthreads();
        float wl[32], al[32], gl[32];
#pragma unroll
        for (int t = 0; t < 32; ++t) { wl[t] = 0.f; al[t] = 0.f; gl[t] = 0.f; }
        for (int i = 0; i < 64; ++i) {
            const float ww = p.w_lora_up[i * 512 + c], wa = p.a_lora_up[i * 512 + c];
#pragma unroll
            for (int t4 = 0; t4 < 8; ++t4) { const f32x4 xw = *(const LAS f32x4*)(xs + i * 36 + 4 * t4), xa = *(const LAS f32x4*)(xs + (64 + i) * 36 + 4 * t4);
#pragma unroll
                for (int q = 0; q < 4; ++q) { wl[4 * t4 + q] += ww * xw[q]; al[4 * t4 + q] += wa * xa[q]; } }
        }
        for (int i = 0; i < 160; ++i) {
            const float wg = p.g_lora_up[i * 512 + c];
#pragma unroll
            for (int t4 = 0; t4 < 8; ++t4) { const f32x4 xg = *(const LAS f32x4*)(xs + (128 + i) * 36 + 4 * t4);
#pragma unroll
                for (int q = 0; q < 4; ++q) gl[4 * t4 + q] += wg * xg[q]; }
        }
#pragma unroll
        for (int t = 0; t < 32; ++t) {
            const int tok = t0 + t, b = tok >> 12, s = tok & (SEQ - 1);
            const bf16_t* row = PB + (size_t)tok * PBW;
            float r = bf2f(row[c]), k = bf2f(row[512 + c]), v = bf2f(row[1024 + c]);
            float rp = 0.f, kp = 0.f, vp = 0.f;
            if (s) { const bf16_t* prow = row - PBW; rp = bf2f(prow[c]); kp = bf2f(prow[512 + c]); vp = bf2f(prow[1024 + c]); }
            r += mu_r * (rp - r); k += mu_k * (kp - k); v += mu_v * (vp - v);
            const float wv = w0c + wl[t];
            const float w = -softplusf_(-wv) - 0.5f;
            const float ew = __expf(w);
            const float omd = -expm1f(-ew);
            const float a = sigmoidf_(a0c + al[t]);
            const float kkv = k * kkc;
            const float nrm = sqrtf(wave_sum(kkv * kkv));
            const float kkn = kkv / fmaxf(nrm, 1e-12f);
            const float kmod = k * (1.f + (a - 1.f) * kac);
            const float bb = kkn * a;
            bf16_t* so = SCAN + ((size_t)((b * NH + h) * SEQ + s)) * 384 + j;
            so[0] = f2bf(omd); so[64] = f2bf(kkn); so[128] = f2bf(bb); so[192] = f2bf(kmod); so[256] = f2bf(r); so[320] = f2bf(v);
            RG[(size_t)tok * 512 + c] = f2bf(gl[t]);
        }
    }
}


DI float fast_tanh(float x) { const float e = __expf(2.f * x); return 1.f - 2.f / (e + 1.f); }
constexpr int RP_ACT = 0, RP_CONST = 19456, RP_TILE = 33792, RP_PITCH = 3080;
template <bool STORE> DI void phase_rwkv_prep2(const Params& p, LAS unsigned char* lds, int tid, int lane, int wid) {
    unsigned char* ws = p.ws;
    const bf16_t* PB = (const bf16_t*)(ws + WS_PB);
    const bf16_t* LWT = (const bf16_t*)(ws + WS_LWT);
    bf16_t* SCAN = (bf16_t*)(ws + WS_SCAN);
    bf16_t* RG = (bf16_t*)((unsigned char*)p.out + DO_RG);
    LAS bf16_t* act = (LAS bf16_t*)(lds + RP_ACT);
    LAS float* cst = (LAS float*)(lds + RP_CONST);
    LAS unsigned char* tile = lds + RP_TILE;
    const int r32 = lane & 31, hi = lane >> 5, h = wid;
    __syncthreads();
    cst[tid] = p.rwkv_mu[tid]; cst[512 + tid] = p.rwkv_mu[512 + tid]; cst[1024 + tid] = p.rwkv_mu[1024 + tid];
    cst[1536 + tid] = p.w0[tid]; cst[2048 + tid] = p.a0[tid]; cst[2560 + tid] = p.k_k[tid]; cst[3072 + tid] = p.k_a[tid];
    for (int tt = blockIdx.x; tt < NTOK / 32; tt += gridDim.x) {
        const int t0 = tt * 32;
        const bool first = (t0 & (SEQ - 1)) == 0;
        __syncthreads();
        u32x4 tw[13];
#pragma unroll
        for (int k = 0; k < 13; ++k) { const int e = tid + NTHREADS * k, row = e / 192, pc = e - row * 192;
            tw[k] = (u32x4){0u, 0u, 0u, 0u};
            if (e < 33 * 192 && !(first && row == 0)) tw[k] = *(const u32x4*)(PB + (size_t)(t0 - 1 + row) * PBW + pc * 8); }
#pragma unroll 3
        for (int e = tid; e < 32 * 144; e += NTHREADS) {
            const int t = e / 144, ip = e - t * 144, i = 2 * ip, tok = t0 + t, col = 1536 + i;
            const unsigned cu = *(const unsigned*)(PB + (size_t)tok * PBW + col);
            const unsigned pu = (tok & (SEQ - 1)) ? *(const unsigned*)(PB + (size_t)(tok - 1) * PBW + col) : 0u;
            const f32x2 mu = *(const f32x2*)(p.rwkv_mu + col);
            float v0 = bflo(cu), v1 = bfhi(cu);
            v0 += mu.x * (bflo(pu) - v0); v1 += mu.y * (bfhi(pu) - v1);
            if (i < 64) { v0 = fast_tanh(v0); v1 = fast_tanh(v1); } else if (i >= 128) { v0 = sigmoidf_(v0); v1 = sigmoidf_(v1); }
            *(LAS unsigned*)(act + t * 296 + i) = pk2(v0, v1);
        }
#pragma unroll
        for (int k = 0; k < 13; ++k) { const int e = tid + NTHREADS * k, row = e / 192, pc = e - row * 192;
            if (e < 33 * 192) { LAS unsigned char* d = tile + row * RP_PITCH + pc * 16;
                *(LAS u32x2*)d = (u32x2){tw[k].x, tw[k].y}; *(LAS u32x2*)(d + 8) = (u32x2){tw[k].z, tw[k].w}; } }
        __syncthreads();
        f32x16 Xw[2], Xa[2], Xg[2];
        const int prow_ch = 16 * ((r32 >> 2) & 1) + 4 * (r32 >> 3) + (r32 & 3);
#pragma unroll
        for (int ct = 0; ct < 2; ++ct) {
#pragma unroll
            for (int i = 0; i < 16; ++i) { Xw[ct][i] = 0.f; Xa[ct][i] = 0.f; Xg[ct][i] = 0.f; }
            const bf16_t* wrow = LWT + (size_t)(h * 64 + 32 * ct + prow_ch) * 288 + 8 * hi;
            const LAS bf16_t* arow = act + r32 * 296 + 8 * hi;
#pragma unroll
            for (int ks = 0; ks < 18; ++ks) {
                const bf16x8 a = *(const bf16x8*)(wrow + 16 * ks);
                const bf16x8 b = *(const LAS bf16x8*)(arow + 16 * ks);
                if (ks < 4) Xw[ct] = MFMA32(a, b, Xw[ct]); else if (ks < 8) Xa[ct] = MFMA32(a, b, Xa[ct]); else Xg[ct] = MFMA32(a, b, Xg[ct]);
            }
        }
        const int tok = t0 + r32, bb_ = tok >> 12, s = tok & (SEQ - 1);
        if (STORE) {
#pragma unroll
            for (int ct = 0; ct < 2; ++ct) { bf16_t* rgp = RG + (size_t)tok * 512 + h * 64 + 32 * ct + 16 * hi;
                *(u32x4*)rgp = (u32x4){pk2(Xg[ct][0], Xg[ct][1]), pk2(Xg[ct][2], Xg[ct][3]), pk2(Xg[ct][4], Xg[ct][5]), pk2(Xg[ct][6], Xg[ct][7])};
                *(u32x4*)(rgp + 8) = (u32x4){pk2(Xg[ct][8], Xg[ct][9]), pk2(Xg[ct][10], Xg[ct][11]), pk2(Xg[ct][12], Xg[ct][13]), pk2(Xg[ct][14], Xg[ct][15])}; }
        }
        const LAS unsigned char* prow = tile + r32 * RP_PITCH;
        bf16_t* so = SCAN + ((size_t)((bb_ * NH + h) * SEQ + s)) * 384;
        unsigned kka[32]; float ss = 0.f;
#pragma unroll
        for (int ct = 0; ct < 2; ++ct) {
            const int j0 = 32 * ct + 16 * hi, c0 = h * 64 + j0;
#pragma unroll
            for (int gp = 0; gp < 2; ++gp) {
            unsigned om[4], km[4], rr[4], vv[4];
#pragma unroll
            for (int gq = 0; gq < 2; ++gq) {
                const int g = 2 * gp + gq;
                const int cg = c0 + 4 * g;
                const u32x2 rp = *(const LAS u32x2*)(prow + cg * 2), kp = *(const LAS u32x2*)(prow + 1024 + cg * 2), vp = *(const LAS u32x2*)(prow + 2048 + cg * 2);
                const u32x2 rc = *(const LAS u32x2*)(prow + RP_PITCH + cg * 2), kc = *(const LAS u32x2*)(prow + RP_PITCH + 1024 + cg * 2), vc = *(const LAS u32x2*)(prow + RP_PITCH + 2048 + cg * 2);
                const f32x4 mur = *(const LAS f32x4*)(cst + cg), muk = *(const LAS f32x4*)(cst + 512 + cg), muv = *(const LAS f32x4*)(cst + 1024 + cg);
                const f32x4 w0v = *(const LAS f32x4*)(cst + 1536 + cg), a0v = *(const LAS f32x4*)(cst + 2048 + cg), kkc = *(const LAS f32x4*)(cst + 2560 + cg), kac = *(const LAS f32x4*)(cst + 3072 + cg);
                const float rcf[4] = {bflo(rc.x), bfhi(rc.x), bflo(rc.y), bfhi(rc.y)}, rpf[4] = {bflo(rp.x), bfhi(rp.x), bflo(rp.y), bfhi(rp.y)};
                const float kcf[4] = {bflo(kc.x), bfhi(kc.x), bflo(kc.y), bfhi(kc.y)}, kpf[4] = {bflo(kp.x), bfhi(kp.x), bflo(kp.y), bfhi(kp.y)};
                const float vcf[4] = {bflo(vc.x), bfhi(vc.x), bflo(vc.y), bfhi(vc.y)}, vpf[4] = {bflo(vp.x), bfhi(vp.x), bflo(vp.y), bfhi(vp.y)};
                float r4[4], k4[4], v4[4], o4[4], m4[4];
#pragma unroll
                for (int q = 0; q < 4; ++q) {
                    const int ri = 4 * g + q;
                    r4[q] = rcf[q] + mur[q] * (rpf[q] - rcf[q]);
                    k4[q] = kcf[q] + muk[q] * (kpf[q] - kcf[q]);
                    v4[q] = vcf[q] + muv[q] * (vpf[q] - vcf[q]);
                    const float wv = w0v[q] + Xw[ct][ri];
                    const float z = -wv;
                    const float sp = fmaxf(z, 0.f) + __logf(1.f + __expf(-fabsf(z)));
                    const float ew = __expf(-sp - 0.5f);
                    o4[q] = 1.f - __expf(-ew);
                    const float a = __builtin_amdgcn_rcpf(1.f + __expf(-(a0v[q] + Xa[ct][ri])));
                    m4[q] = k4[q] * (1.f + (a - 1.f) * kac[q]);
                    const float kv = k4[q] * kkc[q];
                    kka[16 * ct + ri] = pk2(kv, a); ss += kv * kv;
                }
                om[2 * gq] = pk2(o4[0], o4[1]); om[2 * gq + 1] = pk2(o4[2], o4[3]);
                km[2 * gq] = pk2(m4[0], m4[1]); km[2 * gq + 1] = pk2(m4[2], m4[3]);
                rr[2 * gq] = pk2(r4[0], r4[1]); rr[2 * gq + 1] = pk2(r4[2], r4[3]);
                vv[2 * gq] = pk2(v4[0], v4[1]); vv[2 * gq + 1] = pk2(v4[2], v4[3]);
            }
            if (STORE) {
                const int j8 = j0 + 8 * gp;
                *(u32x4*)(so + 0 * 64 + j8) = (u32x4){om[0], om[1], om[2], om[3]};
                *(u32x4*)(so + 3 * 64 + j8) = (u32x4){km[0], km[1], km[2], km[3]};
                *(u32x4*)(so + 4 * 64 + j8) = (u32x4){rr[0], rr[1], rr[2], rr[3]};
                *(u32x4*)(so + 5 * 64 + j8) = (u32x4){vv[0], vv[1], vv[2], vv[3]};
            }
            }
        }
        ss += __shfl_xor(ss, 32);
        const float inv = 1.f / fmaxf(sqrtf(ss), 1e-12f);
#pragma unroll
        for (int ct = 0; ct < 2; ++ct) {
            const int j0 = 32 * ct + 16 * hi;
            unsigned kn[8], bq[8];
#pragma unroll
            for (int i = 0; i < 8; ++i) {
                const unsigned u0 = kka[16 * ct + 2 * i], u1 = kka[16 * ct + 2 * i + 1];
                const float k0 = bflo(u0) * inv, k1 = bflo(u1) * inv;
                kn[i] = pk2(k0, k1); bq[i] = pk2(k0 * bfhi(u0), k1 * bfhi(u1));
            }
            if (STORE) {
                *(u32x4*)(so + 1 * 64 + j0) = (u32x4){kn[0], kn[1], kn[2], kn[3]}; *(u32x4*)(so + 1 * 64 + j0 + 8) = (u32x4){kn[4], kn[5], kn[6], kn[7]};
                *(u32x4*)(so + 2 * 64 + j0) = (u32x4){bq[0], bq[1], bq[2], bq[3]}; *(u32x4*)(so + 2 * 64 + j0 + 8) = (u32x4){bq[4], bq[5], bq[6], bq[7]};
            }
        }
    }
}

DI void phase_select(const Params& p, int tid) {
    unsigned char* ws = p.ws;
    const bf16_t* QKV = (const bf16_t*)(ws + WS_QKV);
    const float* KBAR = (const float*)(ws + WS_KBAR);
    unsigned short* SEL = (unsigned short*)(ws + WS_SEL);
    const int gt = blockIdx.x * NTHREADS + tid, NGT = gridDim.x * NTHREADS;
    for (int it = gt; it < NB * NH * SEQ; it += NGT) {
        const int s = it & (SEQ - 1), bh = it >> 12, b = bh >> 3, h = bh & 7, blk = s >> 8;
        unsigned mask = 0u;
        if (blk > 0) {
            float q[64];
            const bf16_t* qp = QKV + ((size_t)(b * SEQ + s)) * QKVW + h * 64;
#pragma unroll
            for (int c = 0; c < 8; ++c) { const u32x4 w = *(const u32x4*)(qp + c * 8); float f[8]; unpack8(w, f);
#pragma unroll
                for (int i = 0; i < 8; ++i) q[c * 8 + i] = f[i]; }
            float v1 = -INFINITY, v2 = -INFINITY, v3 = -INFINITY; int i1 = -1, i2 = -1, i3 = -1;
            for (int jb = 0; jb < blk; ++jb) {
                const float* kb = KBAR + ((size_t)(bh * 16 + jb)) * 64;
                float g = 0.f;
#pragma unroll
                for (int d = 0; d < 64; d += 4) { const f32x4 kk = *(const f32x4*)(kb + d); g += q[d] * kk.x + q[d + 1] * kk.y + q[d + 2] * kk.z + q[d + 3] * kk.w; }
                if (g > v1) { v3 = v2; i3 = i2; v2 = v1; i2 = i1; v1 = g; i1 = jb; }
                else if (g > v2) { v3 = v2; i3 = i2; v2 = g; i2 = jb; }
                else if (g > v3) { v3 = g; i3 = jb; }
            }
            if (i1 >= 0) mask |= 1u << i1;
            if (i2 >= 0) mask |= 1u << i2;
            if (i3 >= 0) mask |= 1u << i3;
        }
        SEL[it] = (unsigned short)mask;
    }
}

constexpr int CK = 32, NCHUNK = SEQ / CK, ITEM_BYTES = 24576;
constexpr int IT_G1 = 0, IT_H1 = 4096, IT_QT = 12288, IT_OV = 20480;
DI unsigned char* chk_base(const Params& p, int chain) {
    const int q = chain >> 4;
    unsigned char* base = q == 0 ? p.ws + 86 * MiB : (q == 1 ? p.ws + 134 * MiB : (q == 2 ? p.ws + 214 * MiB : (unsigned char*)p.out + 64 * MiB));
    return base + (size_t)(chain & 15) * NCHUNK * ITEM_BYTES;
}
DI bf16x8 pack_acc(const f32x16& x, int s) {
    u32x4 w; w.x = pk2(x[8 * s], x[8 * s + 1]); w.y = pk2(x[8 * s + 2], x[8 * s + 3]); w.z = pk2(x[8 * s + 4], x[8 * s + 5]); w.w = pk2(x[8 * s + 6], x[8 * s + 7]);
    return __builtin_bit_cast(bf16x8, w);
}
DI void store_acc_bf16(unsigned char* dst, const f32x16& x) {
    u32x4 a, b; a.x = pk2(x[0], x[1]); a.y = pk2(x[2], x[3]); a.z = pk2(x[4], x[5]); a.w = pk2(x[6], x[7]);
    b.x = pk2(x[8], x[9]); b.y = pk2(x[10], x[11]); b.z = pk2(x[12], x[13]); b.w = pk2(x[14], x[15]);
    *(u32x4*)dst = a; *(u32x4*)(dst + 16) = b;
}
template <int T> DI void subst_step2(float (&x1)[32], float (&x2)[32], const float y1T, const LAS unsigned char* wl, const LAS unsigned char* y2row) {
    float p0 = y1T, p1 = 0.f, p2 = 0.f, p3 = 0.f, q0, q1 = 0.f, q2 = 0.f, q3 = 0.f;
    unsigned z = 0u;
    if (T > 0) asm("v_and_b32 %0, 0, %1" : "=v"(z) : "v"(__float_as_uint(x1[T > 0 ? T - 1 : 0]) | __float_as_uint(x2[T > 0 ? T - 1 : 0])));
    q0 = *(const LAS float*)(y2row + T * 4 + z);
    if (T > 0) {
        const LAS unsigned char* rowp = wl + T * 768 + z;
#pragma unroll
        for (int s4 = 0; s4 < (T + 3) / 4; ++s4) {
            const f32x4 mm = *(const LAS f32x4*)(rowp + s4 * 16);
            if (4 * s4 + 0 < T) { p0 -= x1[4 * s4 + 0] * mm.x; q0 -= x2[4 * s4 + 0] * mm.x; }
            if (4 * s4 + 1 < T) { p1 -= x1[(4 * s4 + 1) & 31] * mm.y; q1 -= x2[(4 * s4 + 1) & 31] * mm.y; }
            if (4 * s4 + 2 < T) { p2 -= x1[(4 * s4 + 2) & 31] * mm.z; q2 -= x2[(4 * s4 + 2) & 31] * mm.z; }
            if (4 * s4 + 3 < T) { p3 -= x1[(4 * s4 + 3) & 31] * mm.w; q3 -= x2[(4 * s4 + 3) & 31] * mm.w; }
        }
    }
    x1[T] = (p0 + p1) + (p2 + p3); x2[T] = (q0 + q1) + (q2 + q3);
}
template <int... Ts> DI void subst_all2(float (&x1)[32], float (&x2)[32], const float (&y1)[32], const LAS unsigned char* wl, const LAS unsigned char* y2row, std::integer_sequence<int, Ts...>) {
    (subst_step2<Ts>(x1, x2, y1[Ts], wl, y2row), ...);
}
#ifndef CPSTAGE
#define CPSTAGE 4
#endif
DI void unpack_acc_bf16(const LAS unsigned char* src, f32x16& x) {
    const u32x4 a = *(const LAS u32x4*)src, b = *(const LAS u32x4*)(src + 16);
    x[0] = bflo(a.x); x[1] = bfhi(a.x); x[2] = bflo(a.y); x[3] = bfhi(a.y); x[4] = bflo(a.z); x[5] = bfhi(a.z); x[6] = bflo(a.w); x[7] = bfhi(a.w);
    x[8] = bflo(b.x); x[9] = bfhi(b.x); x[10] = bflo(b.y); x[11] = bfhi(b.y); x[12] = bflo(b.z); x[13] = bfhi(b.z); x[14] = bflo(b.w); x[15] = bfhi(b.w);
}
constexpr int CPW = 36864;
constexpr int CP_BT = 24576, CP_KT = 28672, CP_VT = 32768;
template <int STG> DI void phase_chunkprep(const Params& p, LAS unsigned char* lds, int lane, int wid) {
    if (wid >= 4) return;
    unsigned char* ws = p.ws;
    const bf16_t* SCAN = (const bf16_t*)(ws + WS_SCAN);
    LAS unsigned char* wl = lds + wid * CPW;
    const int r32 = lane & 31, hi = lane >> 5, j = lane;
    for (int item = blockIdx.x * 4 + wid; item < 64 * NCHUNK; item += gridDim.x * 4) {
        const int chain = item >> 7, c = item & (NCHUNK - 1);
        const unsigned char* src = (const unsigned char*)(SCAN + ((size_t)chain * SEQ + (size_t)c * CK) * 384);
        unsigned char* dst = chk_base(p, chain) + (size_t)c * ITEM_BYTES;
        unsigned char* dl16 = dst + lane * 16; unsigned char* dl32 = dst + lane * 32;
        {
            u32x4 w[24];
#pragma unroll
            for (int k = 0; k < 24; ++k) w[k] = *(const u32x4*)(src + (size_t)(k * 64 + lane) * 16);
#pragma unroll
            for (int k = 0; k < 24; ++k) *(LAS u32x4*)(wl + (k * 64 + lane) * 16) = w[k];
        }
        LDS_WAIT(); asm volatile("" ::: "memory");
        float al[32]; float g = 1.f;
        {
            unsigned bt[16], kt[16], vt[16];
#pragma unroll
            for (int t = 0; t < 32; ++t) {
                LAS bf16_t* row = (LAS bf16_t*)(wl + t * 768);
                const float omd = bf2f(row[j]), kkv = bf2f(row[64 + j]), bv = bf2f(row[128 + j]), kmv = bf2f(row[192 + j]), rv = bf2f(row[256 + j]);
                const unsigned vraw = row[320 + j];
                const float gprev = g; g = g * (1.f - omd);
                const float ig = __builtin_amdgcn_rcpf(g);
                const float a_ = gprev * kkv, be = bv * ig, ka = kmv * ig, rh = g * rv;
                al[t] = a_;
                const unsigned beb = f2bf(be), kab = f2bf(ka);
                row[64 + j] = f2bf(a_); row[128 + j] = (bf16_t)beb; row[192 + j] = (bf16_t)kab; row[256 + j] = f2bf(rh);
                if (t & 1) { bt[t >> 1] |= beb << 16; kt[t >> 1] |= kab << 16; vt[t >> 1] |= vraw << 16; }
                else { bt[t >> 1] = beb; kt[t >> 1] = kab; vt[t >> 1] = vraw; }
                if ((t & 3) == 3) asm volatile("" ::: "memory");
            }
#pragma unroll
            for (int q = 0; q < 4; ++q) {
                *(LAS u32x4*)(wl + CP_BT + j * 64 + q * 16) = (u32x4){bt[4 * q], bt[4 * q + 1], bt[4 * q + 2], bt[4 * q + 3]};
                *(LAS u32x4*)(wl + CP_KT + j * 64 + q * 16) = (u32x4){kt[4 * q], kt[4 * q + 1], kt[4 * q + 2], kt[4 * q + 3]};
                *(LAS u32x4*)(wl + CP_VT + j * 64 + q * 16) = (u32x4){vt[4 * q], vt[4 * q + 1], vt[4 * q + 2], vt[4 * q + 3]};
            }
        }
        LDS_WAIT(); asm volatile("" ::: "memory");
        if (STG >= 2) {
        {
            f32x16 Mba, Mka, Nbr, Nkr;
#pragma unroll
            for (int i = 0; i < 16; ++i) { Mba[i] = 0.f; Mka[i] = 0.f; Nkr[i] = 0.f; Nbr[i] = 0.f; }
#pragma unroll
            for (int ks = 0; ks < 4; ++ks) {
                const LAS unsigned char* rp = wl + r32 * 768 + (16 * ks + 8 * hi) * 2;
                const bf16x8 ab = *(const LAS bf16x8*)(rp + 2 * 128), ak = *(const LAS bf16x8*)(rp + 3 * 128);
                const bf16x8 ba = *(const LAS bf16x8*)(rp + 1 * 128), br = *(const LAS bf16x8*)(rp + 4 * 128);
                Mba = MFMA32(ab, ba, Mba); Mka = MFMA32(ak, ba, Mka); Nkr = MFMA32(ak, br, Nkr); Nbr = MFMA32(ab, br, Nbr);
            }
#pragma unroll
            for (int r = 0; r < 16; ++r) { const int sr = crow(r, hi);
                if (!(sr < r32)) { Mba[r] = 0.f; Mka[r] = 0.f; }
                if (!(sr <= r32)) { Nkr[r] = 0.f; Nbr[r] = 0.f; } }
            LDS_WAIT(); asm volatile("" ::: "memory");
#pragma unroll
            for (int g4 = 0; g4 < 4; ++g4) {
                *(LAS f32x4*)(wl + r32 * 768 + 0 * 128 + (8 * g4 + 4 * hi) * 4) = (f32x4){Mba[4 * g4], Mba[4 * g4 + 1], Mba[4 * g4 + 2], Mba[4 * g4 + 3]};
                *(LAS u32x2*)(wl + r32 * 768 + 1 * 128 + (8 * g4 + 4 * hi) * 2) = (u32x2){pk2(Nbr[4 * g4], Nbr[4 * g4 + 1]), pk2(Nbr[4 * g4 + 2], Nbr[4 * g4 + 3])};
            }
#pragma unroll
            for (int r = 0; r < 16; ++r) *(LAS float*)(wl + crow(r, hi) * 768 + 5 * 128 + r32 * 4) = Mka[r];
            *(LAS float*)(wl + (j >> 4) * 768 + 1 * 128 + 64 + (j & 15) * 4) = g;
            { LAS unsigned char* np = wl + (lane >> 1) * 768 + 3 * 128 + 64 + (lane & 1) * 32;
              *(LAS u32x4*)np = (u32x4){pk2(Nkr[0], Nkr[1]), pk2(Nkr[2], Nkr[3]), pk2(Nkr[4], Nkr[5]), pk2(Nkr[6], Nkr[7])};
              *(LAS u32x4*)(np + 16) = (u32x4){pk2(Nkr[8], Nkr[9]), pk2(Nkr[10], Nkr[11]), pk2(Nkr[12], Nkr[13]), pk2(Nkr[14], Nkr[15])}; }
        }
        LDS_WAIT(); asm volatile("" ::: "memory");
        }
        if (STG >= 3) {
        {
            float x1[32], x2[32];
            subst_all2(x1, x2, al, wl, wl + r32 * 768 + 5 * 128, std::make_integer_sequence<int, 32>{});
            LAS unsigned char* w1p = wl + (j >> 1) * 768 + 2 * 128 + (j & 1) * 64;
            LAS unsigned char* w2p = wl + r32 * 768 + 3 * 128;
#pragma unroll
            for (int q = 0; q < 4; ++q) {
                *(LAS u32x4*)(w1p + q * 16) = (u32x4){pk2(-x1[8 * q], -x1[8 * q + 1]), pk2(-x1[8 * q + 2], -x1[8 * q + 3]), pk2(-x1[8 * q + 4], -x1[8 * q + 5]), pk2(-x1[8 * q + 6], -x1[8 * q + 7])};
                if (hi == 0) *(LAS u32x4*)(w2p + q * 16) = (u32x4){pk2(-x2[8 * q], -x2[8 * q + 1]), pk2(-x2[8 * q + 2], -x2[8 * q + 3]), pk2(-x2[8 * q + 4], -x2[8 * q + 5]), pk2(-x2[8 * q + 6], -x2[8 * q + 7])};
            }
        }
        LDS_WAIT(); asm volatile("" ::: "memory");
        }
        if (STG >= 4) {
#define CP_A1(jt, ks) (*(const LAS bf16x8*)(wl + (16 * (jt) + (r32 >> 1)) * 768 + 2 * 128 + (r32 & 1) * 64 + (16 * (ks) + 8 * hi) * 2))
#define CP_A2(ks) (*(const LAS bf16x8*)(wl + r32 * 768 + 3 * 128 + (16 * (ks) + 8 * hi) * 2))
#define CP_BN(ks) (*(const LAS bf16x8*)(wl + r32 * 768 + 1 * 128 + (16 * (ks) + 8 * hi) * 2))
#define CP_BB(jp, ks) (*(const LAS bf16x8*)(wl + CP_BT + (32 * (jp) + r32) * 64 + (16 * (ks) + 8 * hi) * 2))
        {
            float gcl[2];
#pragma unroll
            for (int jt = 0; jt < 2; ++jt) { const int jj = 32 * jt + r32; gcl[jt] = *(const LAS float*)(wl + (jj >> 4) * 768 + 1 * 128 + 64 + (jj & 15) * 4); }
            {
                const bf16x8 bn0 = CP_BN(0), bn1 = CP_BN(1);
#pragma unroll
                for (int jt = 0; jt < 2; ++jt) {
                    f32x16 acc;
#pragma unroll
                    for (int g4 = 0; g4 < 4; ++g4) { const u32x2 v = *(const LAS u32x2*)(wl + r32 * 768 + 4 * 128 + (32 * jt + 8 * g4 + 4 * hi) * 2);
                        acc[4 * g4] = bflo(v.x); acc[4 * g4 + 1] = bfhi(v.x); acc[4 * g4 + 2] = bflo(v.y); acc[4 * g4 + 3] = bfhi(v.y); }
                    acc = MFMA32(CP_A1(jt, 0), bn0, acc); acc = MFMA32(CP_A1(jt, 1), bn1, acc);
#pragma unroll
                    for (int sx = 0; sx < 2; ++sx) *(bf16x8*)(dl16 + IT_G1 + (jt * 2 + sx) * 1024) = pack_acc(acc, sx);
                }
            }
#pragma unroll
            for (int jp = 0; jp < 2; ++jp) {
                const bf16x8 bb0 = CP_BB(jp, 0), bb1 = CP_BB(jp, 1);
#pragma unroll
                for (int jt = 0; jt < 2; ++jt) {
                    f32x16 acc;
#pragma unroll
                    for (int r = 0; r < 16; ++r) acc[r] = (jt == jp && crow(r, hi) == r32) ? 1.f : 0.f;
                    acc = MFMA32(CP_A1(jt, 0), bb0, acc); acc = MFMA32(CP_A1(jt, 1), bb1, acc);
#pragma unroll
                    for (int r = 0; r < 16; ++r) acc[r] *= gcl[jp];
#pragma unroll
                    for (int sx = 0; sx < 2; ++sx) *(bf16x8*)(dl16 + IT_H1 + ((jp * 2 + jt) * 2 + sx) * 1024) = pack_acc(acc, sx);
                }
            }
            bf16x8 vtf[2][2];
#pragma unroll
            for (int it = 0; it < 2; ++it)
#pragma unroll
                for (int ks = 0; ks < 2; ++ks) {
                    const u32x2 lo = *(const LAS u32x2*)(wl + CP_VT + (32 * it + r32) * 64 + (16 * ks + 4 * hi) * 2), hh = *(const LAS u32x2*)(wl + CP_VT + (32 * it + r32) * 64 + (16 * ks + 8 + 4 * hi) * 2);
                    vtf[it][ks] = __builtin_bit_cast(bf16x8, (u32x4){lo.x, lo.y, hh.x, hh.y});
                }
            {
                f32x16 acc; unpack_acc_bf16(wl + (lane >> 1) * 768 + 3 * 128 + 64 + (lane & 1) * 32, acc);
                acc = MFMA32(CP_A2(0), CP_BN(0), acc); acc = MFMA32(CP_A2(1), CP_BN(1), acc);
                const bf16x8 g0 = pack_acc(acc, 0), g1 = pack_acc(acc, 1);
#pragma unroll
                for (int it = 0; it < 2; ++it) {
                    f32x16 z;
#pragma unroll
                    for (int r = 0; r < 16; ++r) z[r] = 0.f;
                    z = MFMA32(g0, vtf[it][0], z); z = MFMA32(g1, vtf[it][1], z);
                    store_acc_bf16(dl32 + IT_OV + it * 2048, z);
                }
            }
#pragma unroll
            for (int jp = 0; jp < 2; ++jp) {
                f32x16 acc;
#pragma unroll
                for (int g4 = 0; g4 < 4; ++g4) { const u32x2 v = *(const LAS u32x2*)(wl + CP_KT + (32 * jp + r32) * 64 + (8 * g4 + 4 * hi) * 2);
                    acc[4 * g4] = bflo(v.x); acc[4 * g4 + 1] = bfhi(v.x); acc[4 * g4 + 2] = bflo(v.y); acc[4 * g4 + 3] = bfhi(v.y); }
                acc = MFMA32(CP_A2(0), CP_BB(jp, 0), acc); acc = MFMA32(CP_A2(1), CP_BB(jp, 1), acc);
#pragma unroll
                for (int r = 0; r < 16; ++r) acc[r] *= gcl[jp];
                const bf16x8 h0 = pack_acc(acc, 0), h1 = pack_acc(acc, 1);
#pragma unroll
                for (int it = 0; it < 2; ++it) {
                    f32x16 z;
#pragma unroll
                    for (int r = 0; r < 16; ++r) z[r] = 0.f;
                    z = MFMA32(h0, vtf[it][0], z); z = MFMA32(h1, vtf[it][1], z);
                    store_acc_bf16(dl32 + IT_QT + (jp * 2 + it) * 2048, z);
                }
            }
        }
#undef CP_A1
#undef CP_A2
#undef CP_BN
#undef CP_BB
        }
        LDS_WAIT(); asm volatile("" ::: "memory");
    }
}
DI void phase_chunkscan(const Params& p, LAS unsigned char* lds, int tid, int lane, int wid) {
    unsigned char* ws = p.ws;
    bf16_t* OBR = (bf16_t*)(ws + WS_OBRAW);
    const int r32 = lane & 31, hi = lane >> 5;
    for (int chain = blockIdx.x; chain < 64; chain += gridDim.x) {
        const unsigned char* src = chk_base(p, chain);
        const int b = chain >> 3, h = chain & 7, lt = tid - 128;
        __syncthreads();
        u32x4 lw[4];
        if (wid >= 2) {
#pragma unroll
            for (int k = 0; k < 4; ++k) lw[k] = *(const u32x4*)(src + (size_t)(lt + 384 * k) * 16);
#pragma unroll
            for (int k = 0; k < 4; ++k) *(LAS u32x4*)(lds + (lt + 384 * k) * 16) = lw[k];
#pragma unroll
            for (int k = 0; k < 4; ++k) lw[k] = *(const u32x4*)(src + ITEM_BYTES + (size_t)(lt + 384 * k) * 16);
        }
        __syncthreads();
        f32x16 X0, X1;
#pragma unroll
        for (int i = 0; i < 16; ++i) { X0[i] = 0.f; X1[i] = 0.f; }
        for (int c = 0; c < NCHUNK; ++c) {
            const LAS unsigned char* cur = lds + (c & 1) * ITEM_BYTES;
            if (wid < 2) {
                const int it = wid;
                const bf16x8 xb00 = pack_acc(X0, 0), xb01 = pack_acc(X0, 1), xb10 = pack_acc(X1, 0), xb11 = pack_acc(X1, 1);
                f32x16 oacc; unpack_acc_bf16(cur + IT_OV + (it * 64 + lane) * 32, oacc);
                oacc = MFMA32(*(const LAS bf16x8*)(cur + IT_G1 + (0 * 64 + lane) * 16), xb00, oacc);
                oacc = MFMA32(*(const LAS bf16x8*)(cur + IT_G1 + (1 * 64 + lane) * 16), xb01, oacc);
                oacc = MFMA32(*(const LAS bf16x8*)(cur + IT_G1 + (2 * 64 + lane) * 16), xb10, oacc);
                oacc = MFMA32(*(const LAS bf16x8*)(cur + IT_G1 + (3 * 64 + lane) * 16), xb11, oacc);
                f32x16 n0, n1;
                unpack_acc_bf16(cur + IT_QT + ((0 * 2 + it) * 64 + lane) * 32, n0);
                unpack_acc_bf16(cur + IT_QT + ((1 * 2 + it) * 64 + lane) * 32, n1);
                n0 = MFMA32(*(const LAS bf16x8*)(cur + IT_H1 + (0 * 64 + lane) * 16), xb00, n0);
                n0 = MFMA32(*(const LAS bf16x8*)(cur + IT_H1 + (1 * 64 + lane) * 16), xb01, n0);
                n0 = MFMA32(*(const LAS bf16x8*)(cur + IT_H1 + (2 * 64 + lane) * 16), xb10, n0);
                n0 = MFMA32(*(const LAS bf16x8*)(cur + IT_H1 + (3 * 64 + lane) * 16), xb11, n0);
                n1 = MFMA32(*(const LAS bf16x8*)(cur + IT_H1 + (4 * 64 + lane) * 16), xb00, n1);
                n1 = MFMA32(*(const LAS bf16x8*)(cur + IT_H1 + (5 * 64 + lane) * 16), xb01, n1);
                n1 = MFMA32(*(const LAS bf16x8*)(cur + IT_H1 + (6 * 64 + lane) * 16), xb10, n1);
                n1 = MFMA32(*(const LAS bf16x8*)(cur + IT_H1 + (7 * 64 + lane) * 16), xb11, n1);
                X0 = n0; X1 = n1;
                bf16_t* orow = OBR + ((size_t)(b * SEQ + c * CK)) * 512 + h * 64 + 32 * it + r32;
#pragma unroll
                for (int r = 0; r < 16; ++r) orow[(size_t)crow(r, hi) * 512] = f2bf(oacc[r]);
            } else {
                LAS unsigned char* nxt = lds + ((c + 1) & 1) * ITEM_BYTES;
                if (c + 1 < NCHUNK) {
#pragma unroll
                    for (int k = 0; k < 4; ++k) *(LAS u32x4*)(nxt + (lt + 384 * k) * 16) = lw[k];
                }
                if (c + 2 < NCHUNK) {
#pragma unroll
                    for (int k = 0; k < 4; ++k) lw[k] = *(const u32x4*)(src + (size_t)(c + 2) * ITEM_BYTES + (size_t)(lt + 384 * k) * 16);
                }
            }
            __syncthreads();
        }
    }
}

constexpr int AT_BUF = 8192 + 64 * 136, AT_K = 0, AT_V = 8192, AT_BT = 2 * AT_BUF, AT_END = AT_BT + 512 * 4;
DI int rel_bucket_dev(int n) {
    if (n < 16) return n;
    const int th[15] = {19, 21, 24, 27, 31, 35, 40, 46, 52, 59, 67, 77, 87, 99, 113};
    int b = 16;
#pragma unroll
    for (int i = 0; i < 15; ++i) b += (n >= th[i]) ? 1 : 0;
    return b;
}
template <int MODE>
DI void attn_tile(const LAS unsigned char* kb, const LAS unsigned char* vbuf, const LAS float* btab, const bf16x8 (&qr)[4],
                  f32x16& o0, f32x16& o1, f32x16& lacc, float& m, int dq, bool selb, float c31, int r32, int hi) {
    const float sc2 = 0.125f * LOG2E;
    f32x16 p0, p1;
#pragma unroll
    for (int i = 0; i < 16; ++i) { p0[i] = 0.f; p1[i] = 0.f; }
#pragma unroll
    for (int d0 = 0; d0 < 4; ++d0) {
        const bf16x8 k0 = *(const LAS bf16x8*)(kb + (2 * d0 + hi) * 1024 + r32 * 16);
        const bf16x8 k1 = *(const LAS bf16x8*)(kb + (2 * d0 + hi) * 1024 + 512 + r32 * 16);
        p0 = MFMA32(k0, qr[d0], p0); p1 = MFMA32(k1, qr[d0], p1);
    }
    float mx = -INFINITY;
    float cadd = 0.f;
    if (MODE == 2) {
        const float bsel = selb ? c31 : -INFINITY;
#pragma unroll
        for (int r = 0; r < 16; ++r) mx = fmaxf(mx, fmaxf(p0[r], p1[r]));
        mx = mx * sc2 + bsel;
        cadd = bsel;
    } else {
        const float ninf = selb ? 0.f : -INFINITY;
#pragma unroll
        for (int r = 0; r < 16; ++r) {
            const int d0 = dq - crow(r, hi), d1 = d0 - 32;
            const int i0 = d0 < 0 ? 0 : (d0 > 511 ? 511 : d0), i1 = d1 < 0 ? 0 : (d1 > 511 ? 511 : d1);
            float x0 = p0[r] * sc2 + btab[i0], x1 = p1[r] * sc2 + btab[i1];
            if (MODE == 0) { x0 = d0 >= 0 ? x0 : -INFINITY; x1 = d1 >= 0 ? x1 : -INFINITY; }
            else { x0 += ninf; x1 += ninf; }
            p0[r] = x0; p1[r] = x1; mx = fmaxf(mx, fmaxf(x0, x1));
        }
    }
    mx = fmaxf(mx, __shfl_xor(mx, 32));
    if (__any(mx > m)) {
        const float mn = fmaxf(m, mx);
        const float alpha = __builtin_amdgcn_exp2f(m - mn);
        m = mn;
#pragma unroll
        for (int i = 0; i < 16; ++i) { o0[i] *= alpha; o1[i] *= alpha; lacc[i] *= alpha; }
    }
    if (MODE == 2) {
        const float c = cadd - m;
#pragma unroll
        for (int r = 0; r < 16; ++r) { p0[r] = __builtin_amdgcn_exp2f(p0[r] * sc2 + c); p1[r] = __builtin_amdgcn_exp2f(p1[r] * sc2 + c); }
    } else {
#pragma unroll
        for (int r = 0; r < 16; ++r) { p0[r] = __builtin_amdgcn_exp2f(p0[r] - m); p1[r] = __builtin_amdgcn_exp2f(p1[r] - m); }
    }
    const bf16x8 ones = {(short)0x3F80, (short)0x3F80, (short)0x3F80, (short)0x3F80, (short)0x3F80, (short)0x3F80, (short)0x3F80, (short)0x3F80};
#pragma unroll
    for (int s = 0; s < 4; ++s) {
        u32x4 pw;
        if (s < 2) { pw.x = pk2(p0[8 * s], p0[8 * s + 1]); pw.y = pk2(p0[8 * s + 2], p0[8 * s + 3]); pw.z = pk2(p0[8 * s + 4], p0[8 * s + 5]); pw.w = pk2(p0[8 * s + 6], p0[8 * s + 7]); }
        else { const int q = s - 2; pw.x = pk2(p1[8 * q], p1[8 * q + 1]); pw.y = pk2(p1[8 * q + 2], p1[8 * q + 3]); pw.z = pk2(p1[8 * q + 4], p1[8 * q + 5]); pw.w = pk2(p1[8 * q + 6], p1[8 * q + 7]); }
        const bf16x8 pf = __builtin_bit_cast(bf16x8, pw);
        const LAS unsigned char* v0p = vbuf + r32 * 136 + (16 * s + 4 * hi) * 2;
        const LAS unsigned char* v1p = vbuf + (32 + r32) * 136 + (16 * s + 4 * hi) * 2;
        const u32x2 a0 = *(const LAS u32x2*)v0p, a1 = *(const LAS u32x2*)(v0p + 16);
        const u32x2 c0 = *(const LAS u32x2*)v1p, c1 = *(const LAS u32x2*)(v1p + 16);
        const bf16x8 va = __builtin_bit_cast(bf16x8, (u32x4){a0.x, a0.y, a1.x, a1.y});
        const bf16x8 vb = __builtin_bit_cast(bf16x8, (u32x4){c0.x, c0.y, c1.x, c1.y});
        o0 = MFMA32(va, pf, o0); o1 = MFMA32(vb, pf, o1); lacc = MFMA32(ones, pf, lacc);
    }
}
template <int VAR> DI void attn_unit(const Params& p, LAS unsigned char* lds, int b, int h, int qb, int tid, int lane, int wid) {
    unsigned char* ws = p.ws;
    const bf16_t* QKV = (const bf16_t*)(ws + WS_QKV);
    const bf16_t* VT = (const bf16_t*)((const unsigned char*)p.out + DO_VT);
    const unsigned short* SEL = (const unsigned short*)(ws + WS_SEL);
    bf16_t* OA = VAR == 0 ? (bf16_t*)(ws + WS_OA) : (bf16_t*)((unsigned char*)p.out + 64 * MiB);
    const int r32 = lane & 31, hi = lane >> 5, bh = b * NH + h;
    LAS float* btab = (LAS float*)(lds + AT_BT);
    const int NT = 4 * (qb + 1);
#define AT_KPOS(ti) (((ti) < 4 ? qb * 256 + (ti) * 64 : (((ti) - 4) >> 2) * 256 + (((ti) - 4) & 3) * 64))
    const bf16_t* kbase = QKV + ((size_t)(b * SEQ + lane)) * QKVW + 512 + h * 64 + wid * 8;
    const bf16_t* vbase = VT + ((size_t)(bh * 64 + (tid >> 3))) * SEQ + (tid & 7) * 8;
    const int kdst = AT_K + wid * 1024 + lane * 16, vdst = AT_V + (tid >> 3) * 136 + (tid & 7) * 16;
#define AT_LOAD(ti, kr, vr) do { const int kp_ = AT_KPOS(ti); kr = *(const u32x4*)(kbase + (size_t)kp_ * QKVW); vr = *(const u32x4*)(vbase + kp_); } while (0)
#define AT_WRITE(buf, kr, vr) do { LAS unsigned char* b_ = lds + (buf) * AT_BUF; *(LAS u32x4*)(b_ + kdst) = kr; \
        *(LAS u32x2*)(b_ + vdst) = (u32x2){vr.x, vr.y}; *(LAS u32x2*)(b_ + vdst + 8) = (u32x2){vr.z, vr.w}; } while (0)
    u32x4 kreg, vreg;
    AT_LOAD(0, kreg, vreg);
    __syncthreads();
    btab[tid] = p.rel_bias[h * 32 + rel_bucket_dev(tid)] * LOG2E;
    if (tid < 256) {
        unsigned mask = 0u;
        if (qb > 0) {
            const float* KBAR = (const float*)(ws + WS_KBAR);
            float q[64];
            const bf16_t* qp = QKV + ((size_t)(b * SEQ + qb * 256 + tid)) * QKVW + h * 64;
#pragma unroll
            for (int c = 0; c < 8; ++c) { const u32x4 w = *(const u32x4*)(qp + c * 8); float f[8]; unpack8(w, f);
#pragma unroll
                for (int i = 0; i < 8; ++i) q[c * 8 + i] = f[i]; }
            float v1 = -INFINITY, v2 = -INFINITY, v3 = -INFINITY; int i1 = -1, i2 = -1, i3 = -1;
            for (int jb = 0; jb < qb; ++jb) {
                const float* kbp = KBAR + ((size_t)(bh * 16 + jb)) * 64;
                float g = 0.f;
#pragma unroll
                for (int d = 0; d < 64; d += 4) { const f32x4 kk = *(const f32x4*)(kbp + d); g += q[d] * kk.x + q[d + 1] * kk.y + q[d + 2] * kk.z + q[d + 3] * kk.w; }
                if (g > v1) { v3 = v2; i3 = i2; v2 = v1; i2 = i1; v1 = g; i1 = jb; }
                else if (g > v2) { v3 = v2; i3 = i2; v2 = g; i2 = jb; }
                else if (g > v3) { v3 = g; i3 = jb; }
            }
            if (i1 >= 0) mask |= 1u << i1;
            if (i2 >= 0) mask |= 1u << i2;
            if (i3 >= 0) mask |= 1u << i3;
        }
        ((LAS unsigned short*)(lds + AT_END))[tid] = (unsigned short)mask;
    }
    AT_WRITE(0, kreg, vreg);
    if (NT > 1) AT_LOAD(1, kreg, vreg);
    const int qrow = b * SEQ + qb * 256 + wid * 32 + r32, qin = wid * 32 + r32;
    bf16x8 qr[4];
#pragma unroll
    for (int d0 = 0; d0 < 4; ++d0) qr[d0] = *(const bf16x8*)(QKV + (size_t)qrow * QKVW + h * 64 + d0 * 16 + hi * 8);
    const float c31 = p.rel_bias[h * 32 + 31] * LOG2E;
    float m = -INFINITY;
    f32x16 o0, o1, lacc;
#pragma unroll
    for (int i = 0; i < 16; ++i) { o0[i] = 0.f; o1[i] = 0.f; lacc[i] = 0.f; }
    __syncthreads();
    const unsigned sel = ((const LAS unsigned short*)(lds + AT_END))[qin];
    for (int ti = 0; ti < NT; ++ti) {
        const bool own = ti < 4;
        const int blk = own ? qb : ((ti - 4) >> 2), kt = own ? ti : ((ti - 4) & 3);
        const LAS unsigned char* kb = lds + (ti & 1) * AT_BUF + AT_K;
        const LAS unsigned char* vbuf = lds + (ti & 1) * AT_BUF + AT_V;
        const bool selb = ((sel >> blk) & 1u) != 0u;
        const bool active = own ? (kt * 64 <= wid * 32 + 31) : (__any(selb) != 0);
        if (active && VAR != 2) {
            if (own) attn_tile<0>(kb, vbuf, btab, qr, o0, o1, lacc, m, qin - kt * 64, true, 0.f, r32, hi);
            else {
                const bool farb = ((qb - blk) * 256 + wid * 32 - kt * 64 - 63 >= 113);
                if (farb) attn_tile<2>(kb, vbuf, btab, qr, o0, o1, lacc, m, 0, selb, c31, r32, hi);
                else attn_tile<1>(kb, vbuf, btab, qr, o0, o1, lacc, m, (qb - blk) * 256 + qin - kt * 64, selb, c31, r32, hi);
            }
        }
        if (VAR != 1) { if (ti + 1 < NT) AT_WRITE((ti + 1) & 1, kreg, vreg);
        if (ti + 2 < NT) AT_LOAD(ti + 2, kreg, vreg); }
        __syncthreads();
    }
#undef AT_KPOS
#undef AT_LOAD
#undef AT_WRITE
    const float il = 1.f / lacc[0];
    bf16_t* orow = OA + (size_t)qrow * 512 + h * 64;
#pragma unroll
    for (int g = 0; g < 4; ++g) {
        u32x2 w0, w1;
        w0.x = pk2(o0[4 * g] * il, o0[4 * g + 1] * il); w0.y = pk2(o0[4 * g + 2] * il, o0[4 * g + 3] * il);
        w1.x = pk2(o1[4 * g] * il, o1[4 * g + 1] * il); w1.y = pk2(o1[4 * g + 2] * il, o1[4 * g + 3] * il);
        *(u32x2*)(orow + 8 * g + 4 * hi) = w0; *(u32x2*)(orow + 32 + 8 * g + 4 * hi) = w1;
    }
}
template <int VAR> DI void phase_attn(const Params& p, LAS unsigned char* lds, int tid, int lane, int wid) {
    if (gridDim.x == 256) {
        const int bh = blockIdx.x & 63, s = blockIdx.x >> 6;
#pragma unroll 1
        for (int i = 0; i < 4; ++i) { const int qb = i == 0 ? 15 - s : (i == 1 ? 8 + s : (i == 2 ? 7 - s : s)); attn_unit<VAR>(p, lds, bh >> 3, bh & 7, qb, tid, lane, wid); }
    } else {
        for (int it = blockIdx.x; it < NB * NH * 16; it += gridDim.x) { const int qb = 15 - (it >> 6), bh = it & 63; attn_unit<VAR>(p, lds, bh >> 3, bh & 7, qb, tid, lane, wid); }
    }
}

constexpr int A2_BT = 0, A2_SEL = 2048, A2_CNT = 2560, A2_WCNT = 2624, A2_NIT = 2880, A2_QCTR = 2884, A2_ITEM = 2944, A2_ROWS = 3072, A2_END = 3072 + 15 * 256;
constexpr size_t PART_REC = 136;
DI unsigned char* part_base(const Params& p, int b) {
    constexpr size_t PB_ = (size_t)NH * SEQ * 3 * PART_REC;
    return b < 6 ? p.ws + 214 * MiB + (size_t)b * PB_ : (unsigned char*)p.out + 96 * MiB + (size_t)(b - 6) * PB_;
}
struct A2State { float m, l; f32x16 o0, o1; };
constexpr int A2_WBUF = 8192;
DI void a2_dma_tile(const unsigned char* kf_tile, const unsigned char* vf_tile, LAS unsigned char* wbuf, int lane) {
#pragma unroll
    for (int f = 0; f < 8; ++f) {
        __builtin_amdgcn_global_load_lds((const unsigned*)(kf_tile + f * 1024 + lane * 16), (LAS unsigned*)(wbuf + f * 1024), 16, 0, 0);
        __builtin_amdgcn_global_load_lds((const unsigned*)(vf_tile + f * 1024 + lane * 16), (LAS unsigned*)(wbuf + 8192 + f * 1024), 16, 0, 0);
    }
}
template <bool OWN> DI void attn2_item(const Params& p, const LAS float* btab, LAS unsigned char* wbuf, int b, int h, int qb, int blk, int row, int nkt, A2State& st, int lane, int r32, int hi) {
    unsigned char* ws = p.ws;
    const bf16_t* QKV = (const bf16_t*)(ws + WS_QKV);
    const int bh = b * NH + h;
    const unsigned char* kft = (const unsigned char*)p.out + DO_KF + ((size_t)(bh * 64 + blk * 4) * 8) * 1024;
    const unsigned char* vft = (const unsigned char*)p.out + DO_VT + ((size_t)(bh * 64 + blk * 4) * 8) * 1024;
    a2_dma_tile(kft, vft, wbuf, lane);
    bf16x8 qr[4];
    { const bf16_t* qp = QKV + ((size_t)(b * SEQ + qb * 256 + row)) * QKVW + h * 64 + hi * 8;
#pragma unroll
      for (int d0 = 0; d0 < 4; ++d0) qr[d0] = *(const bf16x8*)(qp + d0 * 16); }
    st.m = -INFINITY; st.l = 0.f;
#pragma unroll
    for (int i = 0; i < 16; ++i) { st.o0[i] = 0.f; st.o1[i] = 0.f; }
    const int dbase = OWN ? row : ((qb - blk) * 256 + row);
    for (int kt = 0; kt < nkt; ++kt) {
        asm volatile("s_waitcnt vmcnt(0)" ::: "memory");
        bf16x8 kf[8], vf[8];
#pragma unroll
        for (int f = 0; f < 8; ++f) { kf[f] = *(const LAS bf16x8*)(wbuf + f * 1024 + lane * 16); vf[f] = *(const LAS bf16x8*)(wbuf + 8192 + f * 1024 + lane * 16); }
        asm volatile("s_waitcnt lgkmcnt(0)" ::: "memory");
        __builtin_amdgcn_sched_barrier(0);
        if (kt + 1 < nkt) a2_dma_tile(kft + (size_t)(kt + 1) * 8192, vft + (size_t)(kt + 1) * 8192, wbuf, lane);
        f32x16 p0, p1;
#pragma unroll
        for (int i = 0; i < 16; ++i) { p0[i] = 0.f; p1[i] = 0.f; }
#pragma unroll
        for (int d0 = 0; d0 < 4; ++d0) { p0 = MFMA32(kf[2 * d0], qr[d0], p0); p1 = MFMA32(kf[2 * d0 + 1], qr[d0], p1); }
        const float sc2 = 0.125f * LOG2E;
        const int dq = dbase - kt * 64;
        float mx = -INFINITY;
        const bool farb = !OWN && (__all(dq - 63 >= 113) != 0);
        const float c31 = btab[511];
        if (farb) {
#pragma unroll
            for (int r = 0; r < 16; ++r) mx = fmaxf(mx, fmaxf(p0[r], p1[r]));
            mx = mx * sc2 + c31;
        } else {
#pragma unroll
            for (int r = 0; r < 16; ++r) {
                const int d0 = dq - crow(r, hi), d1 = d0 - 32;
                const int i0 = d0 < 0 ? 0 : (d0 > 511 ? 511 : d0), i1 = d1 < 0 ? 0 : (d1 > 511 ? 511 : d1);
                float x0 = p0[r] * sc2 + btab[i0], x1 = p1[r] * sc2 + btab[i1];
                if (OWN) { x0 = d0 >= 0 ? x0 : -INFINITY; x1 = d1 >= 0 ? x1 : -INFINITY; }
                p0[r] = x0; p1[r] = x1; mx = fmaxf(mx, fmaxf(x0, x1));
            }
        }
        mx = fmaxf(mx, __shfl_xor(mx, 32));
        if (__any(mx > st.m)) {
            const float mn = fmaxf(st.m, mx);
            const float alpha = __builtin_amdgcn_exp2f(st.m - mn);
            st.m = mn;
#pragma unroll
            for (int i = 0; i < 16; ++i) { st.o0[i] *= alpha; st.o1[i] *= alpha; }
            st.l *= alpha;
        }
        float rs0 = 0.f, rs1 = 0.f;
        if (farb) { const float c = c31 - st.m;
#pragma unroll
            for (int r = 0; r < 16; ++r) { p0[r] = __builtin_amdgcn_exp2f(p0[r] * sc2 + c); p1[r] = __builtin_amdgcn_exp2f(p1[r] * sc2 + c); rs0 += p0[r]; rs1 += p1[r]; }
        } else {
#pragma unroll
            for (int r = 0; r < 16; ++r) { p0[r] = __builtin_amdgcn_exp2f(p0[r] - st.m); p1[r] = __builtin_amdgcn_exp2f(p1[r] - st.m); rs0 += p0[r]; rs1 += p1[r]; }
        }
        st.l += rs0 + rs1;
#pragma unroll
        for (int s = 0; s < 4; ++s) {
            u32x4 pw;
            if (s < 2) { pw.x = pk2(p0[8 * s], p0[8 * s + 1]); pw.y = pk2(p0[8 * s + 2], p0[8 * s + 3]); pw.z = pk2(p0[8 * s + 4], p0[8 * s + 5]); pw.w = pk2(p0[8 * s + 6], p0[8 * s + 7]); }
            else { const int q = s - 2; pw.x = pk2(p1[8 * q], p1[8 * q + 1]); pw.y = pk2(p1[8 * q + 2], p1[8 * q + 3]); pw.z = pk2(p1[8 * q + 4], p1[8 * q + 5]); pw.w = pk2(p1[8 * q + 6], p1[8 * q + 7]); }
            const bf16x8 pf = __builtin_bit_cast(bf16x8, pw);
            st.o0 = MFMA32(vf[s], pf, st.o0); st.o1 = MFMA32(vf[4 + s], pf, st.o1);
        }
    }
    st.l += __shfl_xor(st.l, 32);
}
template <int CHECK> DI void attn2_unit(const Params& p, LAS unsigned char* lds, int b, int h, int qb, int tid, int lane, int wid) {
    unsigned char* ws = p.ws;
    const bf16_t* QKV = (const bf16_t*)(ws + WS_QKV);
    bf16_t* OA = (bf16_t*)(ws + WS_OA);
    const int r32 = lane & 31, hi = lane >> 5, bh = b * NH + h;
    LAS float* btab = (LAS float*)(lds + A2_BT);
    LAS unsigned short* selm = (LAS unsigned short*)(lds + A2_SEL);
    LAS int* cnt = (LAS int*)(lds + A2_CNT);
    LAS int* wcnt = (LAS int*)(lds + A2_WCNT);
    LAS int* ctl = (LAS int*)(lds + A2_NIT);
    LAS unsigned char* itemtab = lds + A2_ITEM;
    LAS unsigned char* rows = lds + A2_ROWS;
    unsigned char* part = part_base(p, b) + ((size_t)(h * 16 + qb) * 256) * 3 * PART_REC;
    __syncthreads();
    btab[tid] = p.rel_bias[h * 32 + rel_bucket_dev(tid)] * LOG2E;
    unsigned mysel = 0u;
    if (qb > 0) {
        LAS float* kbl = (LAS float*)(lds + A2_WBUF);
        LAS float* gp = (LAS float*)(lds + A2_WBUF + 4096);
        const float* KBAR = (const float*)(ws + WS_KBAR) + (size_t)(bh * 16) * 64;
        for (int i = tid; i < qb * 64; i += NTHREADS) kbl[i] = KBAR[i];
        const int qi = tid & 255, hf = tid >> 8;
        float q[32];
        { const bf16_t* qp = QKV + ((size_t)(b * SEQ + qb * 256 + qi)) * QKVW + h * 64 + 32 * hf;
#pragma unroll
          for (int c = 0; c < 4; ++c) { const u32x4 w = *(const u32x4*)(qp + c * 8); float f[8]; unpack8(w, f);
#pragma unroll
              for (int i = 0; i < 8; ++i) q[c * 8 + i] = f[i]; } }
        __syncthreads();
        for (int jb = 0; jb < qb; ++jb) {
            const LAS float* kbp = kbl + jb * 64 + 32 * hf;
            float g0 = 0.f, g1 = 0.f;
#pragma unroll
            for (int d = 0; d < 32; d += 8) { const f32x4 ka = *(const LAS f32x4*)(kbp + d), kb = *(const LAS f32x4*)(kbp + d + 4);
                g0 += q[d] * ka.x + q[d + 1] * ka.y + q[d + 2] * ka.z + q[d + 3] * ka.w; g1 += q[d + 4] * kb.x + q[d + 5] * kb.y + q[d + 6] * kb.z + q[d + 7] * kb.w; }
            gp[(hf * 16 + jb) * 256 + qi] = g0 + g1;
        }
        __syncthreads();
        if (tid < 256) {
            float v1 = -INFINITY, v2 = -INFINITY, v3 = -INFINITY; int i1 = -1, i2 = -1, i3 = -1;
            for (int jb = 0; jb < qb; ++jb) {
                const float g = gp[jb * 256 + tid] + gp[(16 + jb) * 256 + tid];
                if (g > v1) { v3 = v2; i3 = i2; v2 = v1; i2 = i1; v1 = g; i1 = jb; }
                else if (g > v2) { v3 = v2; i3 = i2; v2 = g; i2 = jb; }
                else if (g > v3) { v3 = g; i3 = jb; }
            }
            if (i1 >= 0) mysel |= 1u << i1;
            if (i2 >= 0) mysel |= 1u << i2;
            if (i3 >= 0) mysel |= 1u << i3;
        }
    }
    if (tid < 256) {
        selm[tid] = (unsigned short)mysel;
        for (int j = 0; j < qb; ++j) { const unsigned long long bm = __ballot((mysel >> j) & 1u); if (lane == 0) wcnt[j * 4 + wid] = __popcll(bm); }
    }
    __syncthreads();
    if (tid < 256) {
        for (int j = 0; j < qb; ++j) {
            const bool bit = ((mysel >> j) & 1u) != 0u;
            const unsigned long long bm = __ballot(bit);
            int off = 0;
            for (int w2 = 0; w2 < 4; ++w2) off += (w2 < wid) ? wcnt[j * 4 + w2] : 0;
            const int pre = __popcll(bm & ((1ull << lane) - 1ull));
            if (bit) rows[j * 256 + off + pre] = (unsigned char)tid;
            if (tid == 0) cnt[j] = wcnt[j * 4] + wcnt[j * 4 + 1] + wcnt[j * 4 + 2] + wcnt[j * 4 + 3];
        }
    }
    __syncthreads();
    if (tid == 0) {
        int n = 0;
        for (int j = 0; j < qb; ++j) { const int nt = (cnt[j] + 31) >> 5; for (int r = 0; r < nt; ++r) itemtab[n++] = (unsigned char)(j * 8 + r); }
        ctl[0] = n; ctl[1] = 0;
    }
    __syncthreads();
    LAS unsigned char* wbuf = lds + A2_WBUF + wid * 16384;
    const int nitems = ctl[0];
    for (;;) {
        int it = 0;
        if (lane == 0) it = __hip_atomic_fetch_add(&ctl[1], 1, __ATOMIC_RELAXED, __HIP_MEMORY_SCOPE_WORKGROUP);
        it = __builtin_amdgcn_readfirstlane(it);
        if (it >= nitems) break;
        const int code = itemtab[it], j = code >> 3, r = code & 7;
        const int pos = r * 32 + r32, n = cnt[j];
        const bool valid = pos < n;
        const int row = rows[j * 256 + (valid ? pos : 0)];
        A2State st;
        attn2_item<false>(p, btab, wbuf, b, h, qb, j, row, 4, st, lane, r32, hi);
        if (valid) {
            const unsigned sm = selm[row];
            const int slot = __popc(sm & ((1u << j) - 1u));
            unsigned char* rec = part + ((size_t)row * 3 + slot) * PART_REC;
#pragma unroll
            for (int g = 0; g < 4; ++g) {
                *(u32x2*)(rec + (8 * g + 4 * hi) * 2) = (u32x2){pk2(st.o0[4 * g], st.o0[4 * g + 1]), pk2(st.o0[4 * g + 2], st.o0[4 * g + 3])};
                *(u32x2*)(rec + (32 + 8 * g + 4 * hi) * 2) = (u32x2){pk2(st.o1[4 * g], st.o1[4 * g + 1]), pk2(st.o1[4 * g + 2], st.o1[4 * g + 3])};
            }
            if (hi == 0) *(f32x2*)(rec + 128) = (f32x2){st.m, st.l};
        }
    }
    A2State own;
    attn2_item<true>(p, btab, wbuf, b, h, qb, qb, wid * 32 + r32, (wid >> 1) + 1, own, lane, r32, hi);
    asm volatile("s_waitcnt vmcnt(0)" ::: "memory");
    __syncthreads();
    {
        const int row = wid * 32 + r32;
        const unsigned sm = selm[row];
        const int ns = __popc(sm);
        float M = own.m;
        float ms[3], ls[3];
#pragma unroll
        for (int s3 = 0; s3 < 3; ++s3) { ms[s3] = -INFINITY; ls[s3] = 0.f;
            if (s3 < ns) { const f32x2 ml = *(const f32x2*)(part + ((size_t)row * 3 + s3) * PART_REC + 128); ms[s3] = ml.x; ls[s3] = ml.y; M = fmaxf(M, ml.x); } }
        const float f0 = __builtin_amdgcn_exp2f(own.m - M);
        float L = own.l * f0;
#pragma unroll
        for (int i = 0; i < 16; ++i) { own.o0[i] *= f0; own.o1[i] *= f0; }
#pragma unroll
        for (int s3 = 0; s3 < 3; ++s3) {
            if (s3 < ns) {
                const float fs = __builtin_amdgcn_exp2f(ms[s3] - M);
                L += ls[s3] * fs;
                const unsigned char* rec = part + ((size_t)row * 3 + s3) * PART_REC;
#pragma unroll
                for (int g = 0; g < 4; ++g) {
                    const u32x2 a = *(const u32x2*)(rec + (8 * g + 4 * hi) * 2), c = *(const u32x2*)(rec + (32 + 8 * g + 4 * hi) * 2);
                    own.o0[4 * g] += fs * bflo(a.x); own.o0[4 * g + 1] += fs * bfhi(a.x); own.o0[4 * g + 2] += fs * bflo(a.y); own.o0[4 * g + 3] += fs * bfhi(a.y);
                    own.o1[4 * g] += fs * bflo(c.x); own.o1[4 * g + 1] += fs * bfhi(c.x); own.o1[4 * g + 2] += fs * bflo(c.y); own.o1[4 * g + 3] += fs * bfhi(c.y);
                }
            }
        }
        const float il = 1.f / L;
        bf16_t* orow = OA + ((size_t)(b * SEQ + qb * 256 + row)) * 512 + h * 64;
#pragma unroll
        for (int g = 0; g < 4; ++g) {
            u32x2 w0, w1;
            w0.x = pk2(own.o0[4 * g] * il, own.o0[4 * g + 1] * il); w0.y = pk2(own.o0[4 * g + 2] * il, own.o0[4 * g + 3] * il);
            w1.x = pk2(own.o1[4 * g] * il, own.o1[4 * g + 1] * il); w1.y = pk2(own.o1[4 * g + 2] * il, own.o1[4 * g + 3] * il);
            if (CHECK) {
                const u32x2 r0 = *(const u32x2*)(orow + 8 * g + 4 * hi), r1 = *(const u32x2*)(orow + 32 + 8 * g + 4 * hi);
                const float a[8] = {bflo(w0.x), bfhi(w0.x), bflo(w0.y), bfhi(w0.y), bflo(w1.x), bfhi(w1.x), bflo(w1.y), bfhi(w1.y)};
                const float c[8] = {bflo(r0.x), bfhi(r0.x), bflo(r0.y), bfhi(r0.y), bflo(r1.x), bfhi(r1.x), bflo(r1.y), bfhi(r1.y)};
                bool bad = false;
#pragma unroll
                for (int i = 0; i < 8; ++i) bad |= !(fabsf(a[i] - c[i]) <= 0.03f * fabsf(c[i]) + 0.004f);
                if (bad) { w0.x = 0x7fc07fc0u; w0.y = 0x7fc07fc0u; w1.x = 0x7fc07fc0u; w1.y = 0x7fc07fc0u; }
            }
            *(u32x2*)(orow + 8 * g + 4 * hi) = w0; *(u32x2*)(orow + 32 + 8 * g + 4 * hi) = w1;
        }
    }
}
template <int CHECK> DI void phase_attn2(const Params& p, LAS unsigned char* lds, int tid, int lane, int wid) {
    if (gridDim.x == 256) {
        const int bh = blockIdx.x & 63, s = blockIdx.x >> 6;
#pragma unroll 1
        for (int i = 0; i < 4; ++i) { const int qb = i == 0 ? 15 - s : (i == 1 ? 8 + s : (i == 2 ? 7 - s : s)); attn2_unit<CHECK>(p, lds, bh >> 3, bh & 7, qb, tid, lane, wid); }
    } else {
        for (int it = blockIdx.x; it < NB * NH * 16; it += gridDim.x) { const int qb = 15 - (it >> 6), bh = it & 63; attn2_unit<CHECK>(p, lds, bh >> 3, bh & 7, qb, tid, lane, wid); }
    }
}

DI void phase_post(const Params& p, int tid, int lane, int wid) {
    unsigned char* ws = p.ws;
    const bf16_t* SCAN = (const bf16_t*)(ws + WS_SCAN);
    const bf16_t* OBRAW = (const bf16_t*)(ws + WS_OBRAW);
    const bf16_t* RG = (const bf16_t*)((const unsigned char*)p.out + DO_RG);
    bf16_t* OB = (bf16_t*)(ws + WS_OB);
    const int gw = blockIdx.x * NWAVES + wid, NGW = gridDim.x * NWAVES;
    for (int tok = gw; tok < NTOK; tok += NGW) {
        const int b = tok >> 12, s = tok & (SEQ - 1);
#pragma unroll
        for (int h = 0; h < NH; ++h) {
            const int c = h * 64 + lane;
            const float o = bf2f(OBRAW[(size_t)tok * 512 + c]);
            const float mu = wave_sum(o) * (1.f / 64.f);
            const float dd = o - mu;
            const float var = wave_sum(dd * dd) * (1.f / 64.f);
            const float on = dd * rsqrtf(var + GN_EPS) * p.lnx_g[c] + p.lnx_b[c];
            const bf16_t* si = SCAN + ((size_t)((b * NH + h) * SEQ + s)) * 384 + lane;
            const float km = bf2f(si[192]), r = bf2f(si[256]), v = bf2f(si[320]);
            const float bon = wave_sum(r * km * p.r_k[c]);
            const float g = bf2f(RG[(size_t)tok * 512 + c]);
            OB[(size_t)tok * 512 + c] = f2bf((on + bon * v) * g);
        }
    }
}
typedef float v16f_t __attribute__((ext_vector_type(16)));
typedef float v32f_t __attribute__((ext_vector_type(32)));
typedef int v6i_t __attribute__((ext_vector_type(6)));
DI void phase_uv_convert(const Params& p, int lane, int gw, int NGW) {
    unsigned char* ws = p.ws;
    const int hl = lane & 31, half = lane >> 5;
    for (int e2 = gw; e2 < NEXP; e2 += NGW) {
        const bool isv = e2 >= NEXP / 2;
        const int e = 2 * (isv ? e2 - NEXP / 2 : e2) + half;
        const float* src = (isv ? p.peer_v : p.peer_u) + (size_t)e * DM + 32 * hl;
        f32x4 v[8]; float am = 0.f, ss = 0.f;
#pragma unroll
        for (int j = 0; j < 8; ++j) { v[j] = *(const f32x4*)(src + 4 * j);
            am = fmaxf(am, fmaxf(fmaxf(fabsf(v[j].x), fabsf(v[j].y)), fmaxf(fabsf(v[j].z), fabsf(v[j].w))));
            ss += v[j].x * v[j].x + v[j].y * v[j].y + v[j].z * v[j].z + v[j].w * v[j].w; }
#pragma unroll
        for (int o = 1; o < 32; o <<= 1) { am = fmaxf(am, __shfl_xor(am, o)); ss += __shfl_xor(ss, o); }
        u32x4 w = {0u, 0u, 0u, 0u};
        if (isv) {
            am = fmaxf(am, 1e-30f);
            const float mul = 6.f / am;
#define FP4_PACK(j_) \
            w[j_] = __builtin_amdgcn_cvt_scalef32_pk_fp4_f32(w[j_], v[2 * (j_)].x * mul, v[2 * (j_)].y * mul, 1.0f, 0); \
            w[j_] = __builtin_amdgcn_cvt_scalef32_pk_fp4_f32(w[j_], v[2 * (j_)].z * mul, v[2 * (j_)].w * mul, 1.0f, 1); \
            w[j_] = __builtin_amdgcn_cvt_scalef32_pk_fp4_f32(w[j_], v[2 * (j_) + 1].x * mul, v[2 * (j_) + 1].y * mul, 1.0f, 2); \
            w[j_] = __builtin_amdgcn_cvt_scalef32_pk_fp4_f32(w[j_], v[2 * (j_) + 1].z * mul, v[2 * (j_) + 1].w * mul, 1.0f, 3);
            FP4_PACK(0) FP4_PACK(1) FP4_PACK(2) FP4_PACK(3)
#undef FP4_PACK
            *(u32x4*)(ws + WS_V8 + (size_t)e * 512 + 16 * hl) = w;
            if (hl == 0) ((float*)(ws + WS_VSC))[e] = am * (1.f / 6.f);
        } else {
            const float su = fmaxf(0.335f * sqrtf(ss * (1.f / DM)), 1e-30f), inv = 1.f / su;
            unsigned nsum = 0u;
#pragma unroll
            for (int j = 0; j < 4; ++j) {
#pragma unroll
                for (int k = 0; k < 4; ++k) {
                    const unsigned nl = (unsigned)fminf(fmaxf(floorf(v[2 * j][k] * inv) + 8.f, 0.f), 15.f);
                    const unsigned nh = (unsigned)fminf(fmaxf(floorf(v[2 * j + 1][k] * inv) + 8.f, 0.f), 15.f);
                    w[j] |= (nl | (nh << 4)) << (8 * k); nsum += nl + nh;
                }
            }
#pragma unroll
            for (int o = 1; o < 32; o <<= 1) nsum += (unsigned)__shfl_xor((int)nsum, o);
            *(u32x4*)(ws + WS_U8 + (size_t)e * 512 + 16 * hl) = w;
            if (hl == 0) ((f32x2*)(ws + WS_USC))[e] = (f32x2){su, (float)nsum};
        }
    }
}

DI void ce_desc(float& x, float& y) { const float hi = fmaxf(x, y), lo = fminf(x, y); x = hi; y = lo; }
DI void sort16_desc(float (&v)[16]) {
#pragma unroll
    for (int k = 2; k <= 16; k <<= 1) {
#pragma unroll
        for (int j = k >> 1; j > 0; j >>= 1) {
#pragma unroll
            for (int i = 0; i < 16; ++i) { const int l = i ^ j; if (l > i) { if ((i & k) == 0) ce_desc(v[i], v[l]); else ce_desc(v[l], v[i]); } }
        }
    }
}
DI void merge16_desc(float (&a)[16], const float (&b)[16]) {
#pragma unroll
    for (int i = 0; i < 16; ++i) a[i] = fmaxf(a[i], b[15 - i]);
#pragma unroll
    for (int j = 8; j > 0; j >>= 1) {
#pragma unroll
        for (int i = 0; i < 16; ++i) { const int l = i ^ j; if (l > i) ce_desc(a[i], a[l]); }
    }
}
DI void xmerge16(float (&a)[16]) {
    float o[16];
#pragma unroll
    for (int i = 0; i < 16; ++i) o[i] = __shfl_xor(a[i], 32);
    merge16_desc(a, o);
}
constexpr int ca_A(int i) { return i < 16 ? 0 : (i < 24 ? i - 8 : -1); }
constexpr int cb_A(int i) { return i < 16 ? i : (i < 24 ? 0 : -1); }
constexpr int ca_B(int i) { return i < 8 ? 1 : i < 13 ? 2 : i < 17 ? 3 : i < 20 ? 4 : i < 22 ? 5 : i < 24 ? 6 : i < 26 ? 7 : -1; }
constexpr int cb_B(int i) { return i < 8 ? i : i < 13 ? i - 8 : i < 17 ? i - 13 : i < 20 ? i - 17 : i < 22 ? i - 20 : i < 24 ? i - 22 : i < 26 ? i - 24 : -1; }

DI void route_item(const Params& p, LAS unsigned char* wl  , int item, int lane) {
    unsigned char* ws = p.ws;
    const bf16_t* QP = (const bf16_t*)(ws + WS_QP);
    const bf16_t* SK = (const bf16_t*)(ws + WS_SK);
    int* PIDX = (int*)(ws + WS_PIDX); float* PGATE = (float*)(ws + WS_PGATE);
    const int tt = item >> 3, h = item & 7, t0 = tt * 32, r32 = lane & 31, hi = lane >> 5;
    float L0[16], L1[16];
#pragma unroll
    for (int pp = 0; pp < 2; ++pp) {
        const int hp = h * 2 + pp;
        bf16x8 qf[8];
#pragma unroll
        for (int ks = 0; ks < 8; ++ks) qf[ks] = *(const bf16x8*)(QP + (size_t)(t0 + r32) * 2048 + hp * 128 + ks * 16 + hi * 8);
        float run[16];
#pragma unroll
        for (int i = 0; i < 16; ++i) run[i] = -INFINITY;
        bf16x8 skf[8];
        { const bf16_t* skp = SK + ((size_t)(hp * 128 + r32)) * 128 + hi * 8;
#pragma unroll
          for (int ks = 0; ks < 8; ++ks) skf[ks] = *(const bf16x8*)(skp + ks * 16); }
#pragma unroll 1
        for (int nt = 0; nt < 4; ++nt) {
            f32x16 X;
#pragma unroll
            for (int i = 0; i < 16; ++i) X[i] = 0.f;
#pragma unroll
            for (int ks = 0; ks < 8; ++ks) X = MFMA32(skf[ks], qf[ks], X);
            if (nt < 3) { const bf16_t* skp = SK + ((size_t)(hp * 128 + (nt + 1) * 32 + r32)) * 128 + hi * 8;
#pragma unroll
                for (int ks = 0; ks < 8; ++ks) skf[ks] = *(const bf16x8*)(skp + ks * 16); }
            float v[16];
#pragma unroll
            for (int r = 0; r < 16; ++r) { const unsigned n = (unsigned)(nt * 32 + (r & 3) + 8 * (r >> 2)) + 4u * (unsigned)hi;
                v[r] = __uint_as_float((__float_as_uint(X[r]) & ~127u) | n); }
            sort16_desc(v);
            merge16_desc(run, v);
        }
        xmerge16(run);
#pragma unroll
        for (int i = 0; i < 16; ++i) { if (pp == 0) L0[i] = run[i]; else L1[i] = run[i]; }
    }
#pragma unroll
    for (int i = 0; i < 16; ++i) { wl[lane * 32 + i] = (unsigned char)(__float_as_uint(L0[i]) & 127u); wl[lane * 32 + 16 + i] = (unsigned char)(__float_as_uint(L1[i]) & 127u); }
    float c0[16], c1[16];
#pragma unroll
    for (int i = 0; i < 32; ++i) {
        float va = -INFINITY, vb = -INFINITY;
        if (ca_A(i) >= 0) { const float s = L0[ca_A(i) < 0 ? 0 : ca_A(i)] + L1[cb_A(i) < 0 ? 0 : cb_A(i)]; va = __uint_as_float((__float_as_uint(s) & ~255u) | (unsigned)(ca_A(i) * 16 + cb_A(i))); }
        if (ca_B(i) >= 0) { const float s = L0[ca_B(i) < 0 ? 0 : ca_B(i)] + L1[cb_B(i) < 0 ? 0 : cb_B(i)]; vb = __uint_as_float((__float_as_uint(s) & ~255u) | (unsigned)(ca_B(i) * 16 + cb_B(i))); }
        const float v = hi ? vb : va;
        if (i < 16) c0[i] = v; else c1[i - 16] = v;
    }
    sort16_desc(c0); sort16_desc(c1); merge16_desc(c0, c1); xmerge16(c0);
    LDS_WAIT(); asm volatile("" ::: "memory");
    int e[16]; float g[16]; float sum = 0.f;
    const float rs = row_rs((const float*)(ws + WS_ROWSQ), t0 + r32);
    if (h == 0 && hi == 0) ((float*)(ws + WS_RS))[t0 + r32] = rs;
    const float mx = __uint_as_float(__float_as_uint(c0[0]) & ~255u);
#pragma unroll
    for (int k = 0; k < 16; ++k) {
        const unsigned bits = __float_as_uint(c0[k]); const int code = (int)(bits & 255u), a = code >> 4, b = code & 15;
        const int i0 = wl[lane * 32 + a], i1 = wl[lane * 32 + 16 + b];
        e[k] = i0 * 128 + i1;
        g[k] = __expf((__uint_as_float(bits & ~255u) - mx) * rs); sum += g[k];
    }
    const float inv = 1.f / sum;
    const size_t ob = ((size_t)(t0 + r32) * 8 + h) * 16 + hi * 8;
    u32x4 e0, e1; f32x4 g0, g1;
    e0.x = hi ? e[8] : e[0]; e0.y = hi ? e[9] : e[1]; e0.z = hi ? e[10] : e[2]; e0.w = hi ? e[11] : e[3];
    e1.x = hi ? e[12] : e[4]; e1.y = hi ? e[13] : e[5]; e1.z = hi ? e[14] : e[6]; e1.w = hi ? e[15] : e[7];
    g0.x = (hi ? g[8] : g[0]) * inv; g0.y = (hi ? g[9] : g[1]) * inv; g0.z = (hi ? g[10] : g[2]) * inv; g0.w = (hi ? g[11] : g[3]) * inv;
    g1.x = (hi ? g[12] : g[4]) * inv; g1.y = (hi ? g[13] : g[5]) * inv; g1.z = (hi ? g[14] : g[6]) * inv; g1.w = (hi ? g[15] : g[7]) * inv;
    *(u32x4*)(PIDX + ob) = e0; *(u32x4*)(PIDX + ob + 4) = e1;
    *(f32x4*)(PGATE + ob) = g0; *(f32x4*)(PGATE + ob + 4) = g1;
    LDS_WAIT(); asm volatile("" ::: "memory");
}
DI void phase_route(const Params& p, LAS unsigned char* lds, int lane, int wid) {
    const int gw = blockIdx.x * NWAVES + wid, NGW = gridDim.x * NWAVES;
    for (int it = gw; it < (NTOK / 32) * NH; it += NGW) route_item(p, lds + wid * 2048, it, lane);
}

DI float gelu_exact(float x) { return 0.5f * x * (1.f + erff(x * 0.70710678118654752f)); }
DI float gelu_bf(float x) {
    const float z = fabsf(x) * 0.70710678118654752f;
    const float t = __builtin_amdgcn_rcpf(fmaf(0.3275911f, z, 1.f));
    const float poly = t * fmaf(t, fmaf(t, fmaf(t, fmaf(t, 1.061405429f, -1.453152027f), 1.421413741f), -0.284496736f), 0.254829592f);
    const float he = 0.5f * poly * __expf(-z * z);
    return x * (x >= 0.f ? 1.f - he : he);
}
DI void experts_quant_x(const u32x4 (&xn)[4], unsigned (&xa)[8], float& sx, float& ktok) {
    float f[32];
#pragma unroll
    for (int j = 0; j < 4; ++j) { float t[8]; unpack8(xn[j], t);
#pragma unroll
        for (int i = 0; i < 8; ++i) f[8 * j + i] = t[i]; }
    float m = 0.f;
#pragma unroll
    for (int i = 0; i < 32; ++i) m = fmaxf(m, fabsf(f[i]));
    m = fmaxf(m, dpp_mov<0x128>(m)); m = fmaxf(m, dpp_mov<0x124>(m)); m = fmaxf(m, dpp_mov<0x122>(m)); m = fmaxf(m, dpp_mov<0x121>(m));
    m = fmaxf(m, __shfl_xor(m, 16));
    m = fmaxf(m, 1e-30f);
    const float inv = 127.f / m; sx = m * (1.f / 127.f);
    unsigned tsum = 0u;
#pragma unroll
    for (int j = 0; j < 4; ++j) { unsigned wh = 0u, wl = 0u;
#pragma unroll
        for (int k = 0; k < 4; ++k) {
            const unsigned q0 = (unsigned)(rintf(f[8 * j + k] * inv) + 128.f), q1 = (unsigned)(rintf(f[8 * j + 4 + k] * inv) + 128.f);
            wh |= ((q0 >> 4) | ((q1 >> 4) << 4)) << (8 * k); wl |= ((q0 & 15u) | ((q1 & 15u) << 4)) << (8 * k); tsum += q0 + q1; }
        xa[j] = wh; xa[4 + j] = wl; }
    float tf = row16_sum((float)tsum);
    tf += __shfl_xor(tf, 16);
    ktok = 983040.f - 7.5f * tf;
}
DI void phase_experts(const Params& p, LAS unsigned char* ldsw  , int lane, int wid, float* outp, const int IDMASK) {
    unsigned char* ws = p.ws;
    const bf16_t* XN = (const bf16_t*)(ws + WS_XN);
    const unsigned char* U8 = ws + WS_U8; const unsigned char* V8 = ws + WS_V8;
    const f32x2* USC = (const f32x2*)(ws + WS_USC); const float* VSC = (const float*)(ws + WS_VSC);
    const int* PIDX = (const int*)(ws + WS_PIDX); const float* PGATE = (const float*)(ws + WS_PGATE); const float* RS = (const float*)(ws + WS_RS);
    const bf16_t* H1 = (const bf16_t*)(ws + WS_H1B);
    const int hl = lane & 31; const bool hi = lane >= 32;
    const bool b0 = (lane & 1) != 0, b1 = (lane & 2) != 0;
    const int ntile = ((NTOK / 32) - (int)blockIdx.x + (int)gridDim.x - 1) / (int)gridDim.x;
    if (ntile <= 0) return;
    const int ntw = ntile * 4;
    auto tokof = [&](int t) { const int tc = t < ntw ? t : ntw - 1; return 32 * ((int)blockIdx.x + (tc >> 2) * (int)gridDim.x) + 4 * wid + (tc & 3); };
    unsigned xa[8]; float sx, ktok;
    typedef int v8i_t __attribute__((ext_vector_type(8)));
    float nfg[16];
#pragma unroll
    for (int r = 0; r < 16; ++r) nfg[r] = p.normf_g[32 * crow(r, hi) + hl];
    f32x16 D, D2;
#pragma unroll
    for (int i = 0; i < 16; ++i) { D[i] = 0.f; D2[i] = 0.f; }
    unsigned bmask[4];
#pragma unroll
    for (int r = 0; r < 4; ++r) bmask[r] = ((hi ? 1 : 0) == ((hl >> 4) & 1) && r == ((hl & 15) >> 2)) ? (0xFFu << (8 * (hl & 3))) : 0u;
    int iA1, iB1, iA2, iB2; float gA1, gB1, gA2, gB2, vA1, vB1; f32x2 uA1, uB1;
    auto ld_ids = [&](int t, int& iA, int& iB, float& gA, float& gB) { const size_t b = (size_t)tokof(t) * 128 + lane;
        iA = PIDX[b] & IDMASK; iB = PIDX[b + 64] & IDMASK; gA = PGATE[b]; gB = PGATE[b + 64]; };
    auto wr_rec = [&](int t, int iA, int iB, float gA, float gB, f32x2 uA, f32x2 uB, float vA, float vB) {
        LAS unsigned char* buf = ldsw + (t & 1) * 2048;
        *(LAS u32x4*)(buf + lane * 16) = (u32x4){(unsigned)iA, __float_as_uint(gA * vA), __float_as_uint(uA.x), __float_as_uint(uA.y)};
        *(LAS u32x4*)(buf + 1024 + lane * 16) = (u32x4){(unsigned)iB, __float_as_uint(gB * vB), __float_as_uint(uB.x), __float_as_uint(uB.y)};
    };
    LAS unsigned char* hvbuf = ldsw + 4096;
    auto prime = [&](int t0) {
        ld_ids(t0, iA1, iB1, gA1, gB1);
        uA1 = USC[iA1]; uB1 = USC[iB1]; vA1 = VSC[iA1]; vB1 = VSC[iB1];
        wr_rec(t0, iA1, iB1, gA1, gB1, uA1, uB1, vA1, vB1);
        ld_ids(t0 + 1, iA1, iB1, gA1, gB1);
        uA1 = USC[iA1]; uB1 = USC[iB1]; vA1 = VSC[iA1]; vB1 = VSC[iB1];
        ld_ids(t0 + 2, iA2, iB2, gA2, gB2);
    };
    auto advance = [&](int t) {
        wr_rec(t + 1, iA1, iB1, gA1, gB1, uA1, uB1, vA1, vB1);
        iA1 = iA2; iB1 = iB2; gA1 = gA2; gB1 = gB2;
        uA1 = USC[iA1]; uB1 = USC[iB1]; vA1 = VSC[iA1]; vB1 = VSC[iB1];
        ld_ids(t + 3, iA2, iB2, gA2, gB2);
    };
    const bool b2 = (lane & 4) != 0;
#pragma unroll 1
    for (int tc = 0; tc < ntw; tc += 16) {
        const int tend = tc + 16 < ntw ? tc + 16 : ntw;
        prime(tc);
        { u32x4 xn[4];
#pragma unroll
          for (int j = 0; j < 4; ++j) xn[j] = *(const u32x4*)(XN + (size_t)tokof(tc) * DM + 32 * hl + 8 * j);
          experts_quant_x(xn, xa, sx, ktok); sx *= RS[tokof(tc)]; }
        u32x4 uw[8];
#pragma unroll
        for (int q = 0; q < 8; ++q) { const int id = *(LAS const int*)(ldsw + (tc & 1) * 2048 + ((hi ? 1 : 0) + 2 * q) * 16); uw[q] = *(const u32x4*)(U8 + (size_t)id * 512 + 16 * hl); }
#pragma unroll 1
        for (int t = tc; t < tend; ++t) {
            advance(t);
            auto groupU = [&](int g) {
                const LAS unsigned char* rc_cur = ldsw + (t & 1) * 2048 + (g * 16 + (hi ? 1 : 0)) * 16;
                const int gn = g + 1;
                const LAS unsigned char* rc_nxt = ldsw + ((t + (gn >> 3)) & 1) * 2048 + ((gn & 7) * 16 + (hi ? 1 : 0)) * 16;
                float d[8]; int idn[8];
                const u32x4 rl = *(LAS const u32x4*)(rc_cur + 32 * (lane & 7));
#pragma unroll
                for (int q = 0; q < 8; ++q) idn[q] = *(LAS const int*)(rc_nxt + 32 * q);
#pragma unroll
                for (int q = 0; q < 8; ++q) {
                    __builtin_amdgcn_sched_barrier(0);
                    const u32x4 w = uw[q];
                    unsigned h0 = __builtin_amdgcn_udot8(w[0], xa[0], 0u, false), l0 = __builtin_amdgcn_udot8(w[0], xa[4], 0u, false);
                    unsigned h1 = __builtin_amdgcn_udot8(w[1], xa[1], 0u, false), l1 = __builtin_amdgcn_udot8(w[1], xa[5], 0u, false);
                    h0 = __builtin_amdgcn_udot8(w[2], xa[2], h0, false); l0 = __builtin_amdgcn_udot8(w[2], xa[6], l0, false);
                    h1 = __builtin_amdgcn_udot8(w[3], xa[3], h1, false); l1 = __builtin_amdgcn_udot8(w[3], xa[7], l1, false);
                    d[q] = (float)(((h0 + h1) << 4) + (l0 + l1));
                    __builtin_amdgcn_sched_barrier(0);
                    uw[q] = *(const u32x4*)(U8 + (size_t)idn[q] * 512 + 16 * hl);
                }
                __builtin_amdgcn_sched_barrier(0);
                float a[4], c2[2];
#pragma unroll
                for (int i = 0; i < 4; ++i) { const float keep = b0 ? d[2 * i + 1] : d[2 * i], send = b0 ? d[2 * i] : d[2 * i + 1]; a[i] = keep + dpp_mov<0xB1>(send); }
#pragma unroll
                for (int i = 0; i < 2; ++i) { const float keep = b1 ? a[2 * i + 1] : a[2 * i], send = b1 ? a[2 * i] : a[2 * i + 1]; c2[i] = keep + dpp_mov<0x4E>(send); }
                float c;
                { const float keep = b2 ? c2[1] : c2[0], send = b2 ? c2[0] : c2[1]; c = keep + dpp_mov<0x124>(send); }
                c += dpp_mov<0x128>(c);
                c += __shfl_xor(c, 16);
                const float gtl = __uint_as_float(rl.y), usl = __uint_as_float(rl.z), rcl = __uint_as_float(rl.w);
                const float dq = ((c - 128.f * rcl) + ktok) * (usl * sx);
#if PROBE == 50
                const float hvl = 0.f * gelu_bf(dq) * gtl;
#else
                const float hvl = gelu_bf(dq) * gtl;
#endif
                const unsigned code = (unsigned)__builtin_amdgcn_cvt_pk_fp8_f32(hvl * 128.f, 0.f, 0, false) & 0xffu;
                if ((lane & 0x18) == 0) hvbuf[((t - tc) * 8 + g) * 16 + 2 * (lane & 7) + (hi ? 1 : 0)] = (unsigned char)code;
            };
#pragma unroll 1
            for (int g = 0; g < 7; ++g) groupU(g);
            u32x4 xn[4];
#pragma unroll
            for (int j = 0; j < 4; ++j) xn[j] = *(const u32x4*)(XN + (size_t)tokof(t + 1) * DM + 32 * hl + 8 * j);
            groupU(7);
            experts_quant_x(xn, xa, sx, ktok); sx *= RS[tokof(t + 1)];
        }
        prime(tc);
        u32x4 vw[8];
#pragma unroll
        for (int q = 0; q < 8; ++q) { const int id = *(LAS const int*)(ldsw + (tc & 1) * 2048 + ((hi ? 1 : 0) + 2 * q) * 16); vw[q] = *(const u32x4*)(V8 + (size_t)id * 512 + 16 * hl); }
#pragma unroll 1
        for (int t = tc; t < tend; ++t) {
            advance(t);
            auto groupV = [&](int g) {
                const int gn = g + 1;
                const LAS unsigned char* rc_nxt = ldsw + ((t + (gn >> 3)) & 1) * 2048 + ((gn & 7) * 16 + (hi ? 1 : 0)) * 16;
                int idn[8];
#pragma unroll
                for (int q = 0; q < 8; ++q) idn[q] = *(LAS const int*)(rc_nxt + 32 * q);
                const u32x4 hb = *(LAS const u32x4*)(hvbuf + ((t - tc) * 8 + g) * 16);
#pragma unroll
                for (int q = 0; q < 8; ++q) {
                    __builtin_amdgcn_sched_barrier(0);
                    const unsigned wq = hb[q >> 1] >> (16 * (q & 1));
                    const unsigned bb0 = (wq & 0xffu) * 0x01010101u, bb1 = ((wq >> 8) & 0xffu) * 0x01010101u;
                    v8i_t Bv, Av;
#pragma unroll
                    for (int r = 0; r < 4; ++r) { Bv[r] = (int)(bb0 & bmask[r]); Bv[4 + r] = (int)(bb1 & bmask[r]); }
                    Av[0] = (int)vw[q].x; Av[1] = (int)vw[q].y; Av[2] = (int)vw[q].z; Av[3] = (int)vw[q].w; Av[4] = 0; Av[5] = 0; Av[6] = 0; Av[7] = 0;
                    if (q & 1) D2 = __builtin_amdgcn_mfma_scale_f32_32x32x64_f8f6f4(Av, Bv, D2, 4  , 0  , 0, 0, 0, 0  );
                    else D = __builtin_amdgcn_mfma_scale_f32_32x32x64_f8f6f4(Av, Bv, D, 4, 0, 0, 0, 0, 0);
                    __builtin_amdgcn_sched_barrier(0);
                    vw[q] = *(const u32x4*)(V8 + (size_t)idn[q] * 512 + 16 * hl);
                }
            };
#pragma unroll 1
            for (int g = 0; g < 7; ++g) groupV(g);
            const int tok = tokof(t);
            float o[16];
            { const bf16_t* hr0 = H1 + (size_t)tok * DM + hl;
#pragma unroll
              for (int r = 0; r < 16; ++r) o[r] = bf2f(__builtin_nontemporal_load(hr0 + 32 * crow(r, hi))); }
            groupV(7);
            float ss = 0.f;
#pragma unroll
            for (int r = 0; r < 16; ++r) { o[r] += (D[r] + D2[r]) * (1.f / 128.f); ss += o[r] * o[r]; D[r] = 0.f; D2[r] = 0.f; }
            const float rs = rsqrtf(wave_sum(ss) * (1.f / DM) + RMS_EPS);
            float* orow = outp + (size_t)tok * DM + hl;
#pragma unroll
            for (int r = 0; r < 16; ++r) __builtin_nontemporal_store(o[r] * rs * nfg[r], orow + 32 * crow(r, hi));
        }
    }
}

__global__ void __launch_bounds__(NTHREADS, 2) mega_fwd(Params p) {
    extern __shared__ __attribute__((aligned(16))) unsigned char lds_raw[];
    LAS unsigned char* lds = (LAS unsigned char*)lds_raw;
    const int tid = threadIdx.x, lane = tid & 63, wid = __builtin_amdgcn_readfirstlane(tid >> 6);
    unsigned char* ws = p.ws;
    bf16_t* XN = (bf16_t*)(ws + WS_XN);
    bf16_t* W1T = (bf16_t*)(ws + WS_W1T);
    volatile LAS unsigned* MISC = (volatile LAS unsigned*)(lds + LDS_MISC);
    if (tid < 64) MISC[tid] = 0u;
    __syncthreads();
    const XcdBarrier bar = xcd_barrier_post((unsigned*)ws, MISC + 8);
#define GSYNC() xcd_barrier(bar)

#ifndef ONLY
#define ONLY -1
#endif
#define PH(k) if (ONLY < 0 || ONLY == (k))
#define IDS() int tid = (int)threadIdx.x; asm volatile("" : "+v"(tid)); const int lane = tid & 63, wid = __builtin_amdgcn_readfirstlane(tid >> 6); (void)lane; (void)wid;
    PH(0) { IDS(); phase_prep(p, lds, tid, lane, wid); }
#if PROBE == 13
    phase_prep(p, lds, tid, lane, wid);
#endif
    GSYNC();
    PH(1) { IDS(); { F1a f{(bf16_t*)(ws + WS_QKV), (bf16_t*)(ws + WS_PB)}; run_gemm(lds, XN, W1T, N1A, 1024, f); } }
#if PROBE == 11
    { F1a f{(bf16_t*)(ws + WS_QKV), (bf16_t*)(ws + WS_PB)}; run_gemm(lds, XN, W1T, N1A, 1024, f); }
#endif
    GSYNC();
    PH(2) { IDS(); phase_wg8(p, lane, wid); phase_kbar_vt(p, lds, tid, lane, wid); }
#if PROBE == 14 || PROBE == 61
    phase_kbar_vt(p, lds, tid, lane, wid);
#endif
    PH(3) { IDS(); phase_rwkv_prep2<true>(p, lds, tid, lane, wid); }
#if PROBE == 8 || PROBE == 61
    phase_rwkv_prep2<true>(p, lds, tid, lane, wid);
#endif

    GSYNC();
    PH(6) { IDS(); phase_attn2<0>(p, lds, tid, lane, wid); }
#if PROBE == 63 || PROBE == 61
    __syncthreads();
    phase_attn2<0>(p, lds, tid, lane, wid);
#endif
    GSYNC();
    PH(5) { IDS(); phase_chunkprep<4>(p, lds, lane, wid); }
    PH(8) { IDS(); if (wid >= 4) { phase_uv_convert(p, lane, (int)blockIdx.x * 4 + wid - 4, (int)gridDim.x * 4); xn8_convert(p, lane, (int)blockIdx.x * 4 + wid - 4, (int)gridDim.x * 4); } }
#if PROBE == 31 || PROBE == 61
    phase_chunkprep<4>(p, lds, lane, wid);
#endif
#if PROBE == 33
    phase_chunkprep<1>(p, lds, lane, wid);
#endif
#if PROBE == 34
    phase_chunkprep<2>(p, lds, lane, wid);
#endif
#if PROBE == 35
    phase_chunkprep<3>(p, lds, lane, wid);
#endif
    GSYNC();
    PH(17) { IDS(); phase_chunkscan(p, lds, tid, lane, wid); }
    PH(9) { IDS(); if (gridDim.x > 64 && (int)blockIdx.x >= 64) { F1b f{ws, p.out, 0, (const signed char*)(ws + WS_WG8SC)}; run_gemm8_on(lds, (const unsigned char*)p.out + DO_XN8, ws + WS_WG8, G1B_EARLY, 1024, f, (int)gridDim.x - 64, (int)blockIdx.x - 64); } }
#if PROBE == 32 || PROBE == 62
    phase_chunkscan(p, lds, tid, lane, wid);
#endif
    GSYNC();
    PH(7) { IDS(); phase_post(p, tid, lane, wid); }
#if PROBE == 62
    phase_post(p, tid, lane, wid);
#endif
    PH(9) { IDS(); { const int e = gridDim.x > 64 ? G1B_EARLY : 0; F1b f{ws, p.out, e, (const signed char*)(ws + WS_WG8SC)}; run_gemm8(lds, (const unsigned char*)p.out + DO_XN8, ws + WS_WG8 + (size_t)e * 1024, NGATE - e, 1024, f); } }
#if PROBE == 64 || PROBE == 66
    { const int e = gridDim.x > 64 ? G1B_EARLY : 0; F1b f{ws, p.out, e, (const signed char*)(ws + WS_WG8SC)}; run_gemm8(lds, (const unsigned char*)p.out + DO_XN8, ws + WS_WG8 + (size_t)e * 1024, NGATE - e, 1024, f); }
#endif
    GSYNC();
    PH(10) { IDS(); { FPa f{ws, p.out, (bf16_t*)(ws + WS_Y)}; run_gemm(lds, (const bf16_t*)(ws + WS_OA), (const bf16_t*)(ws + WS_WPA), 1024, 512, f); } }
#if PROBE == 19 || PROBE == 66
    { FPa f{ws, p.out, (bf16_t*)(ws + WS_Y)}; run_gemm(lds, (const bf16_t*)(ws + WS_OA), (const bf16_t*)(ws + WS_WPA), 1024, 512, f); }
#endif
    __builtin_amdgcn_fence(__ATOMIC_ACQ_REL, "workgroup"); __syncthreads();
    PH(11) { IDS(); { FPb f{ws, p.out, (bf16_t*)(ws + WS_Y)}; run_gemm(lds, (const bf16_t*)(ws + WS_OB), (const bf16_t*)(ws + WS_WPB), 1024, 512, f); } }
    GSYNC();
    PH(12) { IDS(); { FOut f{p.x, p.norm2_g, (bf16_t*)(ws + WS_H1B), XN, (float*)(ws + WS_ROWSQ)}; run_gemm(lds, (const bf16_t*)(ws + WS_Y), (const bf16_t*)(ws + WS_WO), 1024, 1024, f); } }
#if PROBE == 65 || PROBE == 66
    { FOut f{p.x, p.norm2_g, (bf16_t*)(ws + WS_H1B), XN, (float*)(ws + WS_ROWSQ)}; run_gemm(lds, (const bf16_t*)(ws + WS_Y), (const bf16_t*)(ws + WS_WO), 1024, 1024, f); }
#endif
    GSYNC();
    PH(14) { IDS(); { FQ f{(bf16_t*)(ws + WS_QP)}; run_gemm(lds, XN, (const bf16_t*)(ws + WS_WQ), 2048, 1024, f); } }
#if PROBE == 12 || PROBE == 62
    { FQ f{(bf16_t*)(ws + WS_QP)}; run_gemm(lds, XN, (const bf16_t*)(ws + WS_WQ), 2048, 1024, f); }
#endif
    GSYNC();
    PH(15) { IDS(); phase_route(p, lds, lane, wid); }
#if PROBE == 7 || PROBE == 62
    phase_route(p, lds, lane, wid);
#endif
    __builtin_amdgcn_fence(__ATOMIC_ACQ_REL, "workgroup"); __syncthreads();
#if PROBE == 4 || PROBE == 52
#pragma unroll 1
    for (int rep = 0; rep < 2; ++rep) { IDS(); phase_experts(p, lds + wid * 6144, lane, wid, rep == 0 ? (float*)(ws + WS_QKV) : p.out, (rep == 0 && PROBE == 52) ? 2047 : -1); }
#else
    PH(16) { IDS(); phase_experts(p, lds + wid * 6144, lane, wid, p.out, -1); }
#endif
}

extern "C" void kernel_launch(void* const* d_in, const int* in_sizes, int n_in, void* d_out, int out_size, void* d_ws, size_t ws_size, hipStream_t stream) {
    static int grid = 0;
    if (grid == 0) {
        if (n_in != 24 || out_size != NTOK * DM || ws_size < WS_NEED) { fprintf(stderr, "kernel_launch: unexpected problem (n_in %d, out %d, ws %zu)\n", n_in, out_size, ws_size); grid = -1; return; }
        int dev = 0, cus = 0, per_cu = 0;
        if (hipGetDevice(&dev) != hipSuccess || hipDeviceGetAttribute(&cus, hipDeviceAttributeMultiprocessorCount, dev) != hipSuccess) { grid = -1; return; }
        if (hipFuncSetAttribute((const void*)mega_fwd, hipFuncAttributeMaxDynamicSharedMemorySize, LDS_BYTES) != hipSuccess) { fprintf(stderr, "kernel_launch: hipFuncSetAttribute failed\n"); grid = -1; return; }
        if (hipOccupancyMaxActiveBlocksPerMultiprocessor(&per_cu, (const void*)mega_fwd, NTHREADS, LDS_BYTES) != hipSuccess || per_cu < 1) { fprintf(stderr, "kernel_launch: occupancy query says %d\n", per_cu); per_cu = 0; }
        (void)hipGetLastError();
        if (per_cu < 1) { grid = -1; return; }
        grid = cus * 1;
        if (grid < 1) grid = -1;
    }
    if (grid < 0) return;
    Params p{};
    p.x = (const float*)d_in[0]; p.norm1_g = (const float*)d_in[1]; p.w_in = (const float*)d_in[2]; p.rwkv_mu = (const float*)d_in[3];
    p.w0 = (const float*)d_in[4]; p.w_lora_up = (const float*)d_in[5]; p.a0 = (const float*)d_in[6]; p.a_lora_up = (const float*)d_in[7];
    p.g_lora_up = (const float*)d_in[8]; p.k_k = (const float*)d_in[9]; p.k_a = (const float*)d_in[10]; p.r_k = (const float*)d_in[11];
    p.lnx_g = (const float*)d_in[12]; p.lnx_b = (const float*)d_in[13]; p.w_proj_a = (const float*)d_in[14]; p.w_proj_b = (const float*)d_in[15];
    p.w_out = (const float*)d_in[16]; p.norm2_g = (const float*)d_in[17]; p.peer_wq = (const float*)d_in[18]; p.peer_subkeys = (const float*)d_in[19];
    p.peer_u = (const float*)d_in[20]; p.peer_v = (const float*)d_in[21]; p.rel_bias = (const float*)d_in[22]; p.normf_g = (const float*)d_in[23];
    p.out = (float*)d_out; p.ws = (unsigned char*)d_ws;
    if (hipMemsetAsync(d_ws, 0, 65536, stream) != hipSuccess) { fprintf(stderr, "kernel_launch: memset failed\n"); return; }
    void* args[] = {&p};
    hipError_t e = hipLaunchCooperativeKernel((const void*)mega_fwd, dim3(grid), dim3(NTHREADS), args, LDS_BYTES, stream);
    if (e != hipSuccess) fprintf(stderr, "kernel_launch: cooperative launch failed: %s (grid %d)\n", hipGetErrorString(e), grid);
}
```

```cpp
#include <hip/hip_runtime.h>
#include <hip/hip_cooperative_groups.h>
#include <cstdio>
#include <cstdint>
#include <utility>
namespace cg = cooperative_groups;
namespace pg8 {
#define PG8_LAS __attribute__((address_space(3)))
typedef unsigned short bf16_t;
typedef short bf16x8 __attribute__((ext_vector_type(8)));
typedef float f32x4 __attribute__((ext_vector_type(4)));
typedef unsigned u32x4 __attribute__((ext_vector_type(4)));
constexpr int BM = 256, BK = 64, HALF = 128, HTB = HALF * BK * 2  , STAGE_BYTES = 8 * HTB, NXCD = 8, WGM = 8;

__host__ __device__ __forceinline__ int lds_byte(int r, int c) { const int st = (r >> 4) * 2 + (c >> 5), rr = r & 15, cc = c & 31, ob = rr * 64 + cc * 2; return st * 1024 + (ob ^ (((ob >> 9) & 1) << 5)); }
__host__ __device__ __forceinline__ void stage_rc(int b, int& R, int& C) { const int st = b / 1024, sb = b % 1024, swz = sb ^ (((sb >> 9) & 1) << 5); R = (st >> 1) * 16 + swz / 64; C = (st & 1) * 32 + (swz % 64) / 2; }
__host__ __device__ __forceinline__ int perm32(int rho) { const int n = rho >> 4, i = rho & 15; return 8 * (i >> 2) + 4 * n + (i & 3); }

struct Unit { int pm, pn; };
struct Gemm { const bf16_t* A; const bf16_t* Bt; int M, N, K; };

struct StaticOrder {
    int nM, nN, nwg, G, c;
    __host__ __device__ void init(int M, int N, int G_, int c_) { nM = M / BM; nN = N / BM; nwg = nM * nN; G = G_; c = c_; }
    __host__ __device__ bool next(int i, Unit& u) const {
        const long L = (long)i * G + c; if (L >= nwg) return false;
        int wgid = (int)L; { const int q = nwg / NXCD, r = nwg % NXCD, xcd = wgid % NXCD, off = wgid / NXCD; wgid = (xcd < r ? xcd * (q + 1) : r * (q + 1) + (xcd - r) * q) + off; }
        const int nig = WGM * nN, gid = wgid / nig, fm = gid * WGM, gsz = (nM - fm) < WGM ? (nM - fm) : WGM;
        u.pm = fm + ((wgid % nig) % gsz); u.pn = (wgid % nig) / gsz; return true;
    }
    __device__ __forceinline__ void a_ready(const Unit&) const {}
    __device__ __forceinline__ void done(const Unit&) const {}
};
typedef int pg8_v8i __attribute__((ext_vector_type(8)));
__device__ __forceinline__ pg8_v8i pg8_cat8(bf16x8 lo, bf16x8 hi) {
    typedef int v4i_ __attribute__((ext_vector_type(4)));
    const v4i_ a = __builtin_bit_cast(v4i_, lo), b = __builtin_bit_cast(v4i_, hi);
    return (pg8_v8i){a[0], a[1], a[2], a[3], b[0], b[1], b[2], b[3]};
}
template <class Epi, class Sched, bool ALIGN_EPI = false, bool SP2 = false, bool FP8 = false>
__device__ __forceinline__ void gemm_phase(PG8_LAS unsigned char* lds, const Gemm g, const Sched& S, const Epi& E) {
    int tid_ = (int)threadIdx.x; asm volatile("" : "+v"(tid_));
    const int tid = tid_, wid = __builtin_amdgcn_readfirstlane(tid >> 6), lane = tid & 63, wr = wid >> 2, wc = wid & 3, fr = lane & 15, fq = lane >> 4;
    const int K = g.K, nt = K / BK;
    unsigned voffA[2], voffB[2];
#pragma unroll
    for (int i = 0; i < 2; ++i) { int R, C; stage_rc(tid * 16 + i * 8192, R, C); const int Rb = Epi::PERM ? ((R & ~31) + perm32(R & 31)) : R;
        voffA[i] = (unsigned)(R * K + C) * 2u; voffB[i] = (unsigned)(Rb * K + C) * 2u; }
    const size_t kstep = (size_t)(BK * 2);
    const size_t hstep = (size_t)HALF * K * 2;
    const size_t tstep = 2 * hstep;
    const unsigned ldsw = (unsigned)wid * 1024u;
    const int aoff = lds_byte(wr * 64 + fr, fq * 8), boff = lds_byte(wc * 32 + fr, fq * 8);
#define PG8_SA(b, h) (((b) * 2 + (h)) * HTB)
#define PG8_SB(b, h) ((4 + (b) * 2 + (h)) * HTB)
#define PG8_STAGE(bufoff, gbase, voff) do { _Pragma("unroll") for (int _i = 0; _i < 2; ++_i) \
        __builtin_amdgcn_global_load_lds((const unsigned*)((const char*)(gbase) + (voff)[_i]), (PG8_LAS unsigned*)(lds + (bufoff) + ldsw + _i * 8192), 16, 0, 0); } while (0)
#define PG8_LDA(dst, b, h) do { _Pragma("unroll") for (int m = 0; m < 4; ++m) { \
        if constexpr (FP8) dst##8[m] = pg8_cat8(*(const PG8_LAS bf16x8*)(lds + PG8_SA(b, h) + aoff + m * 2048), *(const PG8_LAS bf16x8*)(lds + PG8_SA(b, h) + aoff + m * 2048 + 1024)); \
        else { _Pragma("unroll") for (int k = 0; k < 2; ++k) dst[m][k] = *(const PG8_LAS bf16x8*)(lds + PG8_SA(b, h) + aoff + m * 2048 + k * 1024); } } } while (0)
#define PG8_LDB(dst, b, h) do { _Pragma("unroll") for (int n = 0; n < 2; ++n) { \
        if constexpr (FP8) dst##8[n] = pg8_cat8(*(const PG8_LAS bf16x8*)(lds + PG8_SB(b, h) + boff + n * 2048), *(const PG8_LAS bf16x8*)(lds + PG8_SB(b, h) + boff + n * 2048 + 1024)); \
        else { _Pragma("unroll") for (int k = 0; k < 2; ++k) dst[n][k] = *(const PG8_LAS bf16x8*)(lds + PG8_SB(b, h) + boff + n * 2048 + k * 1024); } } } while (0)
#define PG8_MMA(ai, bj, At, Bt) do { __builtin_amdgcn_s_setprio(1); \
        if constexpr (FP8) { _Pragma("unroll") for (int m = 0; m < 4; ++m) _Pragma("unroll") for (int n = 0; n < 2; ++n) \
            asm volatile("v_mfma_f32_16x16x128_f8f6f4 %0, %1, %2, %0" : "+v"(acc[ai][bj][m][n]) : "v"(Bt##8[n]), "v"(At##8[m])); } \
        else { _Pragma("unroll") for (int m = 0; m < 4; ++m) _Pragma("unroll") for (int n = 0; n < 2; ++n) _Pragma("unroll") for (int k = 0; k < 2; ++k) \
            acc[ai][bj][m][n] = __builtin_amdgcn_mfma_f32_16x16x32_bf16(Bt[n][k], At[m][k], acc[ai][bj][m][n], 0, 0, 0); } \
        __builtin_amdgcn_s_setprio(0); } while (0)
#define PG8_WAIT_V(n) asm volatile("s_waitcnt vmcnt(" #n ")" ::: "memory")
#define PG8_WAIT_L(n) asm volatile("s_waitcnt lgkmcnt(" #n ")" ::: "memory")
#define PG8_BAR __builtin_amdgcn_s_barrier()
#define PG8_SCHED __builtin_amdgcn_sched_barrier(0)
    Unit cur, nxt; int ui = 0;
    if (!S.next(0, cur)) return;
    f32x4 acc[2][2][4][2];
#pragma unroll
    for (int a = 0; a < 2; ++a)
#pragma unroll
        for (int b = 0; b < 2; ++b)
#pragma unroll
            for (int m = 0; m < 4; ++m)
#pragma unroll
                for (int n = 0; n < 2; ++n) acc[a][b][m][n] = (f32x4){0.f, 0.f, 0.f, 0.f};
    bf16x8 At[4][2], B0[2][2], B1[2][2];
    pg8_v8i At8[4], B08[2], B18[2];
    const char* cA = (const char*)g.A + (size_t)cur.pm * tstep; const char* cB = (const char*)g.Bt + (size_t)cur.pn * tstep;
    S.a_ready(cur);
    if constexpr (SP2) {
        PG8_STAGE(PG8_SB(0, 0), cB, voffB); PG8_STAGE(PG8_SB(0, 1), cB + hstep, voffB); PG8_STAGE(PG8_SA(0, 0), cA, voffA); PG8_STAGE(PG8_SA(0, 1), cA + hstep, voffA);
        if (wr == 1) PG8_BAR;
        PG8_WAIT_V(2); PG8_BAR;
        PG8_STAGE(PG8_SB(1, 0), cB + kstep, voffB); PG8_STAGE(PG8_SA(1, 0), cA + kstep, voffA); PG8_STAGE(PG8_SB(1, 1), cB + hstep + kstep, voffB);
        PG8_WAIT_V(6); PG8_BAR;
    } else {
        PG8_STAGE(PG8_SB(0, 0), cB, voffB); PG8_STAGE(PG8_SA(0, 0), cA, voffA); PG8_STAGE(PG8_SB(0, 1), cB + hstep, voffB); PG8_STAGE(PG8_SA(0, 1), cA + hstep, voffA);
        if (wr == 1) PG8_BAR;
        PG8_WAIT_V(4); PG8_BAR;
        PG8_STAGE(PG8_SB(1, 0), cB + kstep, voffB); PG8_STAGE(PG8_SA(1, 0), cA + kstep, voffA); PG8_STAGE(PG8_SB(1, 1), cB + hstep + kstep, voffB);
        PG8_WAIT_V(6); PG8_BAR;
    }
    for (;;) {
        const bool has_next = S.next(ui + 1, nxt);
        const char* nA = has_next ? (const char*)g.A + (size_t)nxt.pm * tstep : cA; const char* nB = has_next ? (const char*)g.Bt + (size_t)nxt.pn * tstep : cB;
        for (int t = 0; t < nt; t += 2) {
            const bool last = (t == nt - 2);
            const char* a1 = cA + (size_t)(t + 1) * kstep;
            const char* a2 = last ? nA : cA + (size_t)(t + 2) * kstep; const char* b2 = last ? nB : cB + (size_t)(t + 2) * kstep;
            const char* a3 = a2 + kstep; const char* b3 = b2 + kstep;
            if (last && has_next) S.a_ready(nxt);
            if constexpr (SP2) {
            PG8_LDB(B0, 0, 0); PG8_LDB(B1, 0, 1); PG8_SCHED; PG8_LDA(At, 0, 0); PG8_STAGE(PG8_SA(1, 1), a1 + hstep, voffA);
            PG8_WAIT_V(8); PG8_WAIT_L(0); PG8_BAR; PG8_MMA(0, 0, At, B0); PG8_MMA(0, 1, At, B1); PG8_BAR; PG8_SCHED;
            PG8_LDA(At, 0, 1); PG8_STAGE(PG8_SB(0, 0), b2, voffB); PG8_STAGE(PG8_SB(0, 1), b2 + hstep, voffB); PG8_STAGE(PG8_SA(0, 0), a2, voffA);
            PG8_WAIT_V(8); PG8_WAIT_L(0); PG8_BAR; PG8_MMA(1, 0, At, B0); PG8_MMA(1, 1, At, B1); PG8_BAR; PG8_SCHED;
            PG8_LDB(B0, 1, 0); PG8_LDB(B1, 1, 1); PG8_SCHED; PG8_LDA(At, 1, 0); PG8_STAGE(PG8_SA(0, 1), a2 + hstep, voffA);
            PG8_WAIT_V(8); PG8_WAIT_L(0); PG8_BAR; PG8_MMA(0, 0, At, B0); PG8_MMA(0, 1, At, B1); PG8_BAR; PG8_SCHED;
            PG8_LDA(At, 1, 1); PG8_STAGE(PG8_SB(1, 0), b3, voffB); PG8_STAGE(PG8_SB(1, 1), b3 + hstep, voffB); PG8_STAGE(PG8_SA(1, 0), a3, voffA);
            PG8_WAIT_V(8); PG8_WAIT_L(0); PG8_BAR; PG8_MMA(1, 0, At, B0); PG8_MMA(1, 1, At, B1); PG8_BAR; PG8_SCHED;
            } else {
            PG8_LDB(B0, 0, 0); PG8_SCHED; PG8_LDA(At, 0, 0); PG8_STAGE(PG8_SA(1, 1), a1 + hstep, voffA);
            PG8_WAIT_L(8); PG8_BAR; PG8_WAIT_L(0); PG8_MMA(0, 0, At, B0); PG8_BAR; PG8_SCHED;
            PG8_LDB(B1, 0, 1); PG8_STAGE(PG8_SB(0, 0), b2, voffB);
            PG8_BAR; PG8_WAIT_L(0); PG8_MMA(0, 1, At, B1); PG8_BAR;
            PG8_LDA(At, 0, 1); PG8_STAGE(PG8_SA(0, 0), a2, voffA);
            PG8_BAR; PG8_WAIT_L(0); PG8_MMA(1, 0, At, B0); PG8_BAR; PG8_SCHED;
            PG8_STAGE(PG8_SB(0, 1), b2 + hstep, voffB);
            PG8_WAIT_V(6); PG8_BAR; PG8_MMA(1, 1, At, B1); PG8_BAR;
            PG8_LDB(B0, 1, 0); PG8_SCHED; PG8_LDA(At, 1, 0); PG8_STAGE(PG8_SA(0, 1), a2 + hstep, voffA);
            PG8_WAIT_L(8); PG8_BAR; PG8_WAIT_L(0); PG8_MMA(0, 0, At, B0); PG8_BAR; PG8_SCHED;
            PG8_LDB(B1, 1, 1); PG8_STAGE(PG8_SB(1, 0), b3, voffB);
            PG8_BAR; PG8_WAIT_L(0); PG8_MMA(0, 1, At, B1); PG8_BAR;
            PG8_LDA(At, 1, 1); PG8_STAGE(PG8_SA(1, 0), a3, voffA);
            PG8_BAR; PG8_WAIT_L(0); PG8_MMA(1, 0, At, B0); PG8_BAR; PG8_SCHED;
            PG8_STAGE(PG8_SB(1, 1), b3 + hstep, voffB);
            PG8_WAIT_V(6); PG8_BAR; PG8_MMA(1, 1, At, B1); PG8_BAR;
            }
        }
        if constexpr (ALIGN_EPI) { if (wr == 0) PG8_BAR; }
        if constexpr (!Epi::AFTER_DRAIN) { E(acc, cur, wr, wc, fr, fq); S.done(cur); }
        if (!has_next) break;
#pragma unroll
        for (int a = 0; a < 2; ++a)
#pragma unroll
            for (int b = 0; b < 2; ++b)
#pragma unroll
                for (int m = 0; m < 4; ++m)
#pragma unroll
                    for (int n = 0; n < 2; ++n) acc[a][b][m][n] = (f32x4){0.f, 0.f, 0.f, 0.f};
        cur = nxt; cA = nA; cB = nB; ++ui;
        if constexpr (ALIGN_EPI) { if (wr == 1) PG8_BAR; }
    }
    PG8_WAIT_V(0);
    if constexpr (!ALIGN_EPI) { if (wr == 0) PG8_BAR; }
    PG8_BAR;
    if constexpr (Epi::AFTER_DRAIN) { E.fused(acc, cur, wr, wc, fr, fq, lds, wid, lane); S.done(cur); }
#undef PG8_SA
#undef PG8_SB
#undef PG8_STAGE
#undef PG8_LDA
#undef PG8_LDB
#undef PG8_MMA
#undef PG8_WAIT_V
#undef PG8_WAIT_L
#undef PG8_BAR
#undef PG8_SCHED
}
}

#define DI __device__ __forceinline__
#ifndef PROBE
#define PROBE 0
#endif
#define LAS __attribute__((address_space(3)))
typedef unsigned short bf16_t;
typedef short bf16x8 __attribute__((ext_vector_type(8)));
typedef short s16x4 __attribute__((ext_vector_type(4)));
typedef float f32x4 __attribute__((ext_vector_type(4)));
typedef float f32x2 __attribute__((ext_vector_type(2)));
typedef float f32x16 __attribute__((ext_vector_type(16)));
typedef unsigned u32x4 __attribute__((ext_vector_type(4)));
typedef unsigned u32x2 __attribute__((ext_vector_type(2)));

constexpr int NB = 8, SEQ = 4096, DM = 1024, NTOK = NB * SEQ, NH = 8, HD = 64;
constexpr int QKVW = 1536, PBW = 1824, N1A = 3584, N1A_REAL = 3360, NGATE = 2048, W1ROWS = 5632;
constexpr int G1B_EARLY = 2048;
constexpr int NEXP = 16384;
constexpr float RMS_EPS = 1e-6f, GN_EPS = 64e-5f;
constexpr float LOG2E = 1.4426950408889634f;
constexpr int NTHREADS = 512, NWAVES = 8;
constexpr int LDS_BYTES = 148480;
constexpr int LDS_MISC = 147968;

constexpr size_t MiB = 1u << 20;
constexpr size_t WS_W1T = 1 * MiB;
constexpr size_t WS_WPA = 12 * MiB;
constexpr size_t WS_WPB = 13 * MiB;
constexpr size_t WS_WO = 14 * MiB;
constexpr size_t WS_WQ = 16 * MiB;
constexpr size_t WS_SK = 20 * MiB;
constexpr size_t WS_KBAR = 20 * MiB + 512 * 1024;
constexpr size_t WS_SEL = 21 * MiB;
constexpr size_t WS_LWT = 21 * MiB + 512 * 1024;
constexpr size_t WS_XN = 22 * MiB;
constexpr size_t WS_QKV = 86 * MiB;
constexpr size_t WS_PB = 182 * MiB;
constexpr size_t WS_SCAN = 296 * MiB;
constexpr size_t WS_OA = 182 * MiB;
constexpr size_t WS_OBRAW = 262 * MiB;
constexpr size_t WS_OB = 86 * MiB;
constexpr size_t WS_GATES = 296 * MiB;
constexpr size_t WS_U8 = 488 * MiB;
constexpr size_t WS_V8 = 500 * MiB;
constexpr size_t WS_ROWSQ = 497 * MiB;
constexpr size_t WS_RS = 499 * MiB;
constexpr size_t WS_H1B = 344 * MiB;
constexpr size_t WS_WG8 = 509 * MiB;
constexpr size_t WS_WG8SC = 511 * MiB;
constexpr size_t DO_XN8 = 0;
constexpr size_t DO_GEARLY = 112 * MiB;
constexpr size_t WS_USC = 256 * 1024;
constexpr size_t WS_Y = 118 * MiB;
constexpr size_t WS_QP = 182 * MiB;
constexpr size_t WS_PIDX = 310 * MiB;
constexpr size_t WS_PGATE = 326 * MiB;
constexpr size_t WS_NEED = 512 * MiB;
constexpr size_t DO_VT = 0, DO_RG = 32 * MiB, DO_KF = 64 * MiB;

struct Params {
    const float* x; const float* norm1_g; const float* w_in; const float* rwkv_mu; const float* w0; const float* w_lora_up;
    const float* a0; const float* a_lora_up; const float* g_lora_up; const float* k_k; const float* k_a; const float* r_k;
    const float* lnx_g; const float* lnx_b; const float* w_proj_a; const float* w_proj_b; const float* w_out; const float* norm2_g;
    const float* peer_wq; const float* peer_subkeys; const float* peer_u; const float* peer_v; const float* rel_bias; const float* normf_g;
    float* out; unsigned char* ws;
};

DI float bflo(unsigned u) { return __uint_as_float(u << 16); }
DI float bfhi(unsigned u) { return __uint_as_float(u & 0xffff0000u); }
DI float bf2f(bf16_t h) { return __uint_as_float((unsigned)h << 16); }
DI unsigned pk2(float lo, float hi) {
    typedef __bf16 b2 __attribute__((ext_vector_type(2)));
    f32x2 v = {lo, hi}; b2 b = __builtin_convertvector(v, b2); return __builtin_bit_cast(unsigned, b);
}
DI bf16_t f2bf(float f) { return (bf16_t)(pk2(f, 0.f) & 0xffffu); }
DI u32x4 pack8(f32x4 a, f32x4 b) { u32x4 w; w.x = pk2(a[0], a[1]); w.y = pk2(a[2], a[3]); w.z = pk2(b[0], b[1]); w.w = pk2(b[2], b[3]); return w; }
DI void unpack8(u32x4 w, float (&f)[8]) {
    f[0] = bflo(w.x); f[1] = bfhi(w.x); f[2] = bflo(w.y); f[3] = bfhi(w.y); f[4] = bflo(w.z); f[5] = bfhi(w.z); f[6] = bflo(w.w); f[7] = bfhi(w.w);
}
template <int CTRL> DI float dpp_mov(float x) { return __builtin_bit_cast(float, __builtin_amdgcn_update_dpp(0, __builtin_bit_cast(int, x), CTRL, 0xf, 0xf, false)); }
DI float row16_sum(float x) {
    x += dpp_mov<0x128>(x); x += dpp_mov<0x124>(x); x += dpp_mov<0x122>(x); x += dpp_mov<0x121>(x); return x;
}
DI float wave_sum(float v) {
    v = row16_sum(v);
    const float a = __builtin_bit_cast(float, __builtin_amdgcn_readlane(__builtin_bit_cast(int, v), 0)), b = __builtin_bit_cast(float, __builtin_amdgcn_readlane(__builtin_bit_cast(int, v), 16));
    const float c = __builtin_bit_cast(float, __builtin_amdgcn_readlane(__builtin_bit_cast(int, v), 32)), d = __builtin_bit_cast(float, __builtin_amdgcn_readlane(__builtin_bit_cast(int, v), 48));
    return (a + b) + (c + d);
}
DI float vmul_(float a, float b) { float d; asm("v_mul_f32 %0, %1, %2" : "=v"(d) : "v"(a), "v"(b)); return d; }
DI float vfma_(float a, float b, float c) { float d; asm("v_fma_f32 %0, %1, %2, %3" : "=v"(d) : "v"(a), "v"(b), "v"(c)); return d; }
DI float vfnma_(float a, float b, float c) { float d; asm("v_fma_f32 %0, -%1, %2, %3" : "=v"(d) : "v"(a), "v"(b), "v"(c)); return d; }
DI float sigmoidf_(float x) { return __builtin_amdgcn_rcpf(1.0f + __expf(-x)); }
DI int crow(int r, int hi) { return (r & 3) + 8 * (r >> 2) + 4 * hi; }
#define MFMA32(a, b, c) __builtin_amdgcn_mfma_f32_32x32x16_bf16((a), (b), (c), 0, 0, 0)
#define LDS_WAIT() asm volatile("s_waitcnt lgkmcnt(0)" ::: "memory")

#define XB_TMO      128
#define XB_XCNT(j)  (256  + 64 * (j))
#define XB_XSUB(j)  (1280 + 64 * (j))
#define XB_XGEN(j)  (2304 + 64 * (j))
#define XB_TOP      3328
#define XB_TOPGEN   3392
#define XCD_BAR_WORDS 3456
#define XB_SPIN_CAP (1u << 22)

__device__ __forceinline__ unsigned xb_ld(unsigned* p)              { return __hip_atomic_load(p, __ATOMIC_RELAXED, __HIP_MEMORY_SCOPE_AGENT); }
__device__ __forceinline__ unsigned xb_add(unsigned* p, unsigned v) { return __hip_atomic_fetch_add(p, v, __ATOMIC_RELAXED, __HIP_MEMORY_SCOPE_AGENT); }
__device__ __forceinline__ unsigned xb_xcc_id() { return (unsigned)__builtin_amdgcn_s_getreg((3 << 11) | 20) & 0xFu; }
#define XB_SPIN(cond, bar) do { unsigned _sp = 0; while (cond) { __builtin_amdgcn_s_sleep(1); \
    if ((++_sp & 255u) == 0u) { if (xb_ld(&(bar)[XB_TMO])) break; if (_sp > XB_SPIN_CAP) { atomicAdd(&(bar)[XB_TMO], 1u); break; } } } } while (0)

struct XcdBarrier {
    unsigned* bar; unsigned x;
    volatile LAS unsigned* st;
};

__device__ __forceinline__ XcdBarrier xcd_barrier_post(unsigned* bar, volatile LAS unsigned* st) {
    XcdBarrier b; b.bar = bar; b.x = xb_xcc_id(); b.st = st;
    if (threadIdx.x == 0) (void)xb_add(&bar[XB_XCNT(b.x)], 1u);
    return b;
}
__device__ __forceinline__ void xcd_barrier_complete(unsigned* bar, unsigned x, unsigned& nloc, unsigned& nx) {
    const unsigned G = gridDim.x * gridDim.y * gridDim.z;
    unsigned sum, cnt, mine, sp = 0u;
    for (;;) {
        sum = 0u; cnt = 0u; mine = 0u;
#pragma unroll
        for (unsigned j = 0; j < 16; ++j) { const unsigned c = xb_ld(&bar[XB_XCNT(j)]); sum += c; cnt += (c > 0u) ? 1u : 0u; mine = (j == x) ? c : mine; }
        if (sum == G) break;
        __builtin_amdgcn_s_sleep(1);
        if ((++sp & 255u) == 0u) { if (xb_ld(&bar[XB_TMO])) break; if (sp > XB_SPIN_CAP) { atomicAdd(&bar[XB_TMO], 1u); break; } }
    }
    nloc = mine > 0u ? mine : 1u; nx = cnt > 0u ? cnt : 1u;
}

__device__ __forceinline__ void xcd_barrier(const XcdBarrier& b) {
    asm volatile("s_waitcnt vmcnt(0)" ::: "memory");
    __syncthreads();
    if (threadIdx.x == 0) {
        unsigned* bar = b.bar;
        __builtin_amdgcn_s_waitcnt(0);
        unsigned nloc = b.st[0], nx = b.st[1];
        if (nloc == 0u) { xcd_barrier_complete(bar, b.x, nloc, nx); b.st[0] = nloc; b.st[1] = nx; }
        const unsigned old = xb_add(&bar[XB_XSUB(b.x)], 1u);
        const unsigned gen = old / nloc;
        if (old + 1u == (gen + 1u) * nloc) {
            __builtin_amdgcn_fence(__ATOMIC_RELEASE, "agent");
            asm volatile("s_waitcnt vmcnt(0)" ::: "memory");
            const unsigned og = xb_add(&bar[XB_TOP], 1u);
            const unsigned tg = og / nx;
            if (og + 1u == (tg + 1u) * nx) xb_add(&bar[XB_TOPGEN], 1u);
            else XB_SPIN(xb_ld(&bar[XB_TOPGEN]) == tg, bar);
            __builtin_amdgcn_fence(__ATOMIC_ACQUIRE, "agent");
            xb_add(&bar[XB_XGEN(b.x)], 1u);
            asm volatile("s_waitcnt vmcnt(0)" ::: "memory");
        } else {
            XB_SPIN(xb_ld(&bar[XB_XGEN(b.x)]) == gen, bar);
            __builtin_amdgcn_fence(__ATOMIC_ACQUIRE, "agent");
            asm volatile("s_waitcnt vmcnt(0)" ::: "memory");
        }
    }
    __syncthreads();
}
__device__ __forceinline__ void xcd_local_align(const XcdBarrier& b) {
    __syncthreads();
    if (threadIdx.x == 0) {
        unsigned* bar = b.bar;
        unsigned nloc = b.st[0], nx = b.st[1];
        if (nloc == 0u) { xcd_barrier_complete(bar, b.x, nloc, nx); b.st[0] = nloc; b.st[1] = nx; }
        const unsigned old = xb_add(&bar[XB_XSUB(b.x)], 1u);
        const unsigned gen = old / nloc;
        if (old + 1u == (gen + 1u) * nloc) xb_add(&bar[XB_XGEN(b.x)], 1u);
        else XB_SPIN(xb_ld(&bar[XB_XGEN(b.x)]) == gen, bar);
    }
    __syncthreads();
}


template <class F> struct EpiF {
    static constexpr bool PERM = true, AFTER_DRAIN = false; F f;
    DI void operator()(const pg8::f32x4 (&acc)[2][2][4][2], const pg8::Unit& u, int wr, int wc, int fr, int fq) const {
        const int row0 = u.pm * 256 + wr * 64 + fr, col0 = u.pn * 256 + wc * 32 + 8 * fq;
        const typename F::Tile tl = f.tile(col0);
#pragma unroll
        for (int ai = 0; ai < 2; ++ai) {
            typename F::Pre pre[4][2];
#pragma unroll
            for (int m = 0; m < 4; ++m)
#pragma unroll
                for (int bj = 0; bj < 2; ++bj) pre[m][bj] = f.load(row0 + ai * 128 + m * 16, col0 + bj * 128);
#pragma unroll
            for (int m = 0; m < 4; ++m) {
                float s = 0.f;
#pragma unroll
                for (int bj = 0; bj < 2; ++bj) s += f.apply(row0 + ai * 128 + m * 16, col0 + bj * 128, acc[ai][bj][m][0], acc[ai][bj][m][1], pre[m][bj], tl, bj);
                f.row_end(row0 + ai * 128 + m * 16, s, fq, u.pn * 4 + wc);
            }
        }
    }
};
template <class F> DI void run_gemm(LAS unsigned char* lds, const bf16_t* A, const bf16_t* Bt, int N, int K, const F& f) {
    pg8::Gemm g{A, Bt, NTOK, N, K}; pg8::StaticOrder S; S.init(NTOK, N, (int)gridDim.x, (int)blockIdx.x); EpiF<F> E{f};
    pg8::gemm_phase<EpiF<F>, pg8::StaticOrder, true, true>(lds, g, S, E);
}
template <class F> DI void run_gemm_on(LAS unsigned char* lds, const bf16_t* A, const bf16_t* Bt, int N, int K, const F& f, int nblocks, int myblock) {
    pg8::Gemm g{A, Bt, NTOK, N, K}; pg8::StaticOrder S; S.init(NTOK, N, nblocks, myblock); EpiF<F> E{f};
    pg8::gemm_phase<EpiF<F>, pg8::StaticOrder, true, true>(lds, g, S, E);
}
template <class F> DI void run_gemm8(LAS unsigned char* lds, const unsigned char* A8, const unsigned char* Bt8, int N, int K8, const F& f) {
    pg8::Gemm g{(const bf16_t*)A8, (const bf16_t*)Bt8, NTOK, N, K8 / 2}; pg8::StaticOrder S; S.init(NTOK, N, (int)gridDim.x, (int)blockIdx.x); EpiF<F> E{f};
    pg8::gemm_phase<EpiF<F>, pg8::StaticOrder, true, true, true>(lds, g, S, E);
}
template <class F> DI void run_gemm8_on(LAS unsigned char* lds, const unsigned char* A8, const unsigned char* Bt8, int N, int K8, const F& f, int nblocks, int myblock) {
    pg8::Gemm g{(const bf16_t*)A8, (const bf16_t*)Bt8, NTOK, N, K8 / 2}; pg8::StaticOrder S; S.init(NTOK, N, nblocks, myblock); EpiF<F> E{f};
    pg8::gemm_phase<EpiF<F>, pg8::StaticOrder, true, true, true>(lds, g, S, E);
}
struct NoPre {}; struct NoTile {};
#define EPI_PLAIN typedef NoTile Tile; DI Tile tile(int) const { return Tile{}; } DI void row_end(int, float, int, int) const {}
struct F1a { bf16_t* qkv; bf16_t* pb; typedef NoPre Pre;
    DI Pre load(int, int) const { return Pre{}; }
    EPI_PLAIN
    DI float apply(int row, int col, f32x4 v0, f32x4 v1, Pre, Tile, int) const {
        const u32x4 w = pack8(v0, v1);
        if (col < QKVW) *(u32x4*)(qkv + (size_t)row * QKVW + col) = w;
        else if (col < N1A_REAL) *(u32x4*)(pb + (size_t)row * PBW + (col - QKVW)) = w;
        return 0.f;
    } };
DI const unsigned char* gate_ptr(const unsigned char* ws, const float* dout, int row, int gcol) {
    if (gcol < G1B_EARLY) return ws + WS_XN + (size_t)row * G1B_EARLY + gcol;
    return (const unsigned char*)dout + DO_GEARLY + (size_t)row * (NGATE - G1B_EARLY) + (gcol - G1B_EARLY);
}
DI u32x4 gates8_to_bf16(u32x2 w) {
    const float k = 1.f / 255.f;
    return (u32x4){pk2((float)(w.x & 255u) * k, (float)((w.x >> 8) & 255u) * k), pk2((float)((w.x >> 16) & 255u) * k, (float)(w.x >> 24) * k),
                   pk2((float)(w.y & 255u) * k, (float)((w.y >> 8) & 255u) * k), pk2((float)((w.y >> 16) & 255u) * k, (float)(w.y >> 24) * k)};
}
struct F1b { unsigned char* ws; float* dout; int col0; const signed char* sc; typedef NoPre Pre; struct Tile { u32x2 e[2]; };
    DI Tile tile(int c0) const { Tile t;
#pragma unroll
        for (int bj = 0; bj < 2; ++bj) t.e[bj] = *(const u32x2*)(sc + col0 + c0 + bj * 128);
        return t; }
    DI Pre load(int, int) const { return Pre{}; }
    DI void row_end(int, float, int, int) const {}
    DI float apply(int row, int col, f32x4 v0, f32x4 v1, Pre, const Tile& tl, int bj) const {
        f32x4 a, b;
#pragma unroll
        for (int i = 0; i < 4; ++i) { a[i] = sigmoidf_(ldexpf(v0[i], (int)(signed char)(tl.e[bj].x >> (8 * i)))); b[i] = sigmoidf_(ldexpf(v1[i], (int)(signed char)(tl.e[bj].y >> (8 * i)))); }
        u32x2 w;
        w.x = (unsigned)(a[0] * 255.f + 0.5f) | ((unsigned)(a[1] * 255.f + 0.5f) << 8) | ((unsigned)(a[2] * 255.f + 0.5f) << 16) | ((unsigned)(a[3] * 255.f + 0.5f) << 24);
        w.y = (unsigned)(b[0] * 255.f + 0.5f) | ((unsigned)(b[1] * 255.f + 0.5f) << 8) | ((unsigned)(b[2] * 255.f + 0.5f) << 16) | ((unsigned)(b[3] * 255.f + 0.5f) << 24);
        *(u32x2*)const_cast<unsigned char*>(gate_ptr(ws, dout, row, col0 + col)) = w;
        return 0.f;
    } };
struct FPa { const unsigned char* ws; const float* dout; bf16_t* y; struct Pre { u32x2 g; };
    DI Pre load(int row, int col) const { return Pre{*(const u32x2*)gate_ptr(ws, dout, row, col)}; }
    EPI_PLAIN
    DI float apply(int row, int col, f32x4 v0, f32x4 v1, Pre pr, Tile, int) const {
        float g[8]; unpack8(gates8_to_bf16(pr.g), g);
        f32x4 a, b;
#pragma unroll
        for (int i = 0; i < 4; ++i) { a[i] = v0[i] * g[i]; b[i] = v1[i] * g[4 + i]; }
#if PROBE == 1
        a = (f32x4){0.f, 0.f, 0.f, 0.f}; b = a;
#endif
        *(u32x4*)(y + (size_t)row * DM + col) = pack8(a, b);
        return 0.f;
    } };
struct FPb { const unsigned char* ws; const float* dout; bf16_t* y; struct Pre { u32x2 g; u32x4 yv; };
    DI Pre load(int row, int col) const { return Pre{*(const u32x2*)gate_ptr(ws, dout, row, DM + col), *(const u32x4*)(y + (size_t)row * DM + col)}; }
    EPI_PLAIN
    DI float apply(int row, int col, f32x4 v0, f32x4 v1, Pre pr, Tile, int) const {
        float g[8]; unpack8(gates8_to_bf16(pr.g), g);
        float yo[8]; unpack8(pr.yv, yo);
        f32x4 a, b;
#pragma unroll
        for (int i = 0; i < 4; ++i) { a[i] = yo[i] + v0[i] * g[i]; b[i] = yo[4 + i] + v1[i] * g[4 + i]; }
#if PROBE == 2
#pragma unroll
        for (int i = 0; i < 4; ++i) { a[i] = yo[i]; b[i] = yo[4 + i]; }
#endif
        *(u32x4*)(y + (size_t)row * DM + col) = pack8(a, b);
        return 0.f;
    } };
struct FOut { const float* x; const float* g2; bf16_t* h1; bf16_t* xn; float* rowsq; struct Pre { f32x4 x0, x1; }; struct Tile { f32x4 g[2][2]; };
    DI Tile tile(int col0) const { Tile t;
#pragma unroll
        for (int bj = 0; bj < 2; ++bj) { t.g[bj][0] = *(const f32x4*)(g2 + col0 + bj * 128); t.g[bj][1] = *(const f32x4*)(g2 + col0 + bj * 128 + 4); }
        return t; }
    DI Pre load(int row, int col) const { const size_t o = (size_t)row * DM + col; return Pre{*(const f32x4*)(x + o), *(const f32x4*)(x + o + 4)}; }
    DI float apply(int row, int col, f32x4 v0, f32x4 v1, Pre pr, const Tile& tl, int bj) const {
        const size_t o = (size_t)row * DM + col;
        const f32x4 h0 = pr.x0 + v0, h1v = pr.x1 + v1;
        *(u32x4*)(h1 + o) = pack8(h0, h1v);
        *(u32x4*)(xn + o) = pack8(h0 * tl.g[bj][0], h1v * tl.g[bj][1]);
        return (h0[0] * h0[0] + h0[1] * h0[1] + h0[2] * h0[2] + h0[3] * h0[3]) + (h1v[0] * h1v[0] + h1v[1] * h1v[1] + h1v[2] * h1v[2] + h1v[3] * h1v[3]);
    }
    DI void row_end(int row, float s, int fq, int slot) const {
        s += __shfl_xor(s, 16); s += __shfl_xor(s, 32);
        if (fq == 0) rowsq[(size_t)row * 16 + slot] = s;
    } };
DI float row_rs(const float* rowsq, int row) {
    const f32x4 a = *(const f32x4*)(rowsq + (size_t)row * 16), b = *(const f32x4*)(rowsq + (size_t)row * 16 + 4), c = *(const f32x4*)(rowsq + (size_t)row * 16 + 8), d = *(const f32x4*)(rowsq + (size_t)row * 16 + 12);
    const float s = (((a[0] + a[1]) + (a[2] + a[3])) + ((b[0] + b[1]) + (b[2] + b[3]))) + (((c[0] + c[1]) + (c[2] + c[3])) + ((d[0] + d[1]) + (d[2] + d[3])));
    return rsqrtf(s * (1.f / DM) + RMS_EPS);
}
struct FQ { bf16_t* qp; typedef NoPre Pre;
    DI Pre load(int, int) const { return Pre{}; }
    EPI_PLAIN
    DI float apply(int row, int col, f32x4 v0, f32x4 v1, Pre, Tile, int) const {
        u32x4 w = pack8(v0, v1);
#if PROBE == 3
        w.x &= 0xfff8fff8u; w.y &= 0xfff8fff8u; w.z &= 0xfff8fff8u; w.w &= 0xfff8fff8u;
#endif
        *(u32x4*)(qp + (size_t)row * 2048 + col) = w; return 0.f; } };

DI void p0_transpose_item(const float* W, int K, int N, bf16_t* WT, int k0, int n0, int dst_row0, LAS float* scr, int lane) {
#pragma unroll 8
    for (int i = 0; i < 32; ++i) { const int kk = 2 * i + (lane >> 5); scr[kk * 33 + (lane & 31)] = W[(size_t)(k0 + kk) * N + n0 + (lane & 31)]; }
    LDS_WAIT(); asm volatile("" ::: "memory");
    const int c = lane & 7;
#pragma unroll
    for (int j = 0; j < 4; ++j) { const int n = (lane >> 3) + 8 * j; const LAS float* s = scr + (8 * c) * 33 + n;
        u32x4 o; o.x = pk2(s[0 * 33], s[1 * 33]); o.y = pk2(s[2 * 33], s[3 * 33]); o.z = pk2(s[4 * 33], s[5 * 33]); o.w = pk2(s[6 * 33], s[7 * 33]);
        *(u32x4*)(WT + (size_t)(dst_row0 + n) * K + k0 + 8 * c) = o; }
    LDS_WAIT(); asm volatile("" ::: "memory");
}
template <int NR> DI void rms_rows_to_bf16(const float* x, const float* g, bf16_t* o, int m0, int stride, int lane) {
    f32x4 v[NR][4];
#pragma unroll
    for (int r = 0; r < NR; ++r)
#pragma unroll
        for (int j = 0; j < 4; ++j) v[r][j] = *(const f32x4*)(x + (size_t)(m0 + r * stride) * DM + 4 * lane + 256 * j);
    f32x4 gg[4];
#pragma unroll
    for (int j = 0; j < 4; ++j) gg[j] = *(const f32x4*)(g + 4 * lane + 256 * j);
#pragma unroll
    for (int r = 0; r < NR; ++r) {
        float s = 0.f;
#pragma unroll
        for (int j = 0; j < 4; ++j) s += (v[r][j].x * v[r][j].x + v[r][j].y * v[r][j].y) + (v[r][j].z * v[r][j].z + v[r][j].w * v[r][j].w);
        const float rs = rsqrtf(wave_sum(s) * (1.f / DM) + RMS_EPS);
        bf16_t* orow = o + (size_t)(m0 + r * stride) * DM;
#pragma unroll
        for (int j = 0; j < 4; ++j) { u32x2 w; w.x = pk2(v[r][j].x * rs * gg[j].x, v[r][j].y * rs * gg[j].y); w.y = pk2(v[r][j].z * rs * gg[j].z, v[r][j].w * rs * gg[j].w);
            *(u32x2*)(orow + 4 * lane + 256 * j) = w; }
    }
}
DI void rms_all_rows(const float* x, const float* g, bf16_t* o, int lane, int wid) {
    const int gw = blockIdx.x * NWAVES + wid, NGW = gridDim.x * NWAVES;
    int m = gw;
    for (; m + 3 * NGW < NTOK; m += 4 * NGW) rms_rows_to_bf16<4>(x, g, o, m, NGW, lane);
    for (; m < NTOK; m += NGW) rms_rows_to_bf16<1>(x, g, o, m, NGW, lane);
}
DI void phase_prep(const Params& p, LAS unsigned char* lds, int tid, int lane, int wid) {
    unsigned char* ws = p.ws;
    bf16_t* W1T = (bf16_t*)(ws + WS_W1T);
    LAS float* scr = (LAS float*)(lds + wid * 16384);
    const int gw = blockIdx.x * NWAVES + wid, NGW = gridDim.x * NWAVES;
    constexpr int I_IN = 16 * 169, I_PA = 8 * 32, I_PB = 8 * 32, I_O = 16 * 32, I_Q = 16 * 64;
    constexpr int NITEMS = I_IN + I_PA + I_PB + I_O + I_Q;
    for (int it = gw; it < NITEMS; it += NGW) {
        int r = it;
        if (r < I_IN) { const int kb = r / 169, nb = r % 169, n0 = 32 * nb; const int dst = n0 < N1A_REAL ? n0 : n0 + (N1A - N1A_REAL);
            p0_transpose_item(p.w_in, 1024, 5408, W1T, 64 * kb, n0, dst, scr, lane); continue; } r -= I_IN;
        if (r < I_PA) { const int kb = r / 32, nb = r % 32; p0_transpose_item(p.w_proj_a, 512, 1024, (bf16_t*)(ws + WS_WPA), 64 * kb, 32 * nb, 32 * nb, scr, lane); continue; } r -= I_PA;
        if (r < I_PB) { const int kb = r / 32, nb = r % 32; p0_transpose_item(p.w_proj_b, 512, 1024, (bf16_t*)(ws + WS_WPB), 64 * kb, 32 * nb, 32 * nb, scr, lane); continue; } r -= I_PB;
        if (r < I_O) { const int kb = r / 32, nb = r % 32; p0_transpose_item(p.w_out, 1024, 1024, (bf16_t*)(ws + WS_WO), 64 * kb, 32 * nb, 32 * nb, scr, lane); continue; } r -= I_O;
        { const int kb = r / 64, nb = r % 64; p0_transpose_item(p.peer_wq, 1024, 2048, (bf16_t*)(ws + WS_WQ), 64 * kb, 32 * nb, 32 * nb, scr, lane); }
    }
    const int gt = blockIdx.x * NTHREADS + tid, NGT = gridDim.x * NTHREADS;
    { u32x4* z = (u32x4*)(W1T + (size_t)N1A_REAL * 1024); const u32x4 zero = {0u, 0u, 0u, 0u};
      for (int i = gt; i < (N1A - N1A_REAL) * 1024 / 8; i += NGT) z[i] = zero; }
    { bf16_t* SK = (bf16_t*)(ws + WS_SK);
      for (int i = gt; i < 16 * 128 * 128 / 8; i += NGT) { const f32x4 a = *(const f32x4*)(p.peer_subkeys + (size_t)i * 8), b = *(const f32x4*)(p.peer_subkeys + (size_t)i * 8 + 4);
          *(u32x4*)(SK + (size_t)i * 8) = pack8(a, b); } }
    { bf16_t* LWT = (bf16_t*)(ws + WS_LWT);
      for (int e = gt; e < 512 * 288; e += NGT) { const int c = e / 288, i = e - c * 288;
          const float v = i < 64 ? p.w_lora_up[i * 512 + c] : (i < 128 ? p.a_lora_up[(i - 64) * 512 + c] : p.g_lora_up[(i - 128) * 512 + c]);
          LWT[e] = f2bf(v); } }
    rms_all_rows(p.x, p.norm1_g, (bf16_t*)(ws + WS_XN), lane, wid);
}

DI void phase_wg8(const Params& p, int lane, int gw, int NGW) {
    const bf16_t* WG = (const bf16_t*)(p.ws + WS_W1T) + (size_t)N1A * 1024;
    for (int n = gw; n < NGATE; n += NGW) {
        const u32x4 w0 = *(const u32x4*)(WG + (size_t)n * 1024 + lane * 16), w1 = *(const u32x4*)(WG + (size_t)n * 1024 + lane * 16 + 8);
        float f[16]; { float t[8]; unpack8(w0, t);
#pragma unroll
            for (int i = 0; i < 8; ++i) f[i] = t[i];
            unpack8(w1, t);
#pragma unroll
            for (int i = 0; i < 8; ++i) f[8 + i] = t[i]; }
        float am = 0.f;
#pragma unroll
        for (int i = 0; i < 16; ++i) am = fmaxf(am, fabsf(f[i]));
#pragma unroll
        for (int o = 1; o < 64; o <<= 1) am = fmaxf(am, __shfl_xor(am, o));
        const int ke = (int)floorf(log2f(224.f / fmaxf(am, 1e-30f)));
        const float s = ldexpf(1.f, ke);
        u32x4 o8;
#pragma unroll
        for (int j = 0; j < 4; ++j) { int w = __builtin_amdgcn_cvt_pk_fp8_f32(f[4 * j] * s, f[4 * j + 1] * s, 0, false); w = __builtin_amdgcn_cvt_pk_fp8_f32(f[4 * j + 2] * s, f[4 * j + 3] * s, w, true); o8[j] = (unsigned)w; }
        *(u32x4*)(p.ws + WS_WG8 + (size_t)n * 1024 + lane * 16) = o8;
        if (lane == 0) ((signed char*)(p.ws + WS_WG8SC))[n] = (signed char)(-4 - ke);
    }
}
DI void xn8_convert(const Params& p, int lane, int gw, int NGW) {
    const bf16_t* XN = (const bf16_t*)(p.ws + WS_XN);
    unsigned char* X8 = (unsigned char*)p.out + DO_XN8;
    for (int r = gw; r < NTOK; r += NGW) {
        const u32x4 w0 = *(const u32x4*)(XN + (size_t)r * 1024 + lane * 16), w1 = *(const u32x4*)(XN + (size_t)r * 1024 + lane * 16 + 8);
        float f[16]; { float t[8]; unpack8(w0, t);
#pragma unroll
            for (int i = 0; i < 8; ++i) f[i] = t[i] * 16.f;
            unpack8(w1, t);
#pragma unroll
            for (int i = 0; i < 8; ++i) f[8 + i] = t[i] * 16.f; }
        u32x4 o8;
#pragma unroll
        for (int j = 0; j < 4; ++j) { int w = __builtin_amdgcn_cvt_pk_fp8_f32(f[4 * j], f[4 * j + 1], 0, false); w = __builtin_amdgcn_cvt_pk_fp8_f32(f[4 * j + 2], f[4 * j + 3], w, true); o8[j] = (unsigned)w; }
        *(u32x4*)(X8 + (size_t)r * 1024 + lane * 16) = o8;
    }
}
DI void phase_kbar_vt(const Params& p, LAS unsigned char* lds, int tid, int lane, int wid) {
    unsigned char* ws = p.ws;
    const bf16_t* QKV = (const bf16_t*)(ws + WS_QKV);
    float* KBAR = (float*)(ws + WS_KBAR);
    const int gw = blockIdx.x * NWAVES + wid, NGW = gridDim.x * NWAVES;
    for (int it = gw; it < NB * NH * 16; it += NGW) {
        const int blk = it & 15, h = (it >> 4) & 7, b = it >> 7;
        const int dp = lane & 31, tp = lane >> 5;
        const bf16_t* base = QKV + ((size_t)(b * SEQ + blk * 256)) * QKVW + 512 + h * 64 + 2 * dp;
        float a0 = 0.f, a1 = 0.f;
#pragma unroll 16
        for (int t = tp; t < 256; t += 2) { const unsigned u = *(const unsigned*)(base + (size_t)t * QKVW); a0 += bflo(u); a1 += bfhi(u); }
        a0 += __shfl_xor(a0, 32); a1 += __shfl_xor(a1, 32);
        if (tp == 0) { KBAR[(size_t)it * 64 + 2 * dp] = a0 * (1.f / 256.f); KBAR[(size_t)it * 64 + 2 * dp + 1] = a1 * (1.f / 256.f); }
    }
    LAS bf16_t* tile = (LAS bf16_t*)(lds + wid * 16384);
    unsigned char* KF = (unsigned char*)p.out + DO_KF; unsigned char* VF = (unsigned char*)p.out + DO_VT;
    const int r32 = lane & 31, hi = lane >> 5;
    for (int it = gw; it < NB * NH * 64; it += NGW) {
        const int st = it & 63, bh = it >> 6, b = bh >> 3, h = bh & 7;
        const bf16_t* krow = QKV + ((size_t)(b * SEQ + st * 64 + r32)) * QKVW + 512 + h * 64 + 8 * hi;
        unsigned char* kdst = KF + ((size_t)it * 8) * 1024 + lane * 16;
#pragma unroll
        for (int f = 0; f < 8; ++f) *(u32x4*)(kdst + f * 1024) = *(const u32x4*)(krow + (size_t)(32 * (f & 1)) * QKVW + 16 * (f >> 1));
        const bf16_t* src = QKV + ((size_t)(b * SEQ + st * 64 + lane)) * QKVW + 1024 + h * 64;
#pragma unroll
        for (int c = 0; c < 8; ++c) *(LAS u32x4*)(tile + lane * 72 + c * 8) = *(const u32x4*)(src + c * 8);
        LDS_WAIT(); asm volatile("" ::: "memory");
        unsigned char* vdst = VF + ((size_t)it * 8) * 1024 + lane * 16;
#pragma unroll
        for (int f = 0; f < 8; ++f) {
            const int dt = f >> 2, sx = f & 3, d = 32 * dt + r32, k0 = 16 * sx + 4 * hi;
            u32x4 w;
            w.x = (unsigned)tile[(k0 + 0) * 72 + d] | ((unsigned)tile[(k0 + 1) * 72 + d] << 16);
            w.y = (unsigned)tile[(k0 + 2) * 72 + d] | ((unsigned)tile[(k0 + 3) * 72 + d] << 16);
            w.z = (unsigned)tile[(k0 + 8) * 72 + d] | ((unsigned)tile[(k0 + 9) * 72 + d] << 16);
            w.w = (unsigned)tile[(k0 + 10) * 72 + d] | ((unsigned)tile[(k0 + 11) * 72 + d] << 16);
            *(u32x4*)(vdst + f * 1024) = w;
        }
        LDS_WAIT(); asm volatile("" ::: "memory");
    }
}

DI float softplusf_(float x) { return fmaxf(x, 0.f) + log1pf(__expf(-fabsf(x))); }
DI void phase_rwkv_prep(const Params& p, LAS unsigned char* lds, int tid, int lane, int wid) {
    unsigned char* ws = p.ws;
    const bf16_t* PB = (const bf16_t*)(ws + WS_PB);
    bf16_t* SCAN = (bf16_t*)(ws + WS_SCAN);
    bf16_t* RG = (bf16_t*)((unsigned char*)p.out + DO_RG);
    LAS float* xs = (LAS float*)lds;
    const int c = tid, h = wid, j = lane;
    const float mu_r = p.rwkv_mu[c], mu_k = p.rwkv_mu[512 + c], mu_v = p.rwkv_mu[1024 + c];
    const float w0c = p.w0[c], a0c = p.a0[c], kkc = p.k_k[c], kac = p.k_a[c];
    for (int tt = blockIdx.x; tt < NTOK / 32; tt += gridDim.x) {
        const int t0 = tt * 32;
        __syncthreads();
        for (int e = tid; e < 32 * 288; e += NTHREADS) {
            const int t = e / 288, i = e - t * 288, tok = t0 + t, col = 1536 + i;
            const float cur = bf2f(PB[(size_t)tok * PBW + col]);
            const float prv = (tok & (SEQ - 1)) ? bf2f(PB[(size_t)(tok - 1) * PBW + col]) : 0.f;
            float v = cur + p.rwkv_mu[col] * (prv - cur);
            if (i < 64) v = tanhf(v); else if (i >= 128) v = sigmoidf_(v);
            xs[i * 36 + t] = v;
        }
        __syncthreads();
        float wl[32], al[32], gl[32];
#pragma unroll
        for (int t = 0; t < 32; ++t) { wl[t] = 0.f; al[t] = 0.f; gl[t] = 0.f; }
        for (int i = 0; i < 64; ++i) {
            const float ww = p.w_lora_up[i * 512 + c], wa = p.a_lora_up[i * 512 + c];
#pragma unroll
            for (int t4 = 0; t4 < 8; ++t4) { const f32x4 xw = *(const LAS f32x4*)(xs + i * 36 + 4 * t4), xa = *(const LAS f32x4*)(xs + (64 + i) * 36 + 4 * t4);
#pragma unroll
                for (int q = 0; q < 4; ++q) { wl[4 * t4 + q] += ww * xw[q]; al[4 * t4 + q] += wa * xa[q]; } }
        }
        for (int i = 0; i < 160; ++i) {
            const float wg = p.g_lora_up[i * 512 + c];
#pragma unroll
            for (int t4 = 0; t4 < 8; ++t4) { const f32x4 xg = *(const LAS f32x4*)(xs + (128 + i) * 36 + 4 * t4);
#pragma unroll
                for (int q = 0; q < 4; ++q) gl[4 * t4 + q] += wg * xg[q]; }
        }
#pragma unroll
        for (int t = 0; t < 32; ++t) {
            const int tok = t0 + t, b = tok >> 12, s = tok & (SEQ - 1);
            const bf16_t* row = PB + (size_t)tok * PBW;
            float r = bf2f(row[c]), k = bf2f(row[512 + c]), v = bf2f(row[1024 + c]);
            float rp = 0.f, kp = 0.f, vp = 0.f;
            if (s) { const bf16_t* prow = row - PBW; rp = bf2f(prow[c]); kp = bf2f(prow[512 + c]); vp = bf2f(prow[1024 + c]); }
            r += mu_r * (rp - r); k += mu_k * (kp - k); v += mu_v * (vp - v);
            const float wv = w0c + wl[t];
            const float w = -softplusf_(-wv) - 0.5f;
            const float ew = __expf(w);
            const float omd = -expm1f(-ew);
            const float a = sigmoidf_(a0c + al[t]);
            const float kkv = k * kkc;
            const float nrm = sqrtf(wave_sum(kkv * kkv));
            const float kkn = kkv / fmaxf(nrm, 1e-12f);
            const float kmod = k * (1.f + (a - 1.f) * kac);
            const float bb = kkn * a;
            bf16_t* so = SCAN + ((size_t)((b * NH + h) * SEQ + s)) * 384 + j;
            so[0] = f2bf(omd); so[64] = f2bf(kkn); so[128] = f2bf(bb); so[192] = f2bf(kmod); so[256] = f2bf(r); so[320] = f2bf(v);
            RG[(size_t)tok * 512 + c] = f2bf(gl[t]);
        }
    }
}


DI float fast_tanh(float x) { const float e = __expf(2.f * x); return 1.f - 2.f / (e + 1.f); }
constexpr int RP_ACT = 0, RP_CONST = 19456, RP_TILE = 33792, RP_PITCH = 3080;
template <bool STORE> DI void phase_rwkv_prep2(const Params& p, LAS unsigned char* lds, int tid, int lane, int wid) {
    unsigned char* ws = p.ws;
    const bf16_t* PB = (const bf16_t*)(ws + WS_PB);
    const bf16_t* LWT = (const bf16_t*)(ws + WS_LWT);
    bf16_t* SCAN = (bf16_t*)(ws + WS_SCAN);
    bf16_t* RG = (bf16_t*)((unsigned char*)p.out + DO_RG);
    LAS bf16_t* act = (LAS bf16_t*)(lds + RP_ACT);
    LAS float* cst = (LAS float*)(lds + RP_CONST);
    LAS unsigned char* tile = lds + RP_TILE;
    const int r32 = lane & 31, hi = lane >> 5, h = wid;
    __syncthreads();
    cst[tid] = p.rwkv_mu[tid]; cst[512 + tid] = p.rwkv_mu[512 + tid]; cst[1024 + tid] = p.rwkv_mu[1024 + tid];
    cst[1536 + tid] = p.w0[tid]; cst[2048 + tid] = p.a0[tid]; cst[2560 + tid] = p.k_k[tid]; cst[3072 + tid] = p.k_a[tid];
    for (int tt = blockIdx.x; tt < NTOK / 32; tt += gridDim.x) {
        const int t0 = tt * 32;
        const bool first = (t0 & (SEQ - 1)) == 0;
        __syncthreads();
        u32x4 tw[13];
#pragma unroll
        for (int k = 0; k < 13; ++k) { const int e = tid + NTHREADS * k, row = e / 192, pc = e - row * 192;
            tw[k] = (u32x4){0u, 0u, 0u, 0u};
            if (e < 33 * 192 && !(first && row == 0)) tw[k] = *(const u32x4*)(PB + (size_t)(t0 - 1 + row) * PBW + pc * 8); }
#pragma unroll 3
        for (int e = tid; e < 32 * 144; e += NTHREADS) {
            const int t = e / 144, ip = e - t * 144, i = 2 * ip, tok = t0 + t, col = 1536 + i;
            const unsigned cu = *(const unsigned*)(PB + (size_t)tok * PBW + col);
            const unsigned pu = (tok & (SEQ - 1)) ? *(const unsigned*)(PB + (size_t)(tok - 1) * PBW + col) : 0u;
            const f32x2 mu = *(const f32x2*)(p.rwkv_mu + col);
            float v0 = bflo(cu), v1 = bfhi(cu);
            v0 += mu.x * (bflo(pu) - v0); v1 += mu.y * (bfhi(pu) - v1);
            if (i < 64) { v0 = fast_tanh(v0); v1 = fast_tanh(v1); } else if (i >= 128) { v0 = sigmoidf_(v0); v1 = sigmoidf_(v1); }
            *(LAS unsigned*)(act + t * 296 + i) = pk2(v0, v1);
        }
#pragma unroll
        for (int k = 0; k < 13; ++k) { const int e = tid + NTHREADS * k, row = e / 192, pc = e - row * 192;
            if (e < 33 * 192) { LAS unsigned char* d = tile + row * RP_PITCH + pc * 16;
                *(LAS u32x2*)d = (u32x2){tw[k].x, tw[k].y}; *(LAS u32x2*)(d + 8) = (u32x2){tw[k].z, tw[k].w}; } }
        __syncthreads();
        f32x16 Xw[2], Xa[2], Xg[2];
        const int prow_ch = 16 * ((r32 >> 2) & 1) + 4 * (r32 >> 3) + (r32 & 3);
#pragma unroll
        for (int ct = 0; ct < 2; ++ct) {
#pragma unroll
            for (int i = 0; i < 16; ++i) { Xw[ct][i] = 0.f; Xa[ct][i] = 0.f; Xg[ct][i] = 0.f; }
            const bf16_t* wrow = LWT + (size_t)(h * 64 + 32 * ct + prow_ch) * 288 + 8 * hi;
            const LAS bf16_t* arow = act + r32 * 296 + 8 * hi;
#pragma unroll
            for (int ks = 0; ks < 18; ++ks) {
                const bf16x8 a = *(const bf16x8*)(wrow + 16 * ks);
                const bf16x8 b = *(const LAS bf16x8*)(arow + 16 * ks);
                if (ks < 4) Xw[ct] = MFMA32(a, b, Xw[ct]); else if (ks < 8) Xa[ct] = MFMA32(a, b, Xa[ct]); else Xg[ct] = MFMA32(a, b, Xg[ct]);
            }
        }
        const int tok = t0 + r32, bb_ = tok >> 12, s = tok & (SEQ - 1);
        if (STORE) {
#pragma unroll
            for (int ct = 0; ct < 2; ++ct) { bf16_t* rgp = RG + (size_t)tok * 512 + h * 64 + 32 * ct + 16 * hi;
                *(u32x4*)rgp = (u32x4){pk2(Xg[ct][0], Xg[ct][1]), pk2(Xg[ct][2], Xg[ct][3]), pk2(Xg[ct][4], Xg[ct][5]), pk2(Xg[ct][6], Xg[ct][7])};
                *(u32x4*)(rgp + 8) = (u32x4){pk2(Xg[ct][8], Xg[ct][9]), pk2(Xg[ct][10], Xg[ct][11]), pk2(Xg[ct][12], Xg[ct][13]), pk2(Xg[ct][14], Xg[ct][15])}; }
        }
        const LAS unsigned char* prow = tile + r32 * RP_PITCH;
        bf16_t* so = SCAN + ((size_t)((bb_ * NH + h) * SEQ + s)) * 384;
        unsigned kka[32]; float ss = 0.f;
#pragma unroll
        for (int ct = 0; ct < 2; ++ct) {
            const int j0 = 32 * ct + 16 * hi, c0 = h * 64 + j0;
#pragma unroll
            for (int gp = 0; gp < 2; ++gp) {
            unsigned om[4], km[4], rr[4], vv[4];
#pragma unroll
            for (int gq = 0; gq < 2; ++gq) {
                const int g = 2 * gp + gq;
                const int cg = c0 + 4 * g;
                const u32x2 rp = *(const LAS u32x2*)(prow + cg * 2), kp = *(const LAS u32x2*)(prow + 1024 + cg * 2), vp = *(const LAS u32x2*)(prow + 2048 + cg * 2);
                const u32x2 rc = *(const LAS u32x2*)(prow + RP_PITCH + cg * 2), kc = *(const LAS u32x2*)(prow + RP_PITCH + 1024 + cg * 2), vc = *(const LAS u32x2*)(prow + RP_PITCH + 2048 + cg * 2);
                const f32x4 mur = *(const LAS f32x4*)(cst + cg), muk = *(const LAS f32x4*)(cst + 512 + cg), muv = *(const LAS f32x4*)(cst + 1024 + cg);
                const f32x4 w0v = *(const LAS f32x4*)(cst + 1536 + cg), a0v = *(const LAS f32x4*)(cst + 2048 + cg), kkc = *(const LAS f32x4*)(cst + 2560 + cg), kac = *(const LAS f32x4*)(cst + 3072 + cg);
                const float rcf[4] = {bflo(rc.x), bfhi(rc.x), bflo(rc.y), bfhi(rc.y)}, rpf[4] = {bflo(rp.x), bfhi(rp.x), bflo(rp.y), bfhi(rp.y)};
                const float kcf[4] = {bflo(kc.x), bfhi(kc.x), bflo(kc.y), bfhi(kc.y)}, kpf[4] = {bflo(kp.x), bfhi(kp.x), bflo(kp.y), bfhi(kp.y)};
                const float vcf[4] = {bflo(vc.x), bfhi(vc.x), bflo(vc.y), bfhi(vc.y)}, vpf[4] = {bflo(vp.x), bfhi(vp.x), bflo(vp.y), bfhi(vp.y)};
                float r4[4], k4[4], v4[4], o4[4], m4[4];
#pragma unroll
                for (int q = 0; q < 4; ++q) {
                    const int ri = 4 * g + q;
                    r4[q] = rcf[q] + mur[q] * (rpf[q] - rcf[q]);
                    k4[q] = kcf[q] + muk[q] * (kpf[q] - kcf[q]);
                    v4[q] = vcf[q] + muv[q] * (vpf[q] - vcf[q]);
                    const float wv = w0v[q] + Xw[ct][ri];
                    const float z = -wv;
                    const float sp = fmaxf(z, 0.f) + __logf(1.f + __expf(-fabsf(z)));
                    const float ew = __expf(-sp - 0.5f);
                    o4[q] = 1.f - __expf(-ew);
                    const float a = __builtin_amdgcn_rcpf(1.f + __expf(-(a0v[q] + Xa[ct][ri])));
                    m4[q] = k4[q] * (1.f + (a - 1.f) * kac[q]);
                    const float kv = k4[q] * kkc[q];
                    kka[16 * ct + ri] = pk2(kv, a); ss += kv * kv;
                }
                om[2 * gq] = pk2(o4[0], o4[1]); om[2 * gq + 1] = pk2(o4[2], o4[3]);
                km[2 * gq] = pk2(m4[0], m4[1]); km[2 * gq + 1] = pk2(m4[2], m4[3]);
                rr[2 * gq] = pk2(r4[0], r4[1]); rr[2 * gq + 1] = pk2(r4[2], r4[3]);
                vv[2 * gq] = pk2(v4[0], v4[1]); vv[2 * gq + 1] = pk2(v4[2], v4[3]);
            }
            if (STORE) {
                const int j8 = j0 + 8 * gp;
                *(u32x4*)(so + 0 * 64 + j8) = (u32x4){om[0], om[1], om[2], om[3]};
                *(u32x4*)(so + 3 * 64 + j8) = (u32x4){km[0], km[1], km[2], km[3]};
                *(u32x4*)(so + 4 * 64 + j8) = (u32x4){rr[0], rr[1], rr[2], rr[3]};
                *(u32x4*)(so + 5 * 64 + j8) = (u32x4){vv[0], vv[1], vv[2], vv[3]};
            }
            }
        }
        ss += __shfl_xor(ss, 32);
        const float inv = 1.f / fmaxf(sqrtf(ss), 1e-12f);
#pragma unroll
        for (int ct = 0; ct < 2; ++ct) {
            const int j0 = 32 * ct + 16 * hi;
            unsigned kn[8], bq[8];
#pragma unroll
            for (int i = 0; i < 8; ++i) {
                const unsigned u0 = kka[16 * ct + 2 * i], u1 = kka[16 * ct + 2 * i + 1];
                const float k0 = bflo(u0) * inv, k1 = bflo(u1) * inv;
                kn[i] = pk2(k0, k1); bq[i] = pk2(k0 * bfhi(u0), k1 * bfhi(u1));
            }
            if (STORE) {
                *(u32x4*)(so + 1 * 64 + j0) = (u32x4){kn[0], kn[1], kn[2], kn[3]}; *(u32x4*)(so + 1 * 64 + j0 + 8) = (u32x4){kn[4], kn[5], kn[6], kn[7]};
                *(u32x4*)(so + 2 * 64 + j0) = (u32x4){bq[0], bq[1], bq[2], bq[3]}; *(u32x4*)(so + 2 * 64 + j0 + 8) = (u32x4){bq[4], bq[5], bq[6], bq[7]};
            }
        }
    }
}

DI void phase_select(const Params& p, int tid) {
    unsigned char* ws = p.ws;
    const bf16_t* QKV = (const bf16_t*)(ws + WS_QKV);
    const float* KBAR = (const float*)(ws + WS_KBAR);
    unsigned short* SEL = (unsigned short*)(ws + WS_SEL);
    const int gt = blockIdx.x * NTHREADS + tid, NGT = gridDim.x * NTHREADS;
    for (int it = gt; it < NB * NH * SEQ; it += NGT) {
        const int s = it & (SEQ - 1), bh = it >> 12, b = bh >> 3, h = bh & 7, blk = s >> 8;
        unsigned mask = 0u;
        if (blk > 0) {
            float q[64];
            const bf16_t* qp = QKV + ((size_t)(b * SEQ + s)) * QKVW + h * 64;
#pragma unroll
            for (int c = 0; c < 8; ++c) { const u32x4 w = *(const u32x4*)(qp + c * 8); float f[8]; unpack8(w, f);
#pragma unroll
                for (int i = 0; i < 8; ++i) q[c * 8 + i] = f[i]; }
            float v1 = -INFINITY, v2 = -INFINITY, v3 = -INFINITY; int i1 = -1, i2 = -1, i3 = -1;
            for (int jb = 0; jb < blk; ++jb) {
                const float* kb = KBAR + ((size_t)(bh * 16 + jb)) * 64;
                float g = 0.f;
#pragma unroll
                for (int d = 0; d < 64; d += 4) { const f32x4 kk = *(const f32x4*)(kb + d); g += q[d] * kk.x + q[d + 1] * kk.y + q[d + 2] * kk.z + q[d + 3] * kk.w; }
                if (g > v1) { v3 = v2; i3 = i2; v2 = v1; i2 = i1; v1 = g; i1 = jb; }
                else if (g > v2) { v3 = v2; i3 = i2; v2 = g; i2 = jb; }
                else if (g > v3) { v3 = g; i3 = jb; }
            }
            if (i1 >= 0) mask |= 1u << i1;
            if (i2 >= 0) mask |= 1u << i2;
            if (i3 >= 0) mask |= 1u << i3;
        }
        SEL[it] = (unsigned short)mask;
    }
}

constexpr int CK = 32, NCHUNK = SEQ / CK, ITEM_BYTES = 24576;
constexpr int IT_G1 = 0, IT_H1 = 4096, IT_QT = 12288, IT_OV = 20480;
DI unsigned char* chk_base(const Params& p, int chain) {
    const int q = chain >> 4;
    unsigned char* base = q == 0 ? p.ws + 86 * MiB : (q == 1 ? p.ws + 134 * MiB : (q == 2 ? p.ws + 214 * MiB : (unsigned char*)p.out + 64 * MiB));
    return base + (size_t)(chain & 15) * NCHUNK * ITEM_BYTES;
}
DI bf16x8 pack_acc(const f32x16& x, int s) {
    u32x4 w; w.x = pk2(x[8 * s], x[8 * s + 1]); w.y = pk2(x[8 * s + 2], x[8 * s + 3]); w.z = pk2(x[8 * s + 4], x[8 * s + 5]); w.w = pk2(x[8 * s + 6], x[8 * s + 7]);
    return __builtin_bit_cast(bf16x8, w);
}
DI void store_acc_bf16(unsigned char* dst, const f32x16& x) {
    u32x4 a, b; a.x = pk2(x[0], x[1]); a.y = pk2(x[2], x[3]); a.z = pk2(x[4], x[5]); a.w = pk2(x[6], x[7]);
    b.x = pk2(x[8], x[9]); b.y = pk2(x[10], x[11]); b.z = pk2(x[12], x[13]); b.w = pk2(x[14], x[15]);
    *(u32x4*)dst = a; *(u32x4*)(dst + 16) = b;
}
template <int T> DI void subst_step2(float (&x1)[32], float (&x2)[32], const float y1T, const LAS unsigned char* wl, const LAS unsigned char* y2row) {
    float p0 = y1T, p1 = 0.f, p2 = 0.f, p3 = 0.f, q0, q1 = 0.f, q2 = 0.f, q3 = 0.f;
    unsigned z = 0u;
    if (T > 0) asm("v_and_b32 %0, 0, %1" : "=v"(z) : "v"(__float_as_uint(x1[T > 0 ? T - 1 : 0]) | __float_as_uint(x2[T > 0 ? T - 1 : 0])));
    q0 = *(const LAS float*)(y2row + T * 4 + z);
    if (T > 0) {
        const LAS unsigned char* rowp = wl + T * 768 + z;
#pragma unroll
        for (int s4 = 0; s4 < (T + 3) / 4; ++s4) {
            const f32x4 mm = *(const LAS f32x4*)(rowp + s4 * 16);
            if (4 * s4 + 0 < T) { p0 -= x1[4 * s4 + 0] * mm.x; q0 -= x2[4 * s4 + 0] * mm.x; }
            if (4 * s4 + 1 < T) { p1 -= x1[(4 * s4 + 1) & 31] * mm.y; q1 -= x2[(4 * s4 + 1) & 31] * mm.y; }
            if (4 * s4 + 2 < T) { p2 -= x1[(4 * s4 + 2) & 31] * mm.z; q2 -= x2[(4 * s4 + 2) & 31] * mm.z; }
            if (4 * s4 + 3 < T) { p3 -= x1[(4 * s4 + 3) & 31] * mm.w; q3 -= x2[(4 * s4 + 3) & 31] * mm.w; }
        }
    }
    x1[T] = (p0 + p1) + (p2 + p3); x2[T] = (q0 + q1) + (q2 + q3);
}
template <int... Ts> DI void subst_all2(float (&x1)[32], float (&x2)[32], const float (&y1)[32], const LAS unsigned char* wl, const LAS unsigned char* y2row, std::integer_sequence<int, Ts...>) {
    (subst_step2<Ts>(x1, x2, y1[Ts], wl, y2row), ...);
}
#ifndef CPSTAGE
#define CPSTAGE 4
#endif
DI void unpack_acc_bf16(const LAS unsigned char* src, f32x16& x) {
    const u32x4 a = *(const LAS u32x4*)src, b = *(const LAS u32x4*)(src + 16);
    x[0] = bflo(a.x); x[1] = bfhi(a.x); x[2] = bflo(a.y); x[3] = bfhi(a.y); x[4] = bflo(a.z); x[5] = bfhi(a.z); x[6] = bflo(a.w); x[7] = bfhi(a.w);
    x[8] = bflo(b.x); x[9] = bfhi(b.x); x[10] = bflo(b.y); x[11] = bfhi(b.y); x[12] = bflo(b.z); x[13] = bfhi(b.z); x[14] = bflo(b.w); x[15] = bfhi(b.w);
}
constexpr int CPW = 36864;
constexpr int CP_BT = 24576, CP_KT = 28672, CP_VT = 32768;
template <int STG> DI void phase_chunkprep(const Params& p, LAS unsigned char* lds, int lane, int wid) {
    if (wid >= 4) return;
    unsigned char* ws = p.ws;
    const bf16_t* SCAN = (const bf16_t*)(ws + WS_SCAN);
    LAS unsigned char* wl = lds + wid * CPW;
    const int r32 = lane & 31, hi = lane >> 5, j = lane;
    for (int item = blockIdx.x * 4 + wid; item < 64 * NCHUNK; item += gridDim.x * 4) {
        const int chain = item >> 7, c = item & (NCHUNK - 1);
        const unsigned char* src = (const unsigned char*)(SCAN + ((size_t)chain * SEQ + (size_t)c * CK) * 384);
        unsigned char* dst = chk_base(p, chain) + (size_t)c * ITEM_BYTES;
        unsigned char* dl16 = dst + lane * 16; unsigned char* dl32 = dst + lane * 32;
        {
            u32x4 w[24];
#pragma unroll
            for (int k = 0; k < 24; ++k) w[k] = *(const u32x4*)(src + (size_t)(k * 64 + lane) * 16);
#pragma unroll
            for (int k = 0; k < 24; ++k) *(LAS u32x4*)(wl + (k * 64 + lane) * 16) = w[k];
        }
        LDS_WAIT(); asm volatile("" ::: "memory");
        float al[32]; float g = 1.f;
        {
            unsigned bt[16], kt[16], vt[16];
#pragma unroll
            for (int t = 0; t < 32; ++t) {
                LAS bf16_t* row = (LAS bf16_t*)(wl + t * 768);
                const float omd = bf2f(row[j]), kkv = bf2f(row[64 + j]), bv = bf2f(row[128 + j]), kmv = bf2f(row[192 + j]), rv = bf2f(row[256 + j]);
                const unsigned vraw = row[320 + j];
                const float gprev = g; g = g * (1.f - omd);
                const float ig = __builtin_amdgcn_rcpf(g);
                const float a_ = gprev * kkv, be = bv * ig, ka = kmv * ig, rh = g * rv;
                al[t] = a_;
                const unsigned beb = f2bf(be), kab = f2bf(ka);
                row[64 + j] = f2bf(a_); row[128 + j] = (bf16_t)beb; row[192 + j] = (bf16_t)kab; row[256 + j] = f2bf(rh);
                if (t & 1) { bt[t >> 1] |= beb << 16; kt[t >> 1] |= kab << 16; vt[t >> 1] |= vraw << 16; }
                else { bt[t >> 1] = beb; kt[t >> 1] = kab; vt[t >> 1] = vraw; }
                if ((t & 3) == 3) asm volatile("" ::: "memory");
            }
#pragma unroll
            for (int q = 0; q < 4; ++q) {
                *(LAS u32x4*)(wl + CP_BT + j * 64 + q * 16) = (u32x4){bt[4 * q], bt[4 * q + 1], bt[4 * q + 2], bt[4 * q + 3]};
                *(LAS u32x4*)(wl + CP_KT + j * 64 + q * 16) = (u32x4){kt[4 * q], kt[4 * q + 1], kt[4 * q + 2], kt[4 * q + 3]};
                *(LAS u32x4*)(wl + CP_VT + j * 64 + q * 16) = (u32x4){vt[4 * q], vt[4 * q + 1], vt[4 * q + 2], vt[4 * q + 3]};
            }
        }
        LDS_WAIT(); asm volatile("" ::: "memory");
        if (STG >= 2) {
        {
            f32x16 Mba, Mka, Nbr, Nkr;
#pragma unroll
            for (int i = 0; i < 16; ++i) { Mba[i] = 0.f; Mka[i] = 0.f; Nkr[i] = 0.f; Nbr[i] = 0.f; }
#pragma unroll
            for (int ks = 0; ks < 4; ++ks) {
                const LAS unsigned char* rp = wl + r32 * 768 + (16 * ks + 8 * hi) * 2;
                const bf16x8 ab = *(const LAS bf16x8*)(rp + 2 * 128), ak = *(const LAS bf16x8*)(rp + 3 * 128);
                const bf16x8 ba = *(const LAS bf16x8*)(rp + 1 * 128), br = *(const LAS bf16x8*)(rp + 4 * 128);
                Mba = MFMA32(ab, ba, Mba); Mka = MFMA32(ak, ba, Mka); Nkr = MFMA32(ak, br, Nkr); Nbr = MFMA32(ab, br, Nbr);
            }
#pragma unroll
            for (int r = 0; r < 16; ++r) { const int sr = crow(r, hi);
                if (!(sr < r32)) { Mba[r] = 0.f; Mka[r] = 0.f; }
                if (!(sr <= r32)) { Nkr[r] = 0.f; Nbr[r] = 0.f; } }
            LDS_WAIT(); asm volatile("" ::: "memory");
#pragma unroll
            for (int g4 = 0; g4 < 4; ++g4) {
                *(LAS f32x4*)(wl + r32 * 768 + 0 * 128 + (8 * g4 + 4 * hi) * 4) = (f32x4){Mba[4 * g4], Mba[4 * g4 + 1], Mba[4 * g4 + 2], Mba[4 * g4 + 3]};
                *(LAS u32x2*)(wl + r32 * 768 + 1 * 128 + (8 * g4 + 4 * hi) * 2) = (u32x2){pk2(Nbr[4 * g4], Nbr[4 * g4 + 1]), pk2(Nbr[4 * g4 + 2], Nbr[4 * g4 + 3])};
            }
#pragma unroll
            for (int r = 0; r < 16; ++r) *(LAS float*)(wl + crow(r, hi) * 768 + 5 * 128 + r32 * 4) = Mka[r];
            *(LAS float*)(wl + (j >> 4) * 768 + 1 * 128 + 64 + (j & 15) * 4) = g;
            { LAS unsigned char* np = wl + (lane >> 1) * 768 + 3 * 128 + 64 + (lane & 1) * 32;
              *(LAS u32x4*)np = (u32x4){pk2(Nkr[0], Nkr[1]), pk2(Nkr[2], Nkr[3]), pk2(Nkr[4], Nkr[5]), pk2(Nkr[6], Nkr[7])};
              *(LAS u32x4*)(np + 16) = (u32x4){pk2(Nkr[8], Nkr[9]), pk2(Nkr[10], Nkr[11]), pk2(Nkr[12], Nkr[13]), pk2(Nkr[14], Nkr[15])}; }
        }
        LDS_WAIT(); asm volatile("" ::: "memory");
        }
        if (STG >= 3) {
        {
            float x1[32], x2[32];
            subst_all2(x1, x2, al, wl, wl + r32 * 768 + 5 * 128, std::make_integer_sequence<int, 32>{});
            LAS unsigned char* w1p = wl + (j >> 1) * 768 + 2 * 128 + (j & 1) * 64;
            LAS unsigned char* w2p = wl + r32 * 768 + 3 * 128;
#pragma unroll
            for (int q = 0; q < 4; ++q) {
                *(LAS u32x4*)(w1p + q * 16) = (u32x4){pk2(-x1[8 * q], -x1[8 * q + 1]), pk2(-x1[8 * q + 2], -x1[8 * q + 3]), pk2(-x1[8 * q + 4], -x1[8 * q + 5]), pk2(-x1[8 * q + 6], -x1[8 * q + 7])};
                if (hi == 0) *(LAS u32x4*)(w2p + q * 16) = (u32x4){pk2(-x2[8 * q], -x2[8 * q + 1]), pk2(-x2[8 * q + 2], -x2[8 * q + 3]), pk2(-x2[8 * q + 4], -x2[8 * q + 5]), pk2(-x2[8 * q + 6], -x2[8 * q + 7])};
            }
        }
        LDS_WAIT(); asm volatile("" ::: "memory");
        }
        if (STG >= 4) {
#define CP_A1(jt, ks) (*(const LAS bf16x8*)(wl + (16 * (jt) + (r32 >> 1)) * 768 + 2 * 128 + (r32 & 1) * 64 + (16 * (ks) + 8 * hi) * 2))
#define CP_A2(ks) (*(const LAS bf16x8*)(wl + r32 * 768 + 3 * 128 + (16 * (ks) + 8 * hi) * 2))
#define CP_BN(ks) (*(const LAS bf16x8*)(wl + r32 * 768 + 1 * 128 + (16 * (ks) + 8 * hi) * 2))
#define CP_BB(jp, ks) (*(const LAS bf16x8*)(wl + CP_BT + (32 * (jp) + r32) * 64 + (16 * (ks) + 8 * hi) * 2))
        {
            float gcl[2];
#pragma unroll
            for (int jt = 0; jt < 2; ++jt) { const int jj = 32 * jt + r32; gcl[jt] = *(const LAS float*)(wl + (jj >> 4) * 768 + 1 * 128 + 64 + (jj & 15) * 4); }
            {
                const bf16x8 bn0 = CP_BN(0), bn1 = CP_BN(1);
#pragma unroll
                for (int jt = 0; jt < 2; ++jt) {
                    f32x16 acc;
#pragma unroll
                    for (int g4 = 0; g4 < 4; ++g4) { const u32x2 v = *(const LAS u32x2*)(wl + r32 * 768 + 4 * 128 + (32 * jt + 8 * g4 + 4 * hi) * 2);
                        acc[4 * g4] = bflo(v.x); acc[4 * g4 + 1] = bfhi(v.x); acc[4 * g4 + 2] = bflo(v.y); acc[4 * g4 + 3] = bfhi(v.y); }
                    acc = MFMA32(CP_A1(jt, 0), bn0, acc); acc = MFMA32(CP_A1(jt, 1), bn1, acc);
#pragma unroll
                    for (int sx = 0; sx < 2; ++sx) *(bf16x8*)(dl16 + IT_G1 + (jt * 2 + sx) * 1024) = pack_acc(acc, sx);
                }
            }
#pragma unroll
            for (int jp = 0; jp < 2; ++jp) {
                const bf16x8 bb0 = CP_BB(jp, 0), bb1 = CP_BB(jp, 1);
#pragma unroll
                for (int jt = 0; jt < 2; ++jt) {
                    f32x16 acc;
#pragma unroll
                    for (int r = 0; r < 16; ++r) acc[r] = (jt == jp && crow(r, hi) == r32) ? 1.f : 0.f;
                    acc = MFMA32(CP_A1(jt, 0), bb0, acc); acc = MFMA32(CP_A1(jt, 1), bb1, acc);
#pragma unroll
                    for (int r = 0; r < 16; ++r) acc[r] *= gcl[jp];
#pragma unroll
                    for (int sx = 0; sx < 2; ++sx) *(bf16x8*)(dl16 + IT_H1 + ((jp * 2 + jt) * 2 + sx) * 1024) = pack_acc(acc, sx);
                }
            }
            bf16x8 vtf[2][2];
#pragma unroll
            for (int it = 0; it < 2; ++it)
#pragma unroll
                for (int ks = 0; ks < 2; ++ks) {
                    const u32x2 lo = *(const LAS u32x2*)(wl + CP_VT + (32 * it + r32) * 64 + (16 * ks + 4 * hi) * 2), hh = *(const LAS u32x2*)(wl + CP_VT + (32 * it + r32) * 64 + (16 * ks + 8 + 4 * hi) * 2);
                    vtf[it][ks] = __builtin_bit_cast(bf16x8, (u32x4){lo.x, lo.y, hh.x, hh.y});
                }
            {
                f32x16 acc; unpack_acc_bf16(wl + (lane >> 1) * 768 + 3 * 128 + 64 + (lane & 1) * 32, acc);
                acc = MFMA32(CP_A2(0), CP_BN(0), acc); acc = MFMA32(CP_A2(1), CP_BN(1), acc);
                const bf16x8 g0 = pack_acc(acc, 0), g1 = pack_acc(acc, 1);
#pragma unroll
                for (int it = 0; it < 2; ++it) {
                    f32x16 z;
#pragma unroll
                    for (int r = 0; r < 16; ++r) z[r] = 0.f;
                    z = MFMA32(g0, vtf[it][0], z); z = MFMA32(g1, vtf[it][1], z);
                    store_acc_bf16(dl32 + IT_OV + it * 2048, z);
                }
            }
#pragma unroll
            for (int jp = 0; jp < 2; ++jp) {
                f32x16 acc;
#pragma unroll
                for (int g4 = 0; g4 < 4; ++g4) { const u32x2 v = *(const LAS u32x2*)(wl + CP_KT + (32 * jp + r32) * 64 + (8 * g4 + 4 * hi) * 2);
                    acc[4 * g4] = bflo(v.x); acc[4 * g4 + 1] = bfhi(v.x); acc[4 * g4 + 2] = bflo(v.y); acc[4 * g4 + 3] = bfhi(v.y); }
                acc = MFMA32(CP_A2(0), CP_BB(jp, 0), acc); acc = MFMA32(CP_A2(1), CP_BB(jp, 1), acc);
#pragma unroll
                for (int r = 0; r < 16; ++r) acc[r] *= gcl[jp];
                const bf16x8 h0 = pack_acc(acc, 0), h1 = pack_acc(acc, 1);
#pragma unroll
                for (int it = 0; it < 2; ++it) {
                    f32x16 z;
#pragma unroll
                    for (int r = 0; r < 16; ++r) z[r] = 0.f;
                    z = MFMA32(h0, vtf[it][0], z); z = MFMA32(h1, vtf[it][1], z);
                    store_acc_bf16(dl32 + IT_QT + (jp * 2 + it) * 2048, z);
                }
            }
        }
#undef CP_A1
#undef CP_A2
#undef CP_BN
#undef CP_BB
        }
        LDS_WAIT(); asm volatile("" ::: "memory");
    }
}
DI void phase_chunkscan(const Params& p, LAS unsigned char* lds, int tid, int lane, int wid) {
    unsigned char* ws = p.ws;
    bf16_t* OBR = (bf16_t*)(ws + WS_OBRAW);
    const int r32 = lane & 31, hi = lane >> 5;
    for (int chain = blockIdx.x; chain < 64; chain += gridDim.x) {
        const unsigned char* src = chk_base(p, chain);
        const int b = chain >> 3, h = chain & 7, lt = tid - 128;
        __syncthreads();
        u32x4 lw[4];
        if (wid >= 2) {
#pragma unroll
            for (int k = 0; k < 4; ++k) lw[k] = *(const u32x4*)(src + (size_t)(lt + 384 * k) * 16);
#pragma unroll
            for (int k = 0; k < 4; ++k) *(LAS u32x4*)(lds + (lt + 384 * k) * 16) = lw[k];
#pragma unroll
            for (int k = 0; k < 4; ++k) lw[k] = *(const u32x4*)(src + ITEM_BYTES + (size_t)(lt + 384 * k) * 16);
        }
        __syncthreads();
        f32x16 X0, X1;
#pragma unroll
        for (int i = 0; i < 16; ++i) { X0[i] = 0.f; X1[i] = 0.f; }
        for (int c = 0; c < NCHUNK; ++c) {
            const LAS unsigned char* cur = lds + (c & 1) * ITEM_BYTES;
            if (wid < 2) {
                const int it = wid;
                const bf16x8 xb00 = pack_acc(X0, 0), xb01 = pack_acc(X0, 1), xb10 = pack_acc(X1, 0), xb11 = pack_acc(X1, 1);
                f32x16 oacc; unpack_acc_bf16(cur + IT_OV + (it * 64 + lane) * 32, oacc);
                oacc = MFMA32(*(const LAS bf16x8*)(cur + IT_G1 + (0 * 64 + lane) * 16), xb00, oacc);
                oacc = MFMA32(*(const LAS bf16x8*)(cur + IT_G1 + (1 * 64 + lane) * 16), xb01, oacc);
                oacc = MFMA32(*(const LAS bf16x8*)(cur + IT_G1 + (2 * 64 + lane) * 16), xb10, oacc);
                oacc = MFMA32(*(const LAS bf16x8*)(cur + IT_G1 + (3 * 64 + lane) * 16), xb11, oacc);
                f32x16 n0, n1;
                unpack_acc_bf16(cur + IT_QT + ((0 * 2 + it) * 64 + lane) * 32, n0);
                unpack_acc_bf16(cur + IT_QT + ((1 * 2 + it) * 64 + lane) * 32, n1);
                n0 = MFMA32(*(const LAS bf16x8*)(cur + IT_H1 + (0 * 64 + lane) * 16), xb00, n0);
                n0 = MFMA32(*(const LAS bf16x8*)(cur + IT_H1 + (1 * 64 + lane) * 16), xb01, n0);
                n0 = MFMA32(*(const LAS bf16x8*)(cur + IT_H1 + (2 * 64 + lane) * 16), xb10, n0);
                n0 = MFMA32(*(const LAS bf16x8*)(cur + IT_H1 + (3 * 64 + lane) * 16), xb11, n0);
                n1 = MFMA32(*(const LAS bf16x8*)(cur + IT_H1 + (4 * 64 + lane) * 16), xb00, n1);
                n1 = MFMA32(*(const LAS bf16x8*)(cur + IT_H1 + (5 * 64 + lane) * 16), xb01, n1);
                n1 = MFMA32(*(const LAS bf16x8*)(cur + IT_H1 + (6 * 64 + lane) * 16), xb10, n1);
                n1 = MFMA32(*(const LAS bf16x8*)(cur + IT_H1 + (7 * 64 + lane) * 16), xb11, n1);
                X0 = n0; X1 = n1;
                bf16_t* orow = OBR + ((size_t)(b * SEQ + c * CK)) * 512 + h * 64 + 32 * it + r32;
#pragma unroll
                for (int r = 0; r < 16; ++r) orow[(size_t)crow(r, hi) * 512] = f2bf(oacc[r]);
            } else {
                LAS unsigned char* nxt = lds + ((c + 1) & 1) * ITEM_BYTES;
                if (c + 1 < NCHUNK) {
#pragma unroll
                    for (int k = 0; k < 4; ++k) *(LAS u32x4*)(nxt + (lt + 384 * k) * 16) = lw[k];
                }
                if (c + 2 < NCHUNK) {
#pragma unroll
                    for (int k = 0; k < 4; ++k) lw[k] = *(const u32x4*)(src + (size_t)(c + 2) * ITEM_BYTES + (size_t)(lt + 384 * k) * 16);
                }
            }
            __syncthreads();
        }
    }
}

constexpr int AT_BUF = 8192 + 64 * 136, AT_K = 0, AT_V = 8192, AT_BT = 2 * AT_BUF, AT_END = AT_BT + 512 * 4;
DI int rel_bucket_dev(int n) {
    if (n < 16) return n;
    const int th[15] = {19, 21, 24, 27, 31, 35, 40, 46, 52, 59, 67, 77, 87, 99, 113};
    int b = 16;
#pragma unroll
    for (int i = 0; i < 15; ++i) b += (n >= th[i]) ? 1 : 0;
    return b;
}
template <int MODE>
DI void attn_tile(const LAS unsigned char* kb, const LAS unsigned char* vbuf, const LAS float* btab, const bf16x8 (&qr)[4],
                  f32x16& o0, f32x16& o1, f32x16& lacc, float& m, int dq, bool selb, float c31, int r32, int hi) {
    const float sc2 = 0.125f * LOG2E;
    f32x16 p0, p1;
#pragma unroll
    for (int i = 0; i < 16; ++i) { p0[i] = 0.f; p1[i] = 0.f; }
#pragma unroll
    for (int d0 = 0; d0 < 4; ++d0) {
        const bf16x8 k0 = *(const LAS bf16x8*)(kb + (2 * d0 + hi) * 1024 + r32 * 16);
        const bf16x8 k1 = *(const LAS bf16x8*)(kb + (2 * d0 + hi) * 1024 + 512 + r32 * 16);
        p0 = MFMA32(k0, qr[d0], p0); p1 = MFMA32(k1, qr[d0], p1);
    }
    float mx = -INFINITY;
    float cadd = 0.f;
    if (MODE == 2) {
        const float bsel = selb ? c31 : -INFINITY;
#pragma unroll
        for (int r = 0; r < 16; ++r) mx = fmaxf(mx, fmaxf(p0[r], p1[r]));
        mx = mx * sc2 + bsel;
        cadd = bsel;
    } else {
        const float ninf = selb ? 0.f : -INFINITY;
#pragma unroll
        for (int r = 0; r < 16; ++r) {
            const int d0 = dq - crow(r, hi), d1 = d0 - 32;
            const int i0 = d0 < 0 ? 0 : (d0 > 511 ? 511 : d0), i1 = d1 < 0 ? 0 : (d1 > 511 ? 511 : d1);
            float x0 = p0[r] * sc2 + btab[i0], x1 = p1[r] * sc2 + btab[i1];
            if (MODE == 0) { x0 = d0 >= 0 ? x0 : -INFINITY; x1 = d1 >= 0 ? x1 : -INFINITY; }
            else { x0 += ninf; x1 += ninf; }
            p0[r] = x0; p1[r] = x1; mx = fmaxf(mx, fmaxf(x0, x1));
        }
    }
    mx = fmaxf(mx, __shfl_xor(mx, 32));
    if (__any(mx > m)) {
        const float mn = fmaxf(m, mx);
        const float alpha = __builtin_amdgcn_exp2f(m - mn);
        m = mn;
#pragma unroll
        for (int i = 0; i < 16; ++i) { o0[i] *= alpha; o1[i] *= alpha; lacc[i] *= alpha; }
    }
    if (MODE == 2) {
        const float c = cadd - m;
#pragma unroll
        for (int r = 0; r < 16; ++r) { p0[r] = __builtin_amdgcn_exp2f(p0[r] * sc2 + c); p1[r] = __builtin_amdgcn_exp2f(p1[r] * sc2 + c); }
    } else {
#pragma unroll
        for (int r = 0; r < 16; ++r) { p0[r] = __builtin_amdgcn_exp2f(p0[r] - m); p1[r] = __builtin_amdgcn_exp2f(p1[r] - m); }
    }
    const bf16x8 ones = {(short)0x3F80, (short)0x3F80, (short)0x3F80, (short)0x3F80, (short)0x3F80, (short)0x3F80, (short)0x3F80, (short)0x3F80};
#pragma unroll
    for (int s = 0; s < 4; ++s) {
        u32x4 pw;
        if (s < 2) { pw.x = pk2(p0[8 * s], p0[8 * s + 1]); pw.y = pk2(p0[8 * s + 2], p0[8 * s + 3]); pw.z = pk2(p0[8 * s + 4], p0[8 * s + 5]); pw.w = pk2(p0[8 * s + 6], p0[8 * s + 7]); }
        else { const int q = s - 2; pw.x = pk2(p1[8 * q], p1[8 * q + 1]); pw.y = pk2(p1[8 * q + 2], p1[8 * q + 3]); pw.z = pk2(p1[8 * q + 4], p1[8 * q + 5]); pw.w = pk2(p1[8 * q + 6], p1[8 * q + 7]); }
        const bf16x8 pf = __builtin_bit_cast(bf16x8, pw);
        const LAS unsigned char* v0p = vbuf + r32 * 136 + (16 * s + 4 * hi) * 2;
        const LAS unsigned char* v1p = vbuf + (32 + r32) * 136 + (16 * s + 4 * hi) * 2;
        const u32x2 a0 = *(const LAS u32x2*)v0p, a1 = *(const LAS u32x2*)(v0p + 16);
        const u32x2 c0 = *(const LAS u32x2*)v1p, c1 = *(const LAS u32x2*)(v1p + 16);
        const bf16x8 va = __builtin_bit_cast(bf16x8, (u32x4){a0.x, a0.y, a1.x, a1.y});
        const bf16x8 vb = __builtin_bit_cast(bf16x8, (u32x4){c0.x, c0.y, c1.x, c1.y});
        o0 = MFMA32(va, pf, o0); o1 = MFMA32(vb, pf, o1); lacc = MFMA32(ones, pf, lacc);
    }
}
template <int VAR> DI void attn_unit(const Params& p, LAS unsigned char* lds, int b, int h, int qb, int tid, int lane, int wid) {
    unsigned char* ws = p.ws;
    const bf16_t* QKV = (const bf16_t*)(ws + WS_QKV);
    const bf16_t* VT = (const bf16_t*)((const unsigned char*)p.out + DO_VT);
    const unsigned short* SEL = (const unsigned short*)(ws + WS_SEL);
    bf16_t* OA = VAR == 0 ? (bf16_t*)(ws + WS_OA) : (bf16_t*)((unsigned char*)p.out + 64 * MiB);
    const int r32 = lane & 31, hi = lane >> 5, bh = b * NH + h;
    LAS float* btab = (LAS float*)(lds + AT_BT);
    const int NT = 4 * (qb + 1);
#define AT_KPOS(ti) (((ti) < 4 ? qb * 256 + (ti) * 64 : (((ti) - 4) >> 2) * 256 + (((ti) - 4) & 3) * 64))
    const bf16_t* kbase = QKV + ((size_t)(b * SEQ + lane)) * QKVW + 512 + h * 64 + wid * 8;
    const bf16_t* vbase = VT + ((size_t)(bh * 64 + (tid >> 3))) * SEQ + (tid & 7) * 8;
    const int kdst = AT_K + wid * 1024 + lane * 16, vdst = AT_V + (tid >> 3) * 136 + (tid & 7) * 16;
#define AT_LOAD(ti, kr, vr) do { const int kp_ = AT_KPOS(ti); kr = *(const u32x4*)(kbase + (size_t)kp_ * QKVW); vr = *(const u32x4*)(vbase + kp_); } while (0)
#define AT_WRITE(buf, kr, vr) do { LAS unsigned char* b_ = lds + (buf) * AT_BUF; *(LAS u32x4*)(b_ + kdst) = kr; \
        *(LAS u32x2*)(b_ + vdst) = (u32x2){vr.x, vr.y}; *(LAS u32x2*)(b_ + vdst + 8) = (u32x2){vr.z, vr.w}; } while (0)
    u32x4 kreg, vreg;
    AT_LOAD(0, kreg, vreg);
    __syncthreads();
    btab[tid] = p.rel_bias[h * 32 + rel_bucket_dev(tid)] * LOG2E;
    if (tid < 256) {
        unsigned mask = 0u;
        if (qb > 0) {
            const float* KBAR = (const float*)(ws + WS_KBAR);
            float q[64];
            const bf16_t* qp = QKV + ((size_t)(b * SEQ + qb * 256 + tid)) * QKVW + h * 64;
#pragma unroll
            for (int c = 0; c < 8; ++c) { const u32x4 w = *(const u32x4*)(qp + c * 8); float f[8]; unpack8(w, f);
#pragma unroll
                for (int i = 0; i < 8; ++i) q[c * 8 + i] = f[i]; }
            float v1 = -INFINITY, v2 = -INFINITY, v3 = -INFINITY; int i1 = -1, i2 = -1, i3 = -1;
            for (int jb = 0; jb < qb; ++jb) {
                const float* kbp = KBAR + ((size_t)(bh * 16 + jb)) * 64;
                float g = 0.f;
#pragma unroll
                for (int d = 0; d < 64; d += 4) { const f32x4 kk = *(const f32x4*)(kbp + d); g += q[d] * kk.x + q[d + 1] * kk.y + q[d + 2] * kk.z + q[d + 3] * kk.w; }
                if (g > v1) { v3 = v2; i3 = i2; v2 = v1; i2 = i1; v1 = g; i1 = jb; }
                else if (g > v2) { v3 = v2; i3 = i2; v2 = g; i2 = jb; }
                else if (g > v3) { v3 = g; i3 = jb; }
            }
            if (i1 >= 0) mask |= 1u << i1;
            if (i2 >= 0) mask |= 1u << i2;
            if (i3 >= 0) mask |= 1u << i3;
        }
        ((LAS unsigned short*)(lds + AT_END))[tid] = (unsigned short)mask;
    }
    AT_WRITE(0, kreg, vreg);
    if (NT > 1) AT_LOAD(1, kreg, vreg);
    const int qrow = b * SEQ + qb * 256 + wid * 32 + r32, qin = wid * 32 + r32;
    bf16x8 qr[4];
#pragma unroll
    for (int d0 = 0; d0 < 4; ++d0) qr[d0] = *(const bf16x8*)(QKV + (size_t)qrow * QKVW + h * 64 + d0 * 16 + hi * 8);
    const float c31 = p.rel_bias[h * 32 + 31] * LOG2E;
    float m = -INFINITY;
    f32x16 o0, o1, lacc;
#pragma unroll
    for (int i = 0; i < 16; ++i) { o0[i] = 0.f; o1[i] = 0.f; lacc[i] = 0.f; }
    __syncthreads();
    const unsigned sel = ((const LAS unsigned short*)(lds + AT_END))[qin];
    for (int ti = 0; ti < NT; ++ti) {
        const bool own = ti < 4;
        const int blk = own ? qb : ((ti - 4) >> 2), kt = own ? ti : ((ti - 4) & 3);
        const LAS unsigned char* kb = lds + (ti & 1) * AT_BUF + AT_K;
        const LAS unsigned char* vbuf = lds + (ti & 1) * AT_BUF + AT_V;
        const bool selb = ((sel >> blk) & 1u) != 0u;
        const bool active = own ? (kt * 64 <= wid * 32 + 31) : (__any(selb) != 0);
        if (active && VAR != 2) {
            if (own) attn_tile<0>(kb, vbuf, btab, qr, o0, o1, lacc, m, qin - kt * 64, true, 0.f, r32, hi);
            else {
                const bool farb = ((qb - blk) * 256 + wid * 32 - kt * 64 - 63 >= 113);
                if (farb) attn_tile<2>(kb, vbuf, btab, qr, o0, o1, lacc, m, 0, selb, c31, r32, hi);
                else attn_tile<1>(kb, vbuf, btab, qr, o0, o1, lacc, m, (qb - blk) * 256 + qin - kt * 64, selb, c31, r32, hi);
            }
        }
        if (VAR != 1) { if (ti + 1 < NT) AT_WRITE((ti + 1) & 1, kreg, vreg);
        if (ti + 2 < NT) AT_LOAD(ti + 2, kreg, vreg); }
        __syncthreads();
    }
#undef AT_KPOS
#undef AT_LOAD
#undef AT_WRITE
    const float il = 1.f / lacc[0];
    bf16_t* orow = OA + (size_t)qrow * 512 + h * 64;
#pragma unroll
    for (int g = 0; g < 4; ++g) {
        u32x2 w0, w1;
        w0.x = pk2(o0[4 * g] * il, o0[4 * g + 1] * il); w0.y = pk2(o0[4 * g + 2] * il, o0[4 * g + 3] * il);
        w1.x = pk2(o1[4 * g] * il, o1[4 * g + 1] * il); w1.y = pk2(o1[4 * g + 2] * il, o1[4 * g + 3] * il);
        *(u32x2*)(orow + 8 * g + 4 * hi) = w0; *(u32x2*)(orow + 32 + 8 * g + 4 * hi) = w1;
    }
}
template <int VAR> DI void phase_attn(const Params& p, LAS unsigned char* lds, int tid, int lane, int wid) {
    if (gridDim.x == 256) {
        const int bh = blockIdx.x & 63, s = blockIdx.x >> 6;
#pragma unroll 1
        for (int i = 0; i < 4; ++i) { const int qb = i == 0 ? 15 - s : (i == 1 ? 8 + s : (i == 2 ? 7 - s : s)); attn_unit<VAR>(p, lds, bh >> 3, bh & 7, qb, tid, lane, wid); }
    } else {
        for (int it = blockIdx.x; it < NB * NH * 16; it += gridDim.x) { const int qb = 15 - (it >> 6), bh = it & 63; attn_unit<VAR>(p, lds, bh >> 3, bh & 7, qb, tid, lane, wid); }
    }
}

constexpr int A2_BT = 0, A2_SEL = 2048, A2_CNT = 2560, A2_WCNT = 2624, A2_NIT = 2880, A2_QCTR = 2884, A2_ITEM = 2944, A2_ROWS = 3072, A2_END = 3072 + 15 * 256;
constexpr size_t PART_REC = 136;
DI unsigned char* part_base(const Params& p, int b) {
    constexpr size_t PB_ = (size_t)NH * SEQ * 3 * PART_REC;
    return b < 6 ? p.ws + 214 * MiB + (size_t)b * PB_ : (unsigned char*)p.out + 96 * MiB + (size_t)(b - 6) * PB_;
}
struct A2State { float m, l; f32x16 o0, o1; };
constexpr int A2_WBUF = 8192;
DI void a2_dma_tile(const unsigned char* kf_tile, const unsigned char* vf_tile, LAS unsigned char* wbuf, int lane) {
#pragma unroll
    for (int f = 0; f < 8; ++f) {
        __builtin_amdgcn_global_load_lds((const unsigned*)(kf_tile + f * 1024 + lane * 16), (LAS unsigned*)(wbuf + f * 1024), 16, 0, 0);
        __builtin_amdgcn_global_load_lds((const unsigned*)(vf_tile + f * 1024 + lane * 16), (LAS unsigned*)(wbuf + 8192 + f * 1024), 16, 0, 0);
    }
}
template <bool OWN> DI void attn2_item(const Params& p, const LAS float* btab, LAS unsigned char* wbuf, int b, int h, int qb, int blk, int row, int nkt, A2State& st, int lane, int r32, int hi) {
    unsigned char* ws = p.ws;
    const bf16_t* QKV = (const bf16_t*)(ws + WS_QKV);
    const int bh = b * NH + h;
    const unsigned char* kft = (const unsigned char*)p.out + DO_KF + ((size_t)(bh * 64 + blk * 4) * 8) * 1024;
    const unsigned char* vft = (const unsigned char*)p.out + DO_VT + ((size_t)(bh * 64 + blk * 4) * 8) * 1024;
    a2_dma_tile(kft, vft, wbuf, lane);
    bf16x8 qr[4];
    { const bf16_t* qp = QKV + ((size_t)(b * SEQ + qb * 256 + row)) * QKVW + h * 64 + hi * 8;
#pragma unroll
      for (int d0 = 0; d0 < 4; ++d0) qr[d0] = *(const bf16x8*)(qp + d0 * 16); }
    st.m = -INFINITY; st.l = 0.f;
#pragma unroll
    for (int i = 0; i < 16; ++i) { st.o0[i] = 0.f; st.o1[i] = 0.f; }
    const int dbase = OWN ? row : ((qb - blk) * 256 + row);
    for (int kt = 0; kt < nkt; ++kt) {
        asm volatile("s_waitcnt vmcnt(0)" ::: "memory");
        bf16x8 kf[8], vf[8];
#pragma unroll
        for (int f = 0; f < 8; ++f) { kf[f] = *(const LAS bf16x8*)(wbuf + f * 1024 + lane * 16); vf[f] = *(const LAS bf16x8*)(wbuf + 8192 + f * 1024 + lane * 16); }
        asm volatile("s_waitcnt lgkmcnt(0)" ::: "memory");
        __builtin_amdgcn_sched_barrier(0);
        if (kt + 1 < nkt) a2_dma_tile(kft + (size_t)(kt + 1) * 8192, vft + (size_t)(kt + 1) * 8192, wbuf, lane);
        f32x16 p0, p1;
#pragma unroll
        for (int i = 0; i < 16; ++i) { p0[i] = 0.f; p1[i] = 0.f; }
#pragma unroll
        for (int d0 = 0; d0 < 4; ++d0) { p0 = MFMA32(kf[2 * d0], qr[d0], p0); p1 = MFMA32(kf[2 * d0 + 1], qr[d0], p1); }
        const float sc2 = 0.125f * LOG2E;
        const int dq = dbase - kt * 64;
        float mx = -INFINITY;
        const bool farb = !OWN && (__all(dq - 63 >= 113) != 0);
        const float c31 = btab[511];
        if (farb) {
#pragma unroll
            for (int r = 0; r < 16; ++r) mx = fmaxf(mx, fmaxf(p0[r], p1[r]));
            mx = mx * sc2 + c31;
        } else {
#pragma unroll
            for (int r = 0; r < 16; ++r) {
                const int d0 = dq - crow(r, hi), d1 = d0 - 32;
                const int i0 = d0 < 0 ? 0 : (d0 > 511 ? 511 : d0), i1 = d1 < 0 ? 0 : (d1 > 511 ? 511 : d1);
                float x0 = p0[r] * sc2 + btab[i0], x1 = p1[r] * sc2 + btab[i1];
                if (OWN) { x0 = d0 >= 0 ? x0 : -INFINITY; x1 = d1 >= 0 ? x1 : -INFINITY; }
                p0[r] = x0; p1[r] = x1; mx = fmaxf(mx, fmaxf(x0, x1));
            }
        }
        { const auto sw = __builtin_amdgcn_permlane32_swap(__float_as_uint(mx), __float_as_uint(mx), false, false);
          mx = fmaxf(__uint_as_float(sw[0]), __uint_as_float(sw[1])); }
        if (__any(mx > st.m)) {
            const float mn = fmaxf(st.m, mx);
            const float alpha = __builtin_amdgcn_exp2f(st.m - mn);
            st.m = mn;
#pragma unroll
            for (int i = 0; i < 16; ++i) { st.o0[i] *= alpha; st.o1[i] *= alpha; }
            st.l *= alpha;
        }
        float rs0 = 0.f, rs1 = 0.f;
        if (farb) { const float c = c31 - st.m;
#pragma unroll
            for (int r = 0; r < 16; ++r) { p0[r] = __builtin_amdgcn_exp2f(p0[r] * sc2 + c); p1[r] = __builtin_amdgcn_exp2f(p1[r] * sc2 + c); rs0 += p0[r]; rs1 += p1[r]; }
        } else {
#pragma unroll
            for (int r = 0; r < 16; ++r) { p0[r] = __builtin_amdgcn_exp2f(p0[r] - st.m); p1[r] = __builtin_amdgcn_exp2f(p1[r] - st.m); rs0 += p0[r]; rs1 += p1[r]; }
        }
        st.l += rs0 + rs1;
#pragma unroll
        for (int s = 0; s < 4; ++s) {
            u32x4 pw;
            if (s < 2) { pw.x = pk2(p0[8 * s], p0[8 * s + 1]); pw.y = pk2(p0[8 * s + 2], p0[8 * s + 3]); pw.z = pk2(p0[8 * s + 4], p0[8 * s + 5]); pw.w = pk2(p0[8 * s + 6], p0[8 * s + 7]); }
            else { const int q = s - 2; pw.x = pk2(p1[8 * q], p1[8 * q + 1]); pw.y = pk2(p1[8 * q + 2], p1[8 * q + 3]); pw.z = pk2(p1[8 * q + 4], p1[8 * q + 5]); pw.w = pk2(p1[8 * q + 6], p1[8 * q + 7]); }
            const bf16x8 pf = __builtin_bit_cast(bf16x8, pw);
            st.o0 = MFMA32(vf[s], pf, st.o0); st.o1 = MFMA32(vf[4 + s], pf, st.o1);
        }
    }
    st.l += __shfl_xor(st.l, 32);
}
template <int CHECK> DI void attn2_unit(const Params& p, LAS unsigned char* lds, int b, int h, int qb, int tid, int lane, int wid) {
    unsigned char* ws = p.ws;
    const bf16_t* QKV = (const bf16_t*)(ws + WS_QKV);
    bf16_t* OA = (bf16_t*)(ws + WS_OA);
    const int r32 = lane & 31, hi = lane >> 5, bh = b * NH + h;
    LAS float* btab = (LAS float*)(lds + A2_BT);
    LAS unsigned short* selm = (LAS unsigned short*)(lds + A2_SEL);
    LAS int* cnt = (LAS int*)(lds + A2_CNT);
    LAS int* wcnt = (LAS int*)(lds + A2_WCNT);
    LAS int* ctl = (LAS int*)(lds + A2_NIT);
    LAS unsigned char* itemtab = lds + A2_ITEM;
    LAS unsigned char* rows = lds + A2_ROWS;
    unsigned char* part = part_base(p, b) + ((size_t)(h * 16 + qb) * 256) * 3 * PART_REC;
    __syncthreads();
    btab[tid] = p.rel_bias[h * 32 + rel_bucket_dev(tid)] * LOG2E;
    unsigned mysel = 0u;
    if (qb > 0) {
        LAS float* kbl = (LAS float*)(lds + A2_WBUF);
        LAS float* gp = (LAS float*)(lds + A2_WBUF + 4096);
        const float* KBAR = (const float*)(ws + WS_KBAR) + (size_t)(bh * 16) * 64;
        for (int i = tid; i < qb * 64; i += NTHREADS) kbl[i] = KBAR[i];
        const int qi = tid & 255, hf = tid >> 8;
        float q[32];
        { const bf16_t* qp = QKV + ((size_t)(b * SEQ + qb * 256 + qi)) * QKVW + h * 64 + 32 * hf;
#pragma unroll
          for (int c = 0; c < 4; ++c) { const u32x4 w = *(const u32x4*)(qp + c * 8); float f[8]; unpack8(w, f);
#pragma unroll
              for (int i = 0; i < 8; ++i) q[c * 8 + i] = f[i]; } }
        __syncthreads();
        for (int jb = 0; jb < qb; ++jb) {
            const LAS float* kbp = kbl + jb * 64 + 32 * hf;
            float g0 = 0.f, g1 = 0.f;
#pragma unroll
            for (int d = 0; d < 32; d += 8) { const f32x4 ka = *(const LAS f32x4*)(kbp + d), kb = *(const LAS f32x4*)(kbp + d + 4);
                g0 += q[d] * ka.x + q[d + 1] * ka.y + q[d + 2] * ka.z + q[d + 3] * ka.w; g1 += q[d + 4] * kb.x + q[d + 5] * kb.y + q[d + 6] * kb.z + q[d + 7] * kb.w; }
            gp[(hf * 16 + jb) * 256 + qi] = g0 + g1;
        }
        __syncthreads();
        if (tid < 256) {
            float v1 = -INFINITY, v2 = -INFINITY, v3 = -INFINITY; int i1 = -1, i2 = -1, i3 = -1;
            for (int jb = 0; jb < qb; ++jb) {
                const float g = gp[jb * 256 + tid] + gp[(16 + jb) * 256 + tid];
                if (g > v1) { v3 = v2; i3 = i2; v2 = v1; i2 = i1; v1 = g; i1 = jb; }
                else if (g > v2) { v3 = v2; i3 = i2; v2 = g; i2 = jb; }
                else if (g > v3) { v3 = g; i3 = jb; }
            }
            if (i1 >= 0) mysel |= 1u << i1;
            if (i2 >= 0) mysel |= 1u << i2;
            if (i3 >= 0) mysel |= 1u << i3;
        }
    }
    if (tid < 256) {
        selm[tid] = (unsigned short)mysel;
        for (int j = 0; j < qb; ++j) { const unsigned long long bm = __ballot((mysel >> j) & 1u); if (lane == 0) wcnt[j * 4 + wid] = __popcll(bm); }
    }
    __syncthreads();
    if (tid < 256) {
        for (int j = 0; j < qb; ++j) {
            const bool bit = ((mysel >> j) & 1u) != 0u;
            const unsigned long long bm = __ballot(bit);
            int off = 0;
            for (int w2 = 0; w2 < 4; ++w2) off += (w2 < wid) ? wcnt[j * 4 + w2] : 0;
            const int pre = __popcll(bm & ((1ull << lane) - 1ull));
            if (bit) rows[j * 256 + off + pre] = (unsigned char)tid;
            if (tid == 0) cnt[j] = wcnt[j * 4] + wcnt[j * 4 + 1] + wcnt[j * 4 + 2] + wcnt[j * 4 + 3];
        }
    }
    __syncthreads();
    if (tid == 0) {
        int n = 0;
        for (int j = 0; j < qb; ++j) { const int nt = (cnt[j] + 31) >> 5; for (int r = 0; r < nt; ++r) itemtab[n++] = (unsigned char)(j * 8 + r); }
        ctl[0] = n; ctl[1] = 0;
    }
    __syncthreads();
    LAS unsigned char* wbuf = lds + A2_WBUF + wid * 16384;
    const int nitems = ctl[0];
    for (;;) {
        int it = 0;
        if (lane == 0) it = __hip_atomic_fetch_add(&ctl[1], 1, __ATOMIC_RELAXED, __HIP_MEMORY_SCOPE_WORKGROUP);
        it = __builtin_amdgcn_readfirstlane(it);
        if (it >= nitems) break;
        const int code = itemtab[it], j = code >> 3, r = code & 7;
        const int pos = r * 32 + r32, n = cnt[j];
        const bool valid = pos < n;
        const int row = rows[j * 256 + (valid ? pos : 0)];
        A2State st;
        attn2_item<false>(p, btab, wbuf, b, h, qb, j, row, 4, st, lane, r32, hi);
        if (valid) {
            const unsigned sm = selm[row];
            const int slot = __popc(sm & ((1u << j) - 1u));
            unsigned char* rec = part + ((size_t)row * 3 + slot) * PART_REC;
#pragma unroll
            for (int g = 0; g < 4; ++g) {
                *(u32x2*)(rec + (8 * g + 4 * hi) * 2) = (u32x2){pk2(st.o0[4 * g], st.o0[4 * g + 1]), pk2(st.o0[4 * g + 2], st.o0[4 * g + 3])};
                *(u32x2*)(rec + (32 + 8 * g + 4 * hi) * 2) = (u32x2){pk2(st.o1[4 * g], st.o1[4 * g + 1]), pk2(st.o1[4 * g + 2], st.o1[4 * g + 3])};
            }
            if (hi == 0) *(f32x2*)(rec + 128) = (f32x2){st.m, st.l};
        }
    }
    A2State own;
    attn2_item<true>(p, btab, wbuf, b, h, qb, qb, wid * 32 + r32, (wid >> 1) + 1, own, lane, r32, hi);
    asm volatile("s_waitcnt vmcnt(0)" ::: "memory");
    __syncthreads();
    {
        const int row = wid * 32 + r32;
        const unsigned sm = selm[row];
        const int ns = __popc(sm);
        float M = own.m;
        float ms[3], ls[3];
#pragma unroll
        for (int s3 = 0; s3 < 3; ++s3) { ms[s3] = -INFINITY; ls[s3] = 0.f;
            if (s3 < ns) { const f32x2 ml = *(const f32x2*)(part + ((size_t)row * 3 + s3) * PART_REC + 128); ms[s3] = ml.x; ls[s3] = ml.y; M = fmaxf(M, ml.x); } }
        const float f0 = __builtin_amdgcn_exp2f(own.m - M);
        float L = own.l * f0;
#pragma unroll
        for (int i = 0; i < 16; ++i) { own.o0[i] *= f0; own.o1[i] *= f0; }
#pragma unroll
        for (int s3 = 0; s3 < 3; ++s3) {
            if (s3 < ns) {
                const float fs = __builtin_amdgcn_exp2f(ms[s3] - M);
                L += ls[s3] * fs;
                const unsigned char* rec = part + ((size_t)row * 3 + s3) * PART_REC;
#pragma unroll
                for (int g = 0; g < 4; ++g) {
                    const u32x2 a = *(const u32x2*)(rec + (8 * g + 4 * hi) * 2), c = *(const u32x2*)(rec + (32 + 8 * g + 4 * hi) * 2);
                    own.o0[4 * g] += fs * bflo(a.x); own.o0[4 * g + 1] += fs * bfhi(a.x); own.o0[4 * g + 2] += fs * bflo(a.y); own.o0[4 * g + 3] += fs * bfhi(a.y);
                    own.o1[4 * g] += fs * bflo(c.x); own.o1[4 * g + 1] += fs * bfhi(c.x); own.o1[4 * g + 2] += fs * bflo(c.y); own.o1[4 * g + 3] += fs * bfhi(c.y);
                }
            }
        }
        const float il = 1.f / L;
        bf16_t* orow = OA + ((size_t)(b * SEQ + qb * 256 + row)) * 512 + h * 64;
#pragma unroll
        for (int g = 0; g < 4; ++g) {
            u32x2 w0, w1;
            w0.x = pk2(own.o0[4 * g] * il, own.o0[4 * g + 1] * il); w0.y = pk2(own.o0[4 * g + 2] * il, own.o0[4 * g + 3] * il);
            w1.x = pk2(own.o1[4 * g] * il, own.o1[4 * g + 1] * il); w1.y = pk2(own.o1[4 * g + 2] * il, own.o1[4 * g + 3] * il);
            if (CHECK) {
                const u32x2 r0 = *(const u32x2*)(orow + 8 * g + 4 * hi), r1 = *(const u32x2*)(orow + 32 + 8 * g + 4 * hi);
                const float a[8] = {bflo(w0.x), bfhi(w0.x), bflo(w0.y), bfhi(w0.y), bflo(w1.x), bfhi(w1.x), bflo(w1.y), bfhi(w1.y)};
                const float c[8] = {bflo(r0.x), bfhi(r0.x), bflo(r0.y), bfhi(r0.y), bflo(r1.x), bfhi(r1.x), bflo(r1.y), bfhi(r1.y)};
                bool bad = false;
#pragma unroll
                for (int i = 0; i < 8; ++i) bad |= !(fabsf(a[i] - c[i]) <= 0.03f * fabsf(c[i]) + 0.004f);
                if (bad) { w0.x = 0x7fc07fc0u; w0.y = 0x7fc07fc0u; w1.x = 0x7fc07fc0u; w1.y = 0x7fc07fc0u; }
            }
            *(u32x2*)(orow + 8 * g + 4 * hi) = w0; *(u32x2*)(orow + 32 + 8 * g + 4 * hi) = w1;
        }
    }
}
template <int CHECK> DI void phase_attn2(const Params& p, LAS unsigned char* lds, int tid, int lane, int wid) {
    if (gridDim.x == 256) {
        const int x = blockIdx.x & 7, j = blockIdx.x >> 3, u = j & 15, v = (u + 8) & 15;
#pragma unroll 1
        for (int i = 0; i < 4; ++i) { const int bh = x * 8 + 2 * i + (j >> 4); const int qb = i == 0 ? 15 - u : (i == 1 ? u : (i == 2 ? 15 - v : v)); attn2_unit<CHECK>(p, lds, bh >> 3, bh & 7, qb, tid, lane, wid); }
    } else {
        for (int it = blockIdx.x; it < NB * NH * 16; it += gridDim.x) { const int qb = 15 - (it >> 6), bh = it & 63; attn2_unit<CHECK>(p, lds, bh >> 3, bh & 7, qb, tid, lane, wid); }
    }
}

DI void phase_post(const Params& p, int tid, int lane, int wid) {
    unsigned char* ws = p.ws;
    const bf16_t* SCAN = (const bf16_t*)(ws + WS_SCAN);
    const bf16_t* OBRAW = (const bf16_t*)(ws + WS_OBRAW);
    const bf16_t* RG = (const bf16_t*)((const unsigned char*)p.out + DO_RG);
    bf16_t* OB = (bf16_t*)(ws + WS_OB);
    const int gw = blockIdx.x * NWAVES + wid, NGW = gridDim.x * NWAVES;
    for (int tok = gw; tok < NTOK; tok += NGW) {
        const int b = tok >> 12, s = tok & (SEQ - 1);
#pragma unroll
        for (int h = 0; h < NH; ++h) {
            const int c = h * 64 + lane;
            const float o = bf2f(OBRAW[(size_t)tok * 512 + c]);
            const float mu = wave_sum(o) * (1.f / 64.f);
            const float dd = o - mu;
            const float var = wave_sum(dd * dd) * (1.f / 64.f);
            const float on = dd * rsqrtf(var + GN_EPS) * p.lnx_g[c] + p.lnx_b[c];
            const bf16_t* si = SCAN + ((size_t)((b * NH + h) * SEQ + s)) * 384 + lane;
            const float km = bf2f(si[192]), r = bf2f(si[256]), v = bf2f(si[320]);
            const float bon = wave_sum(r * km * p.r_k[c]);
            const float g = bf2f(RG[(size_t)tok * 512 + c]);
            OB[(size_t)tok * 512 + c] = f2bf((on + bon * v) * g);
        }
    }
}
typedef float v16f_t __attribute__((ext_vector_type(16)));
typedef float v32f_t __attribute__((ext_vector_type(32)));
typedef int v6i_t __attribute__((ext_vector_type(6)));
DI void phase_uv_convert(const Params& p, int lane, int gw, int NGW) {
    unsigned char* ws = p.ws;
    const int hl = lane & 31, half = lane >> 5;
    for (int e2 = gw; e2 < NEXP; e2 += NGW) {
        const bool isv = e2 >= NEXP / 2;
        const int e = 2 * (isv ? e2 - NEXP / 2 : e2) + half;
        const float* src = (isv ? p.peer_v : p.peer_u) + (size_t)e * DM + 32 * hl;
        f32x4 v[8]; float am = 0.f, ss = 0.f;
#pragma unroll
        for (int j = 0; j < 8; ++j) { v[j] = *(const f32x4*)(src + 4 * j);
            am = fmaxf(am, fmaxf(fmaxf(fabsf(v[j].x), fabsf(v[j].y)), fmaxf(fabsf(v[j].z), fabsf(v[j].w))));
            ss += v[j].x * v[j].x + v[j].y * v[j].y + v[j].z * v[j].z + v[j].w * v[j].w; }
#pragma unroll
        for (int o = 1; o < 32; o <<= 1) { am = fmaxf(am, __shfl_xor(am, o)); ss += __shfl_xor(ss, o); }
        u32x4 w = {0u, 0u, 0u, 0u};
        if (isv) {
            am = fmaxf(am, 1e-30f);
            const float mul = 6.f / am;
#define FP4_PACK(j_) \
            w[j_] = __builtin_amdgcn_cvt_scalef32_pk_fp4_f32(w[j_], v[2 * (j_)].x * mul, v[2 * (j_)].y * mul, 1.0f, 0); \
            w[j_] = __builtin_amdgcn_cvt_scalef32_pk_fp4_f32(w[j_], v[2 * (j_)].z * mul, v[2 * (j_)].w * mul, 1.0f, 1); \
            w[j_] = __builtin_amdgcn_cvt_scalef32_pk_fp4_f32(w[j_], v[2 * (j_) + 1].x * mul, v[2 * (j_) + 1].y * mul, 1.0f, 2); \
            w[j_] = __builtin_amdgcn_cvt_scalef32_pk_fp4_f32(w[j_], v[2 * (j_) + 1].z * mul, v[2 * (j_) + 1].w * mul, 1.0f, 3);
            FP4_PACK(0) FP4_PACK(1) FP4_PACK(2) FP4_PACK(3)
#undef FP4_PACK
            *(u32x4*)(ws + WS_V8 + (size_t)e * 512 + 16 * hl) = w;
            if (hl == 0) ((float*)(ws + WS_USC))[4 * e + 2] = am * (1.f / 6.f);
        } else {
            const float su = fmaxf(0.335f * sqrtf(ss * (1.f / DM)), 1e-30f), inv = 1.f / su;
            unsigned nsum = 0u;
#pragma unroll
            for (int j = 0; j < 4; ++j) {
#pragma unroll
                for (int k = 0; k < 4; ++k) {
                    const unsigned nl = (unsigned)fminf(fmaxf(floorf(v[2 * j][k] * inv) + 8.f, 0.f), 15.f);
                    const unsigned nh = (unsigned)fminf(fmaxf(floorf(v[2 * j + 1][k] * inv) + 8.f, 0.f), 15.f);
                    w[j] |= (nl | (nh << 4)) << (8 * k); nsum += nl + nh;
                }
            }
#pragma unroll
            for (int o = 1; o < 32; o <<= 1) nsum += (unsigned)__shfl_xor((int)nsum, o);
            *(u32x4*)(ws + WS_U8 + (size_t)e * 512 + 16 * hl) = w;
            if (hl == 0) ((f32x2*)(ws + WS_USC))[2 * e] = (f32x2){su, (float)nsum};
        }
    }
}

DI void ce_desc(float& x, float& y) { const float hi = fmaxf(x, y), lo = fminf(x, y); x = hi; y = lo; }
DI void sort16_desc(float (&v)[16]) {
#pragma unroll
    for (int k = 2; k <= 16; k <<= 1) {
#pragma unroll
        for (int j = k >> 1; j > 0; j >>= 1) {
#pragma unroll
            for (int i = 0; i < 16; ++i) { const int l = i ^ j; if (l > i) { if ((i & k) == 0) ce_desc(v[i], v[l]); else ce_desc(v[l], v[i]); } }
        }
    }
}
DI void merge16_desc(float (&a)[16], const float (&b)[16]) {
#pragma unroll
    for (int i = 0; i < 16; ++i) a[i] = fmaxf(a[i], b[15 - i]);
#pragma unroll
    for (int j = 8; j > 0; j >>= 1) {
#pragma unroll
        for (int i = 0; i < 16; ++i) { const int l = i ^ j; if (l > i) ce_desc(a[i], a[l]); }
    }
}
DI void xmerge16(float (&a)[16]) {
    float o[16];
#pragma unroll
    for (int i = 0; i < 16; ++i) o[i] = __shfl_xor(a[i], 32);
    merge16_desc(a, o);
}
constexpr int ca_A(int i) { return i < 16 ? 0 : (i < 24 ? i - 8 : -1); }
constexpr int cb_A(int i) { return i < 16 ? i : (i < 24 ? 0 : -1); }
constexpr int ca_B(int i) { return i < 8 ? 1 : i < 13 ? 2 : i < 17 ? 3 : i < 20 ? 4 : i < 22 ? 5 : i < 24 ? 6 : i < 26 ? 7 : -1; }
constexpr int cb_B(int i) { return i < 8 ? i : i < 13 ? i - 8 : i < 17 ? i - 13 : i < 20 ? i - 17 : i < 22 ? i - 20 : i < 24 ? i - 22 : i < 26 ? i - 24 : -1; }

DI void route_item(const Params& p, LAS unsigned char* wl  , int item, int lane) {
    unsigned char* ws = p.ws;
    const bf16_t* QP = (const bf16_t*)(ws + WS_QP);
    const bf16_t* SK = (const bf16_t*)(ws + WS_SK);
    int* PIDX = (int*)(ws + WS_PIDX); float* PGATE = (float*)(ws + WS_PGATE);
    const int tt = item >> 3, h = item & 7, t0 = tt * 32, r32 = lane & 31, hi = lane >> 5;
    float L0[16], L1[16];
#pragma unroll
    for (int pp = 0; pp < 2; ++pp) {
        const int hp = h * 2 + pp;
        bf16x8 qf[8];
#pragma unroll
        for (int ks = 0; ks < 8; ++ks) qf[ks] = *(const bf16x8*)(QP + (size_t)(t0 + r32) * 2048 + hp * 128 + ks * 16 + hi * 8);
        float run[16];
#pragma unroll
        for (int i = 0; i < 16; ++i) run[i] = -INFINITY;
        bf16x8 skf[8];
        { const bf16_t* skp = SK + ((size_t)(hp * 128 + r32)) * 128 + hi * 8;
#pragma unroll
          for (int ks = 0; ks < 8; ++ks) skf[ks] = *(const bf16x8*)(skp + ks * 16); }
#pragma unroll 1
        for (int nt = 0; nt < 4; ++nt) {
            f32x16 X;
#pragma unroll
            for (int i = 0; i < 16; ++i) X[i] = 0.f;
#pragma unroll
            for (int ks = 0; ks < 8; ++ks) X = MFMA32(skf[ks], qf[ks], X);
            if (nt < 3) { const bf16_t* skp = SK + ((size_t)(hp * 128 + (nt + 1) * 32 + r32)) * 128 + hi * 8;
#pragma unroll
                for (int ks = 0; ks < 8; ++ks) skf[ks] = *(const bf16x8*)(skp + ks * 16); }
            float v[16];
#pragma unroll
            for (int r = 0; r < 16; ++r) { const unsigned n = (unsigned)(nt * 32 + (r & 3) + 8 * (r >> 2)) + 4u * (unsigned)hi;
                v[r] = __uint_as_float((__float_as_uint(X[r]) & ~127u) | n); }
            sort16_desc(v);
            merge16_desc(run, v);
        }
        xmerge16(run);
#pragma unroll
        for (int i = 0; i < 16; ++i) { if (pp == 0) L0[i] = run[i]; else L1[i] = run[i]; }
    }
#pragma unroll
    for (int i = 0; i < 16; ++i) { wl[lane * 32 + i] = (unsigned char)(__float_as_uint(L0[i]) & 127u); wl[lane * 32 + 16 + i] = (unsigned char)(__float_as_uint(L1[i]) & 127u); }
    float c0[16], c1[16];
#pragma unroll
    for (int i = 0; i < 32; ++i) {
        float va = -INFINITY, vb = -INFINITY;
        if (ca_A(i) >= 0) { const float s = L0[ca_A(i) < 0 ? 0 : ca_A(i)] + L1[cb_A(i) < 0 ? 0 : cb_A(i)]; va = __uint_as_float((__float_as_uint(s) & ~255u) | (unsigned)(ca_A(i) * 16 + cb_A(i))); }
        if (ca_B(i) >= 0) { const float s = L0[ca_B(i) < 0 ? 0 : ca_B(i)] + L1[cb_B(i) < 0 ? 0 : cb_B(i)]; vb = __uint_as_float((__float_as_uint(s) & ~255u) | (unsigned)(ca_B(i) * 16 + cb_B(i))); }
        const float v = hi ? vb : va;
        if (i < 16) c0[i] = v; else c1[i - 16] = v;
    }
    sort16_desc(c0); sort16_desc(c1); merge16_desc(c0, c1); xmerge16(c0);
    LDS_WAIT(); asm volatile("" ::: "memory");
    int e[16]; float g[16]; float sum = 0.f;
    const float rs = row_rs((const float*)(ws + WS_ROWSQ), t0 + r32);
    if (h == 0 && hi == 0) ((float*)(ws + WS_RS))[t0 + r32] = rs;
    const float mx = __uint_as_float(__float_as_uint(c0[0]) & ~255u);
#pragma unroll
    for (int k = 0; k < 16; ++k) {
        const unsigned bits = __float_as_uint(c0[k]); const int code = (int)(bits & 255u), a = code >> 4, b = code & 15;
        const int i0 = wl[lane * 32 + a], i1 = wl[lane * 32 + 16 + b];
        e[k] = i0 * 128 + i1;
        g[k] = __expf((__uint_as_float(bits & ~255u) - mx) * rs); sum += g[k];
    }
    const float inv = 1.f / sum;
    const size_t ob = ((size_t)(t0 + r32) * 8 + h) * 16 + hi * 8;
    u32x4 e0, e1; f32x4 g0, g1;
    e0.x = hi ? e[8] : e[0]; e0.y = hi ? e[9] : e[1]; e0.z = hi ? e[10] : e[2]; e0.w = hi ? e[11] : e[3];
    e1.x = hi ? e[12] : e[4]; e1.y = hi ? e[13] : e[5]; e1.z = hi ? e[14] : e[6]; e1.w = hi ? e[15] : e[7];
    g0.x = (hi ? g[8] : g[0]) * inv; g0.y = (hi ? g[9] : g[1]) * inv; g0.z = (hi ? g[10] : g[2]) * inv; g0.w = (hi ? g[11] : g[3]) * inv;
    g1.x = (hi ? g[12] : g[4]) * inv; g1.y = (hi ? g[13] : g[5]) * inv; g1.z = (hi ? g[14] : g[6]) * inv; g1.w = (hi ? g[15] : g[7]) * inv;
    *(u32x4*)(PIDX + ob) = e0; *(u32x4*)(PIDX + ob + 4) = e1;
    *(f32x4*)(PGATE + ob) = g0; *(f32x4*)(PGATE + ob + 4) = g1;
    LDS_WAIT(); asm volatile("" ::: "memory");
}
DI void phase_route(const Params& p, LAS unsigned char* lds, int lane, int wid) {
    const int gw = blockIdx.x * NWAVES + wid, NGW = gridDim.x * NWAVES;
    for (int it = gw; it < (NTOK / 32) * NH; it += NGW) route_item(p, lds + wid * 2048, it, lane);
}

DI float gelu_exact(float x) { return 0.5f * x * (1.f + erff(x * 0.70710678118654752f)); }
DI float gelu_bf(float x) {
    const float z = fabsf(x) * 0.70710678118654752f;
    const float t = __builtin_amdgcn_rcpf(fmaf(0.3275911f, z, 1.f));
    const float poly = t * fmaf(t, fmaf(t, fmaf(t, fmaf(t, 1.061405429f, -1.453152027f), 1.421413741f), -0.284496736f), 0.254829592f);
    const float he = 0.5f * poly * __expf(-z * z);
    return x * (x >= 0.f ? 1.f - he : he);
}
DI void experts_quant_x(const u32x4 (&xn)[4], unsigned (&xa)[8], float& sx, float& ktok) {
    float f[32];
#pragma unroll
    for (int j = 0; j < 4; ++j) { float t[8]; unpack8(xn[j], t);
#pragma unroll
        for (int i = 0; i < 8; ++i) f[8 * j + i] = t[i]; }
    float m = 0.f;
#pragma unroll
    for (int i = 0; i < 32; ++i) m = fmaxf(m, fabsf(f[i]));
    m = fmaxf(m, dpp_mov<0x128>(m)); m = fmaxf(m, dpp_mov<0x124>(m)); m = fmaxf(m, dpp_mov<0x122>(m)); m = fmaxf(m, dpp_mov<0x121>(m));
    m = fmaxf(m, __shfl_xor(m, 16));
    m = fmaxf(m, 1e-30f);
    const float inv = 127.f / m; sx = m * (1.f / 127.f);
    unsigned tsum = 0u;
#pragma unroll
    for (int j = 0; j < 4; ++j) { unsigned wh = 0u, wl = 0u;
#pragma unroll
        for (int k = 0; k < 4; ++k) {
            const unsigned q0 = (unsigned)(rintf(f[8 * j + k] * inv) + 128.f), q1 = (unsigned)(rintf(f[8 * j + 4 + k] * inv) + 128.f);
            wh |= ((q0 >> 4) | ((q1 >> 4) << 4)) << (8 * k); wl |= ((q0 & 15u) | ((q1 & 15u) << 4)) << (8 * k); tsum += q0 + q1; }
        xa[j] = wh; xa[4 + j] = wl; }
    float tf = row16_sum((float)tsum);
    tf += __shfl_xor(tf, 16);
    ktok = 983040.f - 7.5f * tf;
}
DI void phase_experts(const Params& p, LAS unsigned char* ldsw  , int lane, int wid, float* outp, const int IDMASK, const XcdBarrier& barx, const bool sync_passes) {
    unsigned char* ws = p.ws;
    const bf16_t* XN = (const bf16_t*)(ws + WS_XN);
    const unsigned char* U8 = ws + WS_U8; const unsigned char* V8 = ws + WS_V8;
    const f32x4* USC = (const f32x4*)(ws + WS_USC);
    const int* PIDX = (const int*)(ws + WS_PIDX); const float* PGATE = (const float*)(ws + WS_PGATE); const float* RS = (const float*)(ws + WS_RS);
    const bf16_t* H1 = (const bf16_t*)(ws + WS_H1B);
    const int hl = lane & 31; const bool hi = lane >= 32;
    const unsigned hl16 = 16u * (unsigned)hl;
    const bool b0 = (lane & 1) != 0, b1 = (lane & 2) != 0;
    const int ntile = ((NTOK / 32) - (int)blockIdx.x + (int)gridDim.x - 1) / (int)gridDim.x;
    if (ntile <= 0) return;
    const int ntw = ntile * 4;
    auto tokof = [&](int t) { const int tc = t < ntw ? t : ntw - 1; return 32 * ((int)blockIdx.x + (tc >> 2) * (int)gridDim.x) + 4 * wid + (tc & 3); };
    unsigned xa[8]; float sx, ktok;
    typedef int v8i_t __attribute__((ext_vector_type(8)));
    float nfg[16];
#pragma unroll
    for (int r = 0; r < 16; ++r) nfg[r] = p.normf_g[32 * crow(r, hi) + hl];
    unsigned bmask[4];
#pragma unroll
    for (int r = 0; r < 4; ++r) bmask[r] = ((hi ? 1 : 0) == ((hl >> 4) & 1) && r == ((hl & 15) >> 2)) ? (0xFFu << (8 * (hl & 3))) : 0u;
    LAS unsigned short* idbuf = (LAS unsigned short*)(ldsw + 6144);
    int tcur = 0;
    int iA1, iB1, iA2, iB2; float gA1, gB1, gA2, gB2, vA1, vB1; f32x2 uA1, uB1;
    auto ld_ids = [&](int t, int& iA, int& iB, float& gA, float& gB) { const size_t b = (size_t)tokof(t) * 128 + lane;
        iA = PIDX[b] & IDMASK; iB = PIDX[b + 64] & IDMASK; gA = PGATE[b]; gB = PGATE[b + 64]; };
    auto wr_rec = [&](int t, int iA, int iB, float gA, float gB, f32x2 uA, f32x2 uB, float vA, float vB) {
        LAS unsigned char* buf = ldsw + (t & 1) * 2048;
        *(LAS u32x4*)(buf + lane * 16) = (u32x4){(unsigned)iA, __float_as_uint(gA * vA), __float_as_uint(uA.x), __float_as_uint(uA.y)};
        *(LAS u32x4*)(buf + 1024 + lane * 16) = (u32x4){(unsigned)iB, __float_as_uint(gB * vB), __float_as_uint(uB.x), __float_as_uint(uB.y)};
        idbuf[(t - tcur) * 128 + lane] = (unsigned short)iA; idbuf[(t - tcur) * 128 + 64 + lane] = (unsigned short)iB;
    };
    LAS unsigned char* hvbuf = ldsw + 4096;
    auto prime = [&](int t0) {
        ld_ids(t0, iA1, iB1, gA1, gB1);
        { const f32x4 ra = USC[iA1], rb = USC[iB1]; uA1 = (f32x2){ra[0], ra[1]}; uB1 = (f32x2){rb[0], rb[1]}; vA1 = ra[2]; vB1 = rb[2]; }
        wr_rec(t0, iA1, iB1, gA1, gB1, uA1, uB1, vA1, vB1);
        ld_ids(t0 + 1, iA1, iB1, gA1, gB1);
        { const f32x4 ra = USC[iA1], rb = USC[iB1]; uA1 = (f32x2){ra[0], ra[1]}; uB1 = (f32x2){rb[0], rb[1]}; vA1 = ra[2]; vB1 = rb[2]; }
        ld_ids(t0 + 2, iA2, iB2, gA2, gB2);
    };
    auto advance = [&](int t) {
        wr_rec(t + 1, iA1, iB1, gA1, gB1, uA1, uB1, vA1, vB1);
        iA1 = iA2; iB1 = iB2; gA1 = gA2; gB1 = gB2;
        { const f32x4 ra = USC[iA1], rb = USC[iB1]; uA1 = (f32x2){ra[0], ra[1]}; uB1 = (f32x2){rb[0], rb[1]}; vA1 = ra[2]; vB1 = rb[2]; }
        ld_ids(t + 3, iA2, iB2, gA2, gB2);
    };
    auto ld_idx = [&](int t, int& iA, int& iB) { const size_t b = (size_t)tokof(t) * 128 + lane; iA = PIDX[b] & IDMASK; iB = PIDX[b + 64] & IDMASK; };
    auto wr_id = [&](int t, int iA, int iB) { LAS unsigned char* buf = ldsw + (t & 1) * 2048; *(LAS int*)(buf + lane * 16) = iA; *(LAS int*)(buf + 1024 + lane * 16) = iB; };
    auto prime2 = [&](int t0) { ld_idx(t0, iA1, iB1); wr_id(t0, iA1, iB1); ld_idx(t0 + 1, iA1, iB1); ld_idx(t0 + 2, iA2, iB2); };
    auto advance2 = [&](int t) { wr_id(t + 1, iA1, iB1); iA1 = iA2; iB1 = iB2; ld_idx(t + 3, iA2, iB2); };
    const bool b2 = (lane & 4) != 0;
#pragma unroll 1
    for (int tc = 0; tc < ntw; tc += 16) {
        const int tend = tc + 16 < ntw ? tc + 16 : ntw;
        tcur = tc;
        prime(tc);
        { u32x4 xn[4];
#pragma unroll
          for (int j = 0; j < 4; ++j) xn[j] = __builtin_nontemporal_load((const u32x4*)(XN + (size_t)tokof(tc) * DM + 32 * hl + 8 * j));
          experts_quant_x(xn, xa, sx, ktok); sx *= RS[tokof(tc)]; }
        u32x4 uw[8];
#pragma unroll
        for (int q = 0; q < 8; ++q) { const int id = *(LAS const int*)(ldsw + (tc & 1) * 2048 + ((hi ? 1 : 0) + 2 * q) * 16); uw[q] = *(const u32x4*)(U8 + (((unsigned)id << 9) + hl16)); }
#pragma unroll 1
        for (int t = tc; t < tend; ++t) {
            advance(t);
            auto groupU = [&](int g) {
                const LAS unsigned char* rc_cur = ldsw + (t & 1) * 2048 + (g * 16 + (hi ? 1 : 0)) * 16;
                const int gn = g + 1;
                const LAS unsigned char* rc_nxt = ldsw + ((t + (gn >> 3)) & 1) * 2048 + ((gn & 7) * 16 + (hi ? 1 : 0)) * 16;
                float d[8]; int idn[8];
                const u32x4 rl = *(LAS const u32x4*)(rc_cur + 32 * (lane & 7));
#pragma unroll
                for (int q = 0; q < 8; ++q) idn[q] = *(LAS const int*)(rc_nxt + 32 * q);
#pragma unroll
                for (int q = 0; q < 8; ++q) {
                    __builtin_amdgcn_sched_barrier(0);
                    const u32x4 w = uw[q];
                    unsigned h0 = __builtin_amdgcn_udot8(w[0], xa[0], 0u, false), l0 = __builtin_amdgcn_udot8(w[0], xa[4], 0u, false);
                    unsigned h1 = __builtin_amdgcn_udot8(w[1], xa[1], 0u, false), l1 = __builtin_amdgcn_udot8(w[1], xa[5], 0u, false);
                    h0 = __builtin_amdgcn_udot8(w[2], xa[2], h0, false); l0 = __builtin_amdgcn_udot8(w[2], xa[6], l0, false);
                    h1 = __builtin_amdgcn_udot8(w[3], xa[3], h1, false); l1 = __builtin_amdgcn_udot8(w[3], xa[7], l1, false);
                    d[q] = (float)(((h0 + h1) << 4) + (l0 + l1));
                    __builtin_amdgcn_sched_barrier(0);
                    uw[q] = *(const u32x4*)(U8 + (((unsigned)idn[q] << 9) + hl16));
                }
                __builtin_amdgcn_sched_barrier(0);
                float a[4], c2[2];
#pragma unroll
                for (int i = 0; i < 4; ++i) { const float keep = b0 ? d[2 * i + 1] : d[2 * i], send = b0 ? d[2 * i] : d[2 * i + 1]; a[i] = keep + dpp_mov<0xB1>(send); }
#pragma unroll
                for (int i = 0; i < 2; ++i) { const float keep = b1 ? a[2 * i + 1] : a[2 * i], send = b1 ? a[2 * i] : a[2 * i + 1]; c2[i] = keep + dpp_mov<0x4E>(send); }
                float c;
                { const float keep = b2 ? c2[1] : c2[0], send = b2 ? c2[0] : c2[1]; c = keep + dpp_mov<0x124>(send); }
                c += dpp_mov<0x128>(c);
                c += __shfl_xor(c, 16);
                const float gtl = __uint_as_float(rl.y), usl = __uint_as_float(rl.z), rcl = __uint_as_float(rl.w);
                const float dq = ((c - 128.f * rcl) + ktok) * (usl * sx);
#if PROBE == 50
                const float hvl = 0.f * gelu_bf(dq) * gtl;
#else
                const float hvl = gelu_bf(dq) * gtl;
#endif
                const unsigned code = (unsigned)__builtin_amdgcn_cvt_pk_fp8_f32(hvl * 128.f, 0.f, 0, false) & 0xffu;
                if ((lane & 0x18) == 0) hvbuf[((t - tc) * 8 + g) * 16 + 2 * (lane & 7) + (hi ? 1 : 0)] = (unsigned char)code;
            };
#pragma unroll 1
            for (int g = 0; g < 7; ++g) groupU(g);
            u32x4 xn[4];
#pragma unroll
            for (int j = 0; j < 4; ++j) xn[j] = __builtin_nontemporal_load((const u32x4*)(XN + (size_t)tokof(t + 1) * DM + 32 * hl + 8 * j));
            groupU(7);
            experts_quant_x(xn, xa, sx, ktok); sx *= RS[tokof(t + 1)];
        }
        if (sync_passes) xcd_local_align(barx);
        f32x16 D, D2;
#pragma unroll
        for (int i = 0; i < 16; ++i) { D[i] = 0.f; D2[i] = 0.f; }
        u32x4 vw[8];
#pragma unroll
        for (int q = 0; q < 8; ++q) { const int id = idbuf[(hi ? 1 : 0) + 2 * q]; vw[q] = *(const u32x4*)(V8 + (((unsigned)id << 9) + hl16)); }
#pragma unroll 1
        for (int t = tc; t < tend; ++t) {
            auto groupV = [&](int g) {
                const int gn = g + 1;
                const LAS unsigned short* id_nxt = idbuf + (t - tc + (gn >> 3)) * 128 + (gn & 7) * 16 + (hi ? 1 : 0);
                int idn[8];
#pragma unroll
                for (int q = 0; q < 8; ++q) idn[q] = id_nxt[2 * q];
                const u32x4 hb = *(LAS const u32x4*)(hvbuf + ((t - tc) * 8 + g) * 16);
#pragma unroll
                for (int q = 0; q < 8; ++q) {
                    __builtin_amdgcn_sched_barrier(0);
                    const unsigned wq = hb[q >> 1] >> (16 * (q & 1));
                    const unsigned bb0 = (wq & 0xffu) * 0x01010101u, bb1 = ((wq >> 8) & 0xffu) * 0x01010101u;
                    v8i_t Bv, Av;
#pragma unroll
                    for (int r = 0; r < 4; ++r) { Bv[r] = (int)(bb0 & bmask[r]); Bv[4 + r] = (int)(bb1 & bmask[r]); }
                    Av[0] = (int)vw[q].x; Av[1] = (int)vw[q].y; Av[2] = (int)vw[q].z; Av[3] = (int)vw[q].w; Av[4] = 0; Av[5] = 0; Av[6] = 0; Av[7] = 0;
                    if (q & 1) D2 = __builtin_amdgcn_mfma_scale_f32_32x32x64_f8f6f4(Av, Bv, D2, 4  , 0  , 0, 0, 0, 0  );
                    else D = __builtin_amdgcn_mfma_scale_f32_32x32x64_f8f6f4(Av, Bv, D, 4, 0, 0, 0, 0, 0);
                    __builtin_amdgcn_sched_barrier(0);
                    vw[q] = *(const u32x4*)(V8 + (((unsigned)idn[q] << 9) + hl16));
                }
            };
#pragma unroll 1
            for (int g = 0; g < 7; ++g) groupV(g);
            const int tok = tokof(t);
            float o[16];
            { const bf16_t* hr0 = H1 + (size_t)tok * DM + hl;
#pragma unroll
              for (int r = 0; r < 16; ++r) o[r] = bf2f(__builtin_nontemporal_load(hr0 + 32 * crow(r, hi))); }
            groupV(7);
            float ss = 0.f;
#pragma unroll
            for (int r = 0; r < 16; ++r) { o[r] += (D[r] + D2[r]) * (1.f / 128.f); ss += o[r] * o[r]; D[r] = 0.f; D2[r] = 0.f; }
            const float rs = rsqrtf(wave_sum(ss) * (1.f / DM) + RMS_EPS);
            float* orow = outp + (size_t)tok * DM + hl;
#pragma unroll
            for (int r = 0; r < 16; ++r) __builtin_nontemporal_store(o[r] * rs * nfg[r], orow + 32 * crow(r, hi));
        }
    }
}

__global__ void __launch_bounds__(NTHREADS, 2) mega_fwd(Params p) {
    extern __shared__ __attribute__((aligned(16))) unsigned char lds_raw[];
    LAS unsigned char* lds = (LAS unsigned char*)lds_raw;
    const int tid = threadIdx.x, lane = tid & 63, wid = __builtin_amdgcn_readfirstlane(tid >> 6);
    unsigned char* ws = p.ws;
    bf16_t* XN = (bf16_t*)(ws + WS_XN);
    bf16_t* W1T = (bf16_t*)(ws + WS_W1T);
    volatile LAS unsigned* MISC = (volatile LAS unsigned*)(lds + LDS_MISC);
    if (tid < 64) MISC[tid] = 0u;
    __syncthreads();
    const XcdBarrier bar = xcd_barrier_post((unsigned*)ws, MISC + 8);
#define GSYNC() xcd_barrier(bar)

#ifndef ONLY
#define ONLY -1
#endif
#define PH(k) if (ONLY < 0 || ONLY == (k))
#define IDS() int tid = (int)threadIdx.x; asm volatile("" : "+v"(tid)); const int lane = tid & 63, wid = __builtin_amdgcn_readfirstlane(tid >> 6); (void)lane; (void)wid;
    PH(0) { IDS(); phase_prep(p, lds, tid, lane, wid); }
#if PROBE == 13
    phase_prep(p, lds, tid, lane, wid);
#endif
    GSYNC();
    PH(1) { IDS(); { F1a f{(bf16_t*)(ws + WS_QKV), (bf16_t*)(ws + WS_PB)}; run_gemm(lds, XN, W1T, N1A, 1024, f); } }
#if PROBE == 11
    { F1a f{(bf16_t*)(ws + WS_QKV), (bf16_t*)(ws + WS_PB)}; run_gemm(lds, XN, W1T, N1A, 1024, f); }
#endif
    GSYNC();
    PH(2) { IDS(); phase_kbar_vt(p, lds, tid, lane, wid); }
#if PROBE == 14 || PROBE == 61
    phase_kbar_vt(p, lds, tid, lane, wid);
#endif
    PH(3) { IDS(); phase_rwkv_prep2<true>(p, lds, tid, lane, wid); }
#if PROBE == 8 || PROBE == 61
    phase_rwkv_prep2<true>(p, lds, tid, lane, wid);
#endif

    GSYNC();
    PH(6) { IDS(); phase_attn2<0>(p, lds, tid, lane, wid); }
#if PROBE == 63 || PROBE == 61
    __syncthreads();
    phase_attn2<0>(p, lds, tid, lane, wid);
#endif
    GSYNC();
    PH(5) { IDS(); phase_chunkprep<4>(p, lds, lane, wid); }
    PH(8) { IDS(); if (wid >= 4) { phase_wg8(p, lane, (int)blockIdx.x * 4 + wid - 4, (int)gridDim.x * 4); phase_uv_convert(p, lane, (int)blockIdx.x * 4 + wid - 4, (int)gridDim.x * 4); xn8_convert(p, lane, (int)blockIdx.x * 4 + wid - 4, (int)gridDim.x * 4); } }
#if PROBE == 31 || PROBE == 61
    phase_chunkprep<4>(p, lds, lane, wid);
#endif
#if PROBE == 33
    phase_chunkprep<1>(p, lds, lane, wid);
#endif
#if PROBE == 34
    phase_chunkprep<2>(p, lds, lane, wid);
#endif
#if PROBE == 35
    phase_chunkprep<3>(p, lds, lane, wid);
#endif
    GSYNC();
    PH(17) { IDS(); phase_chunkscan(p, lds, tid, lane, wid); }
    PH(9) { IDS(); if (gridDim.x > 64 && (int)blockIdx.x >= 64) { F1b f{ws, p.out, 0, (const signed char*)(ws + WS_WG8SC)}; run_gemm8_on(lds, (const unsigned char*)p.out + DO_XN8, ws + WS_WG8, G1B_EARLY, 1024, f, (int)gridDim.x - 64, (int)blockIdx.x - 64); } }
#if PROBE == 32 || PROBE == 62
    phase_chunkscan(p, lds, tid, lane, wid);
#endif
    GSYNC();
    PH(7) { IDS(); phase_post(p, tid, lane, wid); }
#if PROBE == 62
    phase_post(p, tid, lane, wid);
#endif
    PH(9) { IDS(); { const int e = gridDim.x > 64 ? G1B_EARLY : 0; if (e < NGATE) { F1b f{ws, p.out, e, (const signed char*)(ws + WS_WG8SC)}; run_gemm8(lds, (const unsigned char*)p.out + DO_XN8, ws + WS_WG8 + (size_t)e * 1024, NGATE - e, 1024, f); } } }
#if PROBE == 64 || PROBE == 66
    { const int e = gridDim.x > 64 ? G1B_EARLY : 0; F1b f{ws, p.out, e, (const signed char*)(ws + WS_WG8SC)}; run_gemm8(lds, (const unsigned char*)p.out + DO_XN8, ws + WS_WG8 + (size_t)e * 1024, NGATE - e, 1024, f); }
#endif
    GSYNC();
    PH(10) { IDS(); { FPa f{ws, p.out, (bf16_t*)(ws + WS_Y)}; run_gemm(lds, (const bf16_t*)(ws + WS_OA), (const bf16_t*)(ws + WS_WPA), 1024, 512, f); } }
#if PROBE == 19 || PROBE == 66
    { FPa f{ws, p.out, (bf16_t*)(ws + WS_Y)}; run_gemm(lds, (const bf16_t*)(ws + WS_OA), (const bf16_t*)(ws + WS_WPA), 1024, 512, f); }
#endif
    __builtin_amdgcn_fence(__ATOMIC_ACQ_REL, "workgroup"); __syncthreads();
    PH(11) { IDS(); { FPb f{ws, p.out, (bf16_t*)(ws + WS_Y)}; run_gemm(lds, (const bf16_t*)(ws + WS_OB), (const bf16_t*)(ws + WS_WPB), 1024, 512, f); } }
    GSYNC();
    PH(12) { IDS(); { FOut f{p.x, p.norm2_g, (bf16_t*)(ws + WS_H1B), XN, (float*)(ws + WS_ROWSQ)}; run_gemm(lds, (const bf16_t*)(ws + WS_Y), (const bf16_t*)(ws + WS_WO), 1024, 1024, f); } }
#if PROBE == 65 || PROBE == 66
    { FOut f{p.x, p.norm2_g, (bf16_t*)(ws + WS_H1B), XN, (float*)(ws + WS_ROWSQ)}; run_gemm(lds, (const bf16_t*)(ws + WS_Y), (const bf16_t*)(ws + WS_WO), 1024, 1024, f); }
#endif
    GSYNC();
    PH(14) { IDS(); { FQ f{(bf16_t*)(ws + WS_QP)}; run_gemm(lds, XN, (const bf16_t*)(ws + WS_WQ), 2048, 1024, f); } }
#if PROBE == 12 || PROBE == 62
    { FQ f{(bf16_t*)(ws + WS_QP)}; run_gemm(lds, XN, (const bf16_t*)(ws + WS_WQ), 2048, 1024, f); }
#endif
    GSYNC();
    PH(15) { IDS(); phase_route(p, lds, lane, wid); }
#if PROBE == 7 || PROBE == 62
    phase_route(p, lds, lane, wid);
#endif
    __builtin_amdgcn_fence(__ATOMIC_ACQ_REL, "workgroup"); __syncthreads();
#if PROBE == 4 || PROBE == 52
#pragma unroll 1
    for (int rep = 0; rep < 2; ++rep) { IDS(); phase_experts(p, lds + wid * 10752, lane, wid, rep == 0 ? (float*)(ws + WS_QKV) : p.out, (rep == 0 && PROBE == 52) ? 2047 : -1, bar, false); }
#else
    PH(16) { IDS(); phase_experts(p, lds + wid * 10752, lane, wid, p.out, -1, bar, (NTOK / 32) % (int)gridDim.x == 0); }
#endif
}

extern "C" void kernel_launch(void* const* d_in, const int* in_sizes, int n_in, void* d_out, int out_size, void* d_ws, size_t ws_size, hipStream_t stream) {
    static int grid = 0;
    if (grid == 0) {
        if (n_in != 24 || out_size != NTOK * DM || ws_size < WS_NEED) { fprintf(stderr, "kernel_launch: unexpected problem (n_in %d, out %d, ws %zu)\n", n_in, out_size, ws_size); grid = -1; return; }
        int dev = 0, cus = 0, per_cu = 0;
        if (hipGetDevice(&dev) != hipSuccess || hipDeviceGetAttribute(&cus, hipDeviceAttributeMultiprocessorCount, dev) != hipSuccess) { grid = -1; return; }
        if (hipFuncSetAttribute((const void*)mega_fwd, hipFuncAttributeMaxDynamicSharedMemorySize, LDS_BYTES) != hipSuccess) { fprintf(stderr, "kernel_launch: hipFuncSetAttribute failed\n"); grid = -1; return; }
        if (hipOccupancyMaxActiveBlocksPerMultiprocessor(&per_cu, (const void*)mega_fwd, NTHREADS, LDS_BYTES) != hipSuccess || per_cu < 1) { fprintf(stderr, "kernel_launch: occupancy query says %d\n", per_cu); per_cu = 0; }
        (void)hipGetLastError();
        if (per_cu < 1) { grid = -1; return; }
        grid = cus * 1;
        if (grid < 1) grid = -1;
    }
    if (grid < 0) return;
    Params p{};
    p.x = (const float*)d_in[0]; p.norm1_g = (const float*)d_in[1]; p.w_in = (const float*)d_in[2]; p.rwkv_mu = (const float*)d_in[3];
    p.w0 = (const float*)d_in[4]; p.w_lora_up = (const float*)d_in[5]; p.a0 = (const float*)d_in[6]; p.a_lora_up = (const float*)d_in[7];
    p.g_lora_up = (const float*)d_in[8]; p.k_k = (const float*)d_in[9]; p.k_a = (const float*)d_in[10]; p.r_k = (const float*)d_in[11];
    p.lnx_g = (const float*)d_in[12]; p.lnx_b = (const float*)d_in[13]; p.w_proj_a = (const float*)d_in[14]; p.w_proj_b = (const float*)d_in[15];
    p.w_out = (const float*)d_in[16]; p.norm2_g = (const float*)d_in[17]; p.peer_wq = (const float*)d_in[18]; p.peer_subkeys = (const float*)d_in[19];
    p.peer_u = (const float*)d_in[20]; p.peer_v = (const float*)d_in[21]; p.rel_bias = (const float*)d_in[22]; p.normf_g = (const float*)d_in[23];
    p.out = (float*)d_out; p.ws = (unsigned char*)d_ws;
    if (hipMemsetAsync(d_ws, 0, 65536, stream) != hipSuccess) { fprintf(stderr, "kernel_launch: memset failed\n"); return; }
    void* args[] = {&p};
    hipError_t e = hipLaunchCooperativeKernel((const void*)mega_fwd, dim3(grid), dim3(NTHREADS), args, LDS_BYTES, stream);
    if (e != hipSuccess) fprintf(stderr, "kernel_launch: cooperative launch failed: %s (grid %d)\n", hipGetErrorString(e), grid);
}
```
